# Optimizing an MI355X kernel written in HIP

```python
import numpy as np
import jax
import jax.numpy as jnp
from jax import lax

D_MODEL = 1024
BATCH = 8
SEQ = 8192
DEPTH = 2

CTX_LEN = 256
GRID_W = 64
N_MOD = 9
D_FF = 2816
NA_HEADS = 6
NA_HEAD_DIM = 64
NA_WIDTH = NA_HEADS * NA_HEAD_DIM
NA_WIN_R = 8
NA_WIN_C = 16
SG_GROUPS = 4
SG_GROUP_DIM = 64
SG_WIDTH = SG_GROUPS * SG_GROUP_DIM
SG_CHUNK = 128
RET_HEADS = 6
RET_HEAD_DIM = 64
RET_WIDTH = RET_HEADS * RET_HEAD_DIM
RET_CHUNK = 128
D_MIX = NA_WIDTH + SG_WIDTH + RET_WIDTH
IN_COLS = 3 * NA_WIDTH + 2 * SG_WIDTH + 5 * RET_WIDTH
ROPE_BASE = 10000.0
ROPE_FREQS = RET_HEAD_DIM // 4
RMS_EPS = 1e-6
LN_EPS = 1e-5

kernel_name = 'hybrid_na_gmlp_retention_dit_block'


def rms_norm(h, w):
    hf = h.astype(jnp.float32)
    hf = hf * lax.rsqrt(jnp.mean(hf * hf, axis=-1, keepdims=True) + RMS_EPS)
    return hf.astype(h.dtype) * w


def ada_rms(h, w, shift, scale):
    return rms_norm(h, w) * (1.0 + scale) + shift


def swiglu(h, w1, w2):
    g, u = jnp.split(h @ w1, 2, axis=-1)
    return (jax.nn.silu(g) * u) @ w2


def ffn_branch(h, mod, i, nw, w1, w2):
    return h + 0.5 * mod[:, i + 2] * swiglu(ada_rms(h, nw, mod[:, i], mod[:, i + 1]), w1, w2)


def split_heads(t, n):
    return t.reshape(*t.shape[:-1], n, t.shape[-1] // n)


def qk_norm(t, w):
    tf = t.astype(jnp.float32)
    tf = tf * lax.rsqrt(jnp.mean(tf * tf, axis=-1, keepdims=True) + RMS_EPS)
    return tf.astype(t.dtype) * w


def rope_rotate(t, ang):
    cos = jnp.cos(ang)[None, :, None, :].astype(t.dtype)
    sin = jnp.sin(ang)[None, :, None, :].astype(t.dtype)
    t1, t2 = jnp.split(t, 2, axis=-1)
    return jnp.concatenate([t1 * cos - t2 * sin, t1 * sin + t2 * cos], axis=-1)


def axial_rope(t, ang_r, ang_c):
    tr, tc = jnp.split(t, 2, axis=-1)
    return jnp.concatenate([rope_rotate(tr, ang_r), rope_rotate(tc, ang_c)], axis=-1)


def neighbourhood_attention(q, k, v, kc, vc, rpb, rows):
    b, s, h, d = q.shape
    kr = min(NA_WIN_R, rows)
    scale = NA_HEAD_DIM ** -0.5
    qg = q.reshape(b, rows, GRID_W, h, d)
    kg = k.reshape(b, rows, GRID_W, h, d)
    vg = v.reshape(b, rows, GRID_W, h, d)
    col = jnp.arange(GRID_W)
    col_start = jnp.clip(col - NA_WIN_C // 2, 0, GRID_W - NA_WIN_C)
    col_idx = col_start[:, None] + jnp.arange(NA_WIN_C)[None, :]
    col_off = col_idx - col[:, None] + (NA_WIN_C - 1)
    n_loc = kr * NA_WIN_C

    def one_row(r):
        r_start = jnp.clip(r - kr // 2, 0, rows - kr)
        q_r = lax.dynamic_index_in_dim(qg, r, axis=1, keepdims=False)
        k_rows = lax.dynamic_slice_in_dim(kg, r_start, kr, axis=1)
        v_rows = lax.dynamic_slice_in_dim(vg, r_start, kr, axis=1)
        k_win = jnp.take(k_rows, col_idx, axis=2)
        v_win = jnp.take(v_rows, col_idx, axis=2)
        row_off = r_start + jnp.arange(kr) - r + (NA_WIN_R - 1)
        bias = rpb[:, row_off[:, None, None], col_off[None, :, :]]
        bias = jnp.transpose(bias, (0, 2, 1, 3))
        s_loc = jnp.einsum('bqhd,biqjhd->bhqij', q_r, k_win) * scale + bias[None]
        s_ctx = jnp.einsum('bqhd,bchd->bhqc', q_r, kc) * scale
        logits = jnp.concatenate([s_loc.reshape(b, h, GRID_W, n_loc), s_ctx], axis=-1)
        p = jax.nn.softmax(logits.astype(jnp.float32), axis=-1).astype(v.dtype)
        p_loc = p[..., :n_loc].reshape(b, h, GRID_W, kr, NA_WIN_C)
        p_ctx = p[..., n_loc:]
        return (jnp.einsum('bhqij,biqjhd->bqhd', p_loc, v_win)
                + jnp.einsum('bhqc,bchd->bqhd', p_ctx, vc))

    out = lax.map(one_row, jnp.arange(rows))
    return jnp.transpose(out, (1, 0, 2, 3, 4)).reshape(b, s, h, d)


def context_attention(q, k, v):
    s = jnp.einsum('bqhd,bkhd->bhqk', q, k) * (NA_HEAD_DIM ** -0.5)
    p = jax.nn.softmax(s.astype(jnp.float32), axis=-1).astype(v.dtype)
    return jnp.einsum('bhqk,bkhd->bqhd', p, v)


def spatial_gating(u, v, w_s, b_s, ln_w, ln_b):
    b, l, _ = v.shape
    u = jax.nn.gelu(u)
    v = jax.nn.gelu(v)
    vf = v.reshape(b, l, SG_GROUPS, SG_GROUP_DIM).astype(jnp.float32)
    mu = jnp.mean(vf, axis=-1, keepdims=True)
    var = jnp.mean(jnp.square(vf - mu), axis=-1, keepdims=True)
    vn = ((vf - mu) * lax.rsqrt(var + LN_EPS)).reshape(b, l, SG_WIDTH).astype(v.dtype) * ln_w + ln_b
    vch = vn.reshape(b, l // SG_CHUNK, SG_CHUNK, SG_GROUPS, SG_GROUP_DIM)
    mixed = jnp.einsum('gpq,bnqgc->bnpgc', w_s, vch) + b_s.T[:, :, None]
    return u * mixed.reshape(b, l, SG_WIDTH)


def retention_final_state(k, v, log_g):
    l = k.shape[1]
    w = jnp.exp((l - 1 - jnp.arange(l, dtype=jnp.float32))[None, :] * log_g[:, None])
    return jnp.einsum('blhd,hl,blhe->bhde', k.astype(jnp.float32), w, v.astype(jnp.float32))


def retention_chunkwise(q, k, v, log_g, state0):
    q, k, v = (a.astype(jnp.float32) for a in (q, k, v))
    b, l, h, d = q.shape
    n = l // RET_CHUNK
    qc = q.reshape(b, n, RET_CHUNK, h, d)
    kc = k.reshape(b, n, RET_CHUNK, h, d)
    vc = v.reshape(b, n, RET_CHUNK, h, d)
    pos = jnp.arange(RET_CHUNK, dtype=jnp.float32)
    diff = pos[:, None] - pos[None, :]
    intra_decay = jnp.where(diff >= 0, jnp.exp(jnp.maximum(diff, 0.0)[None] * log_g[:, None, None]), 0.0)
    scores = jnp.einsum('bnihd,bnjhd->bnhij', qc, kc) * intra_decay
    o_intra = jnp.einsum('bnhij,bnjhe->bnihe', scores, vc)
    to_end = jnp.exp((RET_CHUNK - 1 - pos)[None, :] * log_g[:, None])
    chunk_kv = jnp.einsum('bnjhd,hj,bnjhe->nbhde', kc, to_end, vc)
    chunk_decay = jnp.exp(RET_CHUNK * log_g)[None, :, None, None]

    def step(state, kv):
        return chunk_decay * state + kv, state

    _, prev = lax.scan(step, state0, chunk_kv)
    from_start = jnp.exp((pos + 1.0)[None, :] * log_g[:, None])
    o_cross = jnp.einsum('bnihd,nbhde,hi->bnihe', qc, prev, from_start)
    return (o_intra + o_cross).reshape(b, l, h, d)


def head_group_norm(o):
    b, l, h, d = o.shape
    mu = jnp.mean(o, axis=-1, keepdims=True)
    var = jnp.mean(jnp.square(o - mu), axis=-1, keepdims=True)
    return ((o - mu) * lax.rsqrt(var + LN_EPS)).reshape(b, l, h * d)


def retention_merge(o_f, o_b, g_f, g_b, gn_w):
    y = (head_group_norm(o_f) * jax.nn.silu(g_f.astype(jnp.float32))
         + head_group_norm(o_b) * jax.nn.silu(g_b.astype(jnp.float32)))
    return (y * gn_w.astype(jnp.float32)).astype(g_f.dtype)


def merge_groups(na, sg, ret, w_out):
    b, l = sg.shape[:2]
    return jnp.concatenate([na.reshape(b, l, NA_WIDTH), sg, ret], axis=-1) @ w_out


def hybrid_mixer(hx, hc, rows, ang_r, ang_c, w_in, w_out, na_qn, na_kn, na_rpb,
                 sg_w, sg_b, sg_ln_w, sg_ln_b, ret_logit, ret_gn_w, with_ctx_out):
    sizes = (NA_WIDTH,) * 3 + (SG_WIDTH,) * 2 + (RET_WIDTH,) * 5
    cuts = tuple(int(s) for s in np.cumsum(sizes)[:-1])
    px = jnp.split(hx @ w_in, cuts, axis=-1)
    pc = jnp.split(hc @ w_in, cuts, axis=-1)
    log_g = jax.nn.log_sigmoid(ret_logit.astype(jnp.float32))

    kc_na = qk_norm(split_heads(pc[1], NA_HEADS), na_kn)
    vc_na = split_heads(pc[2], NA_HEADS)
    na_x = neighbourhood_attention(qk_norm(split_heads(px[0], NA_HEADS), na_qn),
                                   qk_norm(split_heads(px[1], NA_HEADS), na_kn),
                                   split_heads(px[2], NA_HEADS), kc_na, vc_na, na_rpb, rows)
    sg_x = spatial_gating(px[3], px[4], sg_w, sg_b, sg_ln_w, sg_ln_b)
    k_scale = RET_HEAD_DIM ** -0.5
    rq_x = axial_rope(split_heads(px[5], RET_HEADS), ang_r, ang_c)
    rk_x = axial_rope(split_heads(px[6], RET_HEADS), ang_r, ang_c) * k_scale
    rv_x = split_heads(px[7], RET_HEADS)
    rk_c = split_heads(pc[6], RET_HEADS) * k_scale
    rv_c = split_heads(pc[7], RET_HEADS)
    flip = lambda t: jnp.flip(t, axis=1)
    state_f = retention_final_state(rk_c, rv_c, log_g[0])
    state_b = retention_final_state(flip(rk_c), flip(rv_c), log_g[1])
    o_f = retention_chunkwise(rq_x, rk_x, rv_x, log_g[0], state_f)
    o_b = flip(retention_chunkwise(flip(rq_x), flip(rk_x), flip(rv_x), log_g[1], state_b))
    ret_x = retention_merge(o_f, o_b, px[8], px[9], ret_gn_w)
    yx = merge_groups(na_x, sg_x, ret_x, w_out)
    if not with_ctx_out:
        return yx, None

    na_c = context_attention(qk_norm(split_heads(pc[0], NA_HEADS), na_qn), kc_na, vc_na)
    sg_c = spatial_gating(pc[3], pc[4], sg_w, sg_b, sg_ln_w, sg_ln_b)
    rq_c = split_heads(pc[5], RET_HEADS)
    zero = jnp.zeros_like(state_f)
    oc_f = retention_chunkwise(rq_c, rk_c, rv_c, log_g[0], zero)
    oc_b = flip(retention_chunkwise(flip(rq_c), flip(rk_c), flip(rv_c), log_g[1], zero))
    ret_c = retention_merge(oc_f, oc_b, pc[8], pc[9], ret_gn_w)
    yc = merge_groups(na_c, sg_c, ret_c, w_out)
    return yx, yc


def setup_inputs(seed: int = 0) -> dict:
    key = jax.random.key(seed)
    ks = jax.random.split(key, 20)
    f32 = jnp.float32

    def nrm(k, shape, scale):
        return jax.random.normal(k, shape, f32) * scale

    base_logit = jnp.log(2.0 ** (5.0 + jnp.arange(RET_HEADS, dtype=f32)) - 1.0)
    return {
        'x': nrm(ks[0], (BATCH, SEQ, D_MODEL), 1.0),
        'c': nrm(ks[1], (BATCH, D_MODEL), 1.0),
        'ctx': nrm(ks[2], (BATCH, CTX_LEN, D_MODEL), 1.0),
        'c_ctx': nrm(ks[3], (D_MODEL,), 1.0),
        'ada_w': nrm(ks[4], (DEPTH, D_MODEL, N_MOD * D_MODEL), D_MODEL ** -0.5),
        'ada_b': nrm(ks[5], (DEPTH, N_MOD * D_MODEL), 0.02),
        'norm_w': 1.0 + nrm(ks[6], (DEPTH, 3, D_MODEL), 0.02),
        'ffn_w1': nrm(ks[7], (DEPTH, 2, D_MODEL, 2 * D_FF), D_MODEL ** -0.5),
        'ffn_w2': nrm(ks[8], (DEPTH, 2, D_FF, D_MODEL), D_FF ** -0.5),
        'mix_w_in': nrm(ks[9], (DEPTH, D_MODEL, IN_COLS), D_MODEL ** -0.5),
        'mix_w_out': nrm(ks[10], (DEPTH, D_MIX, D_MODEL), D_MIX ** -0.5),
        'na_q_norm': 1.0 + nrm(ks[11], (DEPTH, NA_HEAD_DIM), 0.02),
        'na_k_norm': 1.0 + nrm(ks[12], (DEPTH, NA_HEAD_DIM), 0.02),
        'na_rpb': nrm(ks[13], (DEPTH, NA_HEADS, 2 * NA_WIN_R - 1, 2 * NA_WIN_C - 1), 0.02),
        'sg_w': nrm(ks[14], (DEPTH, SG_GROUPS, SG_CHUNK, SG_CHUNK), SG_CHUNK ** -0.5),
        'sg_b': 1.0 + nrm(ks[15], (DEPTH, SG_GROUPS, SG_CHUNK), 0.02),
        'sg_ln_w': 1.0 + nrm(ks[16], (DEPTH, SG_WIDTH), 0.02),
        'sg_ln_b': nrm(ks[17], (DEPTH, SG_WIDTH), 0.02),
        'ret_decay_logit': base_logit + nrm(ks[18], (DEPTH, 2, RET_HEADS), 0.1),
        'ret_gn_w': 1.0 + nrm(ks[19], (DEPTH, RET_WIDTH), 0.02),
    }


def reference(x, c, ctx, c_ctx, ada_w, ada_b, norm_w, ffn_w1, ffn_w2, mix_w_in, mix_w_out,
              na_q_norm, na_k_norm, na_rpb, sg_w, sg_b, sg_ln_w, sg_ln_b, ret_decay_logit, ret_gn_w):
    b, n_lat, d = x.shape
    rows = n_lat // GRID_W
    t = jnp.arange(n_lat)
    inv = ROPE_BASE ** (-jnp.arange(ROPE_FREQS, dtype=jnp.float32) / ROPE_FREQS)
    ang_r = (t // GRID_W).astype(jnp.float32)[:, None] * inv[None, :]
    ang_c = (t % GRID_W).astype(jnp.float32)[:, None] * inv[None, :]
    for layer in range(DEPTH):
        last = layer == DEPTH - 1
        mod_x = (jax.nn.silu(c) @ ada_w[layer] + ada_b[layer]).reshape(b, N_MOD, 1, d)
        mod_c = (jax.nn.silu(c_ctx) @ ada_w[layer] + ada_b[layer]).reshape(1, N_MOD, 1, d)
        x = ffn_branch(x, mod_x, 0, norm_w[layer, 0], ffn_w1[layer, 0], ffn_w2[layer, 0])
        ctx = ffn_branch(ctx, mod_c, 0, norm_w[layer, 0], ffn_w1[layer, 0], ffn_w2[layer, 0])
        hx = ada_rms(x, norm_w[layer, 1], mod_x[:, 3], mod_x[:, 4])
        hc = ada_rms(ctx, norm_w[layer, 1], mod_c[:, 3], mod_c[:, 4])
        yx, yc = hybrid_mixer(hx, hc, rows, ang_r, ang_c, mix_w_in[layer], mix_w_out[layer],
                              na_q_norm[layer], na_k_norm[layer], na_rpb[layer],
                              sg_w[layer], sg_b[layer], sg_ln_w[layer], sg_ln_b[layer],
                              ret_decay_logit[layer], ret_gn_w[layer], not last)
        x = x + mod_x[:, 5] * yx
        x = ffn_branch(x, mod_x, 6, norm_w[layer, 2], ffn_w1[layer, 1], ffn_w2[layer, 1])
        if not last:
            ctx = ctx + mod_c[:, 5] * yc
            ctx = ffn_branch(ctx, mod_c, 6, norm_w[layer, 2], ffn_w1[layer, 1], ffn_w2[layer, 1])
    return x
```

```cpp
#include <hip/hip_runtime.h>
#include <cstdio>
#include <cstdint>
namespace pg8 {
#define PG8_LAS __attribute__((address_space(3)))
typedef unsigned short bf16_t;
typedef short bf16x8 __attribute__((ext_vector_type(8)));
typedef float f32x4 __attribute__((ext_vector_type(4)));
typedef unsigned u32x4 __attribute__((ext_vector_type(4)));
constexpr int BM = 256, BK = 64, HALF = 128, HTB = HALF * BK * 2  , STAGE_BYTES = 8 * HTB, NXCD = 8, WGM = 8;

__host__ __device__ __forceinline__ int lds_byte(int r, int c) { const int st = (r >> 4) * 2 + (c >> 5), rr = r & 15, cc = c & 31, ob = rr * 64 + cc * 2; return st * 1024 + (ob ^ (((ob >> 9) & 1) << 5)); }
__host__ __device__ __forceinline__ void stage_rc(int b, int& R, int& C) { const int st = b / 1024, sb = b % 1024, swz = sb ^ (((sb >> 9) & 1) << 5); R = (st >> 1) * 16 + swz / 64; C = (st & 1) * 32 + (swz % 64) / 2; }
__host__ __device__ __forceinline__ int perm32(int rho) { const int n = rho >> 4, i = rho & 15; return 8 * (i >> 2) + 4 * n + (i & 3); }

struct Unit { int pm, pn; };
struct Gemm { const bf16_t* A; const bf16_t* Bt; int M, N, K; };

struct StaticOrder {
    int nM, nN, nwg, G, c;
    __host__ __device__ void init(int M, int N, int G_, int c_) { nM = M / BM; nN = N / BM; nwg = nM * nN; G = G_; c = c_; }
    __host__ __device__ bool next(int i, Unit& u) const {
        const long L = (long)i * G + c; if (L >= nwg) return false;
        int wgid = (int)L; { const int q = nwg / NXCD, r = nwg % NXCD, xcd = wgid % NXCD, off = wgid / NXCD; wgid = (xcd < r ? xcd * (q + 1) : r * (q + 1) + (xcd - r) * q) + off; }
        const int nig = WGM * nN, gid = wgid / nig, fm = gid * WGM, gsz = (nM - fm) < WGM ? (nM - fm) : WGM;
        u.pm = fm + ((wgid % nig) % gsz); u.pn = (wgid % nig) / gsz; return true;
    }
    __device__ __forceinline__ void a_ready(const Unit&) const {}
    __device__ __forceinline__ void done(const Unit&) const {}
};
__device__ __forceinline__ unsigned cvt_pk_bf16(float lo, float hi) { unsigned r; asm volatile("v_cvt_pk_bf16_f32 %0, %1, %2" : "=v"(r) : "v"(lo), "v"(hi)); return r; }
typedef float f32x2 __attribute__((ext_vector_type(2)));
template <class Epi, class Sched, bool ALIGN_EPI = false, bool SP2 = false>
__device__ __forceinline__ void gemm_phase(PG8_LAS unsigned char* lds, const Gemm g, const Sched& S, const Epi& E) {
    int tid_o = threadIdx.x; asm volatile("" : "+v"(tid_o));
    const int tid = tid_o, wid = __builtin_amdgcn_readfirstlane(tid >> 6), lane = tid & 63, wr = wid >> 2, wc = wid & 3, fr = lane & 15, fq = lane >> 4;
    const int K = g.K, nt = K / BK;
    unsigned voffA[2], voffB[2];
#pragma unroll
    for (int i = 0; i < 2; ++i) { int R, C; stage_rc(tid * 16 + i * 8192, R, C); const int Rb = Epi::PERM ? ((R & ~31) + perm32(R & 31)) : R;
        voffA[i] = (unsigned)(R * K + C) * 2u; voffB[i] = (unsigned)(Rb * K + C) * 2u; }
    const size_t kstep = (size_t)(BK * 2);
    const size_t hstep = (size_t)HALF * K * 2;
    const size_t tstep = 2 * hstep;
    const unsigned ldsw = (unsigned)wid * 1024u;
    const int aoff = lds_byte(wr * 64 + fr, fq * 8), boff = lds_byte(wc * 32 + fr, fq * 8);
#define PG8_SA(b, h) (((b) * 2 + (h)) * HTB)
#define PG8_SB(b, h) ((4 + (b) * 2 + (h)) * HTB)
#define PG8_STAGE(bufoff, gbase, voff) do { _Pragma("unroll") for (int _i = 0; _i < 2; ++_i) \
        __builtin_amdgcn_global_load_lds((const unsigned*)((const char*)(gbase) + (voff)[_i]), (PG8_LAS unsigned*)(lds + (bufoff) + ldsw + _i * 8192), 16, 0, 0); } while (0)
#define PG8_LDA(dst, b, h) do { _Pragma("unroll") for (int m = 0; m < 4; ++m) _Pragma("unroll") for (int k = 0; k < 2; ++k) dst[m][k] = *(const PG8_LAS bf16x8*)(lds + PG8_SA(b, h) + aoff + m * 2048 + k * 1024); } while (0)
#define PG8_LDB(dst, b, h) do { _Pragma("unroll") for (int n = 0; n < 2; ++n) _Pragma("unroll") for (int k = 0; k < 2; ++k) dst[n][k] = *(const PG8_LAS bf16x8*)(lds + PG8_SB(b, h) + boff + n * 2048 + k * 1024); } while (0)
#define PG8_MMA(ai, bj, At, Bt) do { __builtin_amdgcn_s_setprio(1); _Pragma("unroll") for (int m = 0; m < 4; ++m) _Pragma("unroll") for (int n = 0; n < 2; ++n) _Pragma("unroll") for (int k = 0; k < 2; ++k) \
        acc[ai][bj][m][n] = __builtin_amdgcn_mfma_f32_16x16x32_bf16(Bt[n][k], At[m][k], acc[ai][bj][m][n], 0, 0, 0); __builtin_amdgcn_s_setprio(0); } while (0)
#define PG8_WAIT_V(n) asm volatile("s_waitcnt vmcnt(" #n ")" ::: "memory")
#define PG8_WAIT_L(n) asm volatile("s_waitcnt lgkmcnt(" #n ")" ::: "memory")
#define PG8_BAR __builtin_amdgcn_s_barrier()
#define PG8_SCHED __builtin_amdgcn_sched_barrier(0)
    Unit cur, nxt; int ui = 0;
    if (!S.next(0, cur)) return;
    f32x4 acc[2][2][4][2];
#pragma unroll
    for (int a = 0; a < 2; ++a)
#pragma unroll
        for (int b = 0; b < 2; ++b)
#pragma unroll
            for (int m = 0; m < 4; ++m)
#pragma unroll
                for (int n = 0; n < 2; ++n) acc[a][b][m][n] = (f32x4){0.f, 0.f, 0.f, 0.f};
    bf16x8 At[4][2], B0[2][2], B1[2][2];
    const char* cA = (const char*)g.A + (size_t)cur.pm * tstep; const char* cB = (const char*)g.Bt + (size_t)cur.pn * tstep;
    S.a_ready(cur);
    if constexpr (SP2) {
        PG8_STAGE(PG8_SB(0, 0), cB, voffB); PG8_STAGE(PG8_SB(0, 1), cB + hstep, voffB); PG8_STAGE(PG8_SA(0, 0), cA, voffA); PG8_STAGE(PG8_SA(0, 1), cA + hstep, voffA);
        if (wr == 1) PG8_BAR;
        PG8_WAIT_V(2); PG8_BAR;
        PG8_STAGE(PG8_SB(1, 0), cB + kstep, voffB); PG8_STAGE(PG8_SA(1, 0), cA + kstep, voffA); PG8_STAGE(PG8_SB(1, 1), cB + hstep + kstep, voffB);
        PG8_WAIT_V(6); PG8_BAR;
    } else {
        PG8_STAGE(PG8_SB(0, 0), cB, voffB); PG8_STAGE(PG8_SA(0, 0), cA, voffA); PG8_STAGE(PG8_SB(0, 1), cB + hstep, voffB); PG8_STAGE(PG8_SA(0, 1), cA + hstep, voffA);
        if (wr == 1) PG8_BAR;
        PG8_WAIT_V(4); PG8_BAR;
        PG8_STAGE(PG8_SB(1, 0), cB + kstep, voffB); PG8_STAGE(PG8_SA(1, 0), cA + kstep, voffA); PG8_STAGE(PG8_SB(1, 1), cB + hstep + kstep, voffB);
        PG8_WAIT_V(6); PG8_BAR;
    }
    for (;;) {
        const bool has_next = S.next(ui + 1, nxt);
        const char* nA = has_next ? (const char*)g.A + (size_t)nxt.pm * tstep : cA; const char* nB = has_next ? (const char*)g.Bt + (size_t)nxt.pn * tstep : cB;
        for (int t = 0; t < nt; t += 2) {
            const bool last = (t == nt - 2);
            const char* a1 = cA + (size_t)(t + 1) * kstep;
            const char* a2 = last ? nA : cA + (size_t)(t + 2) * kstep; const char* b2 = last ? nB : cB + (size_t)(t + 2) * kstep;
            const char* a3 = a2 + kstep; const char* b3 = b2 + kstep;
            if (last && has_next) S.a_ready(nxt);
            if constexpr (SP2) {
            PG8_LDB(B0, 0, 0); PG8_LDB(B1, 0, 1); PG8_SCHED; PG8_LDA(At, 0, 0); PG8_STAGE(PG8_SA(1, 1), a1 + hstep, voffA);
            PG8_WAIT_V(8); PG8_WAIT_L(0); PG8_BAR; PG8_MMA(0, 0, At, B0); PG8_MMA(0, 1, At, B1); PG8_BAR; PG8_SCHED;
            PG8_LDA(At, 0, 1); PG8_STAGE(PG8_SB(0, 0), b2, voffB); PG8_STAGE(PG8_SB(0, 1), b2 + hstep, voffB); PG8_STAGE(PG8_SA(0, 0), a2, voffA);
            PG8_WAIT_V(8); PG8_WAIT_L(0); PG8_BAR; PG8_MMA(1, 0, At, B0); PG8_MMA(1, 1, At, B1); PG8_BAR; PG8_SCHED;
            PG8_LDB(B0, 1, 0); PG8_LDB(B1, 1, 1); PG8_SCHED; PG8_LDA(At, 1, 0); PG8_STAGE(PG8_SA(0, 1), a2 + hstep, voffA);
            PG8_WAIT_V(8); PG8_WAIT_L(0); PG8_BAR; PG8_MMA(0, 0, At, B0); PG8_MMA(0, 1, At, B1); PG8_BAR; PG8_SCHED;
            PG8_LDA(At, 1, 1); PG8_STAGE(PG8_SB(1, 0), b3, voffB); PG8_STAGE(PG8_SB(1, 1), b3 + hstep, voffB); PG8_STAGE(PG8_SA(1, 0), a3, voffA);
            PG8_WAIT_V(8); PG8_WAIT_L(0); PG8_BAR; PG8_MMA(1, 0, At, B0); PG8_MMA(1, 1, At, B1); PG8_BAR; PG8_SCHED;
            } else {
            PG8_LDB(B0, 0, 0); PG8_SCHED; PG8_LDA(At, 0, 0); PG8_STAGE(PG8_SA(1, 1), a1 + hstep, voffA);
            PG8_WAIT_L(8); PG8_BAR; PG8_WAIT_L(0); PG8_MMA(0, 0, At, B0); PG8_BAR; PG8_SCHED;
            PG8_LDB(B1, 0, 1); PG8_STAGE(PG8_SB(0, 0), b2, voffB);
            PG8_BAR; PG8_WAIT_L(0); PG8_MMA(0, 1, At, B1); PG8_BAR;
            PG8_LDA(At, 0, 1); PG8_STAGE(PG8_SA(0, 0), a2, voffA);
            PG8_BAR; PG8_WAIT_L(0); PG8_MMA(1, 0, At, B0); PG8_BAR; PG8_SCHED;
            PG8_STAGE(PG8_SB(0, 1), b2 + hstep, voffB);
            PG8_WAIT_V(6); PG8_BAR; PG8_MMA(1, 1, At, B1); PG8_BAR;
            PG8_LDB(B0, 1, 0); PG8_SCHED; PG8_LDA(At, 1, 0); PG8_STAGE(PG8_SA(0, 1), a2 + hstep, voffA);
            PG8_WAIT_L(8); PG8_BAR; PG8_WAIT_L(0); PG8_MMA(0, 0, At, B0); PG8_BAR; PG8_SCHED;
            PG8_LDB(B1, 1, 1); PG8_STAGE(PG8_SB(1, 0), b3, voffB);
            PG8_BAR; PG8_WAIT_L(0); PG8_MMA(0, 1, At, B1); PG8_BAR;
            PG8_LDA(At, 1, 1); PG8_STAGE(PG8_SA(1, 0), a3, voffA);
            PG8_BAR; PG8_WAIT_L(0); PG8_MMA(1, 0, At, B0); PG8_BAR; PG8_SCHED;
            PG8_STAGE(PG8_SB(1, 1), b3 + hstep, voffB);
            PG8_WAIT_V(6); PG8_BAR; PG8_MMA(1, 1, At, B1); PG8_BAR;
            }
        }
        if constexpr (ALIGN_EPI) { if (wr == 0) PG8_BAR; }
        if constexpr (!Epi::AFTER_DRAIN) { E(acc, cur, wr, wc, fr, fq); S.done(cur); }
        if (!has_next) break;
#pragma unroll
        for (int a = 0; a < 2; ++a)
#pragma unroll
            for (int b = 0; b < 2; ++b)
#pragma unroll
                for (int m = 0; m < 4; ++m)
#pragma unroll
                    for (int n = 0; n < 2; ++n) acc[a][b][m][n] = (f32x4){0.f, 0.f, 0.f, 0.f};
        cur = nxt; cA = nA; cB = nB; ++ui;
        if constexpr (ALIGN_EPI) { if (wr == 1) PG8_BAR; }
    }
    PG8_WAIT_V(0);
    if constexpr (!ALIGN_EPI) { if (wr == 0) PG8_BAR; }
    PG8_BAR;
    if constexpr (Epi::AFTER_DRAIN) { E.fused(acc, cur, wr, wc, fr, fq, lds, wid, lane); S.done(cur); }
#undef PG8_SA
#undef PG8_SB
#undef PG8_STAGE
#undef PG8_LDA
#undef PG8_LDB
#undef PG8_MMA
#undef PG8_WAIT_V
#undef PG8_WAIT_L
#undef PG8_BAR
#undef PG8_SCHED
}
}

namespace pg8 {
struct EpiSwiGLU {
    static constexpr bool PERM = true, AFTER_DRAIN = false;
    bf16_t* H; int ldc;
    __device__ __forceinline__ void operator()(const f32x4 (&acc)[2][2][4][2], const Unit& u, int wr, int wc, int fr, int fq) const {
        const int row0 = u.pm * BM + wr * 64 + fr, col0 = u.pn * HALF + wc * 32 + 8 * fq;
#pragma unroll
        for (int ai = 0; ai < 2; ++ai)
#pragma unroll
            for (int m = 0; m < 4; ++m) {
                bf16_t* rowp = H + (size_t)(row0 + ai * HALF + m * 16) * ldc + col0;
                float h[8];
#pragma unroll
                for (int n = 0; n < 2; ++n)
#pragma unroll
                    for (int i = 0; i < 4; ++i) { const float g = acc[ai][0][m][n][i], uu = acc[ai][1][m][n][i];
                        const float e = __builtin_amdgcn_exp2f(g * -1.4426950408889634f);
                        h[n * 4 + i] = g * uu * __builtin_amdgcn_rcpf(1.0f + e); }
                u32x4 w; w.x = cvt_pk_bf16(h[0], h[1]); w.y = cvt_pk_bf16(h[2], h[3]); w.z = cvt_pk_bf16(h[4], h[5]); w.w = cvt_pk_bf16(h[6], h[7]);
                *(u32x4*)rowp = w;
            }
    }
};
struct EpiResGate {
    static constexpr bool PERM = false, AFTER_DRAIN = false;
    const float* base_lat; const float* base_ctx; float* out_lat; float* out_ctx; const float* gate; float f;
    __device__ __forceinline__ void operator()(const f32x4 (&acc)[2][2][4][2], const Unit& u, int wr, int wc, int fr, int fq) const {
        const bool lat = u.pm < 256; const int mb = lat ? (u.pm >> 5) : 8; const int prow = lat ? u.pm : (u.pm - 256);
        const float* base = (lat ? base_lat : base_ctx) + (size_t)prow * BM * 1024; float* out = (lat ? out_lat : out_ctx) + (size_t)prow * BM * 1024;
        const int col0 = u.pn * BM + wc * 32 + 4 * fq;
        f32x4 gv[2][2];
#pragma unroll
        for (int bj = 0; bj < 2; ++bj)
#pragma unroll
            for (int n = 0; n < 2; ++n) gv[bj][n] = *(const f32x4*)(gate + (size_t)mb * 9216 + col0 + bj * HALF + n * 16) * f;
#pragma unroll
        for (int ai = 0; ai < 2; ++ai)
#pragma unroll
            for (int m = 0; m < 4; ++m) { const size_t off = (size_t)(wr * 64 + fr + ai * HALF + m * 16) * 1024 + col0;
#pragma unroll
                for (int bj = 0; bj < 2; ++bj)
#pragma unroll
                    for (int n = 0; n < 2; ++n) { const f32x4 b = *(const f32x4*)(base + off + bj * HALF + n * 16);
                        *(f32x4*)(out + off + bj * HALF + n * 16) = b + gv[bj][n] * acc[ai][bj][m][n]; } }
    }
};
struct EpiStoreBf16 {
    static constexpr bool PERM = true, AFTER_DRAIN = false;
    bf16_t* O; int ldc;
    __device__ __forceinline__ void operator()(const f32x4 (&acc)[2][2][4][2], const Unit& u, int wr, int wc, int fr, int fq) const {
        const int row0 = u.pm * BM + wr * 64 + fr, col0 = u.pn * BM + wc * 32 + 8 * fq;
#pragma unroll
        for (int ai = 0; ai < 2; ++ai)
#pragma unroll
            for (int m = 0; m < 4; ++m) { bf16_t* rowp = O + (size_t)(row0 + ai * HALF + m * 16) * ldc + col0;
#pragma unroll
                for (int bj = 0; bj < 2; ++bj) { const f32x4 v0 = acc[ai][bj][m][0], v1 = acc[ai][bj][m][1];
                    u32x4 w; w.x = cvt_pk_bf16(v0[0], v0[1]); w.y = cvt_pk_bf16(v0[2], v0[3]); w.z = cvt_pk_bf16(v1[0], v1[1]); w.w = cvt_pk_bf16(v1[2], v1[3]);
                    *(u32x4*)(rowp + bj * HALF) = w; } }
    }
};
}

constexpr int NB = 8, SEQ = 8192, DM = 1024, CTXL = 256, DEPTH = 2, DFF = 2816, NMOD = 9, INC = 3584;
constexpr int TL = NB * SEQ, TC = NB * CTXL, TT = TL + TC;
constexpr int C_NAQ = 0, C_NAK = 384, C_NAV = 768, C_SGU = 1152, C_SGV = 1408, C_RQ = 1664, C_RK = 2048, C_RV = 2432, C_GF = 2816, C_GB = 3200;
constexpr int M_NA = 0, M_SG = 384, M_RET = 640;
constexpr int NCH = TT / 128, NCHL = TL / 128;
constexpr int NWAVES = 8;
#ifndef MK_ONE_LAUNCH
#define MK_ONE_LAUNCH 0
#endif
constexpr int NPH = 1 + DEPTH * 12;

constexpr size_t MiB = 1u << 20;
constexpr size_t WS_CTL = 0, CTL_ZERO_BYTES = 1 * MiB;
constexpr size_t WS_MOD = 1 * MiB;
constexpr size_t WS_ROPE = 2 * MiB;
constexpr size_t WS_W1T = 4 * MiB, WS_W2T = 48 * MiB, WS_WINT = 70 * MiB, WS_WOUTT = 84 * MiB;
constexpr size_t WS_CTXBUF = 88 * MiB;
constexpr size_t WS_XN = 96 * MiB;
constexpr size_t WS_P = 228 * MiB;
constexpr size_t WS_KV = 690 * MiB;
constexpr size_t WS_PREV = 789 * MiB;
constexpr size_t WS_END = 888 * MiB;
constexpr int CW_BAR = 4096;

constexpr int RING_BYTES = 131072, LDSCTL_OFF = RING_BYTES, MISC_OFF = LDSCTL_OFF + 320, LDS_BYTES = 147456;
#define GAS __attribute__((address_space(1)))
#define LAS __attribute__((address_space(3)))
typedef unsigned short bf16;
typedef unsigned v4u __attribute__((ext_vector_type(4)));
typedef float f32x4 __attribute__((ext_vector_type(4)));
typedef short bf16x8 __attribute__((ext_vector_type(8)));
typedef GAS unsigned gu32;
typedef GAS unsigned long long gu64;
#define RLX_AGENT __ATOMIC_RELAXED, __HIP_MEMORY_SCOPE_AGENT
#define LDS_WAIT() asm volatile("s_waitcnt lgkmcnt(0)" ::: "memory")
#define VM_WAIT() asm volatile("s_waitcnt vmcnt(0)" ::: "memory")
__device__ __forceinline__ unsigned long long rt() { return __builtin_amdgcn_s_memrealtime(); }
__device__ __forceinline__ unsigned f2bf(float f) { unsigned u = __builtin_bit_cast(unsigned, f); return (u + 0x7fffu + ((u >> 16) & 1u)) >> 16; }
__device__ __forceinline__ unsigned pk2(float lo, float hi) { return f2bf(lo) | (f2bf(hi) << 16); }
#define XB_TMO      128
#define XB_XCNT(j)  (256  + 64 * (j))
#define XB_XSUB(j)  (1280 + 64 * (j))
#define XB_XGEN(j)  (2304 + 64 * (j))
#define XB_TOP      3328
#define XB_TOPGEN   3392
#define XCD_BAR_WORDS 3456
#define XB_SPIN_CAP (1u << 18)

__device__ __forceinline__ unsigned xb_ld(unsigned* p)              { return __hip_atomic_load(p, __ATOMIC_RELAXED, __HIP_MEMORY_SCOPE_AGENT); }
__device__ __forceinline__ unsigned xb_add(unsigned* p, unsigned v) { return __hip_atomic_fetch_add(p, v, __ATOMIC_RELAXED, __HIP_MEMORY_SCOPE_AGENT); }
__device__ __forceinline__ unsigned xb_xcc_id() { return (unsigned)__builtin_amdgcn_s_getreg((3 << 11) | 20) & 0xFu; }
#define XB_SPIN(cond, bar) do { unsigned _sp = 0; while (cond) { __builtin_amdgcn_s_sleep(1); \
    if ((++_sp & 255u) == 0u) { if (xb_ld(&(bar)[XB_TMO])) break; if (_sp > XB_SPIN_CAP) { atomicAdd(&(bar)[XB_TMO], 1u); break; } } } } while (0)

struct XcdBarrier {
    unsigned* bar; unsigned x;
    volatile LAS unsigned* st;
};

__device__ __forceinline__ XcdBarrier xcd_barrier_post(unsigned* bar, volatile LAS unsigned* st) {
    XcdBarrier b; b.bar = bar; b.x = xb_xcc_id(); b.st = st;
    if (threadIdx.x == 0) (void)xb_add(&bar[XB_XCNT(b.x)], 1u);
    return b;
}
__device__ __forceinline__ void xcd_barrier_complete(unsigned* bar, unsigned x, unsigned& nloc, unsigned& nx) {
    const unsigned G = gridDim.x * gridDim.y * gridDim.z;
    unsigned sum, cnt, mine, sp = 0u;
    for (;;) {
        sum = 0u; cnt = 0u; mine = 0u;
#pragma unroll
        for (unsigned j = 0; j < 16; ++j) { const unsigned c = xb_ld(&bar[XB_XCNT(j)]); sum += c; cnt += (c > 0u) ? 1u : 0u; mine = (j == x) ? c : mine; }
        if (sum == G) break;
        __builtin_amdgcn_s_sleep(1);
        if ((++sp & 255u) == 0u) { if (xb_ld(&bar[XB_TMO])) break; if (sp > XB_SPIN_CAP) { atomicAdd(&bar[XB_TMO], 1u); break; } }
    }
    nloc = mine > 0u ? mine : 1u; nx = cnt > 0u ? cnt : 1u;
}

__device__ __forceinline__ void xcd_barrier(const XcdBarrier& b) {
    asm volatile("s_waitcnt vmcnt(0)" ::: "memory");
    __syncthreads();
    if (threadIdx.x == 0) {
        unsigned* bar = b.bar;
        __builtin_amdgcn_s_waitcnt(0);
        unsigned nloc = b.st[0], nx = b.st[1];
        if (nloc == 0u) { xcd_barrier_complete(bar, b.x, nloc, nx); b.st[0] = nloc; b.st[1] = nx; }
        const unsigned old = xb_add(&bar[XB_XSUB(b.x)], 1u);
        const unsigned gen = old / nloc;
        if (old + 1u == (gen + 1u) * nloc) {
            __builtin_amdgcn_fence(__ATOMIC_RELEASE, "agent");
            asm volatile("s_waitcnt vmcnt(0)" ::: "memory");
            const unsigned og = xb_add(&bar[XB_TOP], 1u);
            const unsigned tg = og / nx;
            if (og + 1u == (tg + 1u) * nx) xb_add(&bar[XB_TOPGEN], 1u);
            else XB_SPIN(xb_ld(&bar[XB_TOPGEN]) == tg, bar);
            __builtin_amdgcn_fence(__ATOMIC_ACQUIRE, "agent");
            xb_add(&bar[XB_XGEN(b.x)], 1u);
            asm volatile("s_waitcnt vmcnt(0)" ::: "memory");
        } else {
            XB_SPIN(xb_ld(&bar[XB_XGEN(b.x)]) == gen, bar);
            __builtin_amdgcn_fence(__ATOMIC_ACQUIRE, "agent");
            asm volatile("s_waitcnt vmcnt(0)" ::: "memory");
        }
    }
    __syncthreads();
}

typedef unsigned u32x2 __attribute__((ext_vector_type(2)));
__device__ __forceinline__ float wave_sum(float v) {
#pragma unroll
    for (int o = 1; o < 64; o <<= 1) v += __shfl_xor(v, o);
    return v;
}
__device__ __forceinline__ float bflo(unsigned w) { return __uint_as_float(w << 16); }
__device__ __forceinline__ float bfhi(unsigned w) { return __uint_as_float(w & 0xffff0000u); }
__device__ __forceinline__ void load8(const bf16* p, float* o) {
    const v4u w = *(const v4u*)p;
    o[0] = bflo(w.x); o[1] = bfhi(w.x); o[2] = bflo(w.y); o[3] = bfhi(w.y); o[4] = bflo(w.z); o[5] = bfhi(w.z); o[6] = bflo(w.w); o[7] = bfhi(w.w);
}
__device__ __forceinline__ void store8(bf16* p, const float* o) {
    v4u w; w.x = pk2(o[0], o[1]); w.y = pk2(o[2], o[3]); w.z = pk2(o[4], o[5]); w.w = pk2(o[6], o[7]); *(v4u*)p = w;
}
__device__ __forceinline__ float sigmoidf_(float x) { return 1.0f / (1.0f + __expf(-x)); }
__device__ __forceinline__ float gelu_tanh(float x) { const float y = 0.7978845608028654f * (x + 0.044715f * x * x * x); return x * sigmoidf_(2.0f * y); }
__device__ __forceinline__ float log_sigmoid(float x) { return fminf(x, 0.0f) - log1pf(expf(-fabsf(x))); }

__device__ __forceinline__ void p0_transpose_item(const float* W, int K, int N, bf16* WT, bool swiglu, LAS float* scr, int item, int lane) {
    const int nblk = N / 32, kb = item / nblk, nb = item % nblk, k0 = 64 * kb, n0 = 32 * nb;
    int d0 = n0;
    if (swiglu) { const int hid = n0 < DFF ? n0 : n0 - DFF; d0 = (hid >> 7) * 256 + (n0 < DFF ? 0 : 128) + (hid & 127); }
#pragma unroll 8
    for (int i = 0; i < 32; ++i) { const int kk = 2 * i + (lane >> 5); scr[kk * 33 + (lane & 31)] = W[(size_t)(k0 + kk) * N + n0 + (lane & 31)]; }
    LDS_WAIT(); asm volatile("" ::: "memory");
    const int c = lane & 7;
#pragma unroll
    for (int j = 0; j < 4; ++j) { const int n = (lane >> 3) + 8 * j; const LAS float* s = scr + (8 * c) * 33 + n;
        v4u o; o.x = pk2(s[0 * 33], s[1 * 33]); o.y = pk2(s[2 * 33], s[3 * 33]); o.z = pk2(s[4 * 33], s[5 * 33]); o.w = pk2(s[6 * 33], s[7 * 33]);
        *(GAS v4u*)(WT + (size_t)(d0 + n) * K + k0 + 8 * c) = o; }
    LDS_WAIT(); asm volatile("" ::: "memory");
}
struct In { const float *x, *c, *ctx, *c_ctx, *ada_w, *ada_b, *norm_w, *ffn_w1, *ffn_w2, *w_in, *w_out, *na_qn, *na_kn, *na_rpb, *sg_w, *sg_b, *sg_ln_w, *sg_ln_b, *ret_logit, *ret_gn_w; };

__device__ __forceinline__ void p0_prologue(const In& I, unsigned char* ws, LAS unsigned char* lds, int tid, int lane, int wave, int vcu, int G) {
    LAS float* scr = (LAS float*)(lds + wave * 16384);
    const int gw = vcu * NWAVES + wave, NGW = G * NWAVES;
    constexpr int I_W1 = (DM / 64) * (2 * DFF / 32), I_W2 = (DFF / 64) * (DM / 32), I_WIN = (DM / 64) * (INC / 32), I_WOUT = (DM / 64) * (DM / 32);
    constexpr int PER_L = 2 * I_W1 + 2 * I_W2 + I_WIN + I_WOUT;
    bf16* W1T = (bf16*)(ws + WS_W1T); bf16* W2T = (bf16*)(ws + WS_W2T); bf16* WINT = (bf16*)(ws + WS_WINT); bf16* WOUTT = (bf16*)(ws + WS_WOUTT);
    for (int it = gw; it < DEPTH * PER_L; it += NGW) {
        const int L = it / PER_L; int r = it % PER_L;
        if (r < 2 * I_W1) { const int i = r / I_W1; r %= I_W1; const size_t o = (size_t)(L * 2 + i) * DM * 2 * DFF; p0_transpose_item(I.ffn_w1 + o, DM, 2 * DFF, W1T + o, true, scr, r, lane); continue; } r -= 2 * I_W1;
        if (r < 2 * I_W2) { const int i = r / I_W2; r %= I_W2; const size_t o = (size_t)(L * 2 + i) * DFF * DM; p0_transpose_item(I.ffn_w2 + o, DFF, DM, W2T + o, false, scr, r, lane); continue; } r -= 2 * I_W2;
        if (r < I_WIN) { const size_t o = (size_t)L * DM * INC; p0_transpose_item(I.w_in + o, DM, INC, WINT + o, false, scr, r, lane); continue; } r -= I_WIN;
        { const size_t o = (size_t)L * DM * DM; p0_transpose_item(I.w_out + o, DM, DM, WOUTT + o, false, scr, r, lane); }
    }
    __syncthreads();
    LAS float* sc = (LAS float*)lds;
    LAS float* part = (LAS float*)(lds + 36864);
    float* mod = (float*)(ws + WS_MOD);
    for (int cb = blockIdx.x; cb < 256; cb += G) {
        for (int i = tid; i < 9 * 1024; i += 512) { const int mb = i >> 10, k = i & 1023; const float v = mb < 8 ? I.c[mb * 1024 + k] : I.c_ctx[k]; sc[i] = v * sigmoidf_(v); }
        __syncthreads();
        const int cc = tid % 72, kp = tid / 72, colg = cb * 72 + cc, L = colg / 9216, j = colg % 9216;
        if (kp < 7) {
            float acc[9];
#pragma unroll
            for (int mb = 0; mb < 9; ++mb) acc[mb] = 0.f;
            for (int k = kp; k < 1024; k += 7) { const float w = I.ada_w[((size_t)L * 1024 + k) * 9216 + j];
#pragma unroll
                for (int mb = 0; mb < 9; ++mb) acc[mb] += sc[mb * 1024 + k] * w; }
#pragma unroll
            for (int mb = 0; mb < 9; ++mb) part[(kp * 72 + cc) * 9 + mb] = acc[mb];
        }
        __syncthreads();
        for (int o = tid; o < 72 * 9; o += 512) { const int c2 = o / 9, mb = o % 9; const int colg2 = cb * 72 + c2, L2 = colg2 / 9216, j2 = colg2 % 9216;
            float s = I.ada_b[L2 * 9216 + j2];
#pragma unroll
            for (int p = 0; p < 7; ++p) s += part[(p * 72 + c2) * 9 + mb];
            mod[((size_t)L2 * 9 + mb) * 9216 + j2] = s; }
        __syncthreads();
    }
    if (blockIdx.x == (unsigned)(G - 1)) {
        float* tab = (float*)(ws + WS_ROPE);
        for (int i = tid; i < 128 * 16; i += 512) { const int n = i >> 4, f = i & 15; const float inv = exp2f(-(float)f * (13.287712379549449f / 16.0f)); const float ang = (float)n * inv;
            tab[2 * i] = cosf(ang); tab[2 * i + 1] = sinf(ang); }
    }
}

__device__ __forceinline__ void norm_phase(const float* xl, const float* xc, int nrows, const float* nw, const float* modL, int sidx, bf16* XN, int gw, int NGW, int lane) {
    const int rpw = (nrows + NGW - 1) / NGW; const int r0 = gw * rpw; int r1 = r0 + rpw; if (r1 > nrows) r1 = nrows;
    int cur = -1; f32x4 g[4], sh[4];
#pragma unroll
    for (int j = 0; j < 4; ++j) { g[j] = (f32x4){0.f, 0.f, 0.f, 0.f}; sh[j] = g[j]; }
    for (int r = r0; r < r1; ++r) {
        const int mb = r < TL ? (r >> 13) : 8;
        if (mb != cur) { cur = mb; const float* sf = modL + (size_t)mb * 9216 + sidx * 1024; const float* sl = sf + 1024;
#pragma unroll
            for (int j = 0; j < 4; ++j) { const f32x4 w = ((const f32x4*)nw)[lane + 64 * j], s1 = ((const f32x4*)sl)[lane + 64 * j]; g[j] = w * (s1 + 1.0f); sh[j] = ((const f32x4*)sf)[lane + 64 * j]; } }
        const float* src = r < TL ? xl + (size_t)r * DM : xc + (size_t)(r - TL) * DM;
        f32x4 v[4]; float s = 0.f;
#pragma unroll
        for (int j = 0; j < 4; ++j) { v[j] = ((const f32x4*)src)[lane + 64 * j]; s += (v[j].x * v[j].x + v[j].y * v[j].y) + (v[j].z * v[j].z + v[j].w * v[j].w); }
        const float rstd = 1.0f / sqrtf(wave_sum(s) * (1.0f / DM) + 1e-6f);
        unsigned long long* o8 = (unsigned long long*)(XN + (size_t)r * DM) + lane;
#pragma unroll
        for (int j = 0; j < 4; ++j) { const f32x4 y = v[j] * rstd * g[j] + sh[j]; o8[64 * j] = (unsigned long long)pk2(y.x, y.y) | ((unsigned long long)pk2(y.z, y.w) << 32); }
    }
}

__device__ __forceinline__ void na_naive(const bf16* P, bf16* MIX, const float* wq, const float* wk, const float* rpb, bool with_ctx, int gtid, int nthreads) {
    float mq = 0.f, mk = 0.f, mr = 0.f;
    for (int d = 0; d < 64; ++d) { mq = fmaxf(mq, fabsf(wq[d])); mk = fmaxf(mk, fabsf(wk[d])); }
    for (int i = 0; i < 6 * 15 * 31; ++i) mr = fmaxf(mr, fabsf(rpb[i]));
    const float mbound = 8.0f * mq * mk + mr;
    const int nitems = (TL + (with_ctx ? TC : 0)) * 6;
    for (int item = gtid; item < nitems; item += nthreads) {
        int h, t; bool isctx;
        if (item < TL * 6) { h = item / TL; t = item % TL; isctx = false; } else { const int r = item - TL * 6; h = r / TC; t = TL + r % TC; isctx = true; }
        float q[64], o[64];
        { const bf16* qp = P + (size_t)t * INC + C_NAQ + h * 64; float ss = 0.f;
#pragma unroll
          for (int d8 = 0; d8 < 8; ++d8) { load8(qp + d8 * 8, q + d8 * 8); }
#pragma unroll
          for (int d = 0; d < 64; ++d) ss += q[d] * q[d];
          const float rstd = 1.0f / sqrtf(ss * (1.0f / 64.0f) + 1e-6f);
#pragma unroll
          for (int d = 0; d < 64; ++d) { q[d] = q[d] * rstd * wq[d] * wk[d] * 0.125f; o[d] = 0.f; } }
        float l = 0.f;
        int b, nloc, r = 0, c = 0, rs = 0, cs = 0;
        if (!isctx) { b = t >> 13; const int pos = t & 8191; r = pos >> 6; c = pos & 63; rs = min(max(r - 4, 0), 120); cs = min(max(c - 8, 0), 48); nloc = 128; }
        else { b = (t - TL) >> 8; nloc = 0; }
        for (int kk = 0; kk < nloc + 256; ++kk) {
            int tk; float bias = 0.f;
            if (kk < nloc) { const int i = kk >> 4, j = kk & 15; tk = b * SEQ + (rs + i) * 64 + cs + j; bias = rpb[(h * 15 + (rs + i - r + 7)) * 31 + (cs + j - c + 15)]; }
            else tk = TL + b * CTXL + (kk - nloc);
            const bf16* kp = P + (size_t)tk * INC + C_NAK + h * 64; const bf16* vp = P + (size_t)tk * INC + C_NAV + h * 64;
            float dot = 0.f, ss = 0.f;
#pragma unroll
            for (int d8 = 0; d8 < 8; ++d8) { float k8[8]; load8(kp + d8 * 8, k8);
#pragma unroll
                for (int e = 0; e < 8; ++e) { dot += q[d8 * 8 + e] * k8[e]; ss += k8[e] * k8[e]; } }
            const float s = dot / sqrtf(ss * (1.0f / 64.0f) + 1e-6f) + bias;
            const float p = __expf(s - mbound); l += p;
#pragma unroll
            for (int d8 = 0; d8 < 8; ++d8) { float v8[8]; load8(vp + d8 * 8, v8);
#pragma unroll
                for (int e = 0; e < 8; ++e) o[d8 * 8 + e] += p * v8[e]; }
        }
        const float il = 1.0f / l; bf16* op = MIX + (size_t)t * DM + M_NA + h * 64;
#pragma unroll
        for (int d8 = 0; d8 < 8; ++d8) { float t8[8];
#pragma unroll
            for (int e = 0; e < 8; ++e) t8[e] = o[d8 * 8 + e] * il;
            store8(op + d8 * 8, t8); }
    }
}

__device__ __forceinline__ void sg_naive(const bf16* P, bf16* MIX, const float* sgw, const float* sgb, const float* lnw, const float* lnb, LAS unsigned char* lds, int tid, int G) {
    LAS float* vn = (LAS float*)lds;
    const int tok = tid >> 2, part = tid & 3;
    for (int it = blockIdx.x; it < NCH * 4; it += G) {
        const int ch = it >> 2, g = it & 3, row0 = ch * 128;
        { const bf16* src = P + (size_t)(row0 + tok) * INC + C_SGV + g * 64 + part * 16; float v[16]; load8(src, v); load8(src + 8, v + 8);
          float s = 0.f;
#pragma unroll
          for (int k = 0; k < 16; ++k) { v[k] = gelu_tanh(v[k]); s += v[k]; }
          s += __shfl_xor(s, 1); s += __shfl_xor(s, 2); const float mu = s * (1.0f / 64.0f); float q = 0.f;
#pragma unroll
          for (int k = 0; k < 16; ++k) { v[k] -= mu; q += v[k] * v[k]; }
          q += __shfl_xor(q, 1); q += __shfl_xor(q, 2); const float rstd = 1.0f / sqrtf(q * (1.0f / 64.0f) + 1e-5f);
#pragma unroll
          for (int k = 0; k < 16; ++k) { const int cch = g * 64 + part * 16 + k; vn[tok * 64 + part * 16 + k] = v[k] * rstd * lnw[cch] + lnb[cch]; } }
        __syncthreads();
        { float acc[16];
#pragma unroll
          for (int k = 0; k < 16; ++k) acc[k] = 0.f;
          const float* wrow = sgw + ((size_t)g * 128 + tok) * 128;
          for (int q = 0; q < 128; ++q) { const float w = wrow[q];
#pragma unroll
              for (int k = 0; k < 16; ++k) acc[k] += w * vn[q * 64 + part * 16 + k]; }
          const float bias = sgb[g * 128 + tok];
          const bf16* up = P + (size_t)(row0 + tok) * INC + C_SGU + g * 64 + part * 16; float u[16]; load8(up, u); load8(up + 8, u + 8);
#pragma unroll
          for (int k = 0; k < 16; ++k) u[k] = gelu_tanh(u[k]) * (acc[k] + bias);
          bf16* op = MIX + (size_t)(row0 + tok) * DM + M_SG + g * 64 + part * 16; store8(op, u); store8(op + 8, u + 8); }
        __syncthreads();
    }
}

__device__ __forceinline__ void rope_load16(const bf16* P, int row, int colbase, int h, int part, bool latent, const float* ropetab, float* out) {
    const bf16* base = P + (size_t)row * INC + colbase + h * 64;
    float mine[16]; load8(base + part * 16, mine); load8(base + part * 16 + 8, mine + 8);
    if (!latent) {
#pragma unroll
        for (int f = 0; f < 16; ++f) out[f] = mine[f];
        return; }
    float oth[16]; load8(base + (part ^ 1) * 16, oth); load8(base + (part ^ 1) * 16 + 8, oth + 8);
    const int pos = row & (SEQ - 1); const int n = (part < 2) ? (pos >> 6) : (pos & 63);
    const float* tb = ropetab + n * 32;
#pragma unroll
    for (int f = 0; f < 16; ++f) { const float cs = tb[2 * f], sn = tb[2 * f + 1]; out[f] = (part & 1) ? (oth[f] * sn + mine[f] * cs) : (mine[f] * cs - oth[f] * sn); }
}
__device__ __forceinline__ void ret_kv_naive(const bf16* P, float* KV, const float* logit, const float* ropetab, LAS unsigned char* lds, int tid, int G) {
    LAS float* kS = (LAS float*)lds; LAS float* vS = kS + 128 * 64; LAS float* wt = vS + 128 * 64;
    const int tok = tid >> 2, part = tid & 3;
    for (int it = blockIdx.x; it < NCH * 6; it += G) {
        const int ch = it / 6, h = it % 6, row0 = ch * 128; const bool latent = ch < NCHL;
        { float k16[16]; rope_load16(P, row0 + tok, C_RK, h, part, latent, ropetab, k16);
#pragma unroll
          for (int f = 0; f < 16; ++f) kS[tok * 64 + part * 16 + f] = k16[f] * 0.125f;
          const bf16* vp = P + (size_t)(row0 + tok) * INC + C_RV + h * 64 + part * 16; float v16[16]; load8(vp, v16); load8(vp + 8, v16 + 8);
#pragma unroll
          for (int f = 0; f < 16; ++f) vS[tok * 64 + part * 16 + f] = v16[f]; }
        if (tid < 256) { const int dir = tid >> 7, j = tid & 127; const float lg = log_sigmoid(logit[dir * 6 + h]); wt[tid] = expf(lg * (float)(dir == 0 ? 127 - j : j)); }
        __syncthreads();
        { const int d = tid >> 3, e0 = (tid & 7) * 8; float af[8], ab[8];
#pragma unroll
          for (int k = 0; k < 8; ++k) { af[k] = 0.f; ab[k] = 0.f; }
          for (int j = 0; j < 128; ++j) { const float kd = kS[j * 64 + d]; const float a = kd * wt[j], b = kd * wt[128 + j];
#pragma unroll
              for (int k = 0; k < 8; ++k) { const float v = vS[j * 64 + e0 + k]; af[k] += a * v; ab[k] += b * v; } }
          float* of = KV + ((size_t)(ch * 6 + h) * 2 + 0) * 4096 + d * 64 + e0; float* ob = of + 4096;
#pragma unroll
          for (int k = 0; k < 8; ++k) { of[k] = af[k]; ob[k] = ab[k]; } }
        __syncthreads();
    }
}
__device__ __forceinline__ void ret_scan(const float* KV, float* PREV, const float* logit, int gtid, int nthreads) {
    for (int it = gtid; it < NB * 6 * 2 * 4096; it += nthreads) {
        const int idx = it & 4095, dir = (it >> 12) & 1, bh = it >> 13, h = bh % 6, b = bh / 6;
        const float cd = expf(128.0f * log_sigmoid(logit[dir * 6 + h]));
#define KVI(ch) (((size_t)((ch) * 6 + h) * 2 + dir) * 4096 + idx)
        const int c0 = NCHL + 2 * b, c1 = c0 + 1;
        const float k0 = KV[KVI(c0)], k1 = KV[KVI(c1)];
        if (dir == 0) { PREV[KVI(c0)] = 0.f; PREV[KVI(c1)] = k0; float s = cd * k0 + k1;
            for (int n = 0; n < 64; ++n) { const int ch = b * 64 + n; PREV[KVI(ch)] = s; s = cd * s + KV[KVI(ch)]; } }
        else { PREV[KVI(c0)] = k1; PREV[KVI(c1)] = 0.f; float s = k0 + cd * k1;
            for (int n = 63; n >= 0; --n) { const int ch = b * 64 + n; PREV[KVI(ch)] = s; s = cd * s + KV[KVI(ch)]; } }
#undef KVI
    }
}
__device__ __forceinline__ void ret_out_naive(const bf16* P, const float* PREV, bf16* MIX, const float* logit, const float* gnw, const float* ropetab, LAS unsigned char* lds, int tid, int G) {
    LAS bf16* qS = (LAS bf16*)lds; LAS bf16* kS = qS + 128 * 64; LAS bf16* vS = kS + 128 * 64;
    LAS float* S = (LAS float*)(lds + 49152);
    LAS float* dec = (LAS float*)(lds + 49152 + 65536);
    const int tok = tid >> 2, part = tid & 3;
    for (int it = blockIdx.x; it < NCH * 6; it += G) {
        const int ch = it / 6, h = it % 6, row0 = ch * 128; const bool latent = ch < NCHL;
        { float t16[16]; rope_load16(P, row0 + tok, C_RQ, h, part, latent, ropetab, t16);
#pragma unroll
          for (int f = 0; f < 16; ++f) qS[tok * 64 + part * 16 + f] = (bf16)f2bf(t16[f]);
          rope_load16(P, row0 + tok, C_RK, h, part, latent, ropetab, t16);
#pragma unroll
          for (int f = 0; f < 16; ++f) kS[tok * 64 + part * 16 + f] = (bf16)f2bf(t16[f] * 0.125f);
          const bf16* vp = P + (size_t)(row0 + tok) * INC + C_RV + h * 64 + part * 16; const v4u a = *(const v4u*)vp, b = *(const v4u*)(vp + 8);
          *(LAS v4u*)(vS + tok * 64 + part * 16) = a; *(LAS v4u*)(vS + tok * 64 + part * 16 + 8) = b; }
        if (tid < 258) { const int dir = tid / 129, k = tid % 129; dec[tid] = expf(log_sigmoid(logit[dir * 6 + h]) * (float)k); }
        __syncthreads();
        { float q[64];
#pragma unroll
          for (int d = 0; d < 64; ++d) q[d] = __uint_as_float((unsigned)qS[tok * 64 + d] << 16);
          for (int jj = 0; jj < 32; ++jj) { const int j = part + 4 * jj; float dot = 0.f;
#pragma unroll
              for (int d = 0; d < 64; ++d) dot += q[d] * __uint_as_float((unsigned)kS[j * 64 + d] << 16);
              S[tok * 128 + j] = dot; } }
        __syncthreads();
        { const int i = tok, e0 = part * 16; float of[16], ob[16], cf[16], cb[16];
#pragma unroll
          for (int k = 0; k < 16; ++k) { of[k] = 0.f; ob[k] = 0.f; cf[k] = 0.f; cb[k] = 0.f; }
          for (int j = 0; j < 128; ++j) { const float s = S[i * 128 + j]; const float wf = (j <= i) ? s * dec[i - j] : 0.f, wb = (j >= i) ? s * dec[129 + j - i] : 0.f;
#pragma unroll
              for (int k = 0; k < 16; ++k) { const float v = __uint_as_float((unsigned)vS[j * 64 + e0 + k] << 16); of[k] += wf * v; ob[k] += wb * v; } }
          const float* pf = PREV + ((size_t)(ch * 6 + h) * 2) * 4096 + e0; const float* pb = pf + 4096;
          for (int d = 0; d < 64; ++d) { const float qd = __uint_as_float((unsigned)qS[i * 64 + d] << 16);
#pragma unroll
              for (int k = 0; k < 16; ++k) { cf[k] += qd * pf[d * 64 + k]; cb[k] += qd * pb[d * 64 + k]; } }
          const float df = dec[i + 1], db = dec[129 + 128 - i];
          float sf = 0.f, sb = 0.f;
#pragma unroll
          for (int k = 0; k < 16; ++k) { of[k] += df * cf[k]; ob[k] += db * cb[k]; sf += of[k]; sb += ob[k]; }
          sf += __shfl_xor(sf, 1); sf += __shfl_xor(sf, 2); sb += __shfl_xor(sb, 1); sb += __shfl_xor(sb, 2);
          const float muf = sf * (1.0f / 64.0f), mub = sb * (1.0f / 64.0f); float qf = 0.f, qb = 0.f;
#pragma unroll
          for (int k = 0; k < 16; ++k) { of[k] -= muf; ob[k] -= mub; qf += of[k] * of[k]; qb += ob[k] * ob[k]; }
          qf += __shfl_xor(qf, 1); qf += __shfl_xor(qf, 2); qb += __shfl_xor(qb, 1); qb += __shfl_xor(qb, 2);
          const float rf = 1.0f / sqrtf(qf * (1.0f / 64.0f) + 1e-5f), rb = 1.0f / sqrtf(qb * (1.0f / 64.0f) + 1e-5f);
          const bf16* gp = P + (size_t)(row0 + i) * INC + C_GF + h * 64 + e0; float gf[16], gb[16]; load8(gp, gf); load8(gp + 8, gf + 8); load8(gp + (C_GB - C_GF), gb); load8(gp + (C_GB - C_GF) + 8, gb + 8);
          float y[16];
#pragma unroll
          for (int k = 0; k < 16; ++k) y[k] = (of[k] * rf * (gf[k] * sigmoidf_(gf[k])) + ob[k] * rb * (gb[k] * sigmoidf_(gb[k]))) * gnw[h * 64 + e0 + k];
          bf16* op = MIX + (size_t)(row0 + i) * DM + M_RET + h * 64 + e0; store8(op, y); store8(op + 8, y + 8); }
        __syncthreads();
    }
}

struct Args { In in; float* out; unsigned char* ws; int ph_lo, ph_hi; };
__global__ void __launch_bounds__(NWAVES * 64, 2) hybrid_fwd(Args args) {
    extern __shared__ __attribute__((aligned(16))) unsigned char lds_raw[];
    LAS unsigned char* lds = (LAS unsigned char*)lds_raw;
    volatile LAS unsigned* MISC = (volatile LAS unsigned*)(lds + MISC_OFF);
    const int tid = threadIdx.x, lane = tid & 63, wave = __builtin_amdgcn_readfirstlane(tid >> 6);
    const int G = gridDim.x; const int bx = blockIdx.x; const int vcu = (G % 8 == 0) ? (bx % 8) * (G / 8) + bx / 8 : bx;
    const int NGW = G * NWAVES, nthreads = G * NWAVES * 64;
    unsigned char* ws = args.ws; const In& I = args.in;
    gu32* ctl = (gu32*)(ws + WS_CTL);
    for (int u = tid; u < (LDS_BYTES - LDSCTL_OFF) / 4; u += NWAVES * 64) ((LAS unsigned*)(lds + LDSCTL_OFF))[u] = 0u;
    __syncthreads();
    XcdBarrier bar; bar.bar = (unsigned*)(ctl + CW_BAR); bar.x = 0; bar.st = nullptr;
    if (MK_ONE_LAUNCH) bar = xcd_barrier_post((unsigned*)(ctl + CW_BAR), MISC + 8);
    const int lo = args.ph_lo, hi = args.ph_hi; int ph = 0;
#define PH_ON (ph >= lo && ph < hi)
#define OPQ(x) ({ int _t = (x); asm volatile("" : "+v"(_t)); _t; })
#define PH_END do { if (MK_ONE_LAUNCH && ph >= lo && ph + 1 < hi) xcd_barrier(bar); ++ph; } while (0)

    float* mod = (float*)(ws + WS_MOD); const float* ropetab = (const float*)(ws + WS_ROPE);
    bf16* W1T = (bf16*)(ws + WS_W1T); bf16* W2T = (bf16*)(ws + WS_W2T); bf16* WINT = (bf16*)(ws + WS_WINT); bf16* WOUTT = (bf16*)(ws + WS_WOUTT);
    float* ctxbuf = (float*)(ws + WS_CTXBUF); bf16* XN = (bf16*)(ws + WS_XN); bf16* PB = (bf16*)(ws + WS_P); bf16* HB = (bf16*)(ws + WS_P);
    float* KV = (float*)(ws + WS_KV); float* PREV = (float*)(ws + WS_PREV);

    if (PH_ON) p0_prologue(I, ws, lds, tid, lane, wave, vcu, G);
    PH_END;

    for (int hs = 0; hs < 2 * DEPTH; ++hs) {
        const int L = hs >> 1, half = hs & 1; const bool last = (L == DEPTH - 1), first = (hs == 0);
        const int Mrows = (last && half == 1) ? TL : TT;
        const float* modL = mod + (size_t)L * 9 * 9216;
        const float* xl = first ? I.x : args.out; const float* xc = first ? I.ctx : ctxbuf;
        if (PH_ON) { const int t_ = OPQ(threadIdx.x); norm_phase(xl, xc, Mrows, I.norm_w + (size_t)(L * 3 + (half ? 2 : 0)) * DM, modL, half ? 6 : 0, XN, vcu * NWAVES + (t_ >> 6), NGW, t_ & 63); }
        PH_END;
        if (PH_ON) { pg8::Gemm g{XN, W1T + (size_t)(L * 2 + half) * DM * 2 * DFF, Mrows, 2 * DFF, DM}; pg8::StaticOrder S; S.init(Mrows, 2 * DFF, G, bx);
            pg8::EpiSwiGLU E{HB, DFF};
            pg8::gemm_phase<pg8::EpiSwiGLU, pg8::StaticOrder, true, true>(lds, g, S, E); }
        PH_END;
        if (PH_ON) { pg8::Gemm g{HB, W2T + (size_t)(L * 2 + half) * DFF * DM, Mrows, DM, DFF}; pg8::StaticOrder S; S.init(Mrows, DM, G, bx);
            pg8::EpiResGate E{xl, xc, args.out, ctxbuf, modL + (half ? 8 : 2) * 1024, 0.5f};
            pg8::gemm_phase<pg8::EpiResGate, pg8::StaticOrder, true, true>(lds, g, S, E); }
        PH_END;
        if (half == 0) {
            if (PH_ON) { const int t_ = OPQ(threadIdx.x); norm_phase(args.out, ctxbuf, TT, I.norm_w + (size_t)(L * 3 + 1) * DM, modL, 3, XN, vcu * NWAVES + (t_ >> 6), NGW, t_ & 63); }
            PH_END;
            if (PH_ON) { pg8::Gemm g{XN, WINT + (size_t)L * DM * INC, TT, INC, DM}; pg8::StaticOrder S; S.init(TT, INC, G, bx);
                pg8::EpiStoreBf16 E{PB, INC};
                pg8::gemm_phase<pg8::EpiStoreBf16, pg8::StaticOrder, true, true>(lds, g, S, E); }
            PH_END;
            const float* logit = I.ret_logit + L * 12;
            if (PH_ON) { const int t_ = OPQ(threadIdx.x);
                na_naive(PB, XN, I.na_qn + L * 64, I.na_kn + L * 64, I.na_rpb + (size_t)L * 6 * 15 * 31, !last, bx * (NWAVES * 64) + t_, nthreads);
                sg_naive(PB, XN, I.sg_w + (size_t)L * 4 * 128 * 128, I.sg_b + L * 4 * 128, I.sg_ln_w + L * 256, I.sg_ln_b + L * 256, lds, t_, G);
                ret_kv_naive(PB, KV, logit, ropetab, lds, t_, G);
            }
            PH_END;
            if (PH_ON) { const int t_ = OPQ(threadIdx.x); ret_scan(KV, PREV, logit, bx * (NWAVES * 64) + t_, nthreads); }
            PH_END;
            if (PH_ON) { const int t_ = OPQ(threadIdx.x); ret_out_naive(PB, PREV, XN, logit, I.ret_gn_w + L * 384, ropetab, lds, t_, G); }
            PH_END;
            const int Mo = last ? TL : TT;
            if (PH_ON) { pg8::Gemm g{XN, WOUTT + (size_t)L * DM * DM, Mo, DM, DM}; pg8::StaticOrder S; S.init(Mo, DM, G, bx);
                pg8::EpiResGate E{args.out, ctxbuf, args.out, ctxbuf, modL + 5 * 1024, 1.0f};
                pg8::gemm_phase<pg8::EpiResGate, pg8::StaticOrder, true, true>(lds, g, S, E); }
            PH_END;
        }
    }
#undef PH_ON
#undef PH_END
}

extern "C" void kernel_launch(void* const* d_in, const int* in_sizes, int n_in, void* d_out, int out_size, void* d_ws, size_t ws_size, hipStream_t stream) {
    static int grid = 0;
    if (grid == 0) {
        if (n_in != 20 || in_sizes[0] != TL * DM || out_size != TL * DM || ws_size < WS_END) { fprintf(stderr, "kernel_launch: unexpected shapes (n_in %d, in0 %d, out %d, ws %zu); nothing launched\n", n_in, n_in > 0 ? in_sizes[0] : -1, out_size, ws_size); grid = -1; return; }
        int dev = 0, cus = 0, per_cu = 0;
        if (hipGetDevice(&dev) != hipSuccess || hipDeviceGetAttribute(&cus, hipDeviceAttributeMultiprocessorCount, dev) != hipSuccess) { grid = -1; return; }
        if (hipFuncSetAttribute((const void*)hybrid_fwd, hipFuncAttributeMaxDynamicSharedMemorySize, LDS_BYTES) != hipSuccess) { fprintf(stderr, "kernel_launch: hipFuncSetAttribute failed\n"); grid = -1; return; }
        if (hipOccupancyMaxActiveBlocksPerMultiprocessor(&per_cu, (const void*)hybrid_fwd, NWAVES * 64, LDS_BYTES) != hipSuccess || per_cu < 1)
            fprintf(stderr, "kernel_launch: note: occupancy query reports %d workgroups per CU\n", per_cu);
        (void)hipGetLastError();
        grid = cus;
    }
    if (grid < 0) return;
    if (hipMemsetAsync((char*)d_ws + WS_CTL, 0, CTL_ZERO_BYTES, stream) != hipSuccess) return;
    Args a{};
    const float** ip = (const float**)&a.in;
    for (int i = 0; i < 20; ++i) ip[i] = (const float*)d_in[i];
    a.out = (float*)d_out; a.ws = (unsigned char*)d_ws;
#if MK_ONE_LAUNCH
    a.ph_lo = 0; a.ph_hi = NPH;
    hipLaunchKernelGGL(hybrid_fwd, dim3(grid), dim3(NWAVES * 64), LDS_BYTES, stream, a);
#else
    for (int li = 0; li < NPH; ++li) { a.ph_lo = li; a.ph_hi = li + 1; hipLaunchKernelGGL(hybrid_fwd, dim3(grid), dim3(NWAVES * 64), LDS_BYTES, stream, a); }
#endif
}
```

```cpp
#include <hip/hip_runtime.h>
#include <cstdio>
#include <cstdint>
namespace pg8 {
#define PG8_LAS __attribute__((address_space(3)))
typedef unsigned short bf16_t;
typedef short bf16x8 __attribute__((ext_vector_type(8)));
typedef float f32x4 __attribute__((ext_vector_type(4)));
typedef unsigned u32x4 __attribute__((ext_vector_type(4)));
constexpr int BM = 256, BK = 64, HALF = 128, HTB = HALF * BK * 2  , STAGE_BYTES = 8 * HTB, NXCD = 8, WGM = 8;

__host__ __device__ __forceinline__ int lds_byte(int r, int c) { const int st = (r >> 4) * 2 + (c >> 5), rr = r & 15, cc = c & 31, ob = rr * 64 + cc * 2; return st * 1024 + (ob ^ (((ob >> 9) & 1) << 5)); }
__host__ __device__ __forceinline__ void stage_rc(int b, int& R, int& C) { const int st = b / 1024, sb = b % 1024, swz = sb ^ (((sb >> 9) & 1) << 5); R = (st >> 1) * 16 + swz / 64; C = (st & 1) * 32 + (swz % 64) / 2; }
__host__ __device__ __forceinline__ int perm32(int rho) { const int n = rho >> 4, i = rho & 15; return 8 * (i >> 2) + 4 * n + (i & 3); }

struct Unit { int pm, pn; };
struct Gemm { const bf16_t* A; const bf16_t* Bt; int M, N, K; };

struct StaticOrder {
    int nM, nN, nwg, G, c;
    __host__ __device__ void init(int M, int N, int G_, int c_) { nM = M / BM; nN = N / BM; nwg = nM * nN; G = G_; c = c_; }
    __host__ __device__ bool next(int i, Unit& u) const {
        const long L = (long)i * G + c; if (L >= nwg) return false;
        int wgid = (int)L; { const int q = nwg / NXCD, r = nwg % NXCD, xcd = wgid % NXCD, off = wgid / NXCD; wgid = (xcd < r ? xcd * (q + 1) : r * (q + 1) + (xcd - r) * q) + off; }
        const int nig = WGM * nN, gid = wgid / nig, fm = gid * WGM, gsz = (nM - fm) < WGM ? (nM - fm) : WGM;
        u.pm = fm + ((wgid % nig) % gsz); u.pn = (wgid % nig) / gsz; return true;
    }
    __device__ __forceinline__ void a_ready(const Unit&) const {}
    __device__ __forceinline__ void done(const Unit&) const {}
};
__device__ __forceinline__ unsigned cvt_pk_bf16(float lo, float hi) { unsigned r; asm volatile("v_cvt_pk_bf16_f32 %0, %1, %2" : "=v"(r) : "v"(lo), "v"(hi)); return r; }
typedef float f32x2 __attribute__((ext_vector_type(2)));
template <class Epi, class Sched, bool ALIGN_EPI = false, bool SP2 = false>
__device__ __forceinline__ void gemm_phase(PG8_LAS unsigned char* lds, const Gemm g, const Sched& S, const Epi& E) {
    int tid_o = threadIdx.x; asm volatile("" : "+v"(tid_o));
    const int tid = tid_o, wid = __builtin_amdgcn_readfirstlane(tid >> 6), lane = tid & 63, wr = wid >> 2, wc = wid & 3, fr = lane & 15, fq = lane >> 4;
    const int K = g.K, nt = K / BK;
    unsigned voffA[2], voffB[2];
#pragma unroll
    for (int i = 0; i < 2; ++i) { int R, C; stage_rc(tid * 16 + i * 8192, R, C); const int Rb = Epi::PERM ? ((R & ~31) + perm32(R & 31)) : R;
        voffA[i] = (unsigned)(R * K + C) * 2u; voffB[i] = (unsigned)(Rb * K + C) * 2u; }
    const size_t kstep = (size_t)(BK * 2);
    const size_t hstep = (size_t)HALF * K * 2;
    const size_t tstep = 2 * hstep;
    const unsigned ldsw = (unsigned)wid * 1024u;
    const int aoff = lds_byte(wr * 64 + fr, fq * 8), boff = lds_byte(wc * 32 + fr, fq * 8);
#define PG8_SA(b, h) (((b) * 2 + (h)) * HTB)
#define PG8_SB(b, h) ((4 + (b) * 2 + (h)) * HTB)
#define PG8_STAGE(bufoff, gbase, voff) do { _Pragma("unroll") for (int _i = 0; _i < 2; ++_i) \
        __builtin_amdgcn_global_load_lds((const unsigned*)((const char*)(gbase) + (voff)[_i]), (PG8_LAS unsigned*)(lds + (bufoff) + ldsw + _i * 8192), 16, 0, 0); } while (0)
#define PG8_LDA(dst, b, h) do { _Pragma("unroll") for (int m = 0; m < 4; ++m) _Pragma("unroll") for (int k = 0; k < 2; ++k) dst[m][k] = *(const PG8_LAS bf16x8*)(lds + PG8_SA(b, h) + aoff + m * 2048 + k * 1024); } while (0)
#define PG8_LDB(dst, b, h) do { _Pragma("unroll") for (int n = 0; n < 2; ++n) _Pragma("unroll") for (int k = 0; k < 2; ++k) dst[n][k] = *(const PG8_LAS bf16x8*)(lds + PG8_SB(b, h) + boff + n * 2048 + k * 1024); } while (0)
#define PG8_MMA(ai, bj, At, Bt) do { __builtin_amdgcn_s_setprio(1); _Pragma("unroll") for (int m = 0; m < 4; ++m) _Pragma("unroll") for (int n = 0; n < 2; ++n) _Pragma("unroll") for (int k = 0; k < 2; ++k) \
        acc[ai][bj][m][n] = __builtin_amdgcn_mfma_f32_16x16x32_bf16(Bt[n][k], At[m][k], acc[ai][bj][m][n], 0, 0, 0); __builtin_amdgcn_s_setprio(0); } while (0)
#define PG8_WAIT_V(n) asm volatile("s_waitcnt vmcnt(" #n ")" ::: "memory")
#define PG8_WAIT_L(n) asm volatile("s_waitcnt lgkmcnt(" #n ")" ::: "memory")
#define PG8_BAR __builtin_amdgcn_s_barrier()
#define PG8_SCHED __builtin_amdgcn_sched_barrier(0)
    Unit cur, nxt; int ui = 0;
    if (!S.next(0, cur)) return;
    f32x4 acc[2][2][4][2];
#pragma unroll
    for (int a = 0; a < 2; ++a)
#pragma unroll
        for (int b = 0; b < 2; ++b)
#pragma unroll
            for (int m = 0; m < 4; ++m)
#pragma unroll
                for (int n = 0; n < 2; ++n) acc[a][b][m][n] = (f32x4){0.f, 0.f, 0.f, 0.f};
    bf16x8 At[4][2], B0[2][2], B1[2][2];
    const char* cA = (const char*)g.A + (size_t)cur.pm * tstep; const char* cB = (const char*)g.Bt + (size_t)cur.pn * tstep;
    S.a_ready(cur);
    if constexpr (SP2) {
        PG8_STAGE(PG8_SB(0, 0), cB, voffB); PG8_STAGE(PG8_SB(0, 1), cB + hstep, voffB); PG8_STAGE(PG8_SA(0, 0), cA, voffA); PG8_STAGE(PG8_SA(0, 1), cA + hstep, voffA);
        if (wr == 1) PG8_BAR;
        PG8_WAIT_V(2); PG8_BAR;
        PG8_STAGE(PG8_SB(1, 0), cB + kstep, voffB); PG8_STAGE(PG8_SA(1, 0), cA + kstep, voffA); PG8_STAGE(PG8_SB(1, 1), cB + hstep + kstep, voffB);
        PG8_WAIT_V(6); PG8_BAR;
    } else {
        PG8_STAGE(PG8_SB(0, 0), cB, voffB); PG8_STAGE(PG8_SA(0, 0), cA, voffA); PG8_STAGE(PG8_SB(0, 1), cB + hstep, voffB); PG8_STAGE(PG8_SA(0, 1), cA + hstep, voffA);
        if (wr == 1) PG8_BAR;
        PG8_WAIT_V(4); PG8_BAR;
        PG8_STAGE(PG8_SB(1, 0), cB + kstep, voffB); PG8_STAGE(PG8_SA(1, 0), cA + kstep, voffA); PG8_STAGE(PG8_SB(1, 1), cB + hstep + kstep, voffB);
        PG8_WAIT_V(6); PG8_BAR;
    }
    for (;;) {
        const bool has_next = S.next(ui + 1, nxt);
        const char* nA = has_next ? (const char*)g.A + (size_t)nxt.pm * tstep : cA; const char* nB = has_next ? (const char*)g.Bt + (size_t)nxt.pn * tstep : cB;
        for (int t = 0; t < nt; t += 2) {
            const bool last = (t == nt - 2);
            const char* a1 = cA + (size_t)(t + 1) * kstep;
            const char* a2 = last ? nA : cA + (size_t)(t + 2) * kstep; const char* b2 = last ? nB : cB + (size_t)(t + 2) * kstep;
            const char* a3 = a2 + kstep; const char* b3 = b2 + kstep;
            if (last && has_next) S.a_ready(nxt);
            if constexpr (SP2) {
            PG8_LDB(B0, 0, 0); PG8_LDB(B1, 0, 1); PG8_SCHED; PG8_LDA(At, 0, 0); PG8_STAGE(PG8_SA(1, 1), a1 + hstep, voffA);
            PG8_WAIT_V(8); PG8_WAIT_L(0); PG8_BAR; PG8_MMA(0, 0, At, B0); PG8_MMA(0, 1, At, B1); PG8_BAR; PG8_SCHED;
            PG8_LDA(At, 0, 1); PG8_STAGE(PG8_SB(0, 0), b2, voffB); PG8_STAGE(PG8_SB(0, 1), b2 + hstep, voffB); PG8_STAGE(PG8_SA(0, 0), a2, voffA);
            PG8_WAIT_V(8); PG8_WAIT_L(0); PG8_BAR; PG8_MMA(1, 0, At, B0); PG8_MMA(1, 1, At, B1); PG8_BAR; PG8_SCHED;
            PG8_LDB(B0, 1, 0); PG8_LDB(B1, 1, 1); PG8_SCHED; PG8_LDA(At, 1, 0); PG8_STAGE(PG8_SA(0, 1), a2 + hstep, voffA);
            PG8_WAIT_V(8); PG8_WAIT_L(0); PG8_BAR; PG8_MMA(0, 0, At, B0); PG8_MMA(0, 1, At, B1); PG8_BAR; PG8_SCHED;
            PG8_LDA(At, 1, 1); PG8_STAGE(PG8_SB(1, 0), b3, voffB); PG8_STAGE(PG8_SB(1, 1), b3 + hstep, voffB); PG8_STAGE(PG8_SA(1, 0), a3, voffA);
            PG8_WAIT_V(8); PG8_WAIT_L(0); PG8_BAR; PG8_MMA(1, 0, At, B0); PG8_MMA(1, 1, At, B1); PG8_BAR; PG8_SCHED;
            } else {
            PG8_LDB(B0, 0, 0); PG8_SCHED; PG8_LDA(At, 0, 0); PG8_STAGE(PG8_SA(1, 1), a1 + hstep, voffA);
            PG8_WAIT_L(8); PG8_BAR; PG8_WAIT_L(0); PG8_MMA(0, 0, At, B0); PG8_BAR; PG8_SCHED;
            PG8_LDB(B1, 0, 1); PG8_STAGE(PG8_SB(0, 0), b2, voffB);
            PG8_BAR; PG8_WAIT_L(0); PG8_MMA(0, 1, At, B1); PG8_BAR;
            PG8_LDA(At, 0, 1); PG8_STAGE(PG8_SA(0, 0), a2, voffA);
            PG8_BAR; PG8_WAIT_L(0); PG8_MMA(1, 0, At, B0); PG8_BAR; PG8_SCHED;
            PG8_STAGE(PG8_SB(0, 1), b2 + hstep, voffB);
            PG8_WAIT_V(6); PG8_BAR; PG8_MMA(1, 1, At, B1); PG8_BAR;
            PG8_LDB(B0, 1, 0); PG8_SCHED; PG8_LDA(At, 1, 0); PG8_STAGE(PG8_SA(0, 1), a2 + hstep, voffA);
            PG8_WAIT_L(8); PG8_BAR; PG8_WAIT_L(0); PG8_MMA(0, 0, At, B0); PG8_BAR; PG8_SCHED;
            PG8_LDB(B1, 1, 1); PG8_STAGE(PG8_SB(1, 0), b3, voffB);
            PG8_BAR; PG8_WAIT_L(0); PG8_MMA(0, 1, At, B1); PG8_BAR;
            PG8_LDA(At, 1, 1); PG8_STAGE(PG8_SA(1, 0), a3, voffA);
            PG8_BAR; PG8_WAIT_L(0); PG8_MMA(1, 0, At, B0); PG8_BAR; PG8_SCHED;
            PG8_STAGE(PG8_SB(1, 1), b3 + hstep, voffB);
            PG8_WAIT_V(6); PG8_BAR; PG8_MMA(1, 1, At, B1); PG8_BAR;
            }
        }
        if constexpr (ALIGN_EPI) { if (wr == 0) PG8_BAR; }
        if constexpr (!Epi::AFTER_DRAIN) { E(acc, cur, wr, wc, fr, fq); S.done(cur); }
        if (!has_next) break;
#pragma unroll
        for (int a = 0; a < 2; ++a)
#pragma unroll
            for (int b = 0; b < 2; ++b)
#pragma unroll
                for (int m = 0; m < 4; ++m)
#pragma unroll
                    for (int n = 0; n < 2; ++n) acc[a][b][m][n] = (f32x4){0.f, 0.f, 0.f, 0.f};
        cur = nxt; cA = nA; cB = nB; ++ui;
        if constexpr (ALIGN_EPI) { if (wr == 1) PG8_BAR; }
    }
    PG8_WAIT_V(0);
    if constexpr (!ALIGN_EPI) { if (wr == 0) PG8_BAR; }
    PG8_BAR;
    if constexpr (Epi::AFTER_DRAIN) { E.fused(acc, cur, wr, wc, fr, fq, lds, wid, lane); S.done(cur); }
#undef PG8_SA
#undef PG8_SB
#undef PG8_STAGE
#undef PG8_LDA
#undef PG8_LDB
#undef PG8_MMA
#undef PG8_WAIT_V
#undef PG8_WAIT_L
#undef PG8_BAR
#undef PG8_SCHED
}
}

namespace pg8 {
struct EpiSwiGLU {
    static constexpr bool PERM = true, AFTER_DRAIN = false;
    bf16_t* H; int ldc;
    __device__ __forceinline__ void operator()(const f32x4 (&acc)[2][2][4][2], const Unit& u, int wr, int wc, int fr, int fq) const {
        const int row0 = u.pm * BM + wr * 64 + fr, col0 = u.pn * HALF + wc * 32 + 8 * fq;
#pragma unroll
        for (int ai = 0; ai < 2; ++ai)
#pragma unroll
            for (int m = 0; m < 4; ++m) {
                bf16_t* rowp = H + (size_t)(row0 + ai * HALF + m * 16) * ldc + col0;
                float h[8];
#pragma unroll
                for (int n = 0; n < 2; ++n)
#pragma unroll
                    for (int i = 0; i < 4; ++i) { const float g = acc[ai][0][m][n][i], uu = acc[ai][1][m][n][i];
                        const float e = __builtin_amdgcn_exp2f(g * -1.4426950408889634f);
                        h[n * 4 + i] = g * uu * __builtin_amdgcn_rcpf(1.0f + e); }
                u32x4 w; w.x = cvt_pk_bf16(h[0], h[1]); w.y = cvt_pk_bf16(h[2], h[3]); w.z = cvt_pk_bf16(h[4], h[5]); w.w = cvt_pk_bf16(h[6], h[7]);
                *(u32x4*)rowp = w;
            }
    }
};
struct EpiResGate {
    static constexpr bool PERM = false, AFTER_DRAIN = false;
    const float* base_lat; const float* base_ctx; float* out_lat; float* out_ctx; const float* gate; float f;
    __device__ __forceinline__ void operator()(const f32x4 (&acc)[2][2][4][2], const Unit& u, int wr, int wc, int fr, int fq) const {
        const bool lat = u.pm < 256; const int mb = lat ? (u.pm >> 5) : 8; const int prow = lat ? u.pm : (u.pm - 256);
        const float* base = (lat ? base_lat : base_ctx) + (size_t)prow * BM * 1024; float* out = (lat ? out_lat : out_ctx) + (size_t)prow * BM * 1024;
        const int col0 = u.pn * BM + wc * 32 + 4 * fq;
        f32x4 gv[2][2];
#pragma unroll
        for (int bj = 0; bj < 2; ++bj)
#pragma unroll
            for (int n = 0; n < 2; ++n) gv[bj][n] = *(const f32x4*)(gate + (size_t)mb * 9216 + col0 + bj * HALF + n * 16) * f;
#pragma unroll
        for (int ai = 0; ai < 2; ++ai)
#pragma unroll
            for (int m = 0; m < 4; ++m) { const size_t off = (size_t)(wr * 64 + fr + ai * HALF + m * 16) * 1024 + col0;
#pragma unroll
                for (int bj = 0; bj < 2; ++bj)
#pragma unroll
                    for (int n = 0; n < 2; ++n) { const f32x4 b = *(const f32x4*)(base + off + bj * HALF + n * 16);
                        *(f32x4*)(out + off + bj * HALF + n * 16) = b + gv[bj][n] * acc[ai][bj][m][n]; } }
    }
};
struct EpiStoreBf16 {
    static constexpr bool PERM = true, AFTER_DRAIN = false;
    bf16_t* O; int ldc;
    __device__ __forceinline__ void operator()(const f32x4 (&acc)[2][2][4][2], const Unit& u, int wr, int wc, int fr, int fq) const {
        const int row0 = u.pm * BM + wr * 64 + fr, col0 = u.pn * BM + wc * 32 + 8 * fq;
#pragma unroll
        for (int ai = 0; ai < 2; ++ai)
#pragma unroll
            for (int m = 0; m < 4; ++m) { bf16_t* rowp = O + (size_t)(row0 + ai * HALF + m * 16) * ldc + col0;
#pragma unroll
                for (int bj = 0; bj < 2; ++bj) { const f32x4 v0 = acc[ai][bj][m][0], v1 = acc[ai][bj][m][1];
                    u32x4 w; w.x = cvt_pk_bf16(v0[0], v0[1]); w.y = cvt_pk_bf16(v0[2], v0[3]); w.z = cvt_pk_bf16(v1[0], v1[1]); w.w = cvt_pk_bf16(v1[2], v1[3]);
                    *(u32x4*)(rowp + bj * HALF) = w; } }
    }
};
}

constexpr int NB = 8, SEQ = 8192, DM = 1024, CTXL = 256, DEPTH = 2, DFF = 2816, NMOD = 9, INC = 3584;
constexpr int TL = NB * SEQ, TC = NB * CTXL, TT = TL + TC;
constexpr int C_NAQ = 0, C_NAK = 384, C_NAV = 768, C_SGU = 1152, C_SGV = 1408, C_RQ = 1664, C_RK = 2048, C_RV = 2432, C_GF = 2816, C_GB = 3200;
constexpr int M_NA = 0, M_SG = 384, M_RET = 640;
constexpr int NCH = TT / 128, NCHL = TL / 128;
constexpr int NWAVES = 8;
#ifndef MK_ONE_LAUNCH
#define MK_ONE_LAUNCH 1
#endif
constexpr int NPH = 1 + DEPTH * 12;

constexpr size_t MiB = 1u << 20;
constexpr size_t WS_CTL = 0, CTL_ZERO_BYTES = 1 * MiB;
constexpr size_t WS_MOD = 1 * MiB;
constexpr size_t WS_ROPE = 2 * MiB;
constexpr size_t WS_W1T = 4 * MiB, WS_W2T = 48 * MiB, WS_WINT = 70 * MiB, WS_WOUTT = 84 * MiB;
constexpr size_t WS_CTXBUF = 88 * MiB;
constexpr size_t WS_XN = 96 * MiB;
constexpr size_t WS_P = 228 * MiB;
constexpr size_t WS_KV = 690 * MiB;
constexpr size_t WS_PREV = 789 * MiB;
constexpr size_t WS_END = 888 * MiB;
constexpr int CW_BAR = 4096;

constexpr int RING_BYTES = 131072, LDSCTL_OFF = RING_BYTES, MISC_OFF = LDSCTL_OFF + 320, LDS_BYTES = 147456;
#define GAS __attribute__((address_space(1)))
#define LAS __attribute__((address_space(3)))
typedef unsigned short bf16;
typedef unsigned v4u __attribute__((ext_vector_type(4)));
typedef float f32x4 __attribute__((ext_vector_type(4)));
typedef short bf16x8 __attribute__((ext_vector_type(8)));
typedef GAS unsigned gu32;
typedef GAS unsigned long long gu64;
#define RLX_AGENT __ATOMIC_RELAXED, __HIP_MEMORY_SCOPE_AGENT
#define LDS_WAIT() asm volatile("s_waitcnt lgkmcnt(0)" ::: "memory")
#define VM_WAIT() asm volatile("s_waitcnt vmcnt(0)" ::: "memory")
__device__ __forceinline__ unsigned long long rt() { return __builtin_amdgcn_s_memrealtime(); }
__device__ __forceinline__ unsigned f2bf(float f) { unsigned u = __builtin_bit_cast(unsigned, f); return (u + 0x7fffu + ((u >> 16) & 1u)) >> 16; }
__device__ __forceinline__ unsigned pk2(float lo, float hi) { return f2bf(lo) | (f2bf(hi) << 16); }
#define XB_TMO      128
#define XB_XCNT(j)  (256  + 64 * (j))
#define XB_XSUB(j)  (1280 + 64 * (j))
#define XB_XGEN(j)  (2304 + 64 * (j))
#define XB_TOP      3328
#define XB_TOPGEN   3392
#define XCD_BAR_WORDS 3456
#define XB_SPIN_CAP (1u << 18)

__device__ __forceinline__ unsigned xb_ld(unsigned* p)              { return __hip_atomic_load(p, __ATOMIC_RELAXED, __HIP_MEMORY_SCOPE_AGENT); }
__device__ __forceinline__ unsigned xb_add(unsigned* p, unsigned v) { return __hip_atomic_fetch_add(p, v, __ATOMIC_RELAXED, __HIP_MEMORY_SCOPE_AGENT); }
__device__ __forceinline__ unsigned xb_xcc_id() { return (unsigned)__builtin_amdgcn_s_getreg((3 << 11) | 20) & 0xFu; }
#define XB_SPIN(cond, bar) do { unsigned _sp = 0; while (cond) { __builtin_amdgcn_s_sleep(1); \
    if ((++_sp & 255u) == 0u) { if (xb_ld(&(bar)[XB_TMO])) break; if (_sp > XB_SPIN_CAP) { atomicAdd(&(bar)[XB_TMO], 1u); break; } } } } while (0)

struct XcdBarrier {
    unsigned* bar; unsigned x;
    volatile LAS unsigned* st;
};

__device__ __forceinline__ XcdBarrier xcd_barrier_post(unsigned* bar, volatile LAS unsigned* st) {
    XcdBarrier b; b.bar = bar; b.x = xb_xcc_id(); b.st = st;
    if (threadIdx.x == 0) (void)xb_add(&bar[XB_XCNT(b.x)], 1u);
    return b;
}
__device__ __forceinline__ void xcd_barrier_complete(unsigned* bar, unsigned x, unsigned& nloc, unsigned& nx) {
    const unsigned G = gridDim.x * gridDim.y * gridDim.z;
    unsigned sum, cnt, mine, sp = 0u;
    for (;;) {
        sum = 0u; cnt = 0u; mine = 0u;
#pragma unroll
        for (unsigned j = 0; j < 16; ++j) { const unsigned c = xb_ld(&bar[XB_XCNT(j)]); sum += c; cnt += (c > 0u) ? 1u : 0u; mine = (j == x) ? c : mine; }
        if (sum == G) break;
        __builtin_amdgcn_s_sleep(1);
        if ((++sp & 255u) == 0u) { if (xb_ld(&bar[XB_TMO])) break; if (sp > XB_SPIN_CAP) { atomicAdd(&bar[XB_TMO], 1u); break; } }
    }
    nloc = mine > 0u ? mine : 1u; nx = cnt > 0u ? cnt : 1u;
}

__device__ __forceinline__ void xcd_barrier(const XcdBarrier& b) {
    asm volatile("s_waitcnt vmcnt(0)" ::: "memory");
    __syncthreads();
    if (threadIdx.x == 0) {
        unsigned* bar = b.bar;
        __builtin_amdgcn_s_waitcnt(0);
        unsigned nloc = b.st[0], nx = b.st[1];
        if (nloc == 0u) { xcd_barrier_complete(bar, b.x, nloc, nx); b.st[0] = nloc; b.st[1] = nx; }
        const unsigned old = xb_add(&bar[XB_XSUB(b.x)], 1u);
        const unsigned gen = old / nloc;
        if (old + 1u == (gen + 1u) * nloc) {
            __builtin_amdgcn_fence(__ATOMIC_RELEASE, "agent");
            asm volatile("s_waitcnt vmcnt(0)" ::: "memory");
            const unsigned og = xb_add(&bar[XB_TOP], 1u);
            const unsigned tg = og / nx;
            if (og + 1u == (tg + 1u) * nx) xb_add(&bar[XB_TOPGEN], 1u);
            else XB_SPIN(xb_ld(&bar[XB_TOPGEN]) == tg, bar);
            __builtin_amdgcn_fence(__ATOMIC_ACQUIRE, "agent");
            xb_add(&bar[XB_XGEN(b.x)], 1u);
            asm volatile("s_waitcnt vmcnt(0)" ::: "memory");
        } else {
            XB_SPIN(xb_ld(&bar[XB_XGEN(b.x)]) == gen, bar);
            __builtin_amdgcn_fence(__ATOMIC_ACQUIRE, "agent");
            asm volatile("s_waitcnt vmcnt(0)" ::: "memory");
        }
    }
    __syncthreads();
}

typedef unsigned u32x2 __attribute__((ext_vector_type(2)));
__device__ __forceinline__ float wave_sum(float v) {
#pragma unroll
    for (int o = 1; o < 64; o <<= 1) v += __shfl_xor(v, o);
    return v;
}
__device__ __forceinline__ float bflo(unsigned w) { return __uint_as_float(w << 16); }
__device__ __forceinline__ float bfhi(unsigned w) { return __uint_as_float(w & 0xffff0000u); }
__device__ __forceinline__ void load8(const bf16* p, float* o) {
    const v4u w = *(const v4u*)p;
    o[0] = bflo(w.x); o[1] = bfhi(w.x); o[2] = bflo(w.y); o[3] = bfhi(w.y); o[4] = bflo(w.z); o[5] = bfhi(w.z); o[6] = bflo(w.w); o[7] = bfhi(w.w);
}
__device__ __forceinline__ void store8(bf16* p, const float* o) {
    v4u w; w.x = pk2(o[0], o[1]); w.y = pk2(o[2], o[3]); w.z = pk2(o[4], o[5]); w.w = pk2(o[6], o[7]); *(v4u*)p = w;
}
__device__ __forceinline__ float sigmoidf_(float x) { return 1.0f / (1.0f + __expf(-x)); }
__device__ __forceinline__ float gelu_tanh(float x) { const float y = 0.7978845608028654f * (x + 0.044715f * x * x * x); return x * sigmoidf_(2.0f * y); }
__device__ __forceinline__ float log_sigmoid(float x) { return fminf(x, 0.0f) - log1pf(expf(-fabsf(x))); }

__device__ __forceinline__ void p0_transpose_item(const float* W, int K, int N, bf16* WT, bool swiglu, LAS float* scr, int item, int lane) {
    const int nblk = N / 32, kb = item / nblk, nb = item % nblk, k0 = 64 * kb, n0 = 32 * nb;
    int d0 = n0;
    if (swiglu) { const int hid = n0 < DFF ? n0 : n0 - DFF; d0 = (hid >> 7) * 256 + (n0 < DFF ? 0 : 128) + (hid & 127); }
#pragma unroll 8
    for (int i = 0; i < 32; ++i) { const int kk = 2 * i + (lane >> 5); scr[kk * 33 + (lane & 31)] = W[(size_t)(k0 + kk) * N + n0 + (lane & 31)]; }
    LDS_WAIT(); asm volatile("" ::: "memory");
    const int c = lane & 7;
#pragma unroll
    for (int j = 0; j < 4; ++j) { const int n = (lane >> 3) + 8 * j; const LAS float* s = scr + (8 * c) * 33 + n;
        v4u o; o.x = pk2(s[0 * 33], s[1 * 33]); o.y = pk2(s[2 * 33], s[3 * 33]); o.z = pk2(s[4 * 33], s[5 * 33]); o.w = pk2(s[6 * 33], s[7 * 33]);
        *(GAS v4u*)(WT + (size_t)(d0 + n) * K + k0 + 8 * c) = o; }
    LDS_WAIT(); asm volatile("" ::: "memory");
}
struct In { const float *x, *c, *ctx, *c_ctx, *ada_w, *ada_b, *norm_w, *ffn_w1, *ffn_w2, *w_in, *w_out, *na_qn, *na_kn, *na_rpb, *sg_w, *sg_b, *sg_ln_w, *sg_ln_b, *ret_logit, *ret_gn_w; };

__device__ __forceinline__ void p0_prologue(const In& I, unsigned char* ws, LAS unsigned char* lds, int tid, int lane, int wave, int vcu, int G) {
    LAS float* scr = (LAS float*)(lds + wave * 16384);
    const int gw = vcu * NWAVES + wave, NGW = G * NWAVES;
    constexpr int I_W1 = (DM / 64) * (2 * DFF / 32), I_W2 = (DFF / 64) * (DM / 32), I_WIN = (DM / 64) * (INC / 32), I_WOUT = (DM / 64) * (DM / 32);
    constexpr int PER_L = 2 * I_W1 + 2 * I_W2 + I_WIN + I_WOUT;
    bf16* W1T = (bf16*)(ws + WS_W1T); bf16* W2T = (bf16*)(ws + WS_W2T); bf16* WINT = (bf16*)(ws + WS_WINT); bf16* WOUTT = (bf16*)(ws + WS_WOUTT);
    for (int it = gw; it < DEPTH * PER_L; it += NGW) {
        const int L = it / PER_L; int r = it % PER_L;
        if (r < 2 * I_W1) { const int i = r / I_W1; r %= I_W1; const size_t o = (size_t)(L * 2 + i) * DM * 2 * DFF; p0_transpose_item(I.ffn_w1 + o, DM, 2 * DFF, W1T + o, true, scr, r, lane); continue; } r -= 2 * I_W1;
        if (r < 2 * I_W2) { const int i = r / I_W2; r %= I_W2; const size_t o = (size_t)(L * 2 + i) * DFF * DM; p0_transpose_item(I.ffn_w2 + o, DFF, DM, W2T + o, false, scr, r, lane); continue; } r -= 2 * I_W2;
        if (r < I_WIN) { const size_t o = (size_t)L * DM * INC; p0_transpose_item(I.w_in + o, DM, INC, WINT + o, false, scr, r, lane); continue; } r -= I_WIN;
        { const size_t o = (size_t)L * DM * DM; p0_transpose_item(I.w_out + o, DM, DM, WOUTT + o, false, scr, r, lane); }
    }
    __syncthreads();
    LAS float* sc = (LAS float*)lds;
    LAS float* part = (LAS float*)(lds + 36864);
    float* mod = (float*)(ws + WS_MOD);
    for (int cb = blockIdx.x; cb < 256; cb += G) {
        for (int i = tid; i < 9 * 1024; i += 512) { const int mb = i >> 10, k = i & 1023; const float v = mb < 8 ? I.c[mb * 1024 + k] : I.c_ctx[k]; sc[i] = v * sigmoidf_(v); }
        __syncthreads();
        const int cc = tid % 72, kp = tid / 72, colg = cb * 72 + cc, L = colg / 9216, j = colg % 9216;
        if (kp < 7) {
            float acc[9];
#pragma unroll
            for (int mb = 0; mb < 9; ++mb) acc[mb] = 0.f;
            for (int k = kp; k < 1024; k += 7) { const float w = I.ada_w[((size_t)L * 1024 + k) * 9216 + j];
#pragma unroll
                for (int mb = 0; mb < 9; ++mb) acc[mb] += sc[mb * 1024 + k] * w; }
#pragma unroll
            for (int mb = 0; mb < 9; ++mb) part[(kp * 72 + cc) * 9 + mb] = acc[mb];
        }
        __syncthreads();
        for (int o = tid; o < 72 * 9; o += 512) { const int c2 = o / 9, mb = o % 9; const int colg2 = cb * 72 + c2, L2 = colg2 / 9216, j2 = colg2 % 9216;
            float s = I.ada_b[L2 * 9216 + j2];
#pragma unroll
            for (int p = 0; p < 7; ++p) s += part[(p * 72 + c2) * 9 + mb];
            mod[((size_t)L2 * 9 + mb) * 9216 + j2] = s; }
        __syncthreads();
    }
    if (blockIdx.x == (unsigned)(G - 1)) {
        float* tab = (float*)(ws + WS_ROPE);
        for (int i = tid; i < 128 * 16; i += 512) { const int n = i >> 4, f = i & 15; const float inv = exp2f(-(float)f * (13.287712379549449f / 16.0f)); const float ang = (float)n * inv;
            tab[2 * i] = cosf(ang); tab[2 * i + 1] = sinf(ang); }
    }
}

__device__ __forceinline__ void norm_phase(const float* xl, const float* xc, int nrows, const float* nw, const float* modL, int sidx, bf16* XN, int gw, int NGW, int lane) {
    const int rpw = (nrows + NGW - 1) / NGW; const int r0 = gw * rpw; int r1 = r0 + rpw; if (r1 > nrows) r1 = nrows;
    int cur = -1; f32x4 g[4], sh[4];
#pragma unroll
    for (int j = 0; j < 4; ++j) { g[j] = (f32x4){0.f, 0.f, 0.f, 0.f}; sh[j] = g[j]; }
    for (int r = r0; r < r1; ++r) {
        const int mb = r < TL ? (r >> 13) : 8;
        if (mb != cur) { cur = mb; const float* sf = modL + (size_t)mb * 9216 + sidx * 1024; const float* sl = sf + 1024;
#pragma unroll
            for (int j = 0; j < 4; ++j) { const f32x4 w = ((const f32x4*)nw)[lane + 64 * j], s1 = ((const f32x4*)sl)[lane + 64 * j]; g[j] = w * (s1 + 1.0f); sh[j] = ((const f32x4*)sf)[lane + 64 * j]; } }
        const float* src = r < TL ? xl + (size_t)r * DM : xc + (size_t)(r - TL) * DM;
        f32x4 v[4]; float s = 0.f;
#pragma unroll
        for (int j = 0; j < 4; ++j) { v[j] = ((const f32x4*)src)[lane + 64 * j]; s += (v[j].x * v[j].x + v[j].y * v[j].y) + (v[j].z * v[j].z + v[j].w * v[j].w); }
        const float rstd = 1.0f / sqrtf(wave_sum(s) * (1.0f / DM) + 1e-6f);
        unsigned long long* o8 = (unsigned long long*)(XN + (size_t)r * DM) + lane;
#pragma unroll
        for (int j = 0; j < 4; ++j) { const f32x4 y = v[j] * rstd * g[j] + sh[j]; o8[64 * j] = (unsigned long long)pk2(y.x, y.y) | ((unsigned long long)pk2(y.z, y.w) << 32); }
    }
}

__device__ __forceinline__ void na_naive(const bf16* P, bf16* MIX, const float* wq, const float* wk, const float* rpb, bool with_ctx, int gtid, int nthreads) {
    float mq = 0.f, mk = 0.f, mr = 0.f;
    for (int d = 0; d < 64; ++d) { mq = fmaxf(mq, fabsf(wq[d])); mk = fmaxf(mk, fabsf(wk[d])); }
    for (int i = 0; i < 6 * 15 * 31; ++i) mr = fmaxf(mr, fabsf(rpb[i]));
    const float mbound = 8.0f * mq * mk + mr;
    const int nitems = (TL + (with_ctx ? TC : 0)) * 6;
    for (int item = gtid; item < nitems; item += nthreads) {
        int h, t; bool isctx;
        if (item < TL * 6) { h = item / TL; t = item % TL; isctx = false; } else { const int r = item - TL * 6; h = r / TC; t = TL + r % TC; isctx = true; }
        float q[64], o[64];
        { const bf16* qp = P + (size_t)t * INC + C_NAQ + h * 64; float ss = 0.f;
#pragma unroll
          for (int d8 = 0; d8 < 8; ++d8) { load8(qp + d8 * 8, q + d8 * 8); }
#pragma unroll
          for (int d = 0; d < 64; ++d) ss += q[d] * q[d];
          const float rstd = 1.0f / sqrtf(ss * (1.0f / 64.0f) + 1e-6f);
#pragma unroll
          for (int d = 0; d < 64; ++d) { q[d] = q[d] * rstd * wq[d] * wk[d] * 0.125f; o[d] = 0.f; } }
        float l = 0.f;
        int b, nloc, r = 0, c = 0, rs = 0, cs = 0;
        if (!isctx) { b = t >> 13; const int pos = t & 8191; r = pos >> 6; c = pos & 63; rs = min(max(r - 4, 0), 120); cs = min(max(c - 8, 0), 48); nloc = 128; }
        else { b = (t - TL) >> 8; nloc = 0; }
        for (int kk = 0; kk < nloc + 256; ++kk) {
            int tk; float bias = 0.f;
            if (kk < nloc) { const int i = kk >> 4, j = kk & 15; tk = b * SEQ + (rs + i) * 64 + cs + j; bias = rpb[(h * 15 + (rs + i - r + 7)) * 31 + (cs + j - c + 15)]; }
            else tk = TL + b * CTXL + (kk - nloc);
            const bf16* kp = P + (size_t)tk * INC + C_NAK + h * 64; const bf16* vp = P + (size_t)tk * INC + C_NAV + h * 64;
            float dot = 0.f, ss = 0.f;
#pragma unroll
            for (int d8 = 0; d8 < 8; ++d8) { float k8[8]; load8(kp + d8 * 8, k8);
#pragma unroll
                for (int e = 0; e < 8; ++e) { dot += q[d8 * 8 + e] * k8[e]; ss += k8[e] * k8[e]; } }
            const float s = dot / sqrtf(ss * (1.0f / 64.0f) + 1e-6f) + bias;
            const float p = __expf(s - mbound); l += p;
#pragma unroll
            for (int d8 = 0; d8 < 8; ++d8) { float v8[8]; load8(vp + d8 * 8, v8);
#pragma unroll
                for (int e = 0; e < 8; ++e) o[d8 * 8 + e] += p * v8[e]; }
        }
        const float il = 1.0f / l; bf16* op = MIX + (size_t)t * DM + M_NA + h * 64;
#pragma unroll
        for (int d8 = 0; d8 < 8; ++d8) { float t8[8];
#pragma unroll
            for (int e = 0; e < 8; ++e) t8[e] = o[d8 * 8 + e] * il;
            store8(op + d8 * 8, t8); }
    }
}

__device__ __forceinline__ void sg_naive(const bf16* P, bf16* MIX, const float* sgw, const float* sgb, const float* lnw, const float* lnb, LAS unsigned char* lds, int tid, int G) {
    LAS float* vn = (LAS float*)lds;
    const int tok = tid >> 2, part = tid & 3;
    for (int it = blockIdx.x; it < NCH * 4; it += G) {
        const int ch = it >> 2, g = it & 3, row0 = ch * 128;
        { const bf16* src = P + (size_t)(row0 + tok) * INC + C_SGV + g * 64 + part * 16; float v[16]; load8(src, v); load8(src + 8, v + 8);
          float s = 0.f;
#pragma unroll
          for (int k = 0; k < 16; ++k) { v[k] = gelu_tanh(v[k]); s += v[k]; }
          s += __shfl_xor(s, 1); s += __shfl_xor(s, 2); const float mu = s * (1.0f / 64.0f); float q = 0.f;
#pragma unroll
          for (int k = 0; k < 16; ++k) { v[k] -= mu; q += v[k] * v[k]; }
          q += __shfl_xor(q, 1); q += __shfl_xor(q, 2); const float rstd = 1.0f / sqrtf(q * (1.0f / 64.0f) + 1e-5f);
#pragma unroll
          for (int k = 0; k < 16; ++k) { const int cch = g * 64 + part * 16 + k; vn[tok * 64 + part * 16 + k] = v[k] * rstd * lnw[cch] + lnb[cch]; } }
        __syncthreads();
        { float acc[16];
#pragma unroll
          for (int k = 0; k < 16; ++k) acc[k] = 0.f;
          const float* wrow = sgw + ((size_t)g * 128 + tok) * 128;
          for (int q = 0; q < 128; ++q) { const float w = wrow[q];
#pragma unroll
              for (int k = 0; k < 16; ++k) acc[k] += w * vn[q * 64 + part * 16 + k]; }
          const float bias = sgb[g * 128 + tok];
          const bf16* up = P + (size_t)(row0 + tok) * INC + C_SGU + g * 64 + part * 16; float u[16]; load8(up, u); load8(up + 8, u + 8);
#pragma unroll
          for (int k = 0; k < 16; ++k) u[k] = gelu_tanh(u[k]) * (acc[k] + bias);
          bf16* op = MIX + (size_t)(row0 + tok) * DM + M_SG + g * 64 + part * 16; store8(op, u); store8(op + 8, u + 8); }
        __syncthreads();
    }
}

__device__ __forceinline__ void rope_load16(const bf16* P, int row, int colbase, int h, int part, bool latent, const float* ropetab, float* out) {
    const bf16* base = P + (size_t)row * INC + colbase + h * 64;
    float mine[16]; load8(base + part * 16, mine); load8(base + part * 16 + 8, mine + 8);
    if (!latent) {
#pragma unroll
        for (int f = 0; f < 16; ++f) out[f] = mine[f];
        return; }
    float oth[16]; load8(base + (part ^ 1) * 16, oth); load8(base + (part ^ 1) * 16 + 8, oth + 8);
    const int pos = row & (SEQ - 1); const int n = (part < 2) ? (pos >> 6) : (pos & 63);
    const float* tb = ropetab + n * 32;
#pragma unroll
    for (int f = 0; f < 16; ++f) { const float cs = tb[2 * f], sn = tb[2 * f + 1]; out[f] = (part & 1) ? (oth[f] * sn + mine[f] * cs) : (mine[f] * cs - oth[f] * sn); }
}
__device__ __forceinline__ void ret_kv_naive(const bf16* P, float* KV, const float* logit, const float* ropetab, LAS unsigned char* lds, int tid, int G) {
    LAS float* kS = (LAS float*)lds; LAS float* vS = kS + 128 * 64; LAS float* wt = vS + 128 * 64;
    const int tok = tid >> 2, part = tid & 3;
    for (int it = blockIdx.x; it < NCH * 6; it += G) {
        const int ch = it / 6, h = it % 6, row0 = ch * 128; const bool latent = ch < NCHL;
        { float k16[16]; rope_load16(P, row0 + tok, C_RK, h, part, latent, ropetab, k16);
#pragma unroll
          for (int f = 0; f < 16; ++f) kS[tok * 64 + part * 16 + f] = k16[f] * 0.125f;
          const bf16* vp = P + (size_t)(row0 + tok) * INC + C_RV + h * 64 + part * 16; float v16[16]; load8(vp, v16); load8(vp + 8, v16 + 8);
#pragma unroll
          for (int f = 0; f < 16; ++f) vS[tok * 64 + part * 16 + f] = v16[f]; }
        if (tid < 256) { const int dir = tid >> 7, j = tid & 127; const float lg = log_sigmoid(logit[dir * 6 + h]); wt[tid] = expf(lg * (float)(dir == 0 ? 127 - j : j)); }
        __syncthreads();
        { const int d = tid >> 3, e0 = (tid & 7) * 8; float af[8], ab[8];
#pragma unroll
          for (int k = 0; k < 8; ++k) { af[k] = 0.f; ab[k] = 0.f; }
          for (int j = 0; j < 128; ++j) { const float kd = kS[j * 64 + d]; const float a = kd * wt[j], b = kd * wt[128 + j];
#pragma unroll
              for (int k = 0; k < 8; ++k) { const float v = vS[j * 64 + e0 + k]; af[k] += a * v; ab[k] += b * v; } }
          float* of = KV + ((size_t)(ch * 6 + h) * 2 + 0) * 4096 + d * 64 + e0; float* ob = of + 4096;
#pragma unroll
          for (int k = 0; k < 8; ++k) { of[k] = af[k]; ob[k] = ab[k]; } }
        __syncthreads();
    }
}
__device__ __forceinline__ void ret_scan(const float* KV, float* PREV, const float* logit, int gtid, int nthreads) {
    for (int it = gtid; it < NB * 6 * 2 * 4096; it += nthreads) {
        const int idx = it & 4095, dir = (it >> 12) & 1, bh = it >> 13, h = bh % 6, b = bh / 6;
        const float cd = expf(128.0f * log_sigmoid(logit[dir * 6 + h]));
#define KVI(ch) (((size_t)((ch) * 6 + h) * 2 + dir) * 4096 + idx)
        const int c0 = NCHL + 2 * b, c1 = c0 + 1;
        const float k0 = KV[KVI(c0)], k1 = KV[KVI(c1)];
        if (dir == 0) { PREV[KVI(c0)] = 0.f; PREV[KVI(c1)] = k0; float s = cd * k0 + k1;
            for (int n = 0; n < 64; ++n) { const int ch = b * 64 + n; PREV[KVI(ch)] = s; s = cd * s + KV[KVI(ch)]; } }
        else { PREV[KVI(c0)] = k1; PREV[KVI(c1)] = 0.f; float s = k0 + cd * k1;
            for (int n = 63; n >= 0; --n) { const int ch = b * 64 + n; PREV[KVI(ch)] = s; s = cd * s + KV[KVI(ch)]; } }
#undef KVI
    }
}
__device__ __forceinline__ void ret_out_naive(const bf16* P, const float* PREV, bf16* MIX, const float* logit, const float* gnw, const float* ropetab, LAS unsigned char* lds, int tid, int G) {
    LAS bf16* qS = (LAS bf16*)lds; LAS bf16* kS = qS + 128 * 64; LAS bf16* vS = kS + 128 * 64;
    LAS float* S = (LAS float*)(lds + 49152);
    LAS float* dec = (LAS float*)(lds + 49152 + 65536);
    const int tok = tid >> 2, part = tid & 3;
    for (int it = blockIdx.x; it < NCH * 6; it += G) {
        const int ch = it / 6, h = it % 6, row0 = ch * 128; const bool latent = ch < NCHL;
        { float t16[16]; rope_load16(P, row0 + tok, C_RQ, h, part, latent, ropetab, t16);
#pragma unroll
          for (int f = 0; f < 16; ++f) qS[tok * 64 + part * 16 + f] = (bf16)f2bf(t16[f]);
          rope_load16(P, row0 + tok, C_RK, h, part, latent, ropetab, t16);
#pragma unroll
          for (int f = 0; f < 16; ++f) kS[tok * 64 + part * 16 + f] = (bf16)f2bf(t16[f] * 0.125f);
          const bf16* vp = P + (size_t)(row0 + tok) * INC + C_RV + h * 64 + part * 16; const v4u a = *(const v4u*)vp, b = *(const v4u*)(vp + 8);
          *(LAS v4u*)(vS + tok * 64 + part * 16) = a; *(LAS v4u*)(vS + tok * 64 + part * 16 + 8) = b; }
        if (tid < 258) { const int dir = tid / 129, k = tid % 129; dec[tid] = expf(log_sigmoid(logit[dir * 6 + h]) * (float)k); }
        __syncthreads();
        { float q[64];
#pragma unroll
          for (int d = 0; d < 64; ++d) q[d] = __uint_as_float((unsigned)qS[tok * 64 + d] << 16);
          for (int jj = 0; jj < 32; ++jj) { const int j = part + 4 * jj; float dot = 0.f;
#pragma unroll
              for (int d = 0; d < 64; ++d) dot += q[d] * __uint_as_float((unsigned)kS[j * 64 + d] << 16);
              S[tok * 128 + j] = dot; } }
        __syncthreads();
        { const int i = tok, e0 = part * 16; float of[16], ob[16], cf[16], cb[16];
#pragma unroll
          for (int k = 0; k < 16; ++k) { of[k] = 0.f; ob[k] = 0.f; cf[k] = 0.f; cb[k] = 0.f; }
          for (int j = 0; j < 128; ++j) { const float s = S[i * 128 + j]; const float wf = (j <= i) ? s * dec[i - j] : 0.f, wb = (j >= i) ? s * dec[129 + j - i] : 0.f;
#pragma unroll
              for (int k = 0; k < 16; ++k) { const float v = __uint_as_float((unsigned)vS[j * 64 + e0 + k] << 16); of[k] += wf * v; ob[k] += wb * v; } }
          const float* pf = PREV + ((size_t)(ch * 6 + h) * 2) * 4096 + e0; const float* pb = pf + 4096;
          for (int d = 0; d < 64; ++d) { const float qd = __uint_as_float((unsigned)qS[i * 64 + d] << 16);
#pragma unroll
              for (int k = 0; k < 16; ++k) { cf[k] += qd * pf[d * 64 + k]; cb[k] += qd * pb[d * 64 + k]; } }
          const float df = dec[i + 1], db = dec[129 + 128 - i];
          float sf = 0.f, sb = 0.f;
#pragma unroll
          for (int k = 0; k < 16; ++k) { of[k] += df * cf[k]; ob[k] += db * cb[k]; sf += of[k]; sb += ob[k]; }
          sf += __shfl_xor(sf, 1); sf += __shfl_xor(sf, 2); sb += __shfl_xor(sb, 1); sb += __shfl_xor(sb, 2);
          const float muf = sf * (1.0f / 64.0f), mub = sb * (1.0f / 64.0f); float qf = 0.f, qb = 0.f;
#pragma unroll
          for (int k = 0; k < 16; ++k) { of[k] -= muf; ob[k] -= mub; qf += of[k] * of[k]; qb += ob[k] * ob[k]; }
          qf += __shfl_xor(qf, 1); qf += __shfl_xor(qf, 2); qb += __shfl_xor(qb, 1); qb += __shfl_xor(qb, 2);
          const float rf = 1.0f / sqrtf(qf * (1.0f / 64.0f) + 1e-5f), rb = 1.0f / sqrtf(qb * (1.0f / 64.0f) + 1e-5f);
          const bf16* gp = P + (size_t)(row0 + i) * INC + C_GF + h * 64 + e0; float gf[16], gb[16]; load8(gp, gf); load8(gp + 8, gf + 8); load8(gp + (C_GB - C_GF), gb); load8(gp + (C_GB - C_GF) + 8, gb + 8);
          float y[16];
#pragma unroll
          for (int k = 0; k < 16; ++k) y[k] = (of[k] * rf * (gf[k] * sigmoidf_(gf[k])) + ob[k] * rb * (gb[k] * sigmoidf_(gb[k]))) * gnw[h * 64 + e0 + k];
          bf16* op = MIX + (size_t)(row0 + i) * DM + M_RET + h * 64 + e0; store8(op, y); store8(op + 8, y + 8); }
        __syncthreads();
    }
}

struct Args { In in; float* out; unsigned char* ws; int ph_lo, ph_hi; };
__global__ void __launch_bounds__(NWAVES * 64, 2) hybrid_fwd(Args args) {
    extern __shared__ __attribute__((aligned(16))) unsigned char lds_raw[];
    LAS unsigned char* lds = (LAS unsigned char*)lds_raw;
    volatile LAS unsigned* MISC = (volatile LAS unsigned*)(lds + MISC_OFF);
    const int tid = threadIdx.x, lane = tid & 63, wave = __builtin_amdgcn_readfirstlane(tid >> 6);
    const int G = gridDim.x; const int bx = blockIdx.x; const int vcu = (G % 8 == 0) ? (bx % 8) * (G / 8) + bx / 8 : bx;
    const int NGW = G * NWAVES, nthreads = G * NWAVES * 64;
    unsigned char* ws = args.ws; const In& I = args.in;
    gu32* ctl = (gu32*)(ws + WS_CTL);
    for (int u = tid; u < (LDS_BYTES - LDSCTL_OFF) / 4; u += NWAVES * 64) ((LAS unsigned*)(lds + LDSCTL_OFF))[u] = 0u;
    __syncthreads();
    XcdBarrier bar; bar.bar = (unsigned*)(ctl + CW_BAR); bar.x = 0; bar.st = nullptr;
    if (MK_ONE_LAUNCH) bar = xcd_barrier_post((unsigned*)(ctl + CW_BAR), MISC + 8);
    const int lo = args.ph_lo, hi = args.ph_hi; int ph = 0;
#define PH_ON (ph >= lo && ph < hi)
#define OPQ(x) ({ int _t = (x); asm volatile("" : "+v"(_t)); _t; })
#define PH_END do { if (MK_ONE_LAUNCH && ph >= lo && ph + 1 < hi) xcd_barrier(bar); ++ph; } while (0)

    float* mod = (float*)(ws + WS_MOD); const float* ropetab = (const float*)(ws + WS_ROPE);
    bf16* W1T = (bf16*)(ws + WS_W1T); bf16* W2T = (bf16*)(ws + WS_W2T); bf16* WINT = (bf16*)(ws + WS_WINT); bf16* WOUTT = (bf16*)(ws + WS_WOUTT);
    float* ctxbuf = (float*)(ws + WS_CTXBUF); bf16* XN = (bf16*)(ws + WS_XN); bf16* PB = (bf16*)(ws + WS_P); bf16* HB = (bf16*)(ws + WS_P);
    float* KV = (float*)(ws + WS_KV); float* PREV = (float*)(ws + WS_PREV);

    if (PH_ON) p0_prologue(I, ws, lds, tid, lane, wave, vcu, G);
    PH_END;

    for (int hs = 0; hs < 2 * DEPTH; ++hs) {
        const int L = hs >> 1, half = hs & 1; const bool last = (L == DEPTH - 1), first = (hs == 0);
        const int Mrows = (last && half == 1) ? TL : TT;
        const float* modL = mod + (size_t)L * 9 * 9216;
        const float* xl = first ? I.x : args.out; const float* xc = first ? I.ctx : ctxbuf;
        if (PH_ON) { const int t_ = OPQ(threadIdx.x); norm_phase(xl, xc, Mrows, I.norm_w + (size_t)(L * 3 + (half ? 2 : 0)) * DM, modL, half ? 6 : 0, XN, vcu * NWAVES + (t_ >> 6), NGW, t_ & 63); }
        PH_END;
        if (PH_ON) { pg8::Gemm g{XN, W1T + (size_t)(L * 2 + half) * DM * 2 * DFF, Mrows, 2 * DFF, DM}; pg8::StaticOrder S; S.init(Mrows, 2 * DFF, G, bx);
            pg8::EpiSwiGLU E{HB, DFF};
            pg8::gemm_phase<pg8::EpiSwiGLU, pg8::StaticOrder, true, true>(lds, g, S, E); }
        PH_END;
        if (PH_ON) { pg8::Gemm g{HB, W2T + (size_t)(L * 2 + half) * DFF * DM, Mrows, DM, DFF}; pg8::StaticOrder S; S.init(Mrows, DM, G, bx);
            pg8::EpiResGate E{xl, xc, args.out, ctxbuf, modL + (half ? 8 : 2) * 1024, 0.5f};
            pg8::gemm_phase<pg8::EpiResGate, pg8::StaticOrder, true, true>(lds, g, S, E); }
        PH_END;
        if (half == 0) {
            if (PH_ON) { const int t_ = OPQ(threadIdx.x); norm_phase(args.out, ctxbuf, TT, I.norm_w + (size_t)(L * 3 + 1) * DM, modL, 3, XN, vcu * NWAVES + (t_ >> 6), NGW, t_ & 63); }
            PH_END;
            if (PH_ON) { pg8::Gemm g{XN, WINT + (size_t)L * DM * INC, TT, INC, DM}; pg8::StaticOrder S; S.init(TT, INC, G, bx);
                pg8::EpiStoreBf16 E{PB, INC};
                pg8::gemm_phase<pg8::EpiStoreBf16, pg8::StaticOrder, true, true>(lds, g, S, E); }
            PH_END;
            const float* logit = I.ret_logit + L * 12;
            if (PH_ON) { const int t_ = OPQ(threadIdx.x);
                na_naive(PB, XN, I.na_qn + L * 64, I.na_kn + L * 64, I.na_rpb + (size_t)L * 6 * 15 * 31, !last, bx * (NWAVES * 64) + t_, nthreads);
                sg_naive(PB, XN, I.sg_w + (size_t)L * 4 * 128 * 128, I.sg_b + L * 4 * 128, I.sg_ln_w + L * 256, I.sg_ln_b + L * 256, lds, t_, G);
                ret_kv_naive(PB, KV, logit, ropetab, lds, t_, G);
            }
            PH_END;
            if (PH_ON) { const int t_ = OPQ(threadIdx.x); ret_scan(KV, PREV, logit, bx * (NWAVES * 64) + t_, nthreads); }
            PH_END;
            if (PH_ON) { const int t_ = OPQ(threadIdx.x); ret_out_naive(PB, PREV, XN, logit, I.ret_gn_w + L * 384, ropetab, lds, t_, G); }
            PH_END;
            const int Mo = last ? TL : TT;
            if (PH_ON) { pg8::Gemm g{XN, WOUTT + (size_t)L * DM * DM, Mo, DM, DM}; pg8::StaticOrder S; S.init(Mo, DM, G, bx);
                pg8::EpiResGate E{args.out, ctxbuf, args.out, ctxbuf, modL + 5 * 1024, 1.0f};
                pg8::gemm_phase<pg8::EpiResGate, pg8::StaticOrder, true, true>(lds, g, S, E); }
            PH_END;
        }
    }
#undef PH_ON
#undef PH_END
}

extern "C" void kernel_launch(void* const* d_in, const int* in_sizes, int n_in, void* d_out, int out_size, void* d_ws, size_t ws_size, hipStream_t stream) {
    static int grid = 0;
    if (grid == 0) {
        if (n_in != 20 || in_sizes[0] != TL * DM || out_size != TL * DM || ws_size < WS_END) { fprintf(stderr, "kernel_launch: unexpected shapes (n_in %d, in0 %d, out %d, ws %zu); nothing launched\n", n_in, n_in > 0 ? in_sizes[0] : -1, out_size, ws_size); grid = -1; return; }
        int dev = 0, cus = 0, per_cu = 0;
        if (hipGetDevice(&dev) != hipSuccess || hipDeviceGetAttribute(&cus, hipDeviceAttributeMultiprocessorCount, dev) != hipSuccess) { grid = -1; return; }
        if (hipFuncSetAttribute((const void*)hybrid_fwd, hipFuncAttributeMaxDynamicSharedMemorySize, LDS_BYTES) != hipSuccess) { fprintf(stderr, "kernel_launch: hipFuncSetAttribute failed\n"); grid = -1; return; }
        if (hipOccupancyMaxActiveBlocksPerMultiprocessor(&per_cu, (const void*)hybrid_fwd, NWAVES * 64, LDS_BYTES) != hipSuccess || per_cu < 1)
            fprintf(stderr, "kernel_launch: note: occupancy query reports %d workgroups per CU\n", per_cu);
        (void)hipGetLastError();
        grid = cus;
    }
    if (grid < 0) return;
    if (hipMemsetAsync((char*)d_ws + WS_CTL, 0, CTL_ZERO_BYTES, stream) != hipSuccess) return;
    Args a{};
    const float** ip = (const float**)&a.in;
    for (int i = 0; i < 20; ++i) ip[i] = (const float*)d_in[i];
    a.out = (float*)d_out; a.ws = (unsigned char*)d_ws;
#if MK_ONE_LAUNCH
    a.ph_lo = 0; a.ph_hi = NPH;
    hipLaunchKernelGGL(hybrid_fwd, dim3(grid), dim3(NWAVES * 64), LDS_BYTES, stream, a);
#else
    for (int li = 0; li < NPH; ++li) { a.ph_lo = li; a.ph_hi = li + 1; hipLaunchKernelGGL(hybrid_fwd, dim3(grid), dim3(NWAVES * 64), LDS_BYTES, stream, a); }
#endif
}
```

```cpp
#include <hip/hip_runtime.h>
#include <cstdio>
#include <cstdint>
namespace pg8 {
#define PG8_LAS __attribute__((address_space(3)))
typedef unsigned short bf16_t;
typedef short bf16x8 __attribute__((ext_vector_type(8)));
typedef float f32x4 __attribute__((ext_vector_type(4)));
typedef unsigned u32x4 __attribute__((ext_vector_type(4)));
constexpr int BM = 256, BK = 64, HALF = 128, HTB = HALF * BK * 2  , STAGE_BYTES = 8 * HTB, NXCD = 8, WGM = 8;

__host__ __device__ __forceinline__ int lds_byte(int r, int c) { const int st = (r >> 4) * 2 + (c >> 5), rr = r & 15, cc = c & 31, ob = rr * 64 + cc * 2; return st * 1024 + (ob ^ (((ob >> 9) & 1) << 5)); }
__host__ __device__ __forceinline__ void stage_rc(int b, int& R, int& C) { const int st = b / 1024, sb = b % 1024, swz = sb ^ (((sb >> 9) & 1) << 5); R = (st >> 1) * 16 + swz / 64; C = (st & 1) * 32 + (swz % 64) / 2; }
__host__ __device__ __forceinline__ int perm32(int rho) { const int n = rho >> 4, i = rho & 15; return 8 * (i >> 2) + 4 * n + (i & 3); }

struct Unit { int pm, pn; };
struct Gemm { const bf16_t* A; const bf16_t* Bt; int M, N, K; };

struct StaticOrder {
    int nM, nN, nwg, G, c;
    __host__ __device__ void init(int M, int N, int G_, int c_) { nM = M / BM; nN = N / BM; nwg = nM * nN; G = G_; c = c_; }
    __host__ __device__ bool next(int i, Unit& u) const {
        const long L = (long)i * G + c; if (L >= nwg) return false;
        int wgid = (int)L; { const int q = nwg / NXCD, r = nwg % NXCD, xcd = wgid % NXCD, off = wgid / NXCD; wgid = (xcd < r ? xcd * (q + 1) : r * (q + 1) + (xcd - r) * q) + off; }
        const int nig = WGM * nN, gid = wgid / nig, fm = gid * WGM, gsz = (nM - fm) < WGM ? (nM - fm) : WGM;
        u.pm = fm + ((wgid % nig) % gsz); u.pn = (wgid % nig) / gsz; return true;
    }
    __device__ __forceinline__ void a_ready(const Unit&) const {}
    __device__ __forceinline__ void done(const Unit&) const {}
};
__device__ __forceinline__ unsigned cvt_pk_bf16(float lo, float hi) { unsigned r; asm volatile("v_cvt_pk_bf16_f32 %0, %1, %2" : "=v"(r) : "v"(lo), "v"(hi)); return r; }
typedef float f32x2 __attribute__((ext_vector_type(2)));
template <class Epi, class Sched, bool ALIGN_EPI = false, bool SP2 = false>
__device__ __forceinline__ void gemm_phase(PG8_LAS unsigned char* lds, const Gemm g, const Sched& S, const Epi& E, const int wave_s) {
    int tid_o; asm volatile("v_mbcnt_lo_u32_b32 %0, -1, 0\n\tv_mbcnt_hi_u32_b32 %0, -1, %0" : "=v"(tid_o)); tid_o |= wave_s << 6;
    const int tid = tid_o, wid = __builtin_amdgcn_readfirstlane(tid >> 6), lane = tid & 63, wr = wid >> 2, wc = wid & 3, fr = lane & 15, fq = lane >> 4;
    const int K = g.K, nt = K / BK;
    unsigned voffA[2], voffB[2];
#pragma unroll
    for (int i = 0; i < 2; ++i) { int R, C; stage_rc(tid * 16 + i * 8192, R, C); const int Rb = Epi::PERM ? ((R & ~31) + perm32(R & 31)) : R;
        voffA[i] = (unsigned)(R * K + C) * 2u; voffB[i] = (unsigned)(Rb * K + C) * 2u; }
    const size_t kstep = (size_t)(BK * 2);
    const size_t hstep = (size_t)HALF * K * 2;
    const size_t tstep = 2 * hstep;
    const unsigned ldsw = (unsigned)wid * 1024u;
    const int aoff = lds_byte(wr * 64 + fr, fq * 8), boff = lds_byte(wc * 32 + fr, fq * 8);
#define PG8_SA(b, h) (((b) * 2 + (h)) * HTB)
#define PG8_SB(b, h) ((4 + (b) * 2 + (h)) * HTB)
#define PG8_STAGE(bufoff, gbase, voff) do { _Pragma("unroll") for (int _i = 0; _i < 2; ++_i) \
        __builtin_amdgcn_global_load_lds((const unsigned*)((const char*)(gbase) + (voff)[_i]), (PG8_LAS unsigned*)(lds + (bufoff) + ldsw + _i * 8192), 16, 0, 0); } while (0)
#define PG8_LDA(dst, b, h) do { _Pragma("unroll") for (int m = 0; m < 4; ++m) _Pragma("unroll") for (int k = 0; k < 2; ++k) dst[m][k] = *(const PG8_LAS bf16x8*)(lds + PG8_SA(b, h) + aoff + m * 2048 + k * 1024); } while (0)
#define PG8_LDB(dst, b, h) do { _Pragma("unroll") for (int n = 0; n < 2; ++n) _Pragma("unroll") for (int k = 0; k < 2; ++k) dst[n][k] = *(const PG8_LAS bf16x8*)(lds + PG8_SB(b, h) + boff + n * 2048 + k * 1024); } while (0)
#define PG8_MMA(ai, bj, At, Bt) do { __builtin_amdgcn_s_setprio(1); _Pragma("unroll") for (int m = 0; m < 4; ++m) _Pragma("unroll") for (int n = 0; n < 2; ++n) _Pragma("unroll") for (int k = 0; k < 2; ++k) \
        acc[ai][bj][m][n] = __builtin_amdgcn_mfma_f32_16x16x32_bf16(Bt[n][k], At[m][k], acc[ai][bj][m][n], 0, 0, 0); __builtin_amdgcn_s_setprio(0); } while (0)
#define PG8_WAIT_V(n) asm volatile("s_waitcnt vmcnt(" #n ")" ::: "memory")
#define PG8_WAIT_L(n) asm volatile("s_waitcnt lgkmcnt(" #n ")" ::: "memory")
#define PG8_BAR __builtin_amdgcn_s_barrier()
#define PG8_SCHED __builtin_amdgcn_sched_barrier(0)
    Unit cur, nxt; int ui = 0;
    if (!S.next(0, cur)) return;
    f32x4 acc[2][2][4][2];
#pragma unroll
    for (int a = 0; a < 2; ++a)
#pragma unroll
        for (int b = 0; b < 2; ++b)
#pragma unroll
            for (int m = 0; m < 4; ++m)
#pragma unroll
                for (int n = 0; n < 2; ++n) acc[a][b][m][n] = (f32x4){0.f, 0.f, 0.f, 0.f};
    bf16x8 At[4][2], B0[2][2], B1[2][2];
    const char* cA = (const char*)g.A + (size_t)cur.pm * tstep; const char* cB = (const char*)g.Bt + (size_t)cur.pn * tstep;
    S.a_ready(cur);
    if constexpr (SP2) {
        PG8_STAGE(PG8_SB(0, 0), cB, voffB); PG8_STAGE(PG8_SB(0, 1), cB + hstep, voffB); PG8_STAGE(PG8_SA(0, 0), cA, voffA); PG8_STAGE(PG8_SA(0, 1), cA + hstep, voffA);
        if (wr == 1) PG8_BAR;
        PG8_WAIT_V(2); PG8_BAR;
        PG8_STAGE(PG8_SB(1, 0), cB + kstep, voffB); PG8_STAGE(PG8_SA(1, 0), cA + kstep, voffA); PG8_STAGE(PG8_SB(1, 1), cB + hstep + kstep, voffB);
        PG8_WAIT_V(6); PG8_BAR;
    } else {
        PG8_STAGE(PG8_SB(0, 0), cB, voffB); PG8_STAGE(PG8_SA(0, 0), cA, voffA); PG8_STAGE(PG8_SB(0, 1), cB + hstep, voffB); PG8_STAGE(PG8_SA(0, 1), cA + hstep, voffA);
        if (wr == 1) PG8_BAR;
        PG8_WAIT_V(4); PG8_BAR;
        PG8_STAGE(PG8_SB(1, 0), cB + kstep, voffB); PG8_STAGE(PG8_SA(1, 0), cA + kstep, voffA); PG8_STAGE(PG8_SB(1, 1), cB + hstep + kstep, voffB);
        PG8_WAIT_V(6); PG8_BAR;
    }
    for (;;) {
        const bool has_next = S.next(ui + 1, nxt);
        const char* nA = has_next ? (const char*)g.A + (size_t)nxt.pm * tstep : cA; const char* nB = has_next ? (const char*)g.Bt + (size_t)nxt.pn * tstep : cB;
        for (int t = 0; t < nt; t += 2) {
            const bool last = (t == nt - 2);
            const char* a1 = cA + (size_t)(t + 1) * kstep;
            const char* a2 = last ? nA : cA + (size_t)(t + 2) * kstep; const char* b2 = last ? nB : cB + (size_t)(t + 2) * kstep;
            const char* a3 = a2 + kstep; const char* b3 = b2 + kstep;
            if (last && has_next) S.a_ready(nxt);
            if constexpr (SP2) {
            PG8_LDB(B0, 0, 0); PG8_LDB(B1, 0, 1); PG8_SCHED; PG8_LDA(At, 0, 0); PG8_STAGE(PG8_SA(1, 1), a1 + hstep, voffA);
            PG8_WAIT_V(8); PG8_WAIT_L(0); PG8_BAR; PG8_MMA(0, 0, At, B0); PG8_MMA(0, 1, At, B1); PG8_BAR; PG8_SCHED;
            PG8_LDA(At, 0, 1); PG8_STAGE(PG8_SB(0, 0), b2, voffB); PG8_STAGE(PG8_SB(0, 1), b2 + hstep, voffB); PG8_STAGE(PG8_SA(0, 0), a2, voffA);
            PG8_WAIT_V(8); PG8_WAIT_L(0); PG8_BAR; PG8_MMA(1, 0, At, B0); PG8_MMA(1, 1, At, B1); PG8_BAR; PG8_SCHED;
            PG8_LDB(B0, 1, 0); PG8_LDB(B1, 1, 1); PG8_SCHED; PG8_LDA(At, 1, 0); PG8_STAGE(PG8_SA(0, 1), a2 + hstep, voffA);
            PG8_WAIT_V(8); PG8_WAIT_L(0); PG8_BAR; PG8_MMA(0, 0, At, B0); PG8_MMA(0, 1, At, B1); PG8_BAR; PG8_SCHED;
            PG8_LDA(At, 1, 1); PG8_STAGE(PG8_SB(1, 0), b3, voffB); PG8_STAGE(PG8_SB(1, 1), b3 + hstep, voffB); PG8_STAGE(PG8_SA(1, 0), a3, voffA);
            PG8_WAIT_V(8); PG8_WAIT_L(0); PG8_BAR; PG8_MMA(1, 0, At, B0); PG8_MMA(1, 1, At, B1); PG8_BAR; PG8_SCHED;
            } else {
            PG8_LDB(B0, 0, 0); PG8_SCHED; PG8_LDA(At, 0, 0); PG8_STAGE(PG8_SA(1, 1), a1 + hstep, voffA);
            PG8_WAIT_L(8); PG8_BAR; PG8_WAIT_L(0); PG8_MMA(0, 0, At, B0); PG8_BAR; PG8_SCHED;
            PG8_LDB(B1, 0, 1); PG8_STAGE(PG8_SB(0, 0), b2, voffB);
            PG8_BAR; PG8_WAIT_L(0); PG8_MMA(0, 1, At, B1); PG8_BAR;
            PG8_LDA(At, 0, 1); PG8_STAGE(PG8_SA(0, 0), a2, voffA);
            PG8_BAR; PG8_WAIT_L(0); PG8_MMA(1, 0, At, B0); PG8_BAR; PG8_SCHED;
            PG8_STAGE(PG8_SB(0, 1), b2 + hstep, voffB);
            PG8_WAIT_V(6); PG8_BAR; PG8_MMA(1, 1, At, B1); PG8_BAR;
            PG8_LDB(B0, 1, 0); PG8_SCHED; PG8_LDA(At, 1, 0); PG8_STAGE(PG8_SA(0, 1), a2 + hstep, voffA);
            PG8_WAIT_L(8); PG8_BAR; PG8_WAIT_L(0); PG8_MMA(0, 0, At, B0); PG8_BAR; PG8_SCHED;
            PG8_LDB(B1, 1, 1); PG8_STAGE(PG8_SB(1, 0), b3, voffB);
            PG8_BAR; PG8_WAIT_L(0); PG8_MMA(0, 1, At, B1); PG8_BAR;
            PG8_LDA(At, 1, 1); PG8_STAGE(PG8_SA(1, 0), a3, voffA);
            PG8_BAR; PG8_WAIT_L(0); PG8_MMA(1, 0, At, B0); PG8_BAR; PG8_SCHED;
            PG8_STAGE(PG8_SB(1, 1), b3 + hstep, voffB);
            PG8_WAIT_V(6); PG8_BAR; PG8_MMA(1, 1, At, B1); PG8_BAR;
            }
        }
        if constexpr (ALIGN_EPI) { if (wr == 0) PG8_BAR; }
        if constexpr (!Epi::AFTER_DRAIN) { E(acc, cur, wr, wc, fr, fq); S.done(cur); }
        if (!has_next) break;
#pragma unroll
        for (int a = 0; a < 2; ++a)
#pragma unroll
            for (int b = 0; b < 2; ++b)
#pragma unroll
                for (int m = 0; m < 4; ++m)
#pragma unroll
                    for (int n = 0; n < 2; ++n) acc[a][b][m][n] = (f32x4){0.f, 0.f, 0.f, 0.f};
        cur = nxt; cA = nA; cB = nB; ++ui;
        if constexpr (ALIGN_EPI) { if (wr == 1) PG8_BAR; }
    }
    PG8_WAIT_V(0);
    if constexpr (!ALIGN_EPI) { if (wr == 0) PG8_BAR; }
    PG8_BAR;
    if constexpr (Epi::AFTER_DRAIN) { E.fused(acc, cur, wr, wc, fr, fq, lds, wid, lane); S.done(cur); }
#undef PG8_SA
#undef PG8_SB
#undef PG8_STAGE
#undef PG8_LDA
#undef PG8_LDB
#undef PG8_MMA
#undef PG8_WAIT_V
#undef PG8_WAIT_L
#undef PG8_BAR
#undef PG8_SCHED
}
}

namespace pg8 {
struct EpiSwiGLU {
    static constexpr bool PERM = true, AFTER_DRAIN = false;
    bf16_t* H; int ldc;
    __device__ __forceinline__ void operator()(const f32x4 (&acc)[2][2][4][2], const Unit& u, int wr, int wc, int fr, int fq) const {
        const int row0 = u.pm * BM + wr * 64 + fr, col0 = u.pn * HALF + wc * 32 + 8 * fq;
#pragma unroll
        for (int ai = 0; ai < 2; ++ai)
#pragma unroll
            for (int m = 0; m < 4; ++m) {
                bf16_t* rowp = H + (size_t)(row0 + ai * HALF + m * 16) * ldc + col0;
                float h[8];
#pragma unroll
                for (int n = 0; n < 2; ++n)
#pragma unroll
                    for (int i = 0; i < 4; ++i) { const float g = acc[ai][0][m][n][i], uu = acc[ai][1][m][n][i];
                        const float e = __builtin_amdgcn_exp2f(g * -1.4426950408889634f);
                        h[n * 4 + i] = g * uu * __builtin_amdgcn_rcpf(1.0f + e); }
                u32x4 w; w.x = cvt_pk_bf16(h[0], h[1]); w.y = cvt_pk_bf16(h[2], h[3]); w.z = cvt_pk_bf16(h[4], h[5]); w.w = cvt_pk_bf16(h[6], h[7]);
                *(u32x4*)rowp = w;
            }
    }
};
struct EpiResGate {
    static constexpr bool PERM = false, AFTER_DRAIN = false;
    const float* base_lat; const float* base_ctx; float* out_lat; float* out_ctx; const float* gate; float f;
    __device__ __forceinline__ void operator()(const f32x4 (&acc)[2][2][4][2], const Unit& u, int wr, int wc, int fr, int fq) const {
        const bool lat = u.pm < 256; const int mb = lat ? (u.pm >> 5) : 8; const int prow = lat ? u.pm : (u.pm - 256);
        const float* base = (lat ? base_lat : base_ctx) + (size_t)prow * BM * 1024; float* out = (lat ? out_lat : out_ctx) + (size_t)prow * BM * 1024;
        const int col0 = u.pn * BM + wc * 32 + 4 * fq;
        f32x4 gv[2][2];
#pragma unroll
        for (int bj = 0; bj < 2; ++bj)
#pragma unroll
            for (int n = 0; n < 2; ++n) gv[bj][n] = *(const f32x4*)(gate + (size_t)mb * 9216 + col0 + bj * HALF + n * 16) * f;
#pragma unroll
        for (int ai = 0; ai < 2; ++ai)
#pragma unroll
            for (int m = 0; m < 4; ++m) { const size_t off = (size_t)(wr * 64 + fr + ai * HALF + m * 16) * 1024 + col0;
#pragma unroll
                for (int bj = 0; bj < 2; ++bj)
#pragma unroll
                    for (int n = 0; n < 2; ++n) { const f32x4 b = *(const f32x4*)(base + off + bj * HALF + n * 16);
                        *(f32x4*)(out + off + bj * HALF + n * 16) = b + gv[bj][n] * acc[ai][bj][m][n]; } }
    }
};
struct EpiStoreBf16 {
    static constexpr bool PERM = true, AFTER_DRAIN = false;
    bf16_t* O; int ldc;
    __device__ __forceinline__ void operator()(const f32x4 (&acc)[2][2][4][2], const Unit& u, int wr, int wc, int fr, int fq) const {
        const int row0 = u.pm * BM + wr * 64 + fr, col0 = u.pn * BM + wc * 32 + 8 * fq;
#pragma unroll
        for (int ai = 0; ai < 2; ++ai)
#pragma unroll
            for (int m = 0; m < 4; ++m) { bf16_t* rowp = O + (size_t)(row0 + ai * HALF + m * 16) * ldc + col0;
#pragma unroll
                for (int bj = 0; bj < 2; ++bj) { const f32x4 v0 = acc[ai][bj][m][0], v1 = acc[ai][bj][m][1];
                    u32x4 w; w.x = cvt_pk_bf16(v0[0], v0[1]); w.y = cvt_pk_bf16(v0[2], v0[3]); w.z = cvt_pk_bf16(v1[0], v1[1]); w.w = cvt_pk_bf16(v1[2], v1[3]);
                    *(u32x4*)(rowp + bj * HALF) = w; } }
    }
};
}

constexpr int NB = 8, SEQ = 8192, DM = 1024, CTXL = 256, DEPTH = 2, DFF = 2816, NMOD = 9, INC = 3584;
constexpr int TL = NB * SEQ, TC = NB * CTXL, TT = TL + TC;
constexpr int C_NAQ = 0, C_NAK = 384, C_NAV = 768, C_SGU = 1152, C_SGV = 1408, C_RQ = 1664, C_RK = 2048, C_RV = 2432, C_GF = 2816, C_GB = 3200;
constexpr int M_NA = 0, M_SG = 384, M_RET = 640;
constexpr int NCH = TT / 128, NCHL = TL / 128;
constexpr int NWAVES = 8;
#ifndef MK_ONE_LAUNCH
#define MK_ONE_LAUNCH 1
#endif
constexpr int NPH = 1 + DEPTH * 12;

constexpr size_t MiB = 1u << 20;
constexpr size_t WS_CTL = 0, CTL_ZERO_BYTES = 1 * MiB;
constexpr size_t WS_MOD = 1 * MiB;
constexpr size_t WS_ROPE = 2 * MiB;
constexpr size_t WS_WSG = 3 * MiB;
constexpr size_t WS_W1T = 4 * MiB, WS_W2T = 48 * MiB, WS_WINT = 70 * MiB, WS_WOUTT = 84 * MiB;
constexpr size_t WS_CTXBUF = 88 * MiB;
constexpr size_t WS_XN = 96 * MiB;
constexpr size_t WS_P = 228 * MiB;
constexpr size_t WS_KV = 690 * MiB;
constexpr size_t WS_PREV = 789 * MiB;
constexpr size_t WS_END = 888 * MiB;
constexpr int CW_BAR = 4096;

constexpr int RING_BYTES = 131072, LDSCTL_OFF = RING_BYTES, MISC_OFF = LDSCTL_OFF + 320, LDS_BYTES = 147456;
#define GAS __attribute__((address_space(1)))
#define LAS __attribute__((address_space(3)))
typedef unsigned short bf16;
typedef unsigned v4u __attribute__((ext_vector_type(4)));
typedef float f32x4 __attribute__((ext_vector_type(4)));
typedef short bf16x8 __attribute__((ext_vector_type(8)));
typedef GAS unsigned gu32;
typedef GAS unsigned long long gu64;
#define RLX_AGENT __ATOMIC_RELAXED, __HIP_MEMORY_SCOPE_AGENT
#define LDS_WAIT() asm volatile("s_waitcnt lgkmcnt(0)" ::: "memory")
#define VM_WAIT() asm volatile("s_waitcnt vmcnt(0)" ::: "memory")
__device__ __forceinline__ unsigned long long rt() { return __builtin_amdgcn_s_memrealtime(); }
__device__ __forceinline__ unsigned f2bf(float f) { unsigned u = __builtin_bit_cast(unsigned, f); return (u + 0x7fffu + ((u >> 16) & 1u)) >> 16; }
__device__ __forceinline__ unsigned pk2(float lo, float hi) { return f2bf(lo) | (f2bf(hi) << 16); }
#define XB_TMO      128
#define XB_XCNT(j)  (256  + 64 * (j))
#define XB_XSUB(j)  (1280 + 64 * (j))
#define XB_XGEN(j)  (2304 + 64 * (j))
#define XB_TOP      3328
#define XB_TOPGEN   3392
#define XCD_BAR_WORDS 3456
#define XB_SPIN_CAP (1u << 18)

__device__ __forceinline__ unsigned xb_ld(unsigned* p)              { return __hip_atomic_load(p, __ATOMIC_RELAXED, __HIP_MEMORY_SCOPE_AGENT); }
__device__ __forceinline__ unsigned xb_add(unsigned* p, unsigned v) { return __hip_atomic_fetch_add(p, v, __ATOMIC_RELAXED, __HIP_MEMORY_SCOPE_AGENT); }
__device__ __forceinline__ unsigned xb_xcc_id() { return (unsigned)__builtin_amdgcn_s_getreg((3 << 11) | 20) & 0xFu; }
#define XB_SPIN(cond, bar) do { unsigned _sp = 0; while (cond) { __builtin_amdgcn_s_sleep(1); \
    if ((++_sp & 255u) == 0u) { if (xb_ld(&(bar)[XB_TMO])) break; if (_sp > XB_SPIN_CAP) { atomicAdd(&(bar)[XB_TMO], 1u); break; } } } } while (0)

struct XcdBarrier {
    unsigned* bar; unsigned x;
    volatile LAS unsigned* st;
};

__device__ __forceinline__ XcdBarrier xcd_barrier_post(unsigned* bar, volatile LAS unsigned* st) {
    XcdBarrier b; b.bar = bar; b.x = xb_xcc_id(); b.st = st;
    if (threadIdx.x == 0) (void)xb_add(&bar[XB_XCNT(b.x)], 1u);
    return b;
}
__device__ __forceinline__ void xcd_barrier_complete(unsigned* bar, unsigned x, unsigned& nloc, unsigned& nx) {
    const unsigned G = gridDim.x * gridDim.y * gridDim.z;
    unsigned sum, cnt, mine, sp = 0u;
    for (;;) {
        sum = 0u; cnt = 0u; mine = 0u;
#pragma unroll
        for (unsigned j = 0; j < 16; ++j) { const unsigned c = xb_ld(&bar[XB_XCNT(j)]); sum += c; cnt += (c > 0u) ? 1u : 0u; mine = (j == x) ? c : mine; }
        if (sum == G) break;
        __builtin_amdgcn_s_sleep(1);
        if ((++sp & 255u) == 0u) { if (xb_ld(&bar[XB_TMO])) break; if (sp > XB_SPIN_CAP) { atomicAdd(&bar[XB_TMO], 1u); break; } }
    }
    nloc = mine > 0u ? mine : 1u; nx = cnt > 0u ? cnt : 1u;
}

__device__ __forceinline__ void xcd_barrier(const XcdBarrier& b) {
    asm volatile("s_waitcnt vmcnt(0)" ::: "memory");
    __syncthreads();
    if (threadIdx.x == 0) {
        unsigned* bar = b.bar;
        __builtin_amdgcn_s_waitcnt(0);
        unsigned nloc = b.st[0], nx = b.st[1];
        if (nloc == 0u) { xcd_barrier_complete(bar, b.x, nloc, nx); b.st[0] = nloc; b.st[1] = nx; }
        const unsigned old = xb_add(&bar[XB_XSUB(b.x)], 1u);
        const unsigned gen = old / nloc;
        if (old + 1u == (gen + 1u) * nloc) {
            __builtin_amdgcn_fence(__ATOMIC_RELEASE, "agent");
            asm volatile("s_waitcnt vmcnt(0)" ::: "memory");
            const unsigned og = xb_add(&bar[XB_TOP], 1u);
            const unsigned tg = og / nx;
            if (og + 1u == (tg + 1u) * nx) xb_add(&bar[XB_TOPGEN], 1u);
            else XB_SPIN(xb_ld(&bar[XB_TOPGEN]) == tg, bar);
            __builtin_amdgcn_fence(__ATOMIC_ACQUIRE, "agent");
            xb_add(&bar[XB_XGEN(b.x)], 1u);
            asm volatile("s_waitcnt vmcnt(0)" ::: "memory");
        } else {
            XB_SPIN(xb_ld(&bar[XB_XGEN(b.x)]) == gen, bar);
            __builtin_amdgcn_fence(__ATOMIC_ACQUIRE, "agent");
            asm volatile("s_waitcnt vmcnt(0)" ::: "memory");
        }
    }
    __syncthreads();
}

typedef unsigned u32x2 __attribute__((ext_vector_type(2)));

#define SHX(v, o) __builtin_bit_cast(float, __builtin_amdgcn_ds_swizzle(__builtin_bit_cast(int, (float)(v)), ((o) << 10) | 0x1f))
__device__ __forceinline__ float xhalf_sum(float v) { auto rr = __builtin_amdgcn_permlane32_swap(__float_as_uint(v), __float_as_uint(v), false, false); return __uint_as_float(rr[0]) + __uint_as_float(rr[1]); }
__device__ __forceinline__ float xhalf_max(float v) { auto rr = __builtin_amdgcn_permlane32_swap(__float_as_uint(v), __float_as_uint(v), false, false); return fmaxf(__uint_as_float(rr[0]), __uint_as_float(rr[1])); }
__device__ __forceinline__ float wave_sum(float v) { v += SHX(v, 1); v += SHX(v, 2); v += SHX(v, 4); v += SHX(v, 8); v += SHX(v, 16); return xhalf_sum(v); }
__device__ __forceinline__ float bflo(unsigned w) { return __uint_as_float(w << 16); }
__device__ __forceinline__ float bfhi(unsigned w) { return __uint_as_float(w & 0xffff0000u); }
__device__ __forceinline__ void load8(const bf16* p, float* o) {
    const v4u w = *(const v4u*)p;
    o[0] = bflo(w.x); o[1] = bfhi(w.x); o[2] = bflo(w.y); o[3] = bfhi(w.y); o[4] = bflo(w.z); o[5] = bfhi(w.z); o[6] = bflo(w.w); o[7] = bfhi(w.w);
}
__device__ __forceinline__ void store8(bf16* p, const float* o) {
    v4u w; w.x = pk2(o[0], o[1]); w.y = pk2(o[2], o[3]); w.z = pk2(o[4], o[5]); w.w = pk2(o[6], o[7]); *(v4u*)p = w;
}
__device__ __forceinline__ float sigmoidf_(float x) { return 1.0f / (1.0f + __expf(-x)); }
__device__ __forceinline__ float gelu_tanh(float x) { const float y = 0.7978845608028654f * (x + 0.044715f * x * x * x); return x * sigmoidf_(2.0f * y); }
__device__ __forceinline__ float log_sigmoid(float x) { return fminf(x, 0.0f) - log1pf(expf(-fabsf(x))); }

__device__ __forceinline__ void p0_transpose_item(const float* W, int K, int N, bf16* WT, bool swiglu, LAS float* scr, int item, int lane) {
    const int nblk = N / 32, kb = item / nblk, nb = item % nblk, k0 = 64 * kb, n0 = 32 * nb;
    int d0 = n0;
    if (swiglu) { const int hid = n0 < DFF ? n0 : n0 - DFF; d0 = (hid >> 7) * 256 + (n0 < DFF ? 0 : 128) + (hid & 127); }
#pragma unroll 8
    for (int i = 0; i < 32; ++i) { const int kk = 2 * i + (lane >> 5); scr[kk * 33 + (lane & 31)] = W[(size_t)(k0 + kk) * N + n0 + (lane & 31)]; }
    LDS_WAIT(); asm volatile("" ::: "memory");
    const int c = lane & 7;
#pragma unroll
    for (int j = 0; j < 4; ++j) { const int n = (lane >> 3) + 8 * j; const LAS float* s = scr + (8 * c) * 33 + n;
        v4u o; o.x = pk2(s[0 * 33], s[1 * 33]); o.y = pk2(s[2 * 33], s[3 * 33]); o.z = pk2(s[4 * 33], s[5 * 33]); o.w = pk2(s[6 * 33], s[7 * 33]);
        *(GAS v4u*)(WT + (size_t)(d0 + n) * K + k0 + 8 * c) = o; }
    LDS_WAIT(); asm volatile("" ::: "memory");
}
struct In { const float *x, *c, *ctx, *c_ctx, *ada_w, *ada_b, *norm_w, *ffn_w1, *ffn_w2, *w_in, *w_out, *na_qn, *na_kn, *na_rpb, *sg_w, *sg_b, *sg_ln_w, *sg_ln_b, *ret_logit, *ret_gn_w; };

__device__ __forceinline__ void p0_prologue(const In& I, unsigned char* ws, LAS unsigned char* lds, int tid, int lane, int wave, int vcu, int G) {
    LAS float* scr = (LAS float*)(lds + wave * 16384);
    const int gw = vcu * NWAVES + wave, NGW = G * NWAVES;
    constexpr int I_W1 = (DM / 64) * (2 * DFF / 32), I_W2 = (DFF / 64) * (DM / 32), I_WIN = (DM / 64) * (INC / 32), I_WOUT = (DM / 64) * (DM / 32);
    constexpr int PER_L = 2 * I_W1 + 2 * I_W2 + I_WIN + I_WOUT;
    bf16* W1T = (bf16*)(ws + WS_W1T); bf16* W2T = (bf16*)(ws + WS_W2T); bf16* WINT = (bf16*)(ws + WS_WINT); bf16* WOUTT = (bf16*)(ws + WS_WOUTT);
    for (int it = gw; it < DEPTH * PER_L; it += NGW) {
        const int L = it / PER_L; int r = it % PER_L;
        if (r < 2 * I_W1) { const int i = r / I_W1; r %= I_W1; const size_t o = (size_t)(L * 2 + i) * DM * 2 * DFF; p0_transpose_item(I.ffn_w1 + o, DM, 2 * DFF, W1T + o, true, scr, r, lane); continue; } r -= 2 * I_W1;
        if (r < 2 * I_W2) { const int i = r / I_W2; r %= I_W2; const size_t o = (size_t)(L * 2 + i) * DFF * DM; p0_transpose_item(I.ffn_w2 + o, DFF, DM, W2T + o, false, scr, r, lane); continue; } r -= 2 * I_W2;
        if (r < I_WIN) { const size_t o = (size_t)L * DM * INC; p0_transpose_item(I.w_in + o, DM, INC, WINT + o, false, scr, r, lane); continue; } r -= I_WIN;
        { const size_t o = (size_t)L * DM * DM; p0_transpose_item(I.w_out + o, DM, DM, WOUTT + o, false, scr, r, lane); }
    }
    __syncthreads();
    LAS float* sc = (LAS float*)lds;
    LAS float* part = (LAS float*)(lds + 36864);
    float* mod = (float*)(ws + WS_MOD);
    for (int cb = blockIdx.x; cb < 256; cb += G) {
        for (int i = tid; i < 9 * 1024; i += 512) { const int mb = i >> 10, k = i & 1023; const float v = mb < 8 ? I.c[mb * 1024 + k] : I.c_ctx[k]; sc[i] = v * sigmoidf_(v); }
        __syncthreads();
        const int cc = tid % 72, kp = tid / 72, colg = cb * 72 + cc, L = colg / 9216, j = colg % 9216;
        if (kp < 7) {
            float acc[9];
#pragma unroll
            for (int mb = 0; mb < 9; ++mb) acc[mb] = 0.f;
            for (int k = kp; k < 1024; k += 7) { const float w = I.ada_w[((size_t)L * 1024 + k) * 9216 + j];
#pragma unroll
                for (int mb = 0; mb < 9; ++mb) acc[mb] += sc[mb * 1024 + k] * w; }
#pragma unroll
            for (int mb = 0; mb < 9; ++mb) part[(kp * 72 + cc) * 9 + mb] = acc[mb];
        }
        __syncthreads();
        for (int o = tid; o < 72 * 9; o += 512) { const int c2 = o / 9, mb = o % 9; const int colg2 = cb * 72 + c2, L2 = colg2 / 9216, j2 = colg2 % 9216;
            float s = I.ada_b[L2 * 9216 + j2];
#pragma unroll
            for (int p = 0; p < 7; ++p) s += part[(p * 72 + c2) * 9 + mb];
            mod[((size_t)L2 * 9 + mb) * 9216 + j2] = s; }
        __syncthreads();
    }
    { bf16* wsg = (bf16*)(ws + WS_WSG); for (int i = blockIdx.x * 512 + tid; i < DEPTH * 4 * 128 * 128 / 8; i += G * 512) { const f32x4 a = ((const f32x4*)I.sg_w)[2 * i], b = ((const f32x4*)I.sg_w)[2 * i + 1];
        v4u o; o.x = pk2(a.x, a.y); o.y = pk2(a.z, a.w); o.z = pk2(b.x, b.y); o.w = pk2(b.z, b.w); ((v4u*)wsg)[i] = o; } }
    if (blockIdx.x == (unsigned)(G - 1)) {
        float* tab = (float*)(ws + WS_ROPE);
        for (int i = tid; i < 128 * 16; i += 512) { const int n = i >> 4, f = i & 15; const float inv = exp2f(-(float)f * (13.287712379549449f / 16.0f)); const float ang = (float)n * inv;
            tab[2 * i] = cosf(ang); tab[2 * i + 1] = sinf(ang); }
    }
}

__device__ __forceinline__ void norm_phase(const float* xl, const float* xc, int nrows, const float* nw, const float* modL, int sidx, bf16* XN, int gw, int NGW, int lane) {
    const int rpw = (nrows + NGW - 1) / NGW; const int r0 = gw * rpw; int r1 = r0 + rpw; if (r1 > nrows) r1 = nrows;
    int cur = -1; f32x4 g[4], sh[4];
#pragma unroll
    for (int j = 0; j < 4; ++j) { g[j] = (f32x4){0.f, 0.f, 0.f, 0.f}; sh[j] = g[j]; }
    for (int r = r0; r < r1; ++r) {
        const int mb = r < TL ? (r >> 13) : 8;
        if (mb != cur) { cur = mb; const float* sf = modL + (size_t)mb * 9216 + sidx * 1024; const float* sl = sf + 1024;
#pragma unroll
            for (int j = 0; j < 4; ++j) { const f32x4 w = ((const f32x4*)nw)[lane + 64 * j], s1 = ((const f32x4*)sl)[lane + 64 * j]; g[j] = w * (s1 + 1.0f); sh[j] = ((const f32x4*)sf)[lane + 64 * j]; } }
        const float* src = r < TL ? xl + (size_t)r * DM : xc + (size_t)(r - TL) * DM;
        f32x4 v[4]; float s = 0.f;
#pragma unroll
        for (int j = 0; j < 4; ++j) { v[j] = ((const f32x4*)src)[lane + 64 * j]; s += (v[j].x * v[j].x + v[j].y * v[j].y) + (v[j].z * v[j].z + v[j].w * v[j].w); }
        const float rstd = 1.0f / sqrtf(wave_sum(s) * (1.0f / DM) + 1e-6f);
        unsigned long long* o8 = (unsigned long long*)(XN + (size_t)r * DM) + lane;
#pragma unroll
        for (int j = 0; j < 4; ++j) { const f32x4 y = v[j] * rstd * g[j] + sh[j]; o8[64 * j] = (unsigned long long)pk2(y.x, y.y) | ((unsigned long long)pk2(y.z, y.w) << 32); }
    }
}

__device__ __forceinline__ void na_naive(const bf16* P, bf16* MIX, const float* wq, const float* wk, const float* rpb, bool with_ctx, int gtid, int nthreads) {
    float mq = 0.f, mk = 0.f, mr = 0.f;
    for (int d = 0; d < 64; ++d) { mq = fmaxf(mq, fabsf(wq[d])); mk = fmaxf(mk, fabsf(wk[d])); }
    for (int i = 0; i < 6 * 15 * 31; ++i) mr = fmaxf(mr, fabsf(rpb[i]));
    const float mbound = 8.0f * mq * mk + mr;
    const int nitems = (TL + (with_ctx ? TC : 0)) * 6;
    for (int item = gtid; item < nitems; item += nthreads) {
        int h, t; bool isctx;
        if (item < TL * 6) { h = item / TL; t = item % TL; isctx = false; } else { const int r = item - TL * 6; h = r / TC; t = TL + r % TC; isctx = true; }
        float q[64], o[64];
        { const bf16* qp = P + (size_t)t * INC + C_NAQ + h * 64; float ss = 0.f;
#pragma unroll
          for (int d8 = 0; d8 < 8; ++d8) { load8(qp + d8 * 8, q + d8 * 8); }
#pragma unroll
          for (int d = 0; d < 64; ++d) ss += q[d] * q[d];
          const float rstd = 1.0f / sqrtf(ss * (1.0f / 64.0f) + 1e-6f);
#pragma unroll
          for (int d = 0; d < 64; ++d) { q[d] = q[d] * rstd * wq[d] * wk[d] * 0.125f; o[d] = 0.f; } }
        float l = 0.f;
        int b, nloc, r = 0, c = 0, rs = 0, cs = 0;
        if (!isctx) { b = t >> 13; const int pos = t & 8191; r = pos >> 6; c = pos & 63; rs = min(max(r - 4, 0), 120); cs = min(max(c - 8, 0), 48); nloc = 128; }
        else { b = (t - TL) >> 8; nloc = 0; }
        for (int kk = 0; kk < nloc + 256; ++kk) {
            int tk; float bias = 0.f;
            if (kk < nloc) { const int i = kk >> 4, j = kk & 15; tk = b * SEQ + (rs + i) * 64 + cs + j; bias = rpb[(h * 15 + (rs + i - r + 7)) * 31 + (cs + j - c + 15)]; }
            else tk = TL + b * CTXL + (kk - nloc);
            const bf16* kp = P + (size_t)tk * INC + C_NAK + h * 64; const bf16* vp = P + (size_t)tk * INC + C_NAV + h * 64;
            float dot = 0.f, ss = 0.f;
#pragma unroll
            for (int d8 = 0; d8 < 8; ++d8) { float k8[8]; load8(kp + d8 * 8, k8);
#pragma unroll
                for (int e = 0; e < 8; ++e) { dot += q[d8 * 8 + e] * k8[e]; ss += k8[e] * k8[e]; } }
            const float s = dot / sqrtf(ss * (1.0f / 64.0f) + 1e-6f) + bias;
            const float p = __expf(s - mbound); l += p;
#pragma unroll
            for (int d8 = 0; d8 < 8; ++d8) { float v8[8]; load8(vp + d8 * 8, v8);
#pragma unroll
                for (int e = 0; e < 8; ++e) o[d8 * 8 + e] += p * v8[e]; }
        }
        const float il = 1.0f / l; bf16* op = MIX + (size_t)t * DM + M_NA + h * 64;
#pragma unroll
        for (int d8 = 0; d8 < 8; ++d8) { float t8[8];
#pragma unroll
            for (int e = 0; e < 8; ++e) t8[e] = o[d8 * 8 + e] * il;
            store8(op + d8 * 8, t8); }
    }
}

__device__ __forceinline__ void sg_naive(const bf16* P, bf16* MIX, const float* sgw, const float* sgb, const float* lnw, const float* lnb, LAS unsigned char* lds, int tid, int G) {
    LAS float* vn = (LAS float*)lds;
    const int tok = tid >> 2, part = tid & 3;
    for (int it = blockIdx.x; it < NCH * 4; it += G) {
        const int ch = it >> 2, g = it & 3, row0 = ch * 128;
        { const bf16* src = P + (size_t)(row0 + tok) * INC + C_SGV + g * 64 + part * 16; float v[16]; load8(src, v); load8(src + 8, v + 8);
          float s = 0.f;
#pragma unroll
          for (int k = 0; k < 16; ++k) { v[k] = gelu_tanh(v[k]); s += v[k]; }
          s += SHX(s, 1); s += SHX(s, 2); const float mu = s * (1.0f / 64.0f); float q = 0.f;
#pragma unroll
          for (int k = 0; k < 16; ++k) { v[k] -= mu; q += v[k] * v[k]; }
          q += SHX(q, 1); q += SHX(q, 2); const float rstd = 1.0f / sqrtf(q * (1.0f / 64.0f) + 1e-5f);
#pragma unroll
          for (int k = 0; k < 16; ++k) { const int cch = g * 64 + part * 16 + k; vn[tok * 64 + part * 16 + k] = v[k] * rstd * lnw[cch] + lnb[cch]; } }
        __syncthreads();
        { float acc[16];
#pragma unroll
          for (int k = 0; k < 16; ++k) acc[k] = 0.f;
          const float* wrow = sgw + ((size_t)g * 128 + tok) * 128;
          for (int q = 0; q < 128; ++q) { const float w = wrow[q];
#pragma unroll
              for (int k = 0; k < 16; ++k) acc[k] += w * vn[q * 64 + part * 16 + k]; }
          const float bias = sgb[g * 128 + tok];
          const bf16* up = P + (size_t)(row0 + tok) * INC + C_SGU + g * 64 + part * 16; float u[16]; load8(up, u); load8(up + 8, u + 8);
#pragma unroll
          for (int k = 0; k < 16; ++k) u[k] = gelu_tanh(u[k]) * (acc[k] + bias);
          bf16* op = MIX + (size_t)(row0 + tok) * DM + M_SG + g * 64 + part * 16; store8(op, u); store8(op + 8, u + 8); }
        __syncthreads();
    }
}

__device__ __forceinline__ void rope_load16(const bf16* P, int row, int colbase, int h, int part, bool latent, const float* ropetab, float* out) {
    const bf16* base = P + (size_t)row * INC + colbase + h * 64;
    float mine[16]; load8(base + part * 16, mine); load8(base + part * 16 + 8, mine + 8);
    if (!latent) {
#pragma unroll
        for (int f = 0; f < 16; ++f) out[f] = mine[f];
        return; }
    float oth[16]; load8(base + (part ^ 1) * 16, oth); load8(base + (part ^ 1) * 16 + 8, oth + 8);
    const int pos = row & (SEQ - 1); const int n = (part < 2) ? (pos >> 6) : (pos & 63);
    const float* tb = ropetab + n * 32;
#pragma unroll
    for (int f = 0; f < 16; ++f) { const float cs = tb[2 * f], sn = tb[2 * f + 1]; out[f] = (part & 1) ? (oth[f] * sn + mine[f] * cs) : (mine[f] * cs - oth[f] * sn); }
}
__device__ __forceinline__ void ret_kv_naive(const bf16* P, float* KV, const float* logit, const float* ropetab, LAS unsigned char* lds, int tid, int G) {
    LAS float* kS = (LAS float*)lds; LAS float* vS = kS + 128 * 64; LAS float* wt = vS + 128 * 64;
    const int tok = tid >> 2, part = tid & 3;
    for (int it = blockIdx.x; it < NCH * 6; it += G) {
        const int ch = it / 6, h = it % 6, row0 = ch * 128; const bool latent = ch < NCHL;
        { float k16[16]; rope_load16(P, row0 + tok, C_RK, h, part, latent, ropetab, k16);
#pragma unroll
          for (int f = 0; f < 16; ++f) kS[tok * 64 + part * 16 + f] = k16[f] * 0.125f;
          const bf16* vp = P + (size_t)(row0 + tok) * INC + C_RV + h * 64 + part * 16; float v16[16]; load8(vp, v16); load8(vp + 8, v16 + 8);
#pragma unroll
          for (int f = 0; f < 16; ++f) vS[tok * 64 + part * 16 + f] = v16[f]; }
        if (tid < 256) { const int dir = tid >> 7, j = tid & 127; const float lg = log_sigmoid(logit[dir * 6 + h]); wt[tid] = expf(lg * (float)(dir == 0 ? 127 - j : j)); }
        __syncthreads();
        { const int d = tid >> 3, e0 = (tid & 7) * 8; float af[8], ab[8];
#pragma unroll
          for (int k = 0; k < 8; ++k) { af[k] = 0.f; ab[k] = 0.f; }
          for (int j = 0; j < 128; ++j) { const float kd = kS[j * 64 + d]; const float a = kd * wt[j], b = kd * wt[128 + j];
#pragma unroll
              for (int k = 0; k < 8; ++k) { const float v = vS[j * 64 + e0 + k]; af[k] += a * v; ab[k] += b * v; } }
          float* of = KV + ((size_t)(ch * 6 + h) * 2 + 0) * 4096 + d * 64 + e0; float* ob = of + 4096;
#pragma unroll
          for (int k = 0; k < 8; ++k) { of[k] = af[k]; ob[k] = ab[k]; } }
        __syncthreads();
    }
}
__device__ __forceinline__ void ret_scan(const float* KV, float* PREV, const float* logit, int gtid, int nthreads) {
    for (int it = gtid; it < NB * 6 * 2 * 4096; it += nthreads) {
        const int idx = it & 4095, dir = (it >> 12) & 1, bh = it >> 13, h = bh % 6, b = bh / 6;
        const float cd = expf(128.0f * log_sigmoid(logit[dir * 6 + h]));
#define KVI(ch) (((size_t)((ch) * 6 + h) * 2 + dir) * 4096 + idx)
        const int c0 = NCHL + 2 * b, c1 = c0 + 1;
        const float k0 = KV[KVI(c0)], k1 = KV[KVI(c1)];
        if (dir == 0) { PREV[KVI(c0)] = 0.f; PREV[KVI(c1)] = k0; float s = cd * k0 + k1;
            for (int n = 0; n < 64; ++n) { const int ch = b * 64 + n; PREV[KVI(ch)] = s; s = cd * s + KV[KVI(ch)]; } }
        else { PREV[KVI(c0)] = k1; PREV[KVI(c1)] = 0.f; float s = k0 + cd * k1;
            for (int n = 63; n >= 0; --n) { const int ch = b * 64 + n; PREV[KVI(ch)] = s; s = cd * s + KV[KVI(ch)]; } }
#undef KVI
    }
}
__device__ __forceinline__ void ret_out_naive(const bf16* P, const float* PREV, bf16* MIX, const float* logit, const float* gnw, const float* ropetab, LAS unsigned char* lds, int tid, int G) {
    LAS bf16* qS = (LAS bf16*)lds; LAS bf16* kS = qS + 128 * 64; LAS bf16* vS = kS + 128 * 64;
    LAS float* S = (LAS float*)(lds + 49152);
    LAS float* dec = (LAS float*)(lds + 49152 + 65536);
    const int tok = tid >> 2, part = tid & 3;
    for (int it = blockIdx.x; it < NCH * 6; it += G) {
        const int ch = it / 6, h = it % 6, row0 = ch * 128; const bool latent = ch < NCHL;
        { float t16[16]; rope_load16(P, row0 + tok, C_RQ, h, part, latent, ropetab, t16);
#pragma unroll
          for (int f = 0; f < 16; ++f) qS[tok * 64 + part * 16 + f] = (bf16)f2bf(t16[f]);
          rope_load16(P, row0 + tok, C_RK, h, part, latent, ropetab, t16);
#pragma unroll
          for (int f = 0; f < 16; ++f) kS[tok * 64 + part * 16 + f] = (bf16)f2bf(t16[f] * 0.125f);
          const bf16* vp = P + (size_t)(row0 + tok) * INC + C_RV + h * 64 + part * 16; const v4u a = *(const v4u*)vp, b = *(const v4u*)(vp + 8);
          *(LAS v4u*)(vS + tok * 64 + part * 16) = a; *(LAS v4u*)(vS + tok * 64 + part * 16 + 8) = b; }
        if (tid < 258) { const int dir = tid / 129, k = tid % 129; dec[tid] = expf(log_sigmoid(logit[dir * 6 + h]) * (float)k); }
        __syncthreads();
        { float q[64];
#pragma unroll
          for (int d = 0; d < 64; ++d) q[d] = __uint_as_float((unsigned)qS[tok * 64 + d] << 16);
          for (int jj = 0; jj < 32; ++jj) { const int j = part + 4 * jj; float dot = 0.f;
#pragma unroll
              for (int d = 0; d < 64; ++d) dot += q[d] * __uint_as_float((unsigned)kS[j * 64 + d] << 16);
              S[tok * 128 + j] = dot; } }
        __syncthreads();
        { const int i = tok, e0 = part * 16; float of[16], ob[16], cf[16], cb[16];
#pragma unroll
          for (int k = 0; k < 16; ++k) { of[k] = 0.f; ob[k] = 0.f; cf[k] = 0.f; cb[k] = 0.f; }
          for (int j = 0; j < 128; ++j) { const float s = S[i * 128 + j]; const float wf = (j <= i) ? s * dec[i - j] : 0.f, wb = (j >= i) ? s * dec[129 + j - i] : 0.f;
#pragma unroll
              for (int k = 0; k < 16; ++k) { const float v = __uint_as_float((unsigned)vS[j * 64 + e0 + k] << 16); of[k] += wf * v; ob[k] += wb * v; } }
          const float* pf = PREV + ((size_t)(ch * 6 + h) * 2) * 4096 + e0; const float* pb = pf + 4096;
          for (int d = 0; d < 64; ++d) { const float qd = __uint_as_float((unsigned)qS[i * 64 + d] << 16);
#pragma unroll
              for (int k = 0; k < 16; ++k) { cf[k] += qd * pf[d * 64 + k]; cb[k] += qd * pb[d * 64 + k]; } }
          const float df = dec[i + 1], db = dec[129 + 128 - i];
          float sf = 0.f, sb = 0.f;
#pragma unroll
          for (int k = 0; k < 16; ++k) { of[k] += df * cf[k]; ob[k] += db * cb[k]; sf += of[k]; sb += ob[k]; }
          sf += SHX(sf, 1); sf += SHX(sf, 2); sb += SHX(sb, 1); sb += SHX(sb, 2);
          const float muf = sf * (1.0f / 64.0f), mub = sb * (1.0f / 64.0f); float qf = 0.f, qb = 0.f;
#pragma unroll
          for (int k = 0; k < 16; ++k) { of[k] -= muf; ob[k] -= mub; qf += of[k] * of[k]; qb += ob[k] * ob[k]; }
          qf += SHX(qf, 1); qf += SHX(qf, 2); qb += SHX(qb, 1); qb += SHX(qb, 2);
          const float rf = 1.0f / sqrtf(qf * (1.0f / 64.0f) + 1e-5f), rb = 1.0f / sqrtf(qb * (1.0f / 64.0f) + 1e-5f);
          const bf16* gp = P + (size_t)(row0 + i) * INC + C_GF + h * 64 + e0; float gf[16], gb[16]; load8(gp, gf); load8(gp + 8, gf + 8); load8(gp + (C_GB - C_GF), gb); load8(gp + (C_GB - C_GF) + 8, gb + 8);
          float y[16];
#pragma unroll
          for (int k = 0; k < 16; ++k) y[k] = (of[k] * rf * (gf[k] * sigmoidf_(gf[k])) + ob[k] * rb * (gb[k] * sigmoidf_(gb[k]))) * gnw[h * 64 + e0 + k];
          bf16* op = MIX + (size_t)(row0 + i) * DM + M_RET + h * 64 + e0; store8(op, y); store8(op + 8, y + 8); }
        __syncthreads();
    }
}

typedef short s16x4 __attribute__((ext_vector_type(4)));
typedef float f32x16 __attribute__((ext_vector_type(16)));
typedef float f32x2_t __attribute__((ext_vector_type(2)));
typedef __bf16 bf16x2_t __attribute__((ext_vector_type(2)));
#define MFMA32(a, b, c) __builtin_amdgcn_mfma_f32_32x32x16_bf16((a), (b), (c), 0, 0, 0)
#define LOG2E 1.4426950408889634f
#define OPQV(x) ({ int _t = (x); asm volatile("" : "+v"(_t)); _t; })
#define FRESH_TID(w) ({ int _t; asm volatile("v_mbcnt_lo_u32_b32 %0, -1, 0\n\tv_mbcnt_hi_u32_b32 %0, -1, %0" : "=v"(_t)); _t | ((w) << 6); })
__device__ __forceinline__ unsigned cvtpk(float lo, float hi) { f32x2_t v = {lo, hi}; bf16x2_t b = __builtin_convertvector(v, bf16x2_t); return __builtin_bit_cast(unsigned, b); }
__device__ __forceinline__ int crow0(int reg) { return (reg & 3) + 8 * (reg >> 2); }
__device__ __forceinline__ int swz64(int row) { return (((row >> 1) & 1) << 2) | (((row >> 3) & 1) << 1) | ((row >> 2) & 1); }
__device__ __forceinline__ int off64(int row, int ch) { return 128 * row + 16 * (ch ^ swz64(row)); }
__device__ __forceinline__ bf16x8 rowfrag(LAS unsigned char* img, int row, int ch) { return *(const LAS bf16x8*)(img + off64(row, ch)); }
__device__ __forceinline__ s16x4 tr4(LAS unsigned char* img, int krow, int ct, int lane) {
    const int q = (lane & 15) >> 2, p = lane & 3, blk = (lane >> 4) & 1;
    return __builtin_bit_cast(s16x4, __builtin_amdgcn_ds_read_tr16_b64_v4i16((LAS s16x4*)(img + off64(krow + q, 4 * ct + 2 * blk + (p >> 1)) + 8 * (p & 1))));
}
__device__ __forceinline__ bf16x8 trfrag(LAS unsigned char* img, int krow_lo, int krow_hi, int ct, int lane) {
    const s16x4 lo = tr4(img, krow_lo, ct, lane), hi = tr4(img, krow_hi, ct, lane);
    return (bf16x8){lo[0], lo[1], lo[2], lo[3], hi[0], hi[1], hi[2], hi[3]};
}
__device__ __forceinline__ void st_chunk(LAS unsigned char* img, int row, int ch, const float* v8) {
    v4u w; w.x = cvtpk(v8[0], v8[1]); w.y = cvtpk(v8[2], v8[3]); w.z = cvtpk(v8[4], v8[5]); w.w = cvtpk(v8[6], v8[7]); *(LAS v4u*)(img + off64(row, ch)) = w;
}
#define PACK8(x, s) __builtin_bit_cast(bf16x8, (v4u){cvtpk((x)[8 * (s)], (x)[8 * (s) + 1]), cvtpk((x)[8 * (s) + 2], (x)[8 * (s) + 3]), cvtpk((x)[8 * (s) + 4], (x)[8 * (s) + 5]), cvtpk((x)[8 * (s) + 6], (x)[8 * (s) + 7])})
__device__ __forceinline__ f32x16 zero16() { f32x16 z;
#pragma unroll
    for (int i = 0; i < 16; ++i) z[i] = 0.f;
    return z; }
__device__ __forceinline__ float wave_max(float v) { v = fmaxf(v, SHX(v, 1)); v = fmaxf(v, SHX(v, 2)); v = fmaxf(v, SHX(v, 4)); v = fmaxf(v, SHX(v, 8)); v = fmaxf(v, SHX(v, 16)); return xhalf_max(v); }

__device__ __forceinline__ void na_mfma(const bf16* P, bf16* MIX, const float* wq, const float* wk, const float* rpb, bool with_ctx, LAS unsigned char* lds, int tid_in, int G) {
    const int wave = __builtin_amdgcn_readfirstlane(tid_in >> 6); int tid = tid_in, lane = tid & 63;
    LAS unsigned char* Kimg = lds; LAS unsigned char* Vimg = lds + 16384;
    LAS float* tab = (LAS float*)(lds + 32768) + 64;
    const float mq = wave_max(fabsf(wq[lane])), mk = wave_max(fabsf(wk[lane]));
    const int nunits = NB * 6 * 32 + (with_ctx ? NB * 6 : 0);
    for (int u = blockIdx.x; u < nunits; u += G) {
        tid = FRESH_TID(wave); lane = tid & 63; const int r32 = lane & 31, hh = lane >> 5;
        const int skey = tid >> 3, spart = tid & 7;
        float wk8[8];
#pragma unroll
        for (int j = 0; j < 8; ++j) wk8[j] = wk[8 * spart + j];
        const bool isctx = u >= NB * 6 * 32; int b, h, r0 = 0;
        if (!isctx) { b = u / 192; h = (u >> 5) % 6; r0 = 4 * (u & 31); } else { const int v = u - NB * 6 * 32; b = v / 6; h = v % 6; }
        float mr = 0.f;
        for (int i = lane; i < 465; i += 64) mr = fmaxf(mr, fabsf(rpb[h * 465 + i]));
        mr = wave_max(mr);
        const float mbound = 8.0f * mq * mk + mr, negmb = -mbound * LOG2E;
        if (!isctx) for (int i = tid; i < 465; i += 512) tab[i] = (rpb[h * 465 + i] - mbound) * LOG2E;
        int r = 0, c = 0, tq;
        if (!isctx) { r = r0 + (wave >> 1); c = 32 * (wave & 1) + r32; tq = b * SEQ + r * 64 + c; } else tq = TL + b * CTXL + wave * 32 + r32;
        bf16x8 qf[4];
        { float qv[32]; float ss = 0.f; const bf16* qp = P + (size_t)tq * INC + C_NAQ + h * 64 + 8 * hh;
#pragma unroll
          for (int s = 0; s < 4; ++s) load8(qp + 16 * s, qv + 8 * s);
#pragma unroll
          for (int i = 0; i < 32; ++i) ss += qv[i] * qv[i];
          ss = xhalf_sum(ss);
          const float rstd = (1.0f / sqrtf(ss * (1.0f / 64.0f) + 1e-6f)) * (0.125f * LOG2E);
#pragma unroll
          for (int s = 0; s < 4; ++s) { float t8[8];
#pragma unroll
              for (int j = 0; j < 8; ++j) { const int d = 16 * s + 8 * hh + j; t8[j] = qv[8 * s + j] * rstd * wq[d] * wk[d]; }
              qf[s] = __builtin_bit_cast(bf16x8, (v4u){cvtpk(t8[0], t8[1]), cvtpk(t8[2], t8[3]), cvtpk(t8[4], t8[5]), cvtpk(t8[6], t8[7])}); } }
        const int rs0 = min(max(r0 - 4, 0), 120);
        const int nl = isctx ? 0 : (min(max(r0 + 3 - 4, 0), 120) + 8 - rs0), nchunks = nl + 4;
        const int rs = min(max(r - 4, 0), 120);
#define NA_TOK(ci) ((ci) < nl ? b * SEQ + (rs0 + (ci)) * 64 + skey : TL + b * CTXL + ((ci) - nl) * 64 + skey)
#define NA_STAGE(buf, kw, vw) do { float k8[8]; k8[0] = bflo(kw.x); k8[1] = bfhi(kw.x); k8[2] = bflo(kw.y); k8[3] = bfhi(kw.y); k8[4] = bflo(kw.z); k8[5] = bfhi(kw.z); k8[6] = bflo(kw.w); k8[7] = bfhi(kw.w); \
            float ss_ = 0.f; _Pragma("unroll") for (int j = 0; j < 8; ++j) ss_ += k8[j] * k8[j]; \
            ss_ += SHX(ss_, 1); ss_ += SHX(ss_, 2); ss_ += SHX(ss_, 4); \
            const float rk_ = 1.0f / sqrtf(ss_ * (1.0f / 64.0f) + 1e-6f); \
            _Pragma("unroll") for (int j = 0; j < 8; ++j) k8[j] *= rk_ * wk8[j]; \
            st_chunk(Kimg + (buf) * 8192, skey, spart, k8); *(LAS v4u*)(Vimg + (buf) * 8192 + off64(skey, spart)) = vw; } while (0)
        v4u kw, vw;
        { const bf16* src = P + (size_t)NA_TOK(0) * INC + h * 64 + 8 * spart; kw = *(const v4u*)(src + C_NAK); vw = *(const v4u*)(src + C_NAV); }
        NA_STAGE(0, kw, vw);
        __syncthreads();
        f32x16 o0 = zero16(), o1 = zero16(); float lsum = 0.f;
        for (int ci = 0; ci < nchunks; ++ci) {
            const int buf = ci & 1;
            if (ci + 1 < nchunks) { const bf16* src = P + (size_t)NA_TOK(ci + 1) * INC + h * 64 + 8 * spart; kw = *(const v4u*)(src + C_NAK); vw = *(const v4u*)(src + C_NAV); }
            const bool local = ci < nl; const int kr = rs0 + ci;
            const bool active = local ? (kr >= rs && kr < rs + 8) : true;
            if (active) {
                const int c_o = OPQV(c), cs_o = min(max(c_o - 8, 0), 48);
                LAS unsigned char* Kb = Kimg + buf * 8192; LAS unsigned char* Vb = Vimg + buf * 8192;
#pragma unroll
                for (int kt = 0; kt < 2; ++kt) {
                    f32x16 x;
                    if (local) { const int bidx = (kr - r + 7) * 31 + 32 * kt + 4 * hh - c_o + 15, t0 = 32 * kt + 4 * hh - cs_o;
#pragma unroll
                        for (int i = 0; i < 16; ++i) { const float tv = tab[bidx + crow0(i)]; x[i] = ((unsigned)(t0 + crow0(i)) < 16u) ? tv : -INFINITY; } }
                    else {
#pragma unroll
                        for (int i = 0; i < 16; ++i) x[i] = negmb; }
#pragma unroll
                    for (int s = 0; s < 4; ++s) x = MFMA32(rowfrag(Kb, 32 * kt + r32, 2 * s + hh), qf[s], x);
#pragma unroll
                    for (int i = 0; i < 16; ++i) { x[i] = __builtin_amdgcn_exp2f(x[i]); lsum += x[i]; }
                    const bf16x8 pa0 = PACK8(x, 0), pa1 = PACK8(x, 1);
                    o0 = MFMA32(trfrag(Vb, 32 * kt + 4 * hh, 32 * kt + 8 + 4 * hh, 0, lane), pa0, o0);
                    o0 = MFMA32(trfrag(Vb, 32 * kt + 16 + 4 * hh, 32 * kt + 24 + 4 * hh, 0, lane), pa1, o0);
                    o1 = MFMA32(trfrag(Vb, 32 * kt + 4 * hh, 32 * kt + 8 + 4 * hh, 1, lane), pa0, o1);
                    o1 = MFMA32(trfrag(Vb, 32 * kt + 16 + 4 * hh, 32 * kt + 24 + 4 * hh, 1, lane), pa1, o1);
                }
            }
            if (ci + 1 < nchunks) NA_STAGE(buf ^ 1, kw, vw);
            __syncthreads();
        }
#undef NA_TOK
#undef NA_STAGE
        lsum = xhalf_sum(lsum);
        const float il = 1.0f / lsum; bf16* op = MIX + (size_t)tq * DM + M_NA + h * 64 + 4 * hh;
#pragma unroll
        for (int g4 = 0; g4 < 4; ++g4) {
            u32x2 w0; w0.x = cvtpk(o0[4 * g4] * il, o0[4 * g4 + 1] * il); w0.y = cvtpk(o0[4 * g4 + 2] * il, o0[4 * g4 + 3] * il); *(u32x2*)(op + 8 * g4) = w0;
            u32x2 w1; w1.x = cvtpk(o1[4 * g4] * il, o1[4 * g4 + 1] * il); w1.y = cvtpk(o1[4 * g4 + 2] * il, o1[4 * g4 + 3] * il); *(u32x2*)(op + 32 + 8 * g4) = w1; }
    }
}

__device__ __forceinline__ void sg_mfma(const bf16* P, bf16* MIX, const bf16* Wsg, const float* sgb, const float* lnw, const float* lnb, LAS unsigned char* lds, int tid_in, int G) {
    const int wave = __builtin_amdgcn_readfirstlane(tid_in >> 6);
    for (int ch = blockIdx.x; ch < NCH; ch += G) {
        const int tid = FRESH_TID(wave), lane = tid & 63, r32 = lane & 31, hh = lane >> 5, tok = tid >> 2, sg = tid & 3;
        const int row0 = ch * 128;
        { const bf16* src = P + (size_t)(row0 + tok) * INC + C_SGV + sg * 64; float v[64]; float s = 0.f;
#pragma unroll
          for (int k8 = 0; k8 < 8; ++k8) load8(src + 8 * k8, v + 8 * k8);
#pragma unroll
          for (int k = 0; k < 64; ++k) { v[k] = gelu_tanh(v[k]); s += v[k]; }
          const float mu = s * (1.0f / 64.0f); float q = 0.f;
#pragma unroll
          for (int k = 0; k < 64; ++k) { v[k] -= mu; q += v[k] * v[k]; }
          const float rstd = 1.0f / sqrtf(q * (1.0f / 64.0f) + 1e-5f);
#pragma unroll
          for (int k8 = 0; k8 < 8; ++k8) { float t8[8];
#pragma unroll
              for (int j = 0; j < 8; ++j) { const int cch = sg * 64 + 8 * k8 + j; t8[j] = v[8 * k8 + j] * rstd * lnw[cch] + lnb[cch]; }
              st_chunk(lds + sg * 16384, tok, k8, t8); } }
        __syncthreads();
        { const int g = wave >> 1; LAS unsigned char* img = lds + g * 16384;
#pragma unroll
          for (int pp = 0; pp < 2; ++pp) { const int pt = 2 * (wave & 1) + pp, p = 32 * pt + r32;
            f32x16 a0 = zero16(), a1 = zero16();
            const bf16* wrow = Wsg + ((size_t)g * 128 + p) * 128 + 8 * hh;
#pragma unroll
            for (int ks = 0; ks < 8; ++ks) { const bf16x8 wf = *(const bf16x8*)(wrow + 16 * ks);
                a0 = MFMA32(trfrag(img, 16 * ks + 8 * hh, 16 * ks + 8 * hh + 4, 0, lane), wf, a0);
                a1 = MFMA32(trfrag(img, 16 * ks + 8 * hh, 16 * ks + 8 * hh + 4, 1, lane), wf, a1); }
            const float bias = sgb[g * 128 + p]; const size_t trow = (size_t)(row0 + p);
            const bf16* up = P + trow * INC + C_SGU + g * 64 + 4 * hh; bf16* op = MIX + trow * DM + M_SG + g * 64 + 4 * hh;
#pragma unroll
            for (int g4 = 0; g4 < 4; ++g4) {
                const u32x2 u0 = *(const u32x2*)(up + 8 * g4), u1 = *(const u32x2*)(up + 32 + 8 * g4);
                u32x2 w0, w1;
                w0.x = cvtpk(gelu_tanh(bflo(u0.x)) * (a0[4 * g4] + bias), gelu_tanh(bfhi(u0.x)) * (a0[4 * g4 + 1] + bias)); w0.y = cvtpk(gelu_tanh(bflo(u0.y)) * (a0[4 * g4 + 2] + bias), gelu_tanh(bfhi(u0.y)) * (a0[4 * g4 + 3] + bias));
                w1.x = cvtpk(gelu_tanh(bflo(u1.x)) * (a1[4 * g4] + bias), gelu_tanh(bfhi(u1.x)) * (a1[4 * g4 + 1] + bias)); w1.y = cvtpk(gelu_tanh(bflo(u1.y)) * (a1[4 * g4 + 2] + bias), gelu_tanh(bfhi(u1.y)) * (a1[4 * g4 + 3] + bias));
                *(u32x2*)(op + 8 * g4) = w0; *(u32x2*)(op + 32 + 8 * g4) = w1; } } }
        __syncthreads();
    }
}

__device__ __forceinline__ void ret_kv_mfma(const bf16* P, float* KV, const float* logit, const float* ropetab, LAS unsigned char* lds, int tid_in, int G) {
    const int wave = __builtin_amdgcn_readfirstlane(tid_in >> 6);
    LAS unsigned char* Kf = lds; LAS unsigned char* Kb = lds + 16384; LAS unsigned char* Vi = lds + 32768;
    for (int it = blockIdx.x; it < NCH * 6; it += G) {
        const int tid = FRESH_TID(wave), lane = tid & 63, r32 = lane & 31, hh = lane >> 5, tok = tid >> 2, part = tid & 3;
        const int ch = it / 6, h = it % 6, row0 = ch * 128; const bool latent = ch < NCHL;
        { const float lgf = log_sigmoid(logit[h]) * LOG2E, lgb = log_sigmoid(logit[6 + h]) * LOG2E;
          const float wf = __builtin_amdgcn_exp2f(lgf * (float)(127 - tok)) * 0.125f, wb = __builtin_amdgcn_exp2f(lgb * (float)tok) * 0.125f;
          float k16[16], t8[8]; rope_load16(P, row0 + tok, C_RK, h, part, latent, ropetab, k16);
#pragma unroll
          for (int c2 = 0; c2 < 2; ++c2) {
#pragma unroll
              for (int j = 0; j < 8; ++j) t8[j] = k16[8 * c2 + j] * wf;
              st_chunk(Kf, tok, 2 * part + c2, t8);
#pragma unroll
              for (int j = 0; j < 8; ++j) t8[j] = k16[8 * c2 + j] * wb;
              st_chunk(Kb, tok, 2 * part + c2, t8); }
          const bf16* vp = P + (size_t)(row0 + tok) * INC + C_RV + h * 64 + part * 16;
          *(LAS v4u*)(Vi + off64(tok, 2 * part)) = *(const v4u*)vp; *(LAS v4u*)(Vi + off64(tok, 2 * part + 1)) = *(const v4u*)(vp + 8); }
        __syncthreads();
        { const int dir = wave >> 2, et = (wave >> 1) & 1, dt = wave & 1; LAS unsigned char* Kd = dir ? Kb : Kf;
          f32x16 acc = zero16();
#pragma unroll
          for (int ks = 0; ks < 8; ++ks)
              acc = MFMA32(trfrag(Vi, 16 * ks + 8 * hh, 16 * ks + 8 * hh + 4, et, lane), trfrag(Kd, 16 * ks + 8 * hh, 16 * ks + 8 * hh + 4, dt, lane), acc);
          float* o = KV + ((size_t)(ch * 6 + h) * 2 + dir) * 4096 + (size_t)(32 * et + 4 * hh) * 64 + 32 * dt + r32;
#pragma unroll
          for (int i = 0; i < 16; ++i) o[crow0(i) * 64] = acc[i]; }
        __syncthreads();
    }
}
__device__ __forceinline__ void ret_scan2(const float* KV, bf16* PREV, const float* logit, int gtid, int nthreads) {
    for (int it = gtid; it < NB * 6 * 2 * 4096; it += nthreads) {
        const int idx = it & 4095, dir = (it >> 12) & 1, bh = it >> 13, h = bh % 6, b = bh / 6;
        const float cd = expf(128.0f * log_sigmoid(logit[dir * 6 + h]));
#define KVI(ch) (((size_t)((ch) * 6 + h) * 2 + dir) * 4096 + idx)
        const int c0 = NCHL + 2 * b, c1 = c0 + 1;
        const float k0 = KV[KVI(c0)], k1 = KV[KVI(c1)];
        if (dir == 0) { PREV[KVI(c0)] = 0; PREV[KVI(c1)] = (bf16)f2bf(k0); float s = cd * k0 + k1;
            for (int n = 0; n < 64; ++n) { const int ch = b * 64 + n; PREV[KVI(ch)] = (bf16)f2bf(s); s = cd * s + KV[KVI(ch)]; } }
        else { PREV[KVI(c0)] = (bf16)f2bf(k1); PREV[KVI(c1)] = 0; float s = k0 + cd * k1;
            for (int n = 63; n >= 0; --n) { const int ch = b * 64 + n; PREV[KVI(ch)] = (bf16)f2bf(s); s = cd * s + KV[KVI(ch)]; } }
#undef KVI
    }
}
__device__ __forceinline__ void ret_out_mfma(const bf16* P, const bf16* PREV, bf16* MIX, const float* logit, const float* gnw, const float* ropetab, LAS unsigned char* lds, int tid_in, int G) {
    const int wave = __builtin_amdgcn_readfirstlane(tid_in >> 6);
    LAS unsigned char* Qi = lds; LAS unsigned char* Ki = lds + 16384; LAS unsigned char* Vi = lds + 32768;
    LAS float* st = (LAS float*)(lds + 49152);
    const int it_ = wave >> 1, et = wave & 1;
    for (int itm = blockIdx.x; itm < NCH * 6; itm += G) {
        const int tid = FRESH_TID(wave), lane = tid & 63, r32 = lane & 31, hh = lane >> 5, tok = tid >> 2, part = tid & 3;
        const int ch = itm / 6, h = itm % 6, row0 = ch * 128; const bool latent = ch < NCHL;
        { float t16[16], t8[8]; rope_load16(P, row0 + tok, C_RQ, h, part, latent, ropetab, t16);
          st_chunk(Qi, tok, 2 * part, t16); st_chunk(Qi, tok, 2 * part + 1, t16 + 8);
          rope_load16(P, row0 + tok, C_RK, h, part, latent, ropetab, t16);
#pragma unroll
          for (int c2 = 0; c2 < 2; ++c2) {
#pragma unroll
              for (int j = 0; j < 8; ++j) t8[j] = t16[8 * c2 + j] * 0.125f;
              st_chunk(Ki, tok, 2 * part + c2, t8); }
          const bf16* vp = P + (size_t)(row0 + tok) * INC + C_RV + h * 64 + part * 16;
          *(LAS v4u*)(Vi + off64(tok, 2 * part)) = *(const v4u*)vp; *(LAS v4u*)(Vi + off64(tok, 2 * part + 1)) = *(const v4u*)(vp + 8); }
        __syncthreads();
        const float lgf = log_sigmoid(logit[h]) * LOG2E, lgb = log_sigmoid(logit[6 + h]) * LOG2E;
        const int il = 32 * it_ + r32;
        bf16x8 qf[4];
#pragma unroll
        for (int s = 0; s < 4; ++s) qf[s] = rowfrag(Qi, il, 2 * s + hh);
        f32x16 of = zero16(), ob = zero16();
#pragma unroll
        for (int jt = 0; jt < 4; ++jt) {
            f32x16 x = zero16();
#pragma unroll
            for (int s = 0; s < 4; ++s) x = MFMA32(rowfrag(Ki, 32 * jt + r32, 2 * s + hh), qf[s], x);
            if (jt <= it_) { f32x16 w;
#pragma unroll
                for (int i = 0; i < 16; ++i) { const int jl = 32 * jt + crow0(i) + 4 * hh; w[i] = (jl <= il) ? x[i] * __builtin_amdgcn_exp2f(lgf * (float)(il - jl)) : 0.f; }
                const bf16x8 p0 = PACK8(w, 0), p1 = PACK8(w, 1);
                of = MFMA32(trfrag(Vi, 32 * jt + 4 * hh, 32 * jt + 8 + 4 * hh, et, lane), p0, of);
                of = MFMA32(trfrag(Vi, 32 * jt + 16 + 4 * hh, 32 * jt + 24 + 4 * hh, et, lane), p1, of); }
            if (jt >= it_) { f32x16 w;
#pragma unroll
                for (int i = 0; i < 16; ++i) { const int jl = 32 * jt + crow0(i) + 4 * hh; w[i] = (jl >= il) ? x[i] * __builtin_amdgcn_exp2f(lgb * (float)(jl - il)) : 0.f; }
                const bf16x8 p0 = PACK8(w, 0), p1 = PACK8(w, 1);
                ob = MFMA32(trfrag(Vi, 32 * jt + 4 * hh, 32 * jt + 8 + 4 * hh, et, lane), p0, ob);
                ob = MFMA32(trfrag(Vi, 32 * jt + 16 + 4 * hh, 32 * jt + 24 + 4 * hh, et, lane), p1, ob); }
        }
        { const bf16* pf = PREV + ((size_t)(ch * 6 + h) * 2) * 4096 + (size_t)(32 * et + r32) * 64 + 8 * hh; const bf16* pb = pf + 4096;
          f32x16 cf = zero16(), cb = zero16();
#pragma unroll
          for (int s = 0; s < 4; ++s) { cf = MFMA32(*(const bf16x8*)(pf + 16 * s), qf[s], cf); cb = MFMA32(*(const bf16x8*)(pb + 16 * s), qf[s], cb); }
          const float df = __builtin_amdgcn_exp2f(lgf * (float)(il + 1)), db = __builtin_amdgcn_exp2f(lgb * (float)(128 - il));
#pragma unroll
          for (int i = 0; i < 16; ++i) { of[i] += df * cf[i]; ob[i] += db * cb[i]; } }
        float s1f = 0.f, s2f = 0.f, s1b = 0.f, s2b = 0.f;
#pragma unroll
        for (int i = 0; i < 16; ++i) { s1f += of[i]; s2f += of[i] * of[i]; s1b += ob[i]; s2b += ob[i] * ob[i]; }
        s1f = xhalf_sum(s1f); s2f = xhalf_sum(s2f); s1b = xhalf_sum(s1b); s2b = xhalf_sum(s2b);
        if (hh == 0) { LAS float* sp = st + (wave * 32 + r32) * 4; sp[0] = s1f; sp[1] = s2f; sp[2] = s1b; sp[3] = s2b; }
        __syncthreads();
        { const LAS float* sp = st + ((wave ^ 1) * 32 + r32) * 4; s1f += sp[0]; s2f += sp[1]; s1b += sp[2]; s2b += sp[3]; }
        const float muf = s1f * (1.0f / 64.0f), mub = s1b * (1.0f / 64.0f);
        const float rf = 1.0f / sqrtf(fmaxf(s2f * (1.0f / 64.0f) - muf * muf, 0.f) + 1e-5f), rb = 1.0f / sqrtf(fmaxf(s2b * (1.0f / 64.0f) - mub * mub, 0.f) + 1e-5f);
        { const size_t trow = (size_t)(row0 + il); const int e0 = h * 64 + 32 * et + 4 * hh;
          const bf16* gp = P + trow * INC + C_GF + e0; bf16* op = MIX + trow * DM + M_RET + e0;
#pragma unroll
          for (int g4 = 0; g4 < 4; ++g4) { const u32x2 gfw = *(const u32x2*)(gp + 8 * g4), gbw = *(const u32x2*)(gp + (C_GB - C_GF) + 8 * g4);
              const float gfv[4] = {bflo(gfw.x), bfhi(gfw.x), bflo(gfw.y), bfhi(gfw.y)}, gbv[4] = {bflo(gbw.x), bfhi(gbw.x), bflo(gbw.y), bfhi(gbw.y)};
              float y[4];
#pragma unroll
              for (int k = 0; k < 4; ++k) { const int i = 4 * g4 + k;
                  y[k] = ((of[i] - muf) * rf * (gfv[k] * sigmoidf_(gfv[k])) + (ob[i] - mub) * rb * (gbv[k] * sigmoidf_(gbv[k]))) * gnw[e0 + 8 * g4 + k]; }
              u32x2 w; w.x = cvtpk(y[0], y[1]); w.y = cvtpk(y[2], y[3]); *(u32x2*)(op + 8 * g4) = w; } }
        __syncthreads();
    }
}

struct Args { In in; float* out; unsigned char* ws; int ph_lo, ph_hi; };
__global__ void __launch_bounds__(NWAVES * 64, 2) hybrid_fwd(Args args) {
    extern __shared__ __attribute__((aligned(16))) unsigned char lds_raw[];
    LAS unsigned char* lds = (LAS unsigned char*)lds_raw;
    volatile LAS unsigned* MISC = (volatile LAS unsigned*)(lds + MISC_OFF);
    const int tid = threadIdx.x, lane = tid & 63, wave = __builtin_amdgcn_readfirstlane(tid >> 6);
    const int G = gridDim.x; const int bx = blockIdx.x; const int vcu = (G % 8 == 0) ? (bx % 8) * (G / 8) + bx / 8 : bx;
    const int NGW = G * NWAVES, nthreads = G * NWAVES * 64;
    unsigned char* ws = args.ws; const In& I = args.in;
    gu32* ctl = (gu32*)(ws + WS_CTL);
    for (int u = tid; u < (LDS_BYTES - LDSCTL_OFF) / 4; u += NWAVES * 64) ((LAS unsigned*)(lds + LDSCTL_OFF))[u] = 0u;
    __syncthreads();
    XcdBarrier bar; bar.bar = (unsigned*)(ctl + CW_BAR); bar.x = 0; bar.st = nullptr;
    if (MK_ONE_LAUNCH) bar = xcd_barrier_post((unsigned*)(ctl + CW_BAR), MISC + 8);
    const int lo = args.ph_lo, hi = args.ph_hi; int ph = 0;
#define PH_ON (ph >= lo && ph < hi)
#define OPQ(x) ({ int _t; asm volatile("v_mbcnt_lo_u32_b32 %0, -1, 0\n\tv_mbcnt_hi_u32_b32 %0, -1, %0" : "=v"(_t)); _t | (wave << 6); })
#define PH_END do { if (MK_ONE_LAUNCH && ph >= lo && ph + 1 < hi) xcd_barrier(bar); ++ph; } while (0)

    float* mod = (float*)(ws + WS_MOD); const float* ropetab = (const float*)(ws + WS_ROPE);
    bf16* W1T = (bf16*)(ws + WS_W1T); bf16* W2T = (bf16*)(ws + WS_W2T); bf16* WINT = (bf16*)(ws + WS_WINT); bf16* WOUTT = (bf16*)(ws + WS_WOUTT);
    float* ctxbuf = (float*)(ws + WS_CTXBUF); bf16* XN = (bf16*)(ws + WS_XN); bf16* PB = (bf16*)(ws + WS_P); bf16* HB = (bf16*)(ws + WS_P);
    float* KV = (float*)(ws + WS_KV); float* PREV = (float*)(ws + WS_PREV);

    if (PH_ON) p0_prologue(I, ws, lds, tid, lane, wave, vcu, G);
    PH_END;

    for (int hs = 0; hs < 2 * DEPTH; ++hs) {
        const int L = hs >> 1, half = hs & 1; const bool last = (L == DEPTH - 1), first = (hs == 0);
        const int Mrows = (last && half == 1) ? TL : TT;
        const float* modL = mod + (size_t)L * 9 * 9216;
        const float* xl = first ? I.x : args.out; const float* xc = first ? I.ctx : ctxbuf;
        if (PH_ON) { const int t_ = OPQ(threadIdx.x); norm_phase(xl, xc, Mrows, I.norm_w + (size_t)(L * 3 + (half ? 2 : 0)) * DM, modL, half ? 6 : 0, XN, vcu * NWAVES + (t_ >> 6), NGW, t_ & 63); }
        PH_END;
        if (PH_ON) { pg8::Gemm g{XN, W1T + (size_t)(L * 2 + half) * DM * 2 * DFF, Mrows, 2 * DFF, DM}; pg8::StaticOrder S; S.init(Mrows, 2 * DFF, G, bx);
            pg8::EpiSwiGLU E{HB, DFF};
            pg8::gemm_phase<pg8::EpiSwiGLU, pg8::StaticOrder, true, true>(lds, g, S, E, wave); }
        PH_END;
        if (PH_ON) { pg8::Gemm g{HB, W2T + (size_t)(L * 2 + half) * DFF * DM, Mrows, DM, DFF}; pg8::StaticOrder S; S.init(Mrows, DM, G, bx);
            pg8::EpiResGate E{xl, xc, args.out, ctxbuf, modL + (half ? 8 : 2) * 1024, 0.5f};
            pg8::gemm_phase<pg8::EpiResGate, pg8::StaticOrder, true, true>(lds, g, S, E, wave); }
        PH_END;
        if (half == 0) {
            if (PH_ON) { const int t_ = OPQ(threadIdx.x); norm_phase(args.out, ctxbuf, TT, I.norm_w + (size_t)(L * 3 + 1) * DM, modL, 3, XN, vcu * NWAVES + (t_ >> 6), NGW, t_ & 63); }
            PH_END;
            if (PH_ON) { pg8::Gemm g{XN, WINT + (size_t)L * DM * INC, TT, INC, DM}; pg8::StaticOrder S; S.init(TT, INC, G, bx);
                pg8::EpiStoreBf16 E{PB, INC};
                pg8::gemm_phase<pg8::EpiStoreBf16, pg8::StaticOrder, true, true>(lds, g, S, E, wave); }
            PH_END;
            const float* logit = I.ret_logit + L * 12;
            if (PH_ON) { const int t_ = OPQ(threadIdx.x);
                na_mfma(PB, XN, I.na_qn + L * 64, I.na_kn + L * 64, I.na_rpb + (size_t)L * 6 * 15 * 31, !last, lds, t_, G);
                sg_mfma(PB, XN, (const bf16*)(ws + WS_WSG) + (size_t)L * 4 * 128 * 128, I.sg_b + L * 4 * 128, I.sg_ln_w + L * 256, I.sg_ln_b + L * 256, lds, t_, G);
                ret_kv_mfma(PB, KV, logit, ropetab, lds, t_, G);
            }
            PH_END;
            if (PH_ON) { const int t_ = OPQ(threadIdx.x); ret_scan2(KV, (bf16*)PREV, logit, bx * (NWAVES * 64) + t_, nthreads); }
            PH_END;
            if (PH_ON) { const int t_ = OPQ(threadIdx.x); ret_out_mfma(PB, (const bf16*)PREV, XN, logit, I.ret_gn_w + L * 384, ropetab, lds, t_, G); }
            PH_END;
            const int Mo = last ? TL : TT;
            if (PH_ON) { pg8::Gemm g{XN, WOUTT + (size_t)L * DM * DM, Mo, DM, DM}; pg8::StaticOrder S; S.init(Mo, DM, G, bx);
                pg8::EpiResGate E{args.out, ctxbuf, args.out, ctxbuf, modL + 5 * 1024, 1.0f};
                pg8::gemm_phase<pg8::EpiResGate, pg8::StaticOrder, true, true>(lds, g, S, E, wave); }
            PH_END;
        }
    }
#undef PH_ON
#undef PH_END
}

extern "C" void kernel_launch(void* const* d_in, const int* in_sizes, int n_in, void* d_out, int out_size, void* d_ws, size_t ws_size, hipStream_t stream) {
    static int grid = 0;
    if (grid == 0) {
        if (n_in != 20 || in_sizes[0] != TL * DM || out_size != TL * DM || ws_size < WS_END) { fprintf(stderr, "kernel_launch: unexpected shapes (n_in %d, in0 %d, out %d, ws %zu); nothing launched\n", n_in, n_in > 0 ? in_sizes[0] : -1, out_size, ws_size); grid = -1; return; }
        int dev = 0, cus = 0, per_cu = 0;
        if (hipGetDevice(&dev) != hipSuccess || hipDeviceGetAttribute(&cus, hipDeviceAttributeMultiprocessorCount, dev) != hipSuccess) { grid = -1; return; }
        if (hipFuncSetAttribute((const void*)hybrid_fwd, hipFuncAttributeMaxDynamicSharedMemorySize, LDS_BYTES) != hipSuccess) { fprintf(stderr, "kernel_launch: hipFuncSetAttribute failed\n"); grid = -1; return; }
        if (hipOccupancyMaxActiveBlocksPerMultiprocessor(&per_cu, (const void*)hybrid_fwd, NWAVES * 64, LDS_BYTES) != hipSuccess || per_cu < 1)
            fprintf(stderr, "kernel_launch: note: occupancy query reports %d workgroups per CU\n", per_cu);
        (void)hipGetLastError();
        grid = cus;
    }
    if (grid < 0) return;
    if (hipMemsetAsync((char*)d_ws + WS_CTL, 0, CTL_ZERO_BYTES, stream) != hipSuccess) return;
    Args a{};
    const float** ip = (const float**)&a.in;
    for (int i = 0; i < 20; ++i) ip[i] = (const float*)d_in[i];
    a.out = (float*)d_out; a.ws = (unsigned char*)d_ws;
#if MK_ONE_LAUNCH
    a.ph_lo = 0; a.ph_hi = NPH;
    hipLaunchKernelGGL(hybrid_fwd, dim3(grid), dim3(NWAVES * 64), LDS_BYTES, stream, a);
#else
    for (int li = 0; li < NPH; ++li) { a.ph_lo = li; a.ph_hi = li + 1; hipLaunchKernelGGL(hybrid_fwd, dim3(grid), dim3(NWAVES * 64), LDS_BYTES, stream, a); }
#endif
}
```

```cpp
#include <hip/hip_runtime.h>
#include <cstdio>
#include <cstdint>
namespace pg8 {
#define PG8_LAS __attribute__((address_space(3)))
typedef unsigned short bf16_t;
typedef short bf16x8 __attribute__((ext_vector_type(8)));
typedef float f32x4 __attribute__((ext_vector_type(4)));
typedef unsigned u32x4 __attribute__((ext_vector_type(4)));
constexpr int BM = 256, BK = 64, HALF = 128, HTB = HALF * BK * 2  , STAGE_BYTES = 8 * HTB, NXCD = 8, WGM = 8;

__host__ __device__ __forceinline__ int lds_byte(int r, int c) { const int st = (r >> 4) * 2 + (c >> 5), rr = r & 15, cc = c & 31, ob = rr * 64 + cc * 2; return st * 1024 + (ob ^ (((ob >> 9) & 1) << 5)); }
__host__ __device__ __forceinline__ void stage_rc(int b, int& R, int& C) { const int st = b / 1024, sb = b % 1024, swz = sb ^ (((sb >> 9) & 1) << 5); R = (st >> 1) * 16 + swz / 64; C = (st & 1) * 32 + (swz % 64) / 2; }
__host__ __device__ __forceinline__ int perm32(int rho) { const int n = rho >> 4, i = rho & 15; return 8 * (i >> 2) + 4 * n + (i & 3); }

struct Unit { int pm, pn; };
struct Gemm { const bf16_t* A; const bf16_t* Bt; int M, N, K; };

struct StaticOrder {
    int nM, nN, nwg, G, c;
    __host__ __device__ void init(int M, int N, int G_, int c_) { nM = M / BM; nN = N / BM; nwg = nM * nN; G = G_; c = c_; }
    __host__ __device__ bool next(int i, Unit& u) const {
        const long L = (long)i * G + c; if (L >= nwg) return false;
        int wgid = (int)L; { const int q = nwg / NXCD, r = nwg % NXCD, xcd = wgid % NXCD, off = wgid / NXCD; wgid = (xcd < r ? xcd * (q + 1) : r * (q + 1) + (xcd - r) * q) + off; }
        const int nig = WGM * nN, gid = wgid / nig, fm = gid * WGM, gsz = (nM - fm) < WGM ? (nM - fm) : WGM;
        u.pm = fm + ((wgid % nig) % gsz); u.pn = (wgid % nig) / gsz; return true;
    }
    __device__ __forceinline__ void a_ready(const Unit&) const {}
    __device__ __forceinline__ void done(const Unit&) const {}
};
__device__ __forceinline__ unsigned cvt_pk_bf16(float lo, float hi) { unsigned r; asm volatile("v_cvt_pk_bf16_f32 %0, %1, %2" : "=v"(r) : "v"(lo), "v"(hi)); return r; }
typedef float f32x2 __attribute__((ext_vector_type(2)));
template <class Epi, class Sched, bool ALIGN_EPI = false, bool SP2 = false>
__device__ __forceinline__ void gemm_phase(PG8_LAS unsigned char* lds, const Gemm g, const Sched& S, const Epi& E, const int wave_s) {
    int tid_o; asm volatile("v_mbcnt_lo_u32_b32 %0, -1, 0\n\tv_mbcnt_hi_u32_b32 %0, -1, %0" : "=v"(tid_o)); tid_o |= wave_s << 6;
    const int tid = tid_o, wid = __builtin_amdgcn_readfirstlane(tid >> 6), lane = tid & 63, wr = wid >> 2, wc = wid & 3, fr = lane & 15, fq = lane >> 4;
    const int K = g.K, nt = K / BK;
    unsigned voffA[2], voffB[2];
#pragma unroll
    for (int i = 0; i < 2; ++i) { int R, C; stage_rc(tid * 16 + i * 8192, R, C); const int Rb = Epi::PERM ? ((R & ~31) + perm32(R & 31)) : R;
        voffA[i] = (unsigned)(R * K + C) * 2u; voffB[i] = (unsigned)(Rb * K + C) * 2u; }
    const size_t kstep = (size_t)(BK * 2);
    const size_t hstep = (size_t)HALF * K * 2;
    const size_t tstep = 2 * hstep;
    const unsigned ldsw = (unsigned)wid * 1024u;
    const int aoff = lds_byte(wr * 64 + fr, fq * 8), boff = lds_byte(wc * 32 + fr, fq * 8);
#define PG8_SA(b, h) (((b) * 2 + (h)) * HTB)
#define PG8_SB(b, h) ((4 + (b) * 2 + (h)) * HTB)
#define PG8_STAGE(bufoff, gbase, voff) do { _Pragma("unroll") for (int _i = 0; _i < 2; ++_i) \
        __builtin_amdgcn_global_load_lds((const unsigned*)((const char*)(gbase) + (voff)[_i]), (PG8_LAS unsigned*)(lds + (bufoff) + ldsw + _i * 8192), 16, 0, 0); } while (0)
#define PG8_LDA(dst, b, h) do { _Pragma("unroll") for (int m = 0; m < 4; ++m) _Pragma("unroll") for (int k = 0; k < 2; ++k) dst[m][k] = *(const PG8_LAS bf16x8*)(lds + PG8_SA(b, h) + aoff + m * 2048 + k * 1024); } while (0)
#define PG8_LDB(dst, b, h) do { _Pragma("unroll") for (int n = 0; n < 2; ++n) _Pragma("unroll") for (int k = 0; k < 2; ++k) dst[n][k] = *(const PG8_LAS bf16x8*)(lds + PG8_SB(b, h) + boff + n * 2048 + k * 1024); } while (0)
#define PG8_MMA(ai, bj, At, Bt) do { __builtin_amdgcn_s_setprio(1); _Pragma("unroll") for (int m = 0; m < 4; ++m) _Pragma("unroll") for (int n = 0; n < 2; ++n) _Pragma("unroll") for (int k = 0; k < 2; ++k) \
        acc[ai][bj][m][n] = __builtin_amdgcn_mfma_f32_16x16x32_bf16(Bt[n][k], At[m][k], acc[ai][bj][m][n], 0, 0, 0); __builtin_amdgcn_s_setprio(0); } while (0)
#define PG8_WAIT_V(n) asm volatile("s_waitcnt vmcnt(" #n ")" ::: "memory")
#define PG8_WAIT_L(n) asm volatile("s_waitcnt lgkmcnt(" #n ")" ::: "memory")
#define PG8_BAR __builtin_amdgcn_s_barrier()
#define PG8_SCHED __builtin_amdgcn_sched_barrier(0)
    Unit cur, nxt; int ui = 0;
    if (!S.next(0, cur)) return;
    f32x4 acc[2][2][4][2];
#pragma unroll
    for (int a = 0; a < 2; ++a)
#pragma unroll
        for (int b = 0; b < 2; ++b)
#pragma unroll
            for (int m = 0; m < 4; ++m)
#pragma unroll
                for (int n = 0; n < 2; ++n) acc[a][b][m][n] = (f32x4){0.f, 0.f, 0.f, 0.f};
    bf16x8 At[4][2], B0[2][2], B1[2][2];
    const char* cA = (const char*)g.A + (size_t)cur.pm * tstep; const char* cB = (const char*)g.Bt + (size_t)cur.pn * tstep;
    S.a_ready(cur);
    if constexpr (SP2) {
        PG8_STAGE(PG8_SB(0, 0), cB, voffB); PG8_STAGE(PG8_SB(0, 1), cB + hstep, voffB); PG8_STAGE(PG8_SA(0, 0), cA, voffA); PG8_STAGE(PG8_SA(0, 1), cA + hstep, voffA);
        if (wr == 1) PG8_BAR;
        PG8_WAIT_V(2); PG8_BAR;
        PG8_STAGE(PG8_SB(1, 0), cB + kstep, voffB); PG8_STAGE(PG8_SA(1, 0), cA + kstep, voffA); PG8_STAGE(PG8_SB(1, 1), cB + hstep + kstep, voffB);
        PG8_WAIT_V(6); PG8_BAR;
    } else {
        PG8_STAGE(PG8_SB(0, 0), cB, voffB); PG8_STAGE(PG8_SA(0, 0), cA, voffA); PG8_STAGE(PG8_SB(0, 1), cB + hstep, voffB); PG8_STAGE(PG8_SA(0, 1), cA + hstep, voffA);
        if (wr == 1) PG8_BAR;
        PG8_WAIT_V(4); PG8_BAR;
        PG8_STAGE(PG8_SB(1, 0), cB + kstep, voffB); PG8_STAGE(PG8_SA(1, 0), cA + kstep, voffA); PG8_STAGE(PG8_SB(1, 1), cB + hstep + kstep, voffB);
        PG8_WAIT_V(6); PG8_BAR;
    }
    for (;;) {
        const bool has_next = S.next(ui + 1, nxt);
        const char* nA = has_next ? (const char*)g.A + (size_t)nxt.pm * tstep : cA; const char* nB = has_next ? (const char*)g.Bt + (size_t)nxt.pn * tstep : cB;
        for (int t = 0; t < nt; t += 2) {
            const bool last = (t == nt - 2);
            const char* a1 = cA + (size_t)(t + 1) * kstep;
            const char* a2 = last ? nA : cA + (size_t)(t + 2) * kstep; const char* b2 = last ? nB : cB + (size_t)(t + 2) * kstep;
            const char* a3 = a2 + kstep; const char* b3 = b2 + kstep;
            if (last && has_next) S.a_ready(nxt);
            if constexpr (SP2) {
            PG8_LDB(B0, 0, 0); PG8_LDB(B1, 0, 1); PG8_SCHED; PG8_LDA(At, 0, 0); PG8_STAGE(PG8_SA(1, 1), a1 + hstep, voffA);
            PG8_WAIT_V(8); PG8_WAIT_L(0); PG8_BAR; PG8_MMA(0, 0, At, B0); PG8_MMA(0, 1, At, B1); PG8_BAR; PG8_SCHED;
            PG8_LDA(At, 0, 1); PG8_STAGE(PG8_SB(0, 0), b2, voffB); PG8_STAGE(PG8_SB(0, 1), b2 + hstep, voffB); PG8_STAGE(PG8_SA(0, 0), a2, voffA);
            PG8_WAIT_V(8); PG8_WAIT_L(0); PG8_BAR; PG8_MMA(1, 0, At, B0); PG8_MMA(1, 1, At, B1); PG8_BAR; PG8_SCHED;
            PG8_LDB(B0, 1, 0); PG8_LDB(B1, 1, 1); PG8_SCHED; PG8_LDA(At, 1, 0); PG8_STAGE(PG8_SA(0, 1), a2 + hstep, voffA);
            PG8_WAIT_V(8); PG8_WAIT_L(0); PG8_BAR; PG8_MMA(0, 0, At, B0); PG8_MMA(0, 1, At, B1); PG8_BAR; PG8_SCHED;
            PG8_LDA(At, 1, 1); PG8_STAGE(PG8_SB(1, 0), b3, voffB); PG8_STAGE(PG8_SB(1, 1), b3 + hstep, voffB); PG8_STAGE(PG8_SA(1, 0), a3, voffA);
            PG8_WAIT_V(8); PG8_WAIT_L(0); PG8_BAR; PG8_MMA(1, 0, At, B0); PG8_MMA(1, 1, At, B1); PG8_BAR; PG8_SCHED;
            } else {
            PG8_LDB(B0, 0, 0); PG8_SCHED; PG8_LDA(At, 0, 0); PG8_STAGE(PG8_SA(1, 1), a1 + hstep, voffA);
            PG8_WAIT_L(8); PG8_BAR; PG8_WAIT_L(0); PG8_MMA(0, 0, At, B0); PG8_BAR; PG8_SCHED;
            PG8_LDB(B1, 0, 1); PG8_STAGE(PG8_SB(0, 0), b2, voffB);
            PG8_BAR; PG8_WAIT_L(0); PG8_MMA(0, 1, At, B1); PG8_BAR;
            PG8_LDA(At, 0, 1); PG8_STAGE(PG8_SA(0, 0), a2, voffA);
            PG8_BAR; PG8_WAIT_L(0); PG8_MMA(1, 0, At, B0); PG8_BAR; PG8_SCHED;
            PG8_STAGE(PG8_SB(0, 1), b2 + hstep, voffB);
            PG8_WAIT_V(6); PG8_BAR; PG8_MMA(1, 1, At, B1); PG8_BAR;
            PG8_LDB(B0, 1, 0); PG8_SCHED; PG8_LDA(At, 1, 0); PG8_STAGE(PG8_SA(0, 1), a2 + hstep, voffA);
            PG8_WAIT_L(8); PG8_BAR; PG8_WAIT_L(0); PG8_MMA(0, 0, At, B0); PG8_BAR; PG8_SCHED;
            PG8_LDB(B1, 1, 1); PG8_STAGE(PG8_SB(1, 0), b3, voffB);
            PG8_BAR; PG8_WAIT_L(0); PG8_MMA(0, 1, At, B1); PG8_BAR;
            PG8_LDA(At, 1, 1); PG8_STAGE(PG8_SA(1, 0), a3, voffA);
            PG8_BAR; PG8_WAIT_L(0); PG8_MMA(1, 0, At, B0); PG8_BAR; PG8_SCHED;
            PG8_STAGE(PG8_SB(1, 1), b3 + hstep, voffB);
            PG8_WAIT_V(6); PG8_BAR; PG8_MMA(1, 1, At, B1); PG8_BAR;
            }
        }
        if constexpr (ALIGN_EPI) { if (wr == 0) PG8_BAR; }
        if constexpr (!Epi::AFTER_DRAIN) { E(acc, cur, wr, wc, fr, fq); S.done(cur); }
        if (!has_next) break;
#pragma unroll
        for (int a = 0; a < 2; ++a)
#pragma unroll
            for (int b = 0; b < 2; ++b)
#pragma unroll
                for (int m = 0; m < 4; ++m)
#pragma unroll
                    for (int n = 0; n < 2; ++n) acc[a][b][m][n] = (f32x4){0.f, 0.f, 0.f, 0.f};
        cur = nxt; cA = nA; cB = nB; ++ui;
        if constexpr (ALIGN_EPI) { if (wr == 1) PG8_BAR; }
    }
    PG8_WAIT_V(0);
    if constexpr (!ALIGN_EPI) { if (wr == 0) PG8_BAR; }
    PG8_BAR;
    if constexpr (Epi::AFTER_DRAIN) { E.fused(acc, cur, wr, wc, fr, fq, lds, wid, lane); S.done(cur); }
#undef PG8_SA
#undef PG8_SB
#undef PG8_STAGE
#undef PG8_LDA
#undef PG8_LDB
#undef PG8_MMA
#undef PG8_WAIT_V
#undef PG8_WAIT_L
#undef PG8_BAR
#undef PG8_SCHED
}
}

namespace pg8 {
struct EpiSwiGLU {
    static constexpr bool PERM = true, AFTER_DRAIN = false;
    bf16_t* H; int ldc;
    __device__ __forceinline__ void operator()(const f32x4 (&acc)[2][2][4][2], const Unit& u, int wr, int wc, int fr, int fq) const {
        const int row0 = u.pm * BM + wr * 64 + fr, col0 = u.pn * HALF + wc * 32 + 8 * fq;
#pragma unroll
        for (int ai = 0; ai < 2; ++ai)
#pragma unroll
            for (int m = 0; m < 4; ++m) {
                bf16_t* rowp = H + (size_t)(row0 + ai * HALF + m * 16) * ldc + col0;
                float h[8];
#pragma unroll
                for (int n = 0; n < 2; ++n)
#pragma unroll
                    for (int i = 0; i < 4; ++i) { const float g = acc[ai][0][m][n][i], uu = acc[ai][1][m][n][i];
                        const float e = __builtin_amdgcn_exp2f(g * -1.4426950408889634f);
                        h[n * 4 + i] = g * uu * __builtin_amdgcn_rcpf(1.0f + e); }
                u32x4 w; w.x = cvt_pk_bf16(h[0], h[1]); w.y = cvt_pk_bf16(h[2], h[3]); w.z = cvt_pk_bf16(h[4], h[5]); w.w = cvt_pk_bf16(h[6], h[7]);
                *(u32x4*)rowp = w;
            }
    }
};
struct EpiResGate {
    static constexpr bool PERM = false, AFTER_DRAIN = false;
    const float* base_lat; const float* base_ctx; float* out_lat; float* out_ctx; const float* gate; float f;
    __device__ __forceinline__ void operator()(const f32x4 (&acc)[2][2][4][2], const Unit& u, int wr, int wc, int fr, int fq) const {
        const bool lat = u.pm < 256; const int mb = lat ? (u.pm >> 5) : 8; const int prow = lat ? u.pm : (u.pm - 256);
        const float* base = (lat ? base_lat : base_ctx) + (size_t)prow * BM * 1024; float* out = (lat ? out_lat : out_ctx) + (size_t)prow * BM * 1024;
        const int col0 = u.pn * BM + wc * 32 + 4 * fq;
        f32x4 gv[2][2];
#pragma unroll
        for (int bj = 0; bj < 2; ++bj)
#pragma unroll
            for (int n = 0; n < 2; ++n) gv[bj][n] = *(const f32x4*)(gate + (size_t)mb * 9216 + col0 + bj * HALF + n * 16) * f;
#pragma unroll
        for (int ai = 0; ai < 2; ++ai)
#pragma unroll
            for (int m = 0; m < 4; ++m) { const size_t off = (size_t)(wr * 64 + fr + ai * HALF + m * 16) * 1024 + col0;
#pragma unroll
                for (int bj = 0; bj < 2; ++bj)
#pragma unroll
                    for (int n = 0; n < 2; ++n) { const f32x4 b = *(const f32x4*)(base + off + bj * HALF + n * 16);
                        *(f32x4*)(out + off + bj * HALF + n * 16) = b + gv[bj][n] * acc[ai][bj][m][n]; } }
    }
};
struct EpiStoreBf16 {
    static constexpr bool PERM = true, AFTER_DRAIN = false;
    bf16_t* O; int ldc;
    __device__ __forceinline__ void operator()(const f32x4 (&acc)[2][2][4][2], const Unit& u, int wr, int wc, int fr, int fq) const {
        const int row0 = u.pm * BM + wr * 64 + fr, col0 = u.pn * BM + wc * 32 + 8 * fq;
#pragma unroll
        for (int ai = 0; ai < 2; ++ai)
#pragma unroll
            for (int m = 0; m < 4; ++m) { bf16_t* rowp = O + (size_t)(row0 + ai * HALF + m * 16) * ldc + col0;
#pragma unroll
                for (int bj = 0; bj < 2; ++bj) { const f32x4 v0 = acc[ai][bj][m][0], v1 = acc[ai][bj][m][1];
                    u32x4 w; w.x = cvt_pk_bf16(v0[0], v0[1]); w.y = cvt_pk_bf16(v0[2], v0[3]); w.z = cvt_pk_bf16(v1[0], v1[1]); w.w = cvt_pk_bf16(v1[2], v1[3]);
                    *(u32x4*)(rowp + bj * HALF) = w; } }
    }
};
}

constexpr int NB = 8, SEQ = 8192, DM = 1024, CTXL = 256, DEPTH = 2, DFF = 2816, NMOD = 9, INC = 3584;
constexpr int TL = NB * SEQ, TC = NB * CTXL, TT = TL + TC;
constexpr int C_NAQ = 0, C_NAK = 384, C_NAV = 768, C_SGU = 1152, C_SGV = 1408, C_RQ = 1664, C_RK = 2048, C_RV = 2432, C_GF = 2816, C_GB = 3200;
constexpr int M_NA = 0, M_SG = 384, M_RET = 640;
constexpr int NCH = TT / 128, NCHL = TL / 128;
constexpr int NWAVES = 8;
#ifndef MK_ONE_LAUNCH
#define MK_ONE_LAUNCH 1
#endif
constexpr int NPH = 1 + DEPTH * 12;

constexpr size_t MiB = 1u << 20;
constexpr size_t WS_CTL = 0, CTL_ZERO_BYTES = 1 * MiB;
constexpr size_t WS_MOD = 1 * MiB;
constexpr size_t WS_ROPE = 2 * MiB;
constexpr size_t WS_WSG = 3 * MiB;
constexpr size_t WS_W1T = 4 * MiB, WS_W2T = 48 * MiB, WS_WINT = 70 * MiB, WS_WOUTT = 84 * MiB;
constexpr size_t WS_CTXBUF = 88 * MiB;
constexpr size_t WS_XN = 96 * MiB;
constexpr size_t WS_P = 228 * MiB;
constexpr size_t WS_KV = 690 * MiB;
constexpr size_t WS_PREV = 789 * MiB;
constexpr size_t WS_END = 888 * MiB;
constexpr int CW_BAR = 4096;

constexpr int RING_BYTES = 131072, LDSCTL_OFF = RING_BYTES, MISC_OFF = LDSCTL_OFF + 320, LDS_BYTES = 147456;
#define GAS __attribute__((address_space(1)))
#define LAS __attribute__((address_space(3)))
typedef unsigned short bf16;
typedef unsigned v4u __attribute__((ext_vector_type(4)));
typedef float f32x4 __attribute__((ext_vector_type(4)));
typedef short bf16x8 __attribute__((ext_vector_type(8)));
typedef GAS unsigned gu32;
typedef GAS unsigned long long gu64;
#define RLX_AGENT __ATOMIC_RELAXED, __HIP_MEMORY_SCOPE_AGENT
#define LDS_WAIT() asm volatile("s_waitcnt lgkmcnt(0)" ::: "memory")
#define VM_WAIT() asm volatile("s_waitcnt vmcnt(0)" ::: "memory")
__device__ __forceinline__ unsigned long long rt() { return __builtin_amdgcn_s_memrealtime(); }
__device__ __forceinline__ unsigned f2bf(float f) { unsigned u = __builtin_bit_cast(unsigned, f); return (u + 0x7fffu + ((u >> 16) & 1u)) >> 16; }
__device__ __forceinline__ unsigned pk2(float lo, float hi) { return f2bf(lo) | (f2bf(hi) << 16); }
#define XB_TMO      128
#define XB_XCNT(j)  (256  + 64 * (j))
#define XB_XSUB(j)  (1280 + 64 * (j))
#define XB_XGEN(j)  (2304 + 64 * (j))
#define XB_TOP      3328
#define XB_TOPGEN   3392
#define XCD_BAR_WORDS 3456
#define XB_SPIN_CAP (1u << 18)

__device__ __forceinline__ unsigned xb_ld(unsigned* p)              { return __hip_atomic_load(p, __ATOMIC_RELAXED, __HIP_MEMORY_SCOPE_AGENT); }
__device__ __forceinline__ unsigned xb_add(unsigned* p, unsigned v) { return __hip_atomic_fetch_add(p, v, __ATOMIC_RELAXED, __HIP_MEMORY_SCOPE_AGENT); }
__device__ __forceinline__ unsigned xb_xcc_id() { return (unsigned)__builtin_amdgcn_s_getreg((3 << 11) | 20) & 0xFu; }
#define XB_SPIN(cond, bar) do { unsigned _sp = 0; while (cond) { __builtin_amdgcn_s_sleep(1); \
    if ((++_sp & 255u) == 0u) { if (xb_ld(&(bar)[XB_TMO])) break; if (_sp > XB_SPIN_CAP) { atomicAdd(&(bar)[XB_TMO], 1u); break; } } } } while (0)

struct XcdBarrier {
    unsigned* bar; unsigned x;
    volatile LAS unsigned* st;
};

__device__ __forceinline__ XcdBarrier xcd_barrier_post(unsigned* bar, volatile LAS unsigned* st) {
    XcdBarrier b; b.bar = bar; b.x = xb_xcc_id(); b.st = st;
    if (threadIdx.x == 0) (void)xb_add(&bar[XB_XCNT(b.x)], 1u);
    return b;
}
__device__ __forceinline__ void xcd_barrier_complete(unsigned* bar, unsigned x, unsigned& nloc, unsigned& nx) {
    const unsigned G = gridDim.x * gridDim.y * gridDim.z;
    unsigned sum, cnt, mine, sp = 0u;
    for (;;) {
        sum = 0u; cnt = 0u; mine = 0u;
#pragma unroll
        for (unsigned j = 0; j < 16; ++j) { const unsigned c = xb_ld(&bar[XB_XCNT(j)]); sum += c; cnt += (c > 0u) ? 1u : 0u; mine = (j == x) ? c : mine; }
        if (sum == G) break;
        __builtin_amdgcn_s_sleep(1);
        if ((++sp & 255u) == 0u) { if (xb_ld(&bar[XB_TMO])) break; if (sp > XB_SPIN_CAP) { atomicAdd(&bar[XB_TMO], 1u); break; } }
    }
    nloc = mine > 0u ? mine : 1u; nx = cnt > 0u ? cnt : 1u;
}

__device__ __forceinline__ void xcd_barrier(const XcdBarrier& b) {
    asm volatile("s_waitcnt vmcnt(0)" ::: "memory");
    __syncthreads();
    if (threadIdx.x == 0) {
        unsigned* bar = b.bar;
        __builtin_amdgcn_s_waitcnt(0);
        unsigned nloc = b.st[0], nx = b.st[1];
        if (nloc == 0u) { xcd_barrier_complete(bar, b.x, nloc, nx); b.st[0] = nloc; b.st[1] = nx; }
        const unsigned old = xb_add(&bar[XB_XSUB(b.x)], 1u);
        const unsigned gen = old / nloc;
        if (old + 1u == (gen + 1u) * nloc) {
            __builtin_amdgcn_fence(__ATOMIC_RELEASE, "agent");
            asm volatile("s_waitcnt vmcnt(0)" ::: "memory");
            const unsigned og = xb_add(&bar[XB_TOP], 1u);
            const unsigned tg = og / nx;
            if (og + 1u == (tg + 1u) * nx) xb_add(&bar[XB_TOPGEN], 1u);
            else XB_SPIN(xb_ld(&bar[XB_TOPGEN]) == tg, bar);
            __builtin_amdgcn_fence(__ATOMIC_ACQUIRE, "agent");
            xb_add(&bar[XB_XGEN(b.x)], 1u);
            asm volatile("s_waitcnt vmcnt(0)" ::: "memory");
        } else {
            XB_SPIN(xb_ld(&bar[XB_XGEN(b.x)]) == gen, bar);
            __builtin_amdgcn_fence(__ATOMIC_ACQUIRE, "agent");
            asm volatile("s_waitcnt vmcnt(0)" ::: "memory");
        }
    }
    __syncthreads();
}
#ifndef REP_NORM
#define REP_NORM 1
#endif

typedef unsigned u32x2 __attribute__((ext_vector_type(2)));

#define SHX(v, o) __builtin_bit_cast(float, __builtin_amdgcn_ds_swizzle(__builtin_bit_cast(int, (float)(v)), ((o) << 10) | 0x1f))
__device__ __forceinline__ float xhalf_sum(float v) { auto rr = __builtin_amdgcn_permlane32_swap(__float_as_uint(v), __float_as_uint(v), false, false); return __uint_as_float(rr[0]) + __uint_as_float(rr[1]); }
__device__ __forceinline__ float xhalf_max(float v) { auto rr = __builtin_amdgcn_permlane32_swap(__float_as_uint(v), __float_as_uint(v), false, false); return fmaxf(__uint_as_float(rr[0]), __uint_as_float(rr[1])); }
__device__ __forceinline__ float wave_sum(float v) { v += SHX(v, 1); v += SHX(v, 2); v += SHX(v, 4); v += SHX(v, 8); v += SHX(v, 16); return xhalf_sum(v); }
__device__ __forceinline__ float bflo(unsigned w) { return __uint_as_float(w << 16); }
__device__ __forceinline__ float bfhi(unsigned w) { return __uint_as_float(w & 0xffff0000u); }
__device__ __forceinline__ void load8(const bf16* p, float* o) {
    const v4u w = *(const v4u*)p;
    o[0] = bflo(w.x); o[1] = bfhi(w.x); o[2] = bflo(w.y); o[3] = bfhi(w.y); o[4] = bflo(w.z); o[5] = bfhi(w.z); o[6] = bflo(w.w); o[7] = bfhi(w.w);
}
__device__ __forceinline__ void store8(bf16* p, const float* o) {
    v4u w; w.x = pk2(o[0], o[1]); w.y = pk2(o[2], o[3]); w.z = pk2(o[4], o[5]); w.w = pk2(o[6], o[7]); *(v4u*)p = w;
}
__device__ __forceinline__ float sigmoidf_(float x) { return 1.0f / (1.0f + __expf(-x)); }
__device__ __forceinline__ float gelu_tanh(float x) { const float y = 0.7978845608028654f * (x + 0.044715f * x * x * x); return x * sigmoidf_(2.0f * y); }
__device__ __forceinline__ float log_sigmoid(float x) { return fminf(x, 0.0f) - log1pf(expf(-fabsf(x))); }

__device__ __forceinline__ void p0_transpose_item(const float* W, int K, int N, bf16* WT, bool swiglu, LAS float* scr, int item, int lane) {
    const int nblk = N / 32, kb = item / nblk, nb = item % nblk, k0 = 64 * kb, n0 = 32 * nb;
    int d0 = n0;
    if (swiglu) { const int hid = n0 < DFF ? n0 : n0 - DFF; d0 = (hid >> 7) * 256 + (n0 < DFF ? 0 : 128) + (hid & 127); }
#pragma unroll 8
    for (int i = 0; i < 32; ++i) { const int kk = 2 * i + (lane >> 5); scr[kk * 33 + (lane & 31)] = W[(size_t)(k0 + kk) * N + n0 + (lane & 31)]; }
    LDS_WAIT(); asm volatile("" ::: "memory");
    const int c = lane & 7;
#pragma unroll
    for (int j = 0; j < 4; ++j) { const int n = (lane >> 3) + 8 * j; const LAS float* s = scr + (8 * c) * 33 + n;
        v4u o; o.x = pk2(s[0 * 33], s[1 * 33]); o.y = pk2(s[2 * 33], s[3 * 33]); o.z = pk2(s[4 * 33], s[5 * 33]); o.w = pk2(s[6 * 33], s[7 * 33]);
        *(GAS v4u*)(WT + (size_t)(d0 + n) * K + k0 + 8 * c) = o; }
    LDS_WAIT(); asm volatile("" ::: "memory");
}
struct In { const float *x, *c, *ctx, *c_ctx, *ada_w, *ada_b, *norm_w, *ffn_w1, *ffn_w2, *w_in, *w_out, *na_qn, *na_kn, *na_rpb, *sg_w, *sg_b, *sg_ln_w, *sg_ln_b, *ret_logit, *ret_gn_w; };

__device__ __forceinline__ void p0_prologue(const In& I, unsigned char* ws, LAS unsigned char* lds, int tid, int lane, int wave, int vcu, int G) {
    LAS float* scr = (LAS float*)(lds + wave * 16384);
    const int gw = vcu * NWAVES + wave, NGW = G * NWAVES;
    constexpr int I_W1 = (DM / 64) * (2 * DFF / 32), I_W2 = (DFF / 64) * (DM / 32), I_WIN = (DM / 64) * (INC / 32), I_WOUT = (DM / 64) * (DM / 32);
    constexpr int PER_L = 2 * I_W1 + 2 * I_W2 + I_WIN + I_WOUT;
    bf16* W1T = (bf16*)(ws + WS_W1T); bf16* W2T = (bf16*)(ws + WS_W2T); bf16* WINT = (bf16*)(ws + WS_WINT); bf16* WOUTT = (bf16*)(ws + WS_WOUTT);
    for (int it = gw; it < DEPTH * PER_L; it += NGW) {
        const int L = it / PER_L; int r = it % PER_L;
        if (r < 2 * I_W1) { const int i = r / I_W1; r %= I_W1; const size_t o = (size_t)(L * 2 + i) * DM * 2 * DFF; p0_transpose_item(I.ffn_w1 + o, DM, 2 * DFF, W1T + o, true, scr, r, lane); continue; } r -= 2 * I_W1;
        if (r < 2 * I_W2) { const int i = r / I_W2; r %= I_W2; const size_t o = (size_t)(L * 2 + i) * DFF * DM; p0_transpose_item(I.ffn_w2 + o, DFF, DM, W2T + o, false, scr, r, lane); continue; } r -= 2 * I_W2;
        if (r < I_WIN) { const size_t o = (size_t)L * DM * INC; p0_transpose_item(I.w_in + o, DM, INC, WINT + o, false, scr, r, lane); continue; } r -= I_WIN;
        { const size_t o = (size_t)L * DM * DM; p0_transpose_item(I.w_out + o, DM, DM, WOUTT + o, false, scr, r, lane); }
    }
    __syncthreads();
    LAS float* sc = (LAS float*)lds;
    LAS float* part = (LAS float*)(lds + 36864);
    float* mod = (float*)(ws + WS_MOD);
    for (int cb = blockIdx.x; cb < 256; cb += G) {
        for (int i = tid; i < 9 * 1024; i += 512) { const int mb = i >> 10, k = i & 1023; const float v = mb < 8 ? I.c[mb * 1024 + k] : I.c_ctx[k]; sc[i] = v * sigmoidf_(v); }
        __syncthreads();
        const int cc = tid % 72, kp = tid / 72, colg = cb * 72 + cc, L = colg / 9216, j = colg % 9216;
        if (kp < 7) {
            float acc[9];
#pragma unroll
            for (int mb = 0; mb < 9; ++mb) acc[mb] = 0.f;
            for (int k = kp; k < 1024; k += 7) { const float w = I.ada_w[((size_t)L * 1024 + k) * 9216 + j];
#pragma unroll
                for (int mb = 0; mb < 9; ++mb) acc[mb] += sc[mb * 1024 + k] * w; }
#pragma unroll
            for (int mb = 0; mb < 9; ++mb) part[(kp * 72 + cc) * 9 + mb] = acc[mb];
        }
        __syncthreads();
        for (int o = tid; o < 72 * 9; o += 512) { const int c2 = o / 9, mb = o % 9; const int colg2 = cb * 72 + c2, L2 = colg2 / 9216, j2 = colg2 % 9216;
            float s = I.ada_b[L2 * 9216 + j2];
#pragma unroll
            for (int p = 0; p < 7; ++p) s += part[(p * 72 + c2) * 9 + mb];
            mod[((size_t)L2 * 9 + mb) * 9216 + j2] = s; }
        __syncthreads();
    }
    { bf16* wsg = (bf16*)(ws + WS_WSG); for (int i = blockIdx.x * 512 + tid; i < DEPTH * 4 * 128 * 128 / 8; i += G * 512) { const f32x4 a = ((const f32x4*)I.sg_w)[2 * i], b = ((const f32x4*)I.sg_w)[2 * i + 1];
        v4u o; o.x = pk2(a.x, a.y); o.y = pk2(a.z, a.w); o.z = pk2(b.x, b.y); o.w = pk2(b.z, b.w); ((v4u*)wsg)[i] = o; } }
    if (blockIdx.x == (unsigned)(G - 1)) {
        float* tab = (float*)(ws + WS_ROPE);
        for (int i = tid; i < 128 * 16; i += 512) { const int n = i >> 4, f = i & 15; const float inv = exp2f(-(float)f * (13.287712379549449f / 16.0f)); const float ang = (float)n * inv;
            tab[2 * i] = cosf(ang); tab[2 * i + 1] = sinf(ang); }
    }
}

__device__ __forceinline__ void norm_phase(const float* xl, const float* xc, int nrows, const float* nw, const float* modL, int sidx, bf16* XN, int gw, int NGW, int lane) {
    const int rpw = (nrows + NGW - 1) / NGW; const int r0 = gw * rpw; int r1 = r0 + rpw; if (r1 > nrows) r1 = nrows;
    int cur = -1; f32x4 g[4], sh[4];
#pragma unroll
    for (int j = 0; j < 4; ++j) { g[j] = (f32x4){0.f, 0.f, 0.f, 0.f}; sh[j] = g[j]; }
    for (int rr_ = 0; rr_ < (r1 - r0) * REP_NORM; ++rr_) { const int r = r0 + rr_ % (r1 - r0);
        const int mb = r < TL ? (r >> 13) : 8;
        if (mb != cur) { cur = mb; const float* sf = modL + (size_t)mb * 9216 + sidx * 1024; const float* sl = sf + 1024;
#pragma unroll
            for (int j = 0; j < 4; ++j) { const f32x4 w = ((const f32x4*)nw)[lane + 64 * j], s1 = ((const f32x4*)sl)[lane + 64 * j]; g[j] = w * (s1 + 1.0f); sh[j] = ((const f32x4*)sf)[lane + 64 * j]; } }
        const float* src = r < TL ? xl + (size_t)r * DM : xc + (size_t)(r - TL) * DM;
        f32x4 v[4]; float s = 0.f;
#pragma unroll
        for (int j = 0; j < 4; ++j) { v[j] = ((const f32x4*)src)[lane + 64 * j]; s += (v[j].x * v[j].x + v[j].y * v[j].y) + (v[j].z * v[j].z + v[j].w * v[j].w); }
        const float rstd = 1.0f / sqrtf(wave_sum(s) * (1.0f / DM) + 1e-6f);
        unsigned long long* o8 = (unsigned long long*)(XN + (size_t)r * DM) + lane;
#pragma unroll
        for (int j = 0; j < 4; ++j) { const f32x4 y = v[j] * rstd * g[j] + sh[j]; o8[64 * j] = (unsigned long long)pk2(y.x, y.y) | ((unsigned long long)pk2(y.z, y.w) << 32); }
    }
}

__device__ __forceinline__ void na_naive(const bf16* P, bf16* MIX, const float* wq, const float* wk, const float* rpb, bool with_ctx, int gtid, int nthreads) {
    float mq = 0.f, mk = 0.f, mr = 0.f;
    for (int d = 0; d < 64; ++d) { mq = fmaxf(mq, fabsf(wq[d])); mk = fmaxf(mk, fabsf(wk[d])); }
    for (int i = 0; i < 6 * 15 * 31; ++i) mr = fmaxf(mr, fabsf(rpb[i]));
    const float mbound = 8.0f * mq * mk + mr;
    const int nitems = (TL + (with_ctx ? TC : 0)) * 6;
    for (int item = gtid; item < nitems; item += nthreads) {
        int h, t; bool isctx;
        if (item < TL * 6) { h = item / TL; t = item % TL; isctx = false; } else { const int r = item - TL * 6; h = r / TC; t = TL + r % TC; isctx = true; }
        float q[64], o[64];
        { const bf16* qp = P + (size_t)t * INC + C_NAQ + h * 64; float ss = 0.f;
#pragma unroll
          for (int d8 = 0; d8 < 8; ++d8) { load8(qp + d8 * 8, q + d8 * 8); }
#pragma unroll
          for (int d = 0; d < 64; ++d) ss += q[d] * q[d];
          const float rstd = 1.0f / sqrtf(ss * (1.0f / 64.0f) + 1e-6f);
#pragma unroll
          for (int d = 0; d < 64; ++d) { q[d] = q[d] * rstd * wq[d] * wk[d] * 0.125f; o[d] = 0.f; } }
        float l = 0.f;
        int b, nloc, r = 0, c = 0, rs = 0, cs = 0;
        if (!isctx) { b = t >> 13; const int pos = t & 8191; r = pos >> 6; c = pos & 63; rs = min(max(r - 4, 0), 120); cs = min(max(c - 8, 0), 48); nloc = 128; }
        else { b = (t - TL) >> 8; nloc = 0; }
        for (int kk = 0; kk < nloc + 256; ++kk) {
            int tk; float bias = 0.f;
            if (kk < nloc) { const int i = kk >> 4, j = kk & 15; tk = b * SEQ + (rs + i) * 64 + cs + j; bias = rpb[(h * 15 + (rs + i - r + 7)) * 31 + (cs + j - c + 15)]; }
            else tk = TL + b * CTXL + (kk - nloc);
            const bf16* kp = P + (size_t)tk * INC + C_NAK + h * 64; const bf16* vp = P + (size_t)tk * INC + C_NAV + h * 64;
            float dot = 0.f, ss = 0.f;
#pragma unroll
            for (int d8 = 0; d8 < 8; ++d8) { float k8[8]; load8(kp + d8 * 8, k8);
#pragma unroll
                for (int e = 0; e < 8; ++e) { dot += q[d8 * 8 + e] * k8[e]; ss += k8[e] * k8[e]; } }
            const float s = dot / sqrtf(ss * (1.0f / 64.0f) + 1e-6f) + bias;
            const float p = __expf(s - mbound); l += p;
#pragma unroll
            for (int d8 = 0; d8 < 8; ++d8) { float v8[8]; load8(vp + d8 * 8, v8);
#pragma unroll
                for (int e = 0; e < 8; ++e) o[d8 * 8 + e] += p * v8[e]; }
        }
        const float il = 1.0f / l; bf16* op = MIX + (size_t)t * DM + M_NA + h * 64;
#pragma unroll
        for (int d8 = 0; d8 < 8; ++d8) { float t8[8];
#pragma unroll
            for (int e = 0; e < 8; ++e) t8[e] = o[d8 * 8 + e] * il;
            store8(op + d8 * 8, t8); }
    }
}

__device__ __forceinline__ void sg_naive(const bf16* P, bf16* MIX, const float* sgw, const float* sgb, const float* lnw, const float* lnb, LAS unsigned char* lds, int tid, int G) {
    LAS float* vn = (LAS float*)lds;
    const int tok = tid >> 2, part = tid & 3;
    for (int it = blockIdx.x; it < NCH * 4; it += G) {
        const int ch = it >> 2, g = it & 3, row0 = ch * 128;
        { const bf16* src = P + (size_t)(row0 + tok) * INC + C_SGV + g * 64 + part * 16; float v[16]; load8(src, v); load8(src + 8, v + 8);
          float s = 0.f;
#pragma unroll
          for (int k = 0; k < 16; ++k) { v[k] = gelu_tanh(v[k]); s += v[k]; }
          s += SHX(s, 1); s += SHX(s, 2); const float mu = s * (1.0f / 64.0f); float q = 0.f;
#pragma unroll
          for (int k = 0; k < 16; ++k) { v[k] -= mu; q += v[k] * v[k]; }
          q += SHX(q, 1); q += SHX(q, 2); const float rstd = 1.0f / sqrtf(q * (1.0f / 64.0f) + 1e-5f);
#pragma unroll
          for (int k = 0; k < 16; ++k) { const int cch = g * 64 + part * 16 + k; vn[tok * 64 + part * 16 + k] = v[k] * rstd * lnw[cch] + lnb[cch]; } }
        __syncthreads();
        { float acc[16];
#pragma unroll
          for (int k = 0; k < 16; ++k) acc[k] = 0.f;
          const float* wrow = sgw + ((size_t)g * 128 + tok) * 128;
          for (int q = 0; q < 128; ++q) { const float w = wrow[q];
#pragma unroll
              for (int k = 0; k < 16; ++k) acc[k] += w * vn[q * 64 + part * 16 + k]; }
          const float bias = sgb[g * 128 + tok];
          const bf16* up = P + (size_t)(row0 + tok) * INC + C_SGU + g * 64 + part * 16; float u[16]; load8(up, u); load8(up + 8, u + 8);
#pragma unroll
          for (int k = 0; k < 16; ++k) u[k] = gelu_tanh(u[k]) * (acc[k] + bias);
          bf16* op = MIX + (size_t)(row0 + tok) * DM + M_SG + g * 64 + part * 16; store8(op, u); store8(op + 8, u + 8); }
        __syncthreads();
    }
}

__device__ __forceinline__ void rope_load16(const bf16* P, int row, int colbase, int h, int part, bool latent, const float* ropetab, float* out) {
    const bf16* base = P + (size_t)row * INC + colbase + h * 64;
    float mine[16]; load8(base + part * 16, mine); load8(base + part * 16 + 8, mine + 8);
    if (!latent) {
#pragma unroll
        for (int f = 0; f < 16; ++f) out[f] = mine[f];
        return; }
    float oth[16]; load8(base + (part ^ 1) * 16, oth); load8(base + (part ^ 1) * 16 + 8, oth + 8);
    const int pos = row & (SEQ - 1); const int n = (part < 2) ? (pos >> 6) : (pos & 63);
    const float* tb = ropetab + n * 32;
#pragma unroll
    for (int f = 0; f < 16; ++f) { const float cs = tb[2 * f], sn = tb[2 * f + 1]; out[f] = (part & 1) ? (oth[f] * sn + mine[f] * cs) : (mine[f] * cs - oth[f] * sn); }
}
__device__ __forceinline__ void ret_kv_naive(const bf16* P, float* KV, const float* logit, const float* ropetab, LAS unsigned char* lds, int tid, int G) {
    LAS float* kS = (LAS float*)lds; LAS float* vS = kS + 128 * 64; LAS float* wt = vS + 128 * 64;
    const int tok = tid >> 2, part = tid & 3;
    for (int it = blockIdx.x; it < NCH * 6; it += G) {
        const int ch = it / 6, h = it % 6, row0 = ch * 128; const bool latent = ch < NCHL;
        { float k16[16]; rope_load16(P, row0 + tok, C_RK, h, part, latent, ropetab, k16);
#pragma unroll
          for (int f = 0; f < 16; ++f) kS[tok * 64 + part * 16 + f] = k16[f] * 0.125f;
          const bf16* vp = P + (size_t)(row0 + tok) * INC + C_RV + h * 64 + part * 16; float v16[16]; load8(vp, v16); load8(vp + 8, v16 + 8);
#pragma unroll
          for (int f = 0; f < 16; ++f) vS[tok * 64 + part * 16 + f] = v16[f]; }
        if (tid < 256) { const int dir = tid >> 7, j = tid & 127; const float lg = log_sigmoid(logit[dir * 6 + h]); wt[tid] = expf(lg * (float)(dir == 0 ? 127 - j : j)); }
        __syncthreads();
        { const int d = tid >> 3, e0 = (tid & 7) * 8; float af[8], ab[8];
#pragma unroll
          for (int k = 0; k < 8; ++k) { af[k] = 0.f; ab[k] = 0.f; }
          for (int j = 0; j < 128; ++j) { const float kd = kS[j * 64 + d]; const float a = kd * wt[j], b = kd * wt[128 + j];
#pragma unroll
              for (int k = 0; k < 8; ++k) { const float v = vS[j * 64 + e0 + k]; af[k] += a * v; ab[k] += b * v; } }
          float* of = KV + ((size_t)(ch * 6 + h) * 2 + 0) * 4096 + d * 64 + e0; float* ob = of + 4096;
#pragma unroll
          for (int k = 0; k < 8; ++k) { of[k] = af[k]; ob[k] = ab[k]; } }
        __syncthreads();
    }
}
__device__ __forceinline__ void ret_scan(const float* KV, float* PREV, const float* logit, int gtid, int nthreads) {
    for (int it = gtid; it < NB * 6 * 2 * 4096; it += nthreads) {
        const int idx = it & 4095, dir = (it >> 12) & 1, bh = it >> 13, h = bh % 6, b = bh / 6;
        const float cd = expf(128.0f * log_sigmoid(logit[dir * 6 + h]));
#define KVI(ch) (((size_t)((ch) * 6 + h) * 2 + dir) * 4096 + idx)
        const int c0 = NCHL + 2 * b, c1 = c0 + 1;
        const float k0 = KV[KVI(c0)], k1 = KV[KVI(c1)];
        if (dir == 0) { PREV[KVI(c0)] = 0.f; PREV[KVI(c1)] = k0; float s = cd * k0 + k1;
            for (int n = 0; n < 64; ++n) { const int ch = b * 64 + n; PREV[KVI(ch)] = s; s = cd * s + KV[KVI(ch)]; } }
        else { PREV[KVI(c0)] = k1; PREV[KVI(c1)] = 0.f; float s = k0 + cd * k1;
            for (int n = 63; n >= 0; --n) { const int ch = b * 64 + n; PREV[KVI(ch)] = s; s = cd * s + KV[KVI(ch)]; } }
#undef KVI
    }
}
__device__ __forceinline__ void ret_out_naive(const bf16* P, const float* PREV, bf16* MIX, const float* logit, const float* gnw, const float* ropetab, LAS unsigned char* lds, int tid, int G) {
    LAS bf16* qS = (LAS bf16*)lds; LAS bf16* kS = qS + 128 * 64; LAS bf16* vS = kS + 128 * 64;
    LAS float* S = (LAS float*)(lds + 49152);
    LAS float* dec = (LAS float*)(lds + 49152 + 65536);
    const int tok = tid >> 2, part = tid & 3;
    for (int it = blockIdx.x; it < NCH * 6; it += G) {
        const int ch = it / 6, h = it % 6, row0 = ch * 128; const bool latent = ch < NCHL;
        { float t16[16]; rope_load16(P, row0 + tok, C_RQ, h, part, latent, ropetab, t16);
#pragma unroll
          for (int f = 0; f < 16; ++f) qS[tok * 64 + part * 16 + f] = (bf16)f2bf(t16[f]);
          rope_load16(P, row0 + tok, C_RK, h, part, latent, ropetab, t16);
#pragma unroll
          for (int f = 0; f < 16; ++f) kS[tok * 64 + part * 16 + f] = (bf16)f2bf(t16[f] * 0.125f);
          const bf16* vp = P + (size_t)(row0 + tok) * INC + C_RV + h * 64 + part * 16; const v4u a = *(const v4u*)vp, b = *(const v4u*)(vp + 8);
          *(LAS v4u*)(vS + tok * 64 + part * 16) = a; *(LAS v4u*)(vS + tok * 64 + part * 16 + 8) = b; }
        if (tid < 258) { const int dir = tid / 129, k = tid % 129; dec[tid] = expf(log_sigmoid(logit[dir * 6 + h]) * (float)k); }
        __syncthreads();
        { float q[64];
#pragma unroll
          for (int d = 0; d < 64; ++d) q[d] = __uint_as_float((unsigned)qS[tok * 64 + d] << 16);
          for (int jj = 0; jj < 32; ++jj) { const int j = part + 4 * jj; float dot = 0.f;
#pragma unroll
              for (int d = 0; d < 64; ++d) dot += q[d] * __uint_as_float((unsigned)kS[j * 64 + d] << 16);
              S[tok * 128 + j] = dot; } }
        __syncthreads();
        { const int i = tok, e0 = part * 16; float of[16], ob[16], cf[16], cb[16];
#pragma unroll
          for (int k = 0; k < 16; ++k) { of[k] = 0.f; ob[k] = 0.f; cf[k] = 0.f; cb[k] = 0.f; }
          for (int j = 0; j < 128; ++j) { const float s = S[i * 128 + j]; const float wf = (j <= i) ? s * dec[i - j] : 0.f, wb = (j >= i) ? s * dec[129 + j - i] : 0.f;
#pragma unroll
              for (int k = 0; k < 16; ++k) { const float v = __uint_as_float((unsigned)vS[j * 64 + e0 + k] << 16); of[k] += wf * v; ob[k] += wb * v; } }
          const float* pf = PREV + ((size_t)(ch * 6 + h) * 2) * 4096 + e0; const float* pb = pf + 4096;
          for (int d = 0; d < 64; ++d) { const float qd = __uint_as_float((unsigned)qS[i * 64 + d] << 16);
#pragma unroll
              for (int k = 0; k < 16; ++k) { cf[k] += qd * pf[d * 64 + k]; cb[k] += qd * pb[d * 64 + k]; } }
          const float df = dec[i + 1], db = dec[129 + 128 - i];
          float sf = 0.f, sb = 0.f;
#pragma unroll
          for (int k = 0; k < 16; ++k) { of[k] += df * cf[k]; ob[k] += db * cb[k]; sf += of[k]; sb += ob[k]; }
          sf += SHX(sf, 1); sf += SHX(sf, 2); sb += SHX(sb, 1); sb += SHX(sb, 2);
          const float muf = sf * (1.0f / 64.0f), mub = sb * (1.0f / 64.0f); float qf = 0.f, qb = 0.f;
#pragma unroll
          for (int k = 0; k < 16; ++k) { of[k] -= muf; ob[k] -= mub; qf += of[k] * of[k]; qb += ob[k] * ob[k]; }
          qf += SHX(qf, 1); qf += SHX(qf, 2); qb += SHX(qb, 1); qb += SHX(qb, 2);
          const float rf = 1.0f / sqrtf(qf * (1.0f / 64.0f) + 1e-5f), rb = 1.0f / sqrtf(qb * (1.0f / 64.0f) + 1e-5f);
          const bf16* gp = P + (size_t)(row0 + i) * INC + C_GF + h * 64 + e0; float gf[16], gb[16]; load8(gp, gf); load8(gp + 8, gf + 8); load8(gp + (C_GB - C_GF), gb); load8(gp + (C_GB - C_GF) + 8, gb + 8);
          float y[16];
#pragma unroll
          for (int k = 0; k < 16; ++k) y[k] = (of[k] * rf * (gf[k] * sigmoidf_(gf[k])) + ob[k] * rb * (gb[k] * sigmoidf_(gb[k]))) * gnw[h * 64 + e0 + k];
          bf16* op = MIX + (size_t)(row0 + i) * DM + M_RET + h * 64 + e0; store8(op, y); store8(op + 8, y + 8); }
        __syncthreads();
    }
}
#ifndef REP_KV
#define REP_KV 1
#endif
#ifndef REP_RETO
#define REP_RETO 1
#endif

typedef short s16x4 __attribute__((ext_vector_type(4)));
typedef float f32x16 __attribute__((ext_vector_type(16)));
typedef float f32x2_t __attribute__((ext_vector_type(2)));
typedef __bf16 bf16x2_t __attribute__((ext_vector_type(2)));
#define MFMA32(a, b, c) __builtin_amdgcn_mfma_f32_32x32x16_bf16((a), (b), (c), 0, 0, 0)
#define LOG2E 1.4426950408889634f
#define OPQV(x) ({ int _t = (x); asm volatile("" : "+v"(_t)); _t; })
#define FRESH_TID(w) ({ int _t; asm volatile("v_mbcnt_lo_u32_b32 %0, -1, 0\n\tv_mbcnt_hi_u32_b32 %0, -1, %0" : "=v"(_t)); _t | ((w) << 6); })
__device__ __forceinline__ unsigned cvtpk(float lo, float hi) { f32x2_t v = {lo, hi}; bf16x2_t b = __builtin_convertvector(v, bf16x2_t); return __builtin_bit_cast(unsigned, b); }
__device__ __forceinline__ int crow0(int reg) { return (reg & 3) + 8 * (reg >> 2); }
__device__ __forceinline__ int swz64(int row) { return (((row >> 1) & 1) << 2) | (((row >> 3) & 1) << 1) | ((row >> 2) & 1); }
__device__ __forceinline__ int off64(int row, int ch) { return 128 * row + 16 * (ch ^ swz64(row)); }
__device__ __forceinline__ bf16x8 rowfrag(LAS unsigned char* img, int row, int ch) { return *(const LAS bf16x8*)(img + off64(row, ch)); }
__device__ __forceinline__ s16x4 tr4(LAS unsigned char* img, int krow, int ct, int lane) {
    const int q = (lane & 15) >> 2, p = lane & 3, blk = (lane >> 4) & 1;
    return __builtin_bit_cast(s16x4, __builtin_amdgcn_ds_read_tr16_b64_v4i16((LAS s16x4*)(img + off64(krow + q, 4 * ct + 2 * blk + (p >> 1)) + 8 * (p & 1))));
}
__device__ __forceinline__ bf16x8 trfrag(LAS unsigned char* img, int krow_lo, int krow_hi, int ct, int lane) {
    const s16x4 lo = tr4(img, krow_lo, ct, lane), hi = tr4(img, krow_hi, ct, lane);
    return (bf16x8){lo[0], lo[1], lo[2], lo[3], hi[0], hi[1], hi[2], hi[3]};
}
__device__ __forceinline__ void st_chunk(LAS unsigned char* img, int row, int ch, const float* v8) {
    v4u w; w.x = cvtpk(v8[0], v8[1]); w.y = cvtpk(v8[2], v8[3]); w.z = cvtpk(v8[4], v8[5]); w.w = cvtpk(v8[6], v8[7]); *(LAS v4u*)(img + off64(row, ch)) = w;
}
#define PACK8(x, s) __builtin_bit_cast(bf16x8, (v4u){cvtpk((x)[8 * (s)], (x)[8 * (s) + 1]), cvtpk((x)[8 * (s) + 2], (x)[8 * (s) + 3]), cvtpk((x)[8 * (s) + 4], (x)[8 * (s) + 5]), cvtpk((x)[8 * (s) + 6], (x)[8 * (s) + 7])})
__device__ __forceinline__ f32x16 zero16() { f32x16 z;
#pragma unroll
    for (int i = 0; i < 16; ++i) z[i] = 0.f;
    return z; }
__device__ __forceinline__ float wave_max(float v) { v = fmaxf(v, SHX(v, 1)); v = fmaxf(v, SHX(v, 2)); v = fmaxf(v, SHX(v, 4)); v = fmaxf(v, SHX(v, 8)); v = fmaxf(v, SHX(v, 16)); return xhalf_max(v); }

__device__ __forceinline__ void na_mfma(const bf16* P, bf16* MIX, const float* wq, const float* wk, const float* rpb, bool with_ctx, LAS unsigned char* lds, int tid_in, int G) {
    const int wave = __builtin_amdgcn_readfirstlane(tid_in >> 6); int tid = tid_in, lane = tid & 63;
    LAS unsigned char* Kimg = lds; LAS unsigned char* Vimg = lds + 16384;
    LAS float* tab = (LAS float*)(lds + 32768) + 64;
    const float mq = wave_max(fabsf(wq[lane])), mk = wave_max(fabsf(wk[lane]));
    const int nunits = NB * 6 * 32 + (with_ctx ? NB * 6 : 0);
    for (int u = blockIdx.x; u < nunits; u += G) {
        tid = FRESH_TID(wave); lane = tid & 63; const int r32 = lane & 31, hh = lane >> 5;
        const int skey = tid >> 3, spart = tid & 7;
        float wk8[8];
#pragma unroll
        for (int j = 0; j < 8; ++j) wk8[j] = wk[8 * spart + j];
        const bool isctx = u >= NB * 6 * 32; int b, h, r0 = 0;
        if (!isctx) { b = u / 192; h = (u >> 5) % 6; r0 = 4 * (u & 31); } else { const int v = u - NB * 6 * 32; b = v / 6; h = v % 6; }
        float mr = 0.f;
        for (int i = lane; i < 465; i += 64) mr = fmaxf(mr, fabsf(rpb[h * 465 + i]));
        mr = wave_max(mr);
        const float mbound = 8.0f * mq * mk + mr, negmb = -mbound * LOG2E;
        if (!isctx) for (int i = tid; i < 465; i += 512) tab[i] = (rpb[h * 465 + i] - mbound) * LOG2E;
        int r = 0, c = 0, tq;
        if (!isctx) { r = r0 + (wave >> 1); c = 32 * (wave & 1) + r32; tq = b * SEQ + r * 64 + c; } else tq = TL + b * CTXL + wave * 32 + r32;
        bf16x8 qf[4];
        { float qv[32]; float ss = 0.f; const bf16* qp = P + (size_t)tq * INC + C_NAQ + h * 64 + 8 * hh;
#pragma unroll
          for (int s = 0; s < 4; ++s) load8(qp + 16 * s, qv + 8 * s);
#pragma unroll
          for (int i = 0; i < 32; ++i) ss += qv[i] * qv[i];
          ss = xhalf_sum(ss);
          const float rstd = (1.0f / sqrtf(ss * (1.0f / 64.0f) + 1e-6f)) * (0.125f * LOG2E);
#pragma unroll
          for (int s = 0; s < 4; ++s) { float t8[8];
#pragma unroll
              for (int j = 0; j < 8; ++j) { const int d = 16 * s + 8 * hh + j; t8[j] = qv[8 * s + j] * rstd * wq[d] * wk[d]; }
              qf[s] = __builtin_bit_cast(bf16x8, (v4u){cvtpk(t8[0], t8[1]), cvtpk(t8[2], t8[3]), cvtpk(t8[4], t8[5]), cvtpk(t8[6], t8[7])}); } }
        const int rs0 = min(max(r0 - 4, 0), 120);
        const int nl = isctx ? 0 : (min(max(r0 + 3 - 4, 0), 120) + 8 - rs0), nchunks = nl + 4;
        const int rs = min(max(r - 4, 0), 120);
#define NA_TOK(ci) ((ci) < nl ? b * SEQ + (rs0 + (ci)) * 64 + skey : TL + b * CTXL + ((ci) - nl) * 64 + skey)
#define NA_STAGE(buf, kw, vw) do { float k8[8]; k8[0] = bflo(kw.x); k8[1] = bfhi(kw.x); k8[2] = bflo(kw.y); k8[3] = bfhi(kw.y); k8[4] = bflo(kw.z); k8[5] = bfhi(kw.z); k8[6] = bflo(kw.w); k8[7] = bfhi(kw.w); \
            float ss_ = 0.f; _Pragma("unroll") for (int j = 0; j < 8; ++j) ss_ += k8[j] * k8[j]; \
            ss_ += SHX(ss_, 1); ss_ += SHX(ss_, 2); ss_ += SHX(ss_, 4); \
            const float rk_ = 1.0f / sqrtf(ss_ * (1.0f / 64.0f) + 1e-6f); \
            _Pragma("unroll") for (int j = 0; j < 8; ++j) k8[j] *= rk_ * wk8[j]; \
            st_chunk(Kimg + (buf) * 8192, skey, spart, k8); *(LAS v4u*)(Vimg + (buf) * 8192 + off64(skey, spart)) = vw; } while (0)
        v4u kw, vw;
        { const bf16* src = P + (size_t)NA_TOK(0) * INC + h * 64 + 8 * spart; kw = *(const v4u*)(src + C_NAK); vw = *(const v4u*)(src + C_NAV); }
        NA_STAGE(0, kw, vw);
        __syncthreads();
        f32x16 o0 = zero16(), o1 = zero16(); float lsum = 0.f;
        for (int ci = 0; ci < nchunks; ++ci) {
            const int buf = ci & 1;
            if (ci + 1 < nchunks) { const bf16* src = P + (size_t)NA_TOK(ci + 1) * INC + h * 64 + 8 * spart; kw = *(const v4u*)(src + C_NAK); vw = *(const v4u*)(src + C_NAV); }
            const bool local = ci < nl; const int kr = rs0 + ci;
            const bool active = local ? (kr >= rs && kr < rs + 8) : true;
            if (active) {
                const int c_o = OPQV(c), cs_o = min(max(c_o - 8, 0), 48);
                LAS unsigned char* Kb = Kimg + buf * 8192; LAS unsigned char* Vb = Vimg + buf * 8192;
#pragma unroll
                for (int kt = 0; kt < 2; ++kt) {
                    f32x16 x;
                    if (local) { const int bidx = (kr - r + 7) * 31 + 32 * kt + 4 * hh - c_o + 15, t0 = 32 * kt + 4 * hh - cs_o;
#pragma unroll
                        for (int i = 0; i < 16; ++i) { const float tv = tab[bidx + crow0(i)]; x[i] = ((unsigned)(t0 + crow0(i)) < 16u) ? tv : -INFINITY; } }
                    else {
#pragma unroll
                        for (int i = 0; i < 16; ++i) x[i] = negmb; }
#pragma unroll
                    for (int s = 0; s < 4; ++s) x = MFMA32(rowfrag(Kb, 32 * kt + r32, 2 * s + hh), qf[s], x);
#pragma unroll
                    for (int i = 0; i < 16; ++i) { x[i] = __builtin_amdgcn_exp2f(x[i]); lsum += x[i]; }
                    const bf16x8 pa0 = PACK8(x, 0), pa1 = PACK8(x, 1);
                    o0 = MFMA32(trfrag(Vb, 32 * kt + 4 * hh, 32 * kt + 8 + 4 * hh, 0, lane), pa0, o0);
                    o0 = MFMA32(trfrag(Vb, 32 * kt + 16 + 4 * hh, 32 * kt + 24 + 4 * hh, 0, lane), pa1, o0);
                    o1 = MFMA32(trfrag(Vb, 32 * kt + 4 * hh, 32 * kt + 8 + 4 * hh, 1, lane), pa0, o1);
                    o1 = MFMA32(trfrag(Vb, 32 * kt + 16 + 4 * hh, 32 * kt + 24 + 4 * hh, 1, lane), pa1, o1);
                }
            }
            if (ci + 1 < nchunks) NA_STAGE(buf ^ 1, kw, vw);
            __syncthreads();
        }
#undef NA_TOK
#undef NA_STAGE
        lsum = xhalf_sum(lsum);
        const float il = 1.0f / lsum; bf16* op = MIX + (size_t)tq * DM + M_NA + h * 64 + 4 * hh;
#pragma unroll
        for (int g4 = 0; g4 < 4; ++g4) {
            u32x2 w0; w0.x = cvtpk(o0[4 * g4] * il, o0[4 * g4 + 1] * il); w0.y = cvtpk(o0[4 * g4 + 2] * il, o0[4 * g4 + 3] * il); *(u32x2*)(op + 8 * g4) = w0;
            u32x2 w1; w1.x = cvtpk(o1[4 * g4] * il, o1[4 * g4 + 1] * il); w1.y = cvtpk(o1[4 * g4 + 2] * il, o1[4 * g4 + 3] * il); *(u32x2*)(op + 32 + 8 * g4) = w1; }
    }
}

__device__ __forceinline__ void sg_mfma(const bf16* P, bf16* MIX, const bf16* Wsg, const float* sgb, const float* lnw, const float* lnb, LAS unsigned char* lds, int tid_in, int G) {
    const int wave = __builtin_amdgcn_readfirstlane(tid_in >> 6);
    for (int ch = blockIdx.x; ch < NCH; ch += G) {
        const int tid = FRESH_TID(wave), lane = tid & 63, r32 = lane & 31, hh = lane >> 5, tok = tid >> 2, sg = tid & 3;
        const int row0 = ch * 128;
        { const bf16* src = P + (size_t)(row0 + tok) * INC + C_SGV + sg * 64; float v[64]; float s = 0.f;
#pragma unroll
          for (int k8 = 0; k8 < 8; ++k8) load8(src + 8 * k8, v + 8 * k8);
#pragma unroll
          for (int k = 0; k < 64; ++k) { v[k] = gelu_tanh(v[k]); s += v[k]; }
          const float mu = s * (1.0f / 64.0f); float q = 0.f;
#pragma unroll
          for (int k = 0; k < 64; ++k) { v[k] -= mu; q += v[k] * v[k]; }
          const float rstd = 1.0f / sqrtf(q * (1.0f / 64.0f) + 1e-5f);
#pragma unroll
          for (int k8 = 0; k8 < 8; ++k8) { float t8[8];
#pragma unroll
              for (int j = 0; j < 8; ++j) { const int cch = sg * 64 + 8 * k8 + j; t8[j] = v[8 * k8 + j] * rstd * lnw[cch] + lnb[cch]; }
              st_chunk(lds + sg * 16384, tok, k8, t8); } }
        __syncthreads();
        { const int g = wave >> 1; LAS unsigned char* img = lds + g * 16384;
#pragma unroll
          for (int pp = 0; pp < 2; ++pp) { const int pt = 2 * (wave & 1) + pp, p = 32 * pt + r32;
            f32x16 a0 = zero16(), a1 = zero16();
            const bf16* wrow = Wsg + ((size_t)g * 128 + p) * 128 + 8 * hh;
#pragma unroll
            for (int ks = 0; ks < 8; ++ks) { const bf16x8 wf = *(const bf16x8*)(wrow + 16 * ks);
                a0 = MFMA32(trfrag(img, 16 * ks + 8 * hh, 16 * ks + 8 * hh + 4, 0, lane), wf, a0);
                a1 = MFMA32(trfrag(img, 16 * ks + 8 * hh, 16 * ks + 8 * hh + 4, 1, lane), wf, a1); }
            const float bias = sgb[g * 128 + p]; const size_t trow = (size_t)(row0 + p);
            const bf16* up = P + trow * INC + C_SGU + g * 64 + 4 * hh; bf16* op = MIX + trow * DM + M_SG + g * 64 + 4 * hh;
#pragma unroll
            for (int g4 = 0; g4 < 4; ++g4) {
                const u32x2 u0 = *(const u32x2*)(up + 8 * g4), u1 = *(const u32x2*)(up + 32 + 8 * g4);
                u32x2 w0, w1;
                w0.x = cvtpk(gelu_tanh(bflo(u0.x)) * (a0[4 * g4] + bias), gelu_tanh(bfhi(u0.x)) * (a0[4 * g4 + 1] + bias)); w0.y = cvtpk(gelu_tanh(bflo(u0.y)) * (a0[4 * g4 + 2] + bias), gelu_tanh(bfhi(u0.y)) * (a0[4 * g4 + 3] + bias));
                w1.x = cvtpk(gelu_tanh(bflo(u1.x)) * (a1[4 * g4] + bias), gelu_tanh(bfhi(u1.x)) * (a1[4 * g4 + 1] + bias)); w1.y = cvtpk(gelu_tanh(bflo(u1.y)) * (a1[4 * g4 + 2] + bias), gelu_tanh(bfhi(u1.y)) * (a1[4 * g4 + 3] + bias));
                *(u32x2*)(op + 8 * g4) = w0; *(u32x2*)(op + 32 + 8 * g4) = w1; } } }
        __syncthreads();
    }
}

__device__ __forceinline__ void ret_kv_mfma(const bf16* P, float* KV, const float* logit, const float* ropetab, LAS unsigned char* lds, int tid_in, int G) {
    const int wave = __builtin_amdgcn_readfirstlane(tid_in >> 6);
    LAS unsigned char* Kf = lds; LAS unsigned char* Kb = lds + 16384; LAS unsigned char* Vi = lds + 32768;
    for (int it_r = blockIdx.x; it_r < NCH * 6 * REP_KV; it_r += G) { const int it = it_r % (NCH * 6);
        const int tid = FRESH_TID(wave), lane = tid & 63, r32 = lane & 31, hh = lane >> 5, tok = tid >> 2, part = tid & 3;
        const int ch = it / 6, h = it % 6, row0 = ch * 128; const bool latent = ch < NCHL;
        { const float lgf = log_sigmoid(logit[h]) * LOG2E, lgb = log_sigmoid(logit[6 + h]) * LOG2E;
          const float wf = __builtin_amdgcn_exp2f(lgf * (float)(127 - tok)) * 0.125f, wb = __builtin_amdgcn_exp2f(lgb * (float)tok) * 0.125f;
          float k16[16], t8[8]; rope_load16(P, row0 + tok, C_RK, h, part, latent, ropetab, k16);
#pragma unroll
          for (int c2 = 0; c2 < 2; ++c2) {
#pragma unroll
              for (int j = 0; j < 8; ++j) t8[j] = k16[8 * c2 + j] * wf;
              st_chunk(Kf, tok, 2 * part + c2, t8);
#pragma unroll
              for (int j = 0; j < 8; ++j) t8[j] = k16[8 * c2 + j] * wb;
              st_chunk(Kb, tok, 2 * part + c2, t8); }
          const bf16* vp = P + (size_t)(row0 + tok) * INC + C_RV + h * 64 + part * 16;
          *(LAS v4u*)(Vi + off64(tok, 2 * part)) = *(const v4u*)vp; *(LAS v4u*)(Vi + off64(tok, 2 * part + 1)) = *(const v4u*)(vp + 8); }
        __syncthreads();
        { const int dir = wave >> 2, et = (wave >> 1) & 1, dt = wave & 1; LAS unsigned char* Kd = dir ? Kb : Kf;
          f32x16 acc = zero16();
#pragma unroll
          for (int ks = 0; ks < 8; ++ks)
              acc = MFMA32(trfrag(Vi, 16 * ks + 8 * hh, 16 * ks + 8 * hh + 4, et, lane), trfrag(Kd, 16 * ks + 8 * hh, 16 * ks + 8 * hh + 4, dt, lane), acc);
          float* o = KV + ((size_t)(ch * 6 + h) * 2 + dir) * 4096 + (size_t)(32 * et + 4 * hh) * 64 + 32 * dt + r32;
#pragma unroll
          for (int i = 0; i < 16; ++i) o[crow0(i) * 64] = acc[i]; }
        __syncthreads();
    }
}
__device__ __forceinline__ void ret_scan2(const float* KV, bf16* PREV, const float* logit, int gtid, int nthreads) {
    for (int it = gtid; it < NB * 6 * 2 * 4096; it += nthreads) {
        const int idx = it & 4095, dir = (it >> 12) & 1, bh = it >> 13, h = bh % 6, b = bh / 6;
        const float cd = expf(128.0f * log_sigmoid(logit[dir * 6 + h]));
#define KVI(ch) (((size_t)((ch) * 6 + h) * 2 + dir) * 4096 + idx)
        const int c0 = NCHL + 2 * b, c1 = c0 + 1;
        const float k0 = KV[KVI(c0)], k1 = KV[KVI(c1)];
        if (dir == 0) { PREV[KVI(c0)] = 0; PREV[KVI(c1)] = (bf16)f2bf(k0); float s = cd * k0 + k1;
            for (int n = 0; n < 64; ++n) { const int ch = b * 64 + n; PREV[KVI(ch)] = (bf16)f2bf(s); s = cd * s + KV[KVI(ch)]; } }
        else { PREV[KVI(c0)] = (bf16)f2bf(k1); PREV[KVI(c1)] = 0; float s = k0 + cd * k1;
            for (int n = 63; n >= 0; --n) { const int ch = b * 64 + n; PREV[KVI(ch)] = (bf16)f2bf(s); s = cd * s + KV[KVI(ch)]; } }
#undef KVI
    }
}
__device__ __forceinline__ void ret_out_mfma(const bf16* P, const bf16* PREV, bf16* MIX, const float* logit, const float* gnw, const float* ropetab, LAS unsigned char* lds, int tid_in, int G) {
    const int wave = __builtin_amdgcn_readfirstlane(tid_in >> 6);
    LAS unsigned char* Qi = lds; LAS unsigned char* Ki = lds + 16384; LAS unsigned char* Vi = lds + 32768;
    LAS float* st = (LAS float*)(lds + 49152);
    const int it_ = wave >> 1, et = wave & 1;
    for (int itm_r = blockIdx.x; itm_r < NCH * 6 * REP_RETO; itm_r += G) { const int itm = itm_r % (NCH * 6);
        const int tid = FRESH_TID(wave), lane = tid & 63, r32 = lane & 31, hh = lane >> 5, tok = tid >> 2, part = tid & 3;
        const int ch = itm / 6, h = itm % 6, row0 = ch * 128; const bool latent = ch < NCHL;
        { float t16[16], t8[8]; rope_load16(P, row0 + tok, C_RQ, h, part, latent, ropetab, t16);
          st_chunk(Qi, tok, 2 * part, t16); st_chunk(Qi, tok, 2 * part + 1, t16 + 8);
          rope_load16(P, row0 + tok, C_RK, h, part, latent, ropetab, t16);
#pragma unroll
          for (int c2 = 0; c2 < 2; ++c2) {
#pragma unroll
              for (int j = 0; j < 8; ++j) t8[j] = t16[8 * c2 + j] * 0.125f;
              st_chunk(Ki, tok, 2 * part + c2, t8); }
          const bf16* vp = P + (size_t)(row0 + tok) * INC + C_RV + h * 64 + part * 16;
          *(LAS v4u*)(Vi + off64(tok, 2 * part)) = *(const v4u*)vp; *(LAS v4u*)(Vi + off64(tok, 2 * part + 1)) = *(const v4u*)(vp + 8); }
        __syncthreads();
        const float lgf = log_sigmoid(logit[h]) * LOG2E, lgb = log_sigmoid(logit[6 + h]) * LOG2E;
        const int il = 32 * it_ + r32;
        bf16x8 qf[4];
#pragma unroll
        for (int s = 0; s < 4; ++s) qf[s] = rowfrag(Qi, il, 2 * s + hh);
        f32x16 of = zero16(), ob = zero16();
#pragma unroll
        for (int jt = 0; jt < 4; ++jt) {
            f32x16 x = zero16();
#pragma unroll
            for (int s = 0; s < 4; ++s) x = MFMA32(rowfrag(Ki, 32 * jt + r32, 2 * s + hh), qf[s], x);
            if (jt <= it_) { f32x16 w;
#pragma unroll
                for (int i = 0; i < 16; ++i) { const int jl = 32 * jt + crow0(i) + 4 * hh; w[i] = (jl <= il) ? x[i] * __builtin_amdgcn_exp2f(lgf * (float)(il - jl)) : 0.f; }
                const bf16x8 p0 = PACK8(w, 0), p1 = PACK8(w, 1);
                of = MFMA32(trfrag(Vi, 32 * jt + 4 * hh, 32 * jt + 8 + 4 * hh, et, lane), p0, of);
                of = MFMA32(trfrag(Vi, 32 * jt + 16 + 4 * hh, 32 * jt + 24 + 4 * hh, et, lane), p1, of); }
            if (jt >= it_) { f32x16 w;
#pragma unroll
                for (int i = 0; i < 16; ++i) { const int jl = 32 * jt + crow0(i) + 4 * hh; w[i] = (jl >= il) ? x[i] * __builtin_amdgcn_exp2f(lgb * (float)(jl - il)) : 0.f; }
                const bf16x8 p0 = PACK8(w, 0), p1 = PACK8(w, 1);
                ob = MFMA32(trfrag(Vi, 32 * jt + 4 * hh, 32 * jt + 8 + 4 * hh, et, lane), p0, ob);
                ob = MFMA32(trfrag(Vi, 32 * jt + 16 + 4 * hh, 32 * jt + 24 + 4 * hh, et, lane), p1, ob); }
        }
        { const bf16* pf = PREV + ((size_t)(ch * 6 + h) * 2) * 4096 + (size_t)(32 * et + r32) * 64 + 8 * hh; const bf16* pb = pf + 4096;
          f32x16 cf = zero16(), cb = zero16();
#pragma unroll
          for (int s = 0; s < 4; ++s) { cf = MFMA32(*(const bf16x8*)(pf + 16 * s), qf[s], cf); cb = MFMA32(*(const bf16x8*)(pb + 16 * s), qf[s], cb); }
          const float df = __builtin_amdgcn_exp2f(lgf * (float)(il + 1)), db = __builtin_amdgcn_exp2f(lgb * (float)(128 - il));
#pragma unroll
          for (int i = 0; i < 16; ++i) { of[i] += df * cf[i]; ob[i] += db * cb[i]; } }
        float s1f = 0.f, s2f = 0.f, s1b = 0.f, s2b = 0.f;
#pragma unroll
        for (int i = 0; i < 16; ++i) { s1f += of[i]; s2f += of[i] * of[i]; s1b += ob[i]; s2b += ob[i] * ob[i]; }
        s1f = xhalf_sum(s1f); s2f = xhalf_sum(s2f); s1b = xhalf_sum(s1b); s2b = xhalf_sum(s2b);
        if (hh == 0) { LAS float* sp = st + (wave * 32 + r32) * 4; sp[0] = s1f; sp[1] = s2f; sp[2] = s1b; sp[3] = s2b; }
        __syncthreads();
        { const LAS float* sp = st + ((wave ^ 1) * 32 + r32) * 4; s1f += sp[0]; s2f += sp[1]; s1b += sp[2]; s2b += sp[3]; }
        const float muf = s1f * (1.0f / 64.0f), mub = s1b * (1.0f / 64.0f);
        const float rf = 1.0f / sqrtf(fmaxf(s2f * (1.0f / 64.0f) - muf * muf, 0.f) + 1e-5f), rb = 1.0f / sqrtf(fmaxf(s2b * (1.0f / 64.0f) - mub * mub, 0.f) + 1e-5f);
        { const size_t trow = (size_t)(row0 + il); const int e0 = h * 64 + 32 * et + 4 * hh;
          const bf16* gp = P + trow * INC + C_GF + e0; bf16* op = MIX + trow * DM + M_RET + e0;
#pragma unroll
          for (int g4 = 0; g4 < 4; ++g4) { const u32x2 gfw = *(const u32x2*)(gp + 8 * g4), gbw = *(const u32x2*)(gp + (C_GB - C_GF) + 8 * g4);
              const float gfv[4] = {bflo(gfw.x), bfhi(gfw.x), bflo(gfw.y), bfhi(gfw.y)}, gbv[4] = {bflo(gbw.x), bfhi(gbw.x), bflo(gbw.y), bfhi(gbw.y)};
              float y[4];
#pragma unroll
              for (int k = 0; k < 4; ++k) { const int i = 4 * g4 + k;
                  y[k] = ((of[i] - muf) * rf * (gfv[k] * sigmoidf_(gfv[k])) + (ob[i] - mub) * rb * (gbv[k] * sigmoidf_(gbv[k]))) * gnw[e0 + 8 * g4 + k]; }
              u32x2 w; w.x = cvtpk(y[0], y[1]); w.y = cvtpk(y[2], y[3]); *(u32x2*)(op + 8 * g4) = w; } }
        __syncthreads();
    }
}

__device__ __forceinline__ void ret_out_mfma2(const bf16* P, const bf16* PREV, bf16* MIX, const float* logit, const float* gnw, const float* ropetab, LAS unsigned char* lds, int tid_in, int G) {
    const int wave = __builtin_amdgcn_readfirstlane(tid_in >> 6);
    LAS float* tabL = (LAS float*)(lds + 98304);
    LAS float* stL = (LAS float*)(lds + 98304 + 16384);
    { const int t0 = FRESH_TID(wave); for (int i = t0; i < 1024; i += 512) ((LAS f32x4*)tabL)[i] = ((const f32x4*)ropetab)[i]; }
    __syncthreads();
    const int it_ = wave >> 1, et = wave & 1;
    v4u rq0, rq1, rk0, rk1, rv0, rv1;
#define RO_LOAD(uu) do { const int t_ = FRESH_TID(wave); const int ch_ = (uu) / 6, h_ = (uu) % 6, pt_ = t_ & 3; \
        const bf16* b_ = P + (size_t)(ch_ * 128 + (t_ >> 2)) * INC + h_ * 64 + 32 * (pt_ >> 1) + 8 * (pt_ & 1); \
        rq0 = *(const v4u*)(b_ + C_RQ); rq1 = *(const v4u*)(b_ + C_RQ + 16); rk0 = *(const v4u*)(b_ + C_RK); rk1 = *(const v4u*)(b_ + C_RK + 16); rv0 = *(const v4u*)(b_ + C_RV); rv1 = *(const v4u*)(b_ + C_RV + 16); } while (0)
    int u = blockIdx.x;
    if (u < NCH * 6 * REP_RETO) RO_LOAD(u % (NCH * 6));
    for (int n = 0; u < NCH * 6 * REP_RETO; u += G, ++n) {
        const int itm = u % (NCH * 6);
        const int tid = FRESH_TID(wave), lane = tid & 63, r32 = lane & 31, hh = lane >> 5, tok = tid >> 2, part = tid & 3;
        const int ch = itm / 6, h = itm % 6, row0 = ch * 128; const bool latent = ch < NCHL;
        LAS unsigned char* Qi = lds + (n & 1) * 49152; LAS unsigned char* Ki = Qi + 16384; LAS unsigned char* Vi = Qi + 32768;
        LAS float* st = stL + (n & 1) * 1024;
        { const int c1 = 4 * (part >> 1) + (part & 1), c2 = c1 + 2;
          float q1[8], q2[8], k1[8], k2[8];
          q1[0] = bflo(rq0.x); q1[1] = bfhi(rq0.x); q1[2] = bflo(rq0.y); q1[3] = bfhi(rq0.y); q1[4] = bflo(rq0.z); q1[5] = bfhi(rq0.z); q1[6] = bflo(rq0.w); q1[7] = bfhi(rq0.w);
          q2[0] = bflo(rq1.x); q2[1] = bfhi(rq1.x); q2[2] = bflo(rq1.y); q2[3] = bfhi(rq1.y); q2[4] = bflo(rq1.z); q2[5] = bfhi(rq1.z); q2[6] = bflo(rq1.w); q2[7] = bfhi(rq1.w);
          k1[0] = bflo(rk0.x); k1[1] = bfhi(rk0.x); k1[2] = bflo(rk0.y); k1[3] = bfhi(rk0.y); k1[4] = bflo(rk0.z); k1[5] = bfhi(rk0.z); k1[6] = bflo(rk0.w); k1[7] = bfhi(rk0.w);
          k2[0] = bflo(rk1.x); k2[1] = bfhi(rk1.x); k2[2] = bflo(rk1.y); k2[3] = bfhi(rk1.y); k2[4] = bflo(rk1.z); k2[5] = bfhi(rk1.z); k2[6] = bflo(rk1.w); k2[7] = bfhi(rk1.w);
          if (latent) { const int pos = (row0 + tok) & (SEQ - 1); const int nn = (part >> 1) ? (pos & 63) : (pos >> 6);
              const LAS f32x2_t* tb = (const LAS f32x2_t*)tabL + nn * 16 + 8 * (part & 1);
#pragma unroll
              for (int j = 0; j < 8; ++j) { const f32x2_t cs = tb[j]; const float a = q1[j], b = q2[j], c = k1[j], d = k2[j];
                  q1[j] = a * cs.x - b * cs.y; q2[j] = a * cs.y + b * cs.x; k1[j] = c * cs.x - d * cs.y; k2[j] = c * cs.y + d * cs.x; } }
#pragma unroll
          for (int j = 0; j < 8; ++j) { k1[j] *= 0.125f; k2[j] *= 0.125f; }
          st_chunk(Qi, tok, c1, q1); st_chunk(Qi, tok, c2, q2); st_chunk(Ki, tok, c1, k1); st_chunk(Ki, tok, c2, k2);
          *(LAS v4u*)(Vi + off64(tok, c1)) = rv0; *(LAS v4u*)(Vi + off64(tok, c2)) = rv1; }
        if (u + G < NCH * 6 * REP_RETO) RO_LOAD((u + G) % (NCH * 6));
        const int il = 32 * it_ + r32;
        const bf16* pf = PREV + ((size_t)(ch * 6 + h) * 2) * 4096 + (size_t)(32 * et + r32) * 64 + 8 * hh;
        bf16x8 pff[4], pfb[4];
#pragma unroll
        for (int s = 0; s < 4; ++s) { pff[s] = *(const bf16x8*)(pf + 16 * s); pfb[s] = *(const bf16x8*)(pf + 4096 + 16 * s); }
        const size_t trow = (size_t)(row0 + il); const int e0 = h * 64 + 32 * et + 4 * hh;
        const bf16* gp = P + trow * INC + C_GF + e0;
        u32x2 gfw[4], gbw[4];
#pragma unroll
        for (int g4 = 0; g4 < 4; ++g4) { gfw[g4] = *(const u32x2*)(gp + 8 * g4); gbw[g4] = *(const u32x2*)(gp + (C_GB - C_GF) + 8 * g4); }
        const float lgf = log_sigmoid(logit[h]) * LOG2E, lgb = log_sigmoid(logit[6 + h]) * LOG2E;
        float af[4], bfv[4], ab[4], bb[4];
#pragma unroll
        for (int k = 0; k < 4; ++k) { af[k] = __builtin_amdgcn_exp2f(-lgf * (float)k); bfv[k] = __builtin_amdgcn_exp2f(-lgf * (float)(8 * k)); ab[k] = __builtin_amdgcn_exp2f(lgb * (float)k); bb[k] = __builtin_amdgcn_exp2f(lgb * (float)(8 * k)); }
        __syncthreads();
        bf16x8 qf[4];
#pragma unroll
        for (int s = 0; s < 4; ++s) qf[s] = rowfrag(Qi, il, 2 * s + hh);
        f32x16 of = zero16(), ob = zero16();
#pragma unroll
        for (int jt = 0; jt < 4; ++jt) {
            f32x16 x = zero16();
#pragma unroll
            for (int s = 0; s < 4; ++s) x = MFMA32(rowfrag(Ki, 32 * jt + r32, 2 * s + hh), qf[s], x);
            if (jt <= it_) { f32x16 w; const float lf = __builtin_amdgcn_exp2f(lgf * (float)(il - 32 * jt - 4 * hh));
#pragma unroll
                for (int g = 0; g < 4; ++g) { const float lg = lf * bfv[g];
#pragma unroll
                    for (int k = 0; k < 4; ++k) { const int i = 4 * g + k; const float v = x[i] * (lg * af[k]); w[i] = (jt < it_ || crow0(i) + 4 * hh <= r32) ? v : 0.f; } }
                const bf16x8 p0 = PACK8(w, 0), p1 = PACK8(w, 1);
                of = MFMA32(trfrag(Vi, 32 * jt + 4 * hh, 32 * jt + 8 + 4 * hh, et, lane), p0, of);
                of = MFMA32(trfrag(Vi, 32 * jt + 16 + 4 * hh, 32 * jt + 24 + 4 * hh, et, lane), p1, of); }
            if (jt >= it_) { f32x16 w; const float lb = __builtin_amdgcn_exp2f(lgb * (float)(32 * jt + 4 * hh - il));
#pragma unroll
                for (int g = 0; g < 4; ++g) { const float lg = lb * bb[g];
#pragma unroll
                    for (int k = 0; k < 4; ++k) { const int i = 4 * g + k; const float v = x[i] * (lg * ab[k]); w[i] = (jt > it_ || crow0(i) + 4 * hh >= r32) ? v : 0.f; } }
                const bf16x8 p0 = PACK8(w, 0), p1 = PACK8(w, 1);
                ob = MFMA32(trfrag(Vi, 32 * jt + 4 * hh, 32 * jt + 8 + 4 * hh, et, lane), p0, ob);
                ob = MFMA32(trfrag(Vi, 32 * jt + 16 + 4 * hh, 32 * jt + 24 + 4 * hh, et, lane), p1, ob); }
        }
        { f32x16 cf = zero16(), cb = zero16();
#pragma unroll
          for (int s = 0; s < 4; ++s) { cf = MFMA32(pff[s], qf[s], cf); cb = MFMA32(pfb[s], qf[s], cb); }
          const float df = __builtin_amdgcn_exp2f(lgf * (float)(il + 1)), db = __builtin_amdgcn_exp2f(lgb * (float)(128 - il));
#pragma unroll
          for (int i = 0; i < 16; ++i) { of[i] += df * cf[i]; ob[i] += db * cb[i]; } }
        float s1f = 0.f, s2f = 0.f, s1b = 0.f, s2b = 0.f;
#pragma unroll
        for (int i = 0; i < 16; ++i) { s1f += of[i]; s2f += of[i] * of[i]; s1b += ob[i]; s2b += ob[i] * ob[i]; }
        s1f = xhalf_sum(s1f); s2f = xhalf_sum(s2f); s1b = xhalf_sum(s1b); s2b = xhalf_sum(s2b);
        if (hh == 0) { LAS float* sp = st + (wave * 32 + r32) * 4; sp[0] = s1f; sp[1] = s2f; sp[2] = s1b; sp[3] = s2b; }
        __syncthreads();
        { const LAS float* sp = st + ((wave ^ 1) * 32 + r32) * 4; s1f += sp[0]; s2f += sp[1]; s1b += sp[2]; s2b += sp[3]; }
        const float muf = s1f * (1.0f / 64.0f), mub = s1b * (1.0f / 64.0f);
        const float rf = __builtin_amdgcn_rsqf(fmaxf(s2f * (1.0f / 64.0f) - muf * muf, 0.f) + 1e-5f), rb = __builtin_amdgcn_rsqf(fmaxf(s2b * (1.0f / 64.0f) - mub * mub, 0.f) + 1e-5f);
        { bf16* op = MIX + trow * DM + M_RET + e0;
#pragma unroll
          for (int g4 = 0; g4 < 4; ++g4) {
              const float gfv[4] = {bflo(gfw[g4].x), bfhi(gfw[g4].x), bflo(gfw[g4].y), bfhi(gfw[g4].y)}, gbv[4] = {bflo(gbw[g4].x), bfhi(gbw[g4].x), bflo(gbw[g4].y), bfhi(gbw[g4].y)};
              float y[4];
#pragma unroll
              for (int k = 0; k < 4; ++k) { const int i = 4 * g4 + k;
                  const float sf = gfv[k] * __builtin_amdgcn_rcpf(1.0f + __builtin_amdgcn_exp2f(-LOG2E * gfv[k])), sb = gbv[k] * __builtin_amdgcn_rcpf(1.0f + __builtin_amdgcn_exp2f(-LOG2E * gbv[k]));
                  y[k] = ((of[i] - muf) * rf * sf + (ob[i] - mub) * rb * sb) * gnw[e0 + 8 * g4 + k]; }
              u32x2 w; w.x = cvtpk(y[0], y[1]); w.y = cvtpk(y[2], y[3]); *(u32x2*)(op + 8 * g4) = w; } }
    }
#undef RO_LOAD
    __syncthreads();
}

#ifndef REP_NORM
#define REP_NORM 1
#endif
#ifndef REP_UP
#define REP_UP 1
#endif
#ifndef REP_WIN
#define REP_WIN 1
#endif
#ifndef REP_NA
#define REP_NA 1
#endif
#ifndef REP_SG
#define REP_SG 1
#endif
#ifndef REP_KV
#define REP_KV 1
#endif
#ifndef REP_SCAN
#define REP_SCAN 1
#endif
#ifndef REP_RETO
#define REP_RETO 1
#endif
#ifndef REP_PRO
#define REP_PRO 1
#endif

struct Args { In in; float* out; unsigned char* ws; int ph_lo, ph_hi; };
__global__ void __launch_bounds__(NWAVES * 64, 2) hybrid_fwd(Args args) {
    extern __shared__ __attribute__((aligned(16))) unsigned char lds_raw[];
    LAS unsigned char* lds = (LAS unsigned char*)lds_raw;
    volatile LAS unsigned* MISC = (volatile LAS unsigned*)(lds + MISC_OFF);
    const int tid = threadIdx.x, lane = tid & 63, wave = __builtin_amdgcn_readfirstlane(tid >> 6);
    const int G = gridDim.x; const int bx = blockIdx.x; const int vcu = (G % 8 == 0) ? (bx % 8) * (G / 8) + bx / 8 : bx;
    const int NGW = G * NWAVES, nthreads = G * NWAVES * 64;
    unsigned char* ws = args.ws; const In& I = args.in;
    gu32* ctl = (gu32*)(ws + WS_CTL);
    for (int u = tid; u < (LDS_BYTES - LDSCTL_OFF) / 4; u += NWAVES * 64) ((LAS unsigned*)(lds + LDSCTL_OFF))[u] = 0u;
    __syncthreads();
    XcdBarrier bar; bar.bar = (unsigned*)(ctl + CW_BAR); bar.x = 0; bar.st = nullptr;
    if (MK_ONE_LAUNCH) bar = xcd_barrier_post((unsigned*)(ctl + CW_BAR), MISC + 8);
    const int lo = args.ph_lo, hi = args.ph_hi; int ph = 0;
#define PH_ON (ph >= lo && ph < hi)
#define OPQ(x) ({ int _t; asm volatile("v_mbcnt_lo_u32_b32 %0, -1, 0\n\tv_mbcnt_hi_u32_b32 %0, -1, %0" : "=v"(_t)); _t | (wave << 6); })
#define PH_END do { if (MK_ONE_LAUNCH && ph >= lo && ph + 1 < hi) xcd_barrier(bar); ++ph; } while (0)

    float* mod = (float*)(ws + WS_MOD); const float* ropetab = (const float*)(ws + WS_ROPE);
    bf16* W1T = (bf16*)(ws + WS_W1T); bf16* W2T = (bf16*)(ws + WS_W2T); bf16* WINT = (bf16*)(ws + WS_WINT); bf16* WOUTT = (bf16*)(ws + WS_WOUTT);
    float* ctxbuf = (float*)(ws + WS_CTXBUF); bf16* XN = (bf16*)(ws + WS_XN); bf16* PB = (bf16*)(ws + WS_P); bf16* HB = (bf16*)(ws + WS_P);
    float* KV = (float*)(ws + WS_KV); float* PREV = (float*)(ws + WS_PREV);

    if (PH_ON) for (int rep_ = 0; rep_ < REP_PRO; ++rep_) p0_prologue(I, ws, lds, tid, lane, wave, vcu, G);
    PH_END;

    for (int hs = 0; hs < 2 * DEPTH; ++hs) {
        const int L = hs >> 1, half = hs & 1; const bool last = (L == DEPTH - 1), first = (hs == 0);
        const int Mrows = (last && half == 1) ? TL : TT;
        const float* modL = mod + (size_t)L * 9 * 9216;
        const float* xl = first ? I.x : args.out; const float* xc = first ? I.ctx : ctxbuf;
        if (PH_ON) { const int t_ = OPQ(threadIdx.x); norm_phase(xl, xc, Mrows, I.norm_w + (size_t)(L * 3 + (half ? 2 : 0)) * DM, modL, half ? 6 : 0, XN, vcu * NWAVES + (t_ >> 6), NGW, t_ & 63); }
        PH_END;
        if (PH_ON) for (int rep_ = 0; rep_ < REP_UP; ++rep_) { pg8::Gemm g{XN, W1T + (size_t)(L * 2 + half) * DM * 2 * DFF, Mrows, 2 * DFF, DM}; pg8::StaticOrder S; S.init(Mrows, 2 * DFF, G, bx);
            pg8::EpiSwiGLU E{HB, DFF};
            pg8::gemm_phase<pg8::EpiSwiGLU, pg8::StaticOrder, true, true>(lds, g, S, E, wave); }
        PH_END;
        if (PH_ON) { pg8::Gemm g{HB, W2T + (size_t)(L * 2 + half) * DFF * DM, Mrows, DM, DFF}; pg8::StaticOrder S; S.init(Mrows, DM, G, bx);
            pg8::EpiResGate E{xl, xc, args.out, ctxbuf, modL + (half ? 8 : 2) * 1024, 0.5f};
            pg8::gemm_phase<pg8::EpiResGate, pg8::StaticOrder, true, true>(lds, g, S, E, wave); }
        PH_END;
        if (half == 0) {
            if (PH_ON) { const int t_ = OPQ(threadIdx.x); norm_phase(args.out, ctxbuf, TT, I.norm_w + (size_t)(L * 3 + 1) * DM, modL, 3, XN, vcu * NWAVES + (t_ >> 6), NGW, t_ & 63); }
            PH_END;
            if (PH_ON) for (int rep_ = 0; rep_ < REP_WIN; ++rep_) { pg8::Gemm g{XN, WINT + (size_t)L * DM * INC, TT, INC, DM}; pg8::StaticOrder S; S.init(TT, INC, G, bx);
                pg8::EpiStoreBf16 E{PB, INC};
                pg8::gemm_phase<pg8::EpiStoreBf16, pg8::StaticOrder, true, true>(lds, g, S, E, wave); }
            PH_END;
            const float* logit = I.ret_logit + L * 12;
            if (PH_ON) { const int t_ = OPQ(threadIdx.x);
                for (int rep_ = 0; rep_ < REP_NA; ++rep_) na_mfma(PB, XN, I.na_qn + L * 64, I.na_kn + L * 64, I.na_rpb + (size_t)L * 6 * 15 * 31, !last, lds, t_, G);
                for (int rep_ = 0; rep_ < REP_SG; ++rep_) sg_mfma(PB, XN, (const bf16*)(ws + WS_WSG) + (size_t)L * 4 * 128 * 128, I.sg_b + L * 4 * 128, I.sg_ln_w + L * 256, I.sg_ln_b + L * 256, lds, t_, G);
                ret_kv_mfma(PB, KV, logit, ropetab, lds, t_, G);
            }
            PH_END;
            if (PH_ON) for (int rep_ = 0; rep_ < REP_SCAN; ++rep_) { const int t_ = OPQ(threadIdx.x); ret_scan2(KV, (bf16*)PREV, logit, bx * (NWAVES * 64) + t_, nthreads); }
            PH_END;
            if (PH_ON) { const int t_ = OPQ(threadIdx.x); ret_out_mfma2(PB, (const bf16*)PREV, XN, logit, I.ret_gn_w + L * 384, ropetab, lds, t_, G); }
            PH_END;
            const int Mo = last ? TL : TT;
            if (PH_ON) { pg8::Gemm g{XN, WOUTT + (size_t)L * DM * DM, Mo, DM, DM}; pg8::StaticOrder S; S.init(Mo, DM, G, bx);
                pg8::EpiResGate E{args.out, ctxbuf, args.out, ctxbuf, modL + 5 * 1024, 1.0f};
                pg8::gemm_phase<pg8::EpiResGate, pg8::StaticOrder, true, true>(lds, g, S, E, wave); }
            PH_END;
        }
    }
#undef PH_ON
#undef PH_END
}

extern "C" void kernel_launch(void* const* d_in, const int* in_sizes, int n_in, void* d_out, int out_size, void* d_ws, size_t ws_size, hipStream_t stream) {
    static int grid = 0;
    if (grid == 0) {
        if (n_in != 20 || in_sizes[0] != TL * DM || out_size != TL * DM || ws_size < WS_END) { fprintf(stderr, "kernel_launch: unexpected shapes (n_in %d, in0 %d, out %d, ws %zu); nothing launched\n", n_in, n_in > 0 ? in_sizes[0] : -1, out_size, ws_size); grid = -1; return; }
        int dev = 0, cus = 0, per_cu = 0;
        if (hipGetDevice(&dev) != hipSuccess || hipDeviceGetAttribute(&cus, hipDeviceAttributeMultiprocessorCount, dev) != hipSuccess) { grid = -1; return; }
        if (hipFuncSetAttribute((const void*)hybrid_fwd, hipFuncAttributeMaxDynamicSharedMemorySize, LDS_BYTES) != hipSuccess) { fprintf(stderr, "kernel_launch: hipFuncSetAttribute failed\n"); grid = -1; return; }
        if (hipOccupancyMaxActiveBlocksPerMultiprocessor(&per_cu, (const void*)hybrid_fwd, NWAVES * 64, LDS_BYTES) != hipSuccess || per_cu < 1)
            fprintf(stderr, "kernel_launch: note: occupancy query reports %d workgroups per CU\n", per_cu);
        (void)hipGetLastError();
        grid = cus;
    }
    if (grid < 0) return;
    if (hipMemsetAsync((char*)d_ws + WS_CTL, 0, CTL_ZERO_BYTES, stream) != hipSuccess) return;
    Args a{};
    const float** ip = (const float**)&a.in;
    for (int i = 0; i < 20; ++i) ip[i] = (const float*)d_in[i];
    a.out = (float*)d_out; a.ws = (unsigned char*)d_ws;
#if MK_ONE_LAUNCH
    a.ph_lo = 0; a.ph_hi = NPH;
    hipLaunchKernelGGL(hybrid_fwd, dim3(grid), dim3(NWAVES * 64), LDS_BYTES, stream, a);
#else
    for (int li = 0; li < NPH; ++li) { a.ph_lo = li; a.ph_hi = li + 1; hipLaunchKernelGGL(hybrid_fwd, dim3(grid), dim3(NWAVES * 64), LDS_BYTES, stream, a); }
#endif
}
```

```cpp
#include <hip/hip_runtime.h>
#include <cstdio>
#include <cstdint>
namespace pg8 {
#define PG8_LAS __attribute__((address_space(3)))
typedef unsigned short bf16_t;
typedef short bf16x8 __attribute__((ext_vector_type(8)));
typedef float f32x4 __attribute__((ext_vector_type(4)));
typedef unsigned u32x4 __attribute__((ext_vector_type(4)));
constexpr int BM = 256, BK = 64, HALF = 128, HTB = HALF * BK * 2  , STAGE_BYTES = 8 * HTB, NXCD = 8, WGM = 8;

__host__ __device__ __forceinline__ int lds_byte(int r, int c) { const int st = (r >> 4) * 2 + (c >> 5), rr = r & 15, cc = c & 31, ob = rr * 64 + cc * 2; return st * 1024 + (ob ^ (((ob >> 9) & 1) << 5)); }
__host__ __device__ __forceinline__ void stage_rc(int b, int& R, int& C) { const int st = b / 1024, sb = b % 1024, swz = sb ^ (((sb >> 9) & 1) << 5); R = (st >> 1) * 16 + swz / 64; C = (st & 1) * 32 + (swz % 64) / 2; }
__host__ __device__ __forceinline__ int perm32(int rho) { const int n = rho >> 4, i = rho & 15; return 8 * (i >> 2) + 4 * n + (i & 3); }

struct Unit { int pm, pn; };
struct Gemm { const bf16_t* A; const bf16_t* Bt; int M, N, K; };

struct StaticOrder {
    int nM, nN, nwg, G, c;
    __host__ __device__ void init(int M, int N, int G_, int c_) { nM = M / BM; nN = N / BM; nwg = nM * nN; G = G_; c = c_; }
    __host__ __device__ bool next(int i, Unit& u) const {
        const long L = (long)i * G + c; if (L >= nwg) return false;
        int wgid = (int)L; { const int q = nwg / NXCD, r = nwg % NXCD, xcd = wgid % NXCD, off = wgid / NXCD; wgid = (xcd < r ? xcd * (q + 1) : r * (q + 1) + (xcd - r) * q) + off; }
        const int nig = WGM * nN, gid = wgid / nig, fm = gid * WGM, gsz = (nM - fm) < WGM ? (nM - fm) : WGM;
        u.pm = fm + ((wgid % nig) % gsz); u.pn = (wgid % nig) / gsz; return true;
    }
    __device__ __forceinline__ void a_ready(const Unit&) const {}
    __device__ __forceinline__ void done(const Unit&) const {}
};
__device__ __forceinline__ unsigned cvt_pk_bf16(float lo, float hi) { unsigned r; asm volatile("v_cvt_pk_bf16_f32 %0, %1, %2" : "=v"(r) : "v"(lo), "v"(hi)); return r; }
typedef float f32x2 __attribute__((ext_vector_type(2)));
template <class Epi, class Sched, bool ALIGN_EPI = false, bool SP2 = false>
__device__ __forceinline__ void gemm_phase(PG8_LAS unsigned char* lds, const Gemm g, const Sched& S, const Epi& E, const int wave_s) {
    int tid_o; asm volatile("v_mbcnt_lo_u32_b32 %0, -1, 0\n\tv_mbcnt_hi_u32_b32 %0, -1, %0" : "=v"(tid_o)); tid_o |= wave_s << 6;
    const int tid = tid_o, wid = __builtin_amdgcn_readfirstlane(tid >> 6), lane = tid & 63, wr = wid >> 2, wc = wid & 3, fr = lane & 15, fq = lane >> 4;
    const int K = g.K, nt = K / BK;
    unsigned voffA[2], voffB[2];
#pragma unroll
    for (int i = 0; i < 2; ++i) { int R, C; stage_rc(tid * 16 + i * 8192, R, C); const int Rb = Epi::PERM ? ((R & ~31) + perm32(R & 31)) : R;
        voffA[i] = (unsigned)(R * K + C) * 2u; voffB[i] = (unsigned)(Rb * K + C) * 2u; }
    const size_t kstep = (size_t)(BK * 2);
    const size_t hstep = (size_t)HALF * K * 2;
    const size_t tstep = 2 * hstep;
    const unsigned ldsw = (unsigned)wid * 1024u;
    const int aoff = lds_byte(wr * 64 + fr, fq * 8), boff = lds_byte(wc * 32 + fr, fq * 8);
#define PG8_SA(b, h) (((b) * 2 + (h)) * HTB)
#define PG8_SB(b, h) ((4 + (b) * 2 + (h)) * HTB)
#define PG8_STAGE(bufoff, gbase, voff) do { _Pragma("unroll") for (int _i = 0; _i < 2; ++_i) \
        __builtin_amdgcn_global_load_lds((const unsigned*)((const char*)(gbase) + (voff)[_i]), (PG8_LAS unsigned*)(lds + (bufoff) + ldsw + _i * 8192), 16, 0, 0); } while (0)
#define PG8_LDA(dst, b, h) do { _Pragma("unroll") for (int m = 0; m < 4; ++m) _Pragma("unroll") for (int k = 0; k < 2; ++k) dst[m][k] = *(const PG8_LAS bf16x8*)(lds + PG8_SA(b, h) + aoff + m * 2048 + k * 1024); } while (0)
#define PG8_LDB(dst, b, h) do { _Pragma("unroll") for (int n = 0; n < 2; ++n) _Pragma("unroll") for (int k = 0; k < 2; ++k) dst[n][k] = *(const PG8_LAS bf16x8*)(lds + PG8_SB(b, h) + boff + n * 2048 + k * 1024); } while (0)
#define PG8_MMA(ai, bj, At, Bt) do { __builtin_amdgcn_s_setprio(1); _Pragma("unroll") for (int m = 0; m < 4; ++m) _Pragma("unroll") for (int n = 0; n < 2; ++n) _Pragma("unroll") for (int k = 0; k < 2; ++k) \
        acc[ai][bj][m][n] = __builtin_amdgcn_mfma_f32_16x16x32_bf16(Bt[n][k], At[m][k], acc[ai][bj][m][n], 0, 0, 0); __builtin_amdgcn_s_setprio(0); } while (0)
#define PG8_WAIT_V(n) asm volatile("s_waitcnt vmcnt(" #n ")" ::: "memory")
#define PG8_WAIT_L(n) asm volatile("s_waitcnt lgkmcnt(" #n ")" ::: "memory")
#define PG8_BAR __builtin_amdgcn_s_barrier()
#define PG8_SCHED __builtin_amdgcn_sched_barrier(0)
    Unit cur, nxt; int ui = 0;
    if (!S.next(0, cur)) return;
    f32x4 acc[2][2][4][2];
#pragma unroll
    for (int a = 0; a < 2; ++a)
#pragma unroll
        for (int b = 0; b < 2; ++b)
#pragma unroll
            for (int m = 0; m < 4; ++m)
#pragma unroll
                for (int n = 0; n < 2; ++n) acc[a][b][m][n] = (f32x4){0.f, 0.f, 0.f, 0.f};
    bf16x8 At[4][2], B0[2][2], B1[2][2];
    const char* cA = (const char*)g.A + (size_t)cur.pm * tstep; const char* cB = (const char*)g.Bt + (size_t)cur.pn * tstep;
    S.a_ready(cur);
    if constexpr (SP2) {
        PG8_STAGE(PG8_SB(0, 0), cB, voffB); PG8_STAGE(PG8_SB(0, 1), cB + hstep, voffB); PG8_STAGE(PG8_SA(0, 0), cA, voffA); PG8_STAGE(PG8_SA(0, 1), cA + hstep, voffA);
        if (wr == 1) PG8_BAR;
        PG8_WAIT_V(2); PG8_BAR;
        PG8_STAGE(PG8_SB(1, 0), cB + kstep, voffB); PG8_STAGE(PG8_SA(1, 0), cA + kstep, voffA); PG8_STAGE(PG8_SB(1, 1), cB + hstep + kstep, voffB);
        PG8_WAIT_V(6); PG8_BAR;
    } else {
        PG8_STAGE(PG8_SB(0, 0), cB, voffB); PG8_STAGE(PG8_SA(0, 0), cA, voffA); PG8_STAGE(PG8_SB(0, 1), cB + hstep, voffB); PG8_STAGE(PG8_SA(0, 1), cA + hstep, voffA);
        if (wr == 1) PG8_BAR;
        PG8_WAIT_V(4); PG8_BAR;
        PG8_STAGE(PG8_SB(1, 0), cB + kstep, voffB); PG8_STAGE(PG8_SA(1, 0), cA + kstep, voffA); PG8_STAGE(PG8_SB(1, 1), cB + hstep + kstep, voffB);
        PG8_WAIT_V(6); PG8_BAR;
    }
    for (;;) {
        const bool has_next = S.next(ui + 1, nxt);
        const char* nA = has_next ? (const char*)g.A + (size_t)nxt.pm * tstep : cA; const char* nB = has_next ? (const char*)g.Bt + (size_t)nxt.pn * tstep : cB;
        for (int t = 0; t < nt; t += 2) {
            const bool last = (t == nt - 2);
            const char* a1 = cA + (size_t)(t + 1) * kstep;
            const char* a2 = last ? nA : cA + (size_t)(t + 2) * kstep; const char* b2 = last ? nB : cB + (size_t)(t + 2) * kstep;
            const char* a3 = a2 + kstep; const char* b3 = b2 + kstep;
            if (last && has_next) S.a_ready(nxt);
            if constexpr (SP2) {
            PG8_LDB(B0, 0, 0); PG8_LDB(B1, 0, 1); PG8_SCHED; PG8_LDA(At, 0, 0); PG8_STAGE(PG8_SA(1, 1), a1 + hstep, voffA);
            PG8_WAIT_V(8); PG8_WAIT_L(0); PG8_BAR; PG8_MMA(0, 0, At, B0); PG8_MMA(0, 1, At, B1); PG8_BAR; PG8_SCHED;
            PG8_LDA(At, 0, 1); PG8_STAGE(PG8_SB(0, 0), b2, voffB); PG8_STAGE(PG8_SB(0, 1), b2 + hstep, voffB); PG8_STAGE(PG8_SA(0, 0), a2, voffA);
            PG8_WAIT_V(8); PG8_WAIT_L(0); PG8_BAR; PG8_MMA(1, 0, At, B0); PG8_MMA(1, 1, At, B1); PG8_BAR; PG8_SCHED;
            PG8_LDB(B0, 1, 0); PG8_LDB(B1, 1, 1); PG8_SCHED; PG8_LDA(At, 1, 0); PG8_STAGE(PG8_SA(0, 1), a2 + hstep, voffA);
            PG8_WAIT_V(8); PG8_WAIT_L(0); PG8_BAR; PG8_MMA(0, 0, At, B0); PG8_MMA(0, 1, At, B1); PG8_BAR; PG8_SCHED;
            PG8_LDA(At, 1, 1); PG8_STAGE(PG8_SB(1, 0), b3, voffB); PG8_STAGE(PG8_SB(1, 1), b3 + hstep, voffB); PG8_STAGE(PG8_SA(1, 0), a3, voffA);
            PG8_WAIT_V(8); PG8_WAIT_L(0); PG8_BAR; PG8_MMA(1, 0, At, B0); PG8_MMA(1, 1, At, B1); PG8_BAR; PG8_SCHED;
            } else {
            PG8_LDB(B0, 0, 0); PG8_SCHED; PG8_LDA(At, 0, 0); PG8_STAGE(PG8_SA(1, 1), a1 + hstep, voffA);
            PG8_WAIT_L(8); PG8_BAR; PG8_WAIT_L(0); PG8_MMA(0, 0, At, B0); PG8_BAR; PG8_SCHED;
            PG8_LDB(B1, 0, 1); PG8_STAGE(PG8_SB(0, 0), b2, voffB);
            PG8_BAR; PG8_WAIT_L(0); PG8_MMA(0, 1, At, B1); PG8_BAR;
            PG8_LDA(At, 0, 1); PG8_STAGE(PG8_SA(0, 0), a2, voffA);
            PG8_BAR; PG8_WAIT_L(0); PG8_MMA(1, 0, At, B0); PG8_BAR; PG8_SCHED;
            PG8_STAGE(PG8_SB(0, 1), b2 + hstep, voffB);
            PG8_WAIT_V(6); PG8_BAR; PG8_MMA(1, 1, At, B1); PG8_BAR;
            PG8_LDB(B0, 1, 0); PG8_SCHED; PG8_LDA(At, 1, 0); PG8_STAGE(PG8_SA(0, 1), a2 + hstep, voffA);
            PG8_WAIT_L(8); PG8_BAR; PG8_WAIT_L(0); PG8_MMA(0, 0, At, B0); PG8_BAR; PG8_SCHED;
            PG8_LDB(B1, 1, 1); PG8_STAGE(PG8_SB(1, 0), b3, voffB);
            PG8_BAR; PG8_WAIT_L(0); PG8_MMA(0, 1, At, B1); PG8_BAR;
            PG8_LDA(At, 1, 1); PG8_STAGE(PG8_SA(1, 0), a3, voffA);
            PG8_BAR; PG8_WAIT_L(0); PG8_MMA(1, 0, At, B0); PG8_BAR; PG8_SCHED;
            PG8_STAGE(PG8_SB(1, 1), b3 + hstep, voffB);
            PG8_WAIT_V(6); PG8_BAR; PG8_MMA(1, 1, At, B1); PG8_BAR;
            }
        }
        if constexpr (ALIGN_EPI) { if (wr == 0) PG8_BAR; }
        if constexpr (!Epi::AFTER_DRAIN) { E(acc, cur, wr, wc, fr, fq); S.done(cur); }
        if (!has_next) break;
#pragma unroll
        for (int a = 0; a < 2; ++a)
#pragma unroll
            for (int b = 0; b < 2; ++b)
#pragma unroll
                for (int m = 0; m < 4; ++m)
#pragma unroll
                    for (int n = 0; n < 2; ++n) acc[a][b][m][n] = (f32x4){0.f, 0.f, 0.f, 0.f};
        cur = nxt; cA = nA; cB = nB; ++ui;
        if constexpr (ALIGN_EPI) { if (wr == 1) PG8_BAR; }
    }
    PG8_WAIT_V(0);
    if constexpr (!ALIGN_EPI) { if (wr == 0) PG8_BAR; }
    PG8_BAR;
    if constexpr (Epi::AFTER_DRAIN) { E.fused(acc, cur, wr, wc, fr, fq, lds, wid, lane); S.done(cur); }
#undef PG8_SA
#undef PG8_SB
#undef PG8_STAGE
#undef PG8_LDA
#undef PG8_LDB
#undef PG8_MMA
#undef PG8_WAIT_V
#undef PG8_WAIT_L
#undef PG8_BAR
#undef PG8_SCHED
}
}

namespace pg8 {
struct EpiSwiGLU {
    static constexpr bool PERM = true, AFTER_DRAIN = false;
    bf16_t* H; int ldc;
    __device__ __forceinline__ void operator()(const f32x4 (&acc)[2][2][4][2], const Unit& u, int wr, int wc, int fr, int fq) const {
        const int row0 = u.pm * BM + wr * 64 + fr, col0 = u.pn * HALF + wc * 32 + 8 * fq;
#pragma unroll
        for (int ai = 0; ai < 2; ++ai)
#pragma unroll
            for (int m = 0; m < 4; ++m) {
                bf16_t* rowp = H + (size_t)(row0 + ai * HALF + m * 16) * ldc + col0;
                float h[8];
#pragma unroll
                for (int n = 0; n < 2; ++n)
#pragma unroll
                    for (int i = 0; i < 4; ++i) { const float g = acc[ai][0][m][n][i], uu = acc[ai][1][m][n][i];
                        const float e = __builtin_amdgcn_exp2f(g * -1.4426950408889634f);
                        h[n * 4 + i] = g * uu * __builtin_amdgcn_rcpf(1.0f + e); }
                u32x4 w; w.x = cvt_pk_bf16(h[0], h[1]); w.y = cvt_pk_bf16(h[2], h[3]); w.z = cvt_pk_bf16(h[4], h[5]); w.w = cvt_pk_bf16(h[6], h[7]);
                *(u32x4*)rowp = w;
            }
    }
};
struct EpiResGate {
    static constexpr bool PERM = false, AFTER_DRAIN = false;
    const float* base_lat; const float* base_ctx; float* out_lat; float* out_ctx; const float* gate; float f;
    __device__ __forceinline__ void operator()(const f32x4 (&acc)[2][2][4][2], const Unit& u, int wr, int wc, int fr, int fq) const {
        const bool lat = u.pm < 256; const int mb = lat ? (u.pm >> 5) : 8; const int prow = lat ? u.pm : (u.pm - 256);
        const float* base = (lat ? base_lat : base_ctx) + (size_t)prow * BM * 1024; float* out = (lat ? out_lat : out_ctx) + (size_t)prow * BM * 1024;
        const int col0 = u.pn * BM + wc * 32 + 4 * fq;
        f32x4 gv[2][2];
#pragma unroll
        for (int bj = 0; bj < 2; ++bj)
#pragma unroll
            for (int n = 0; n < 2; ++n) gv[bj][n] = *(const f32x4*)(gate + (size_t)mb * 9216 + col0 + bj * HALF + n * 16) * f;
#pragma unroll
        for (int ai = 0; ai < 2; ++ai)
#pragma unroll
            for (int m = 0; m < 4; ++m) { const size_t off = (size_t)(wr * 64 + fr + ai * HALF + m * 16) * 1024 + col0;
#pragma unroll
                for (int bj = 0; bj < 2; ++bj)
#pragma unroll
                    for (int n = 0; n < 2; ++n) { const f32x4 b = *(const f32x4*)(base + off + bj * HALF + n * 16);
                        *(f32x4*)(out + off + bj * HALF + n * 16) = b + gv[bj][n] * acc[ai][bj][m][n]; } }
    }
};
struct EpiStoreBf16 {
    static constexpr bool PERM = true, AFTER_DRAIN = false;
    bf16_t* O; int ldc;
    __device__ __forceinline__ void operator()(const f32x4 (&acc)[2][2][4][2], const Unit& u, int wr, int wc, int fr, int fq) const {
        const int row0 = u.pm * BM + wr * 64 + fr, col0 = u.pn * BM + wc * 32 + 8 * fq;
#pragma unroll
        for (int ai = 0; ai < 2; ++ai)
#pragma unroll
            for (int m = 0; m < 4; ++m) { bf16_t* rowp = O + (size_t)(row0 + ai * HALF + m * 16) * ldc + col0;
#pragma unroll
                for (int bj = 0; bj < 2; ++bj) { const f32x4 v0 = acc[ai][bj][m][0], v1 = acc[ai][bj][m][1];
                    u32x4 w; w.x = cvt_pk_bf16(v0[0], v0[1]); w.y = cvt_pk_bf16(v0[2], v0[3]); w.z = cvt_pk_bf16(v1[0], v1[1]); w.w = cvt_pk_bf16(v1[2], v1[3]);
                    *(u32x4*)(rowp + bj * HALF) = w; } }
    }
};
}

constexpr int NB = 8, SEQ = 8192, DM = 1024, CTXL = 256, DEPTH = 2, DFF = 2816, NMOD = 9, INC = 3584;
constexpr int TL = NB * SEQ, TC = NB * CTXL, TT = TL + TC;
constexpr int C_NAQ = 0, C_NAK = 384, C_NAV = 768, C_SGU = 1152, C_SGV = 1408, C_RQ = 1664, C_RK = 2048, C_RV = 2432, C_GF = 2816, C_GB = 3200;
constexpr int M_NA = 0, M_SG = 384, M_RET = 640;
constexpr int NCH = TT / 128, NCHL = TL / 128;
constexpr int NWAVES = 8;
#ifndef MK_ONE_LAUNCH
#define MK_ONE_LAUNCH 1
#endif
constexpr int NPH = 1 + DEPTH * 12;

constexpr size_t MiB = 1u << 20;
constexpr size_t WS_CTL = 0, CTL_ZERO_BYTES = 1 * MiB;
constexpr size_t WS_MOD = 1 * MiB;
constexpr size_t WS_ROPE = 2 * MiB;
constexpr size_t WS_WSG = 3 * MiB;
constexpr size_t WS_W1T = 4 * MiB, WS_W2T = 48 * MiB, WS_WINT = 70 * MiB, WS_WOUTT = 84 * MiB;
constexpr size_t WS_CTXBUF = 88 * MiB;
constexpr size_t WS_XN = 96 * MiB;
constexpr size_t WS_P = 228 * MiB;
constexpr size_t WS_KV = 690 * MiB;
constexpr size_t WS_PREV = 789 * MiB;
constexpr size_t WS_END = 888 * MiB;
constexpr int CW_BAR = 4096;

constexpr int RING_BYTES = 131072, LDSCTL_OFF = 163840 - 512, MISC_OFF = LDSCTL_OFF + 320, LDS_BYTES = 163840;
#define GAS __attribute__((address_space(1)))
#define LAS __attribute__((address_space(3)))
typedef unsigned short bf16;
typedef unsigned v4u __attribute__((ext_vector_type(4)));
typedef float f32x4 __attribute__((ext_vector_type(4)));
typedef short bf16x8 __attribute__((ext_vector_type(8)));
typedef GAS unsigned gu32;
typedef GAS unsigned long long gu64;
#define RLX_AGENT __ATOMIC_RELAXED, __HIP_MEMORY_SCOPE_AGENT
#define LDS_WAIT() asm volatile("s_waitcnt lgkmcnt(0)" ::: "memory")
#define VM_WAIT() asm volatile("s_waitcnt vmcnt(0)" ::: "memory")
__device__ __forceinline__ unsigned long long rt() { return __builtin_amdgcn_s_memrealtime(); }
__device__ __forceinline__ unsigned f2bf(float f) { unsigned u = __builtin_bit_cast(unsigned, f); return (u + 0x7fffu + ((u >> 16) & 1u)) >> 16; }
__device__ __forceinline__ unsigned pk2(float lo, float hi) { return f2bf(lo) | (f2bf(hi) << 16); }
#define XB_TMO      128
#define XB_XCNT(j)  (256  + 64 * (j))
#define XB_XSUB(j)  (1280 + 64 * (j))
#define XB_XGEN(j)  (2304 + 64 * (j))
#define XB_TOP      3328
#define XB_TOPGEN   3392
#define XCD_BAR_WORDS 3456
#define XB_SPIN_CAP (1u << 18)

__device__ __forceinline__ unsigned xb_ld(unsigned* p)              { return __hip_atomic_load(p, __ATOMIC_RELAXED, __HIP_MEMORY_SCOPE_AGENT); }
__device__ __forceinline__ unsigned xb_add(unsigned* p, unsigned v) { return __hip_atomic_fetch_add(p, v, __ATOMIC_RELAXED, __HIP_MEMORY_SCOPE_AGENT); }
__device__ __forceinline__ unsigned xb_xcc_id() { return (unsigned)__builtin_amdgcn_s_getreg((3 << 11) | 20) & 0xFu; }
#define XB_SPIN(cond, bar) do { unsigned _sp = 0; while (cond) { __builtin_amdgcn_s_sleep(1); \
    if ((++_sp & 255u) == 0u) { if (xb_ld(&(bar)[XB_TMO])) break; if (_sp > XB_SPIN_CAP) { atomicAdd(&(bar)[XB_TMO], 1u); break; } } } } while (0)

struct XcdBarrier {
    unsigned* bar; unsigned x;
    volatile LAS unsigned* st;
};

__device__ __forceinline__ XcdBarrier xcd_barrier_post(unsigned* bar, volatile LAS unsigned* st) {
    XcdBarrier b; b.bar = bar; b.x = xb_xcc_id(); b.st = st;
    if (threadIdx.x == 0) (void)xb_add(&bar[XB_XCNT(b.x)], 1u);
    return b;
}
__device__ __forceinline__ void xcd_barrier_complete(unsigned* bar, unsigned x, unsigned& nloc, unsigned& nx) {
    const unsigned G = gridDim.x * gridDim.y * gridDim.z;
    unsigned sum, cnt, mine, sp = 0u;
    for (;;) {
        sum = 0u; cnt = 0u; mine = 0u;
#pragma unroll
        for (unsigned j = 0; j < 16; ++j) { const unsigned c = xb_ld(&bar[XB_XCNT(j)]); sum += c; cnt += (c > 0u) ? 1u : 0u; mine = (j == x) ? c : mine; }
        if (sum == G) break;
        __builtin_amdgcn_s_sleep(1);
        if ((++sp & 255u) == 0u) { if (xb_ld(&bar[XB_TMO])) break; if (sp > XB_SPIN_CAP) { atomicAdd(&bar[XB_TMO], 1u); break; } }
    }
    nloc = mine > 0u ? mine : 1u; nx = cnt > 0u ? cnt : 1u;
}

__device__ __forceinline__ void xcd_barrier(const XcdBarrier& b) {
    asm volatile("s_waitcnt vmcnt(0)" ::: "memory");
    __syncthreads();
    if (threadIdx.x == 0) {
        unsigned* bar = b.bar;
        __builtin_amdgcn_s_waitcnt(0);
        unsigned nloc = b.st[0], nx = b.st[1];
        if (nloc == 0u) { xcd_barrier_complete(bar, b.x, nloc, nx); b.st[0] = nloc; b.st[1] = nx; }
        const unsigned old = xb_add(&bar[XB_XSUB(b.x)], 1u);
        const unsigned gen = old / nloc;
        if (old + 1u == (gen + 1u) * nloc) {
            __builtin_amdgcn_fence(__ATOMIC_RELEASE, "agent");
            asm volatile("s_waitcnt vmcnt(0)" ::: "memory");
            const unsigned og = xb_add(&bar[XB_TOP], 1u);
            const unsigned tg = og / nx;
            if (og + 1u == (tg + 1u) * nx) xb_add(&bar[XB_TOPGEN], 1u);
            else XB_SPIN(xb_ld(&bar[XB_TOPGEN]) == tg, bar);
            __builtin_amdgcn_fence(__ATOMIC_ACQUIRE, "agent");
            xb_add(&bar[XB_XGEN(b.x)], 1u);
            asm volatile("s_waitcnt vmcnt(0)" ::: "memory");
        } else {
            XB_SPIN(xb_ld(&bar[XB_XGEN(b.x)]) == gen, bar);
            __builtin_amdgcn_fence(__ATOMIC_ACQUIRE, "agent");
            asm volatile("s_waitcnt vmcnt(0)" ::: "memory");
        }
    }
    __syncthreads();
}
#ifndef REP_NORM
#define REP_NORM 1
#endif

typedef unsigned u32x2 __attribute__((ext_vector_type(2)));

#define SHX(v, o) __builtin_bit_cast(float, __builtin_amdgcn_ds_swizzle(__builtin_bit_cast(int, (float)(v)), ((o) << 10) | 0x1f))
__device__ __forceinline__ float xhalf_sum(float v) { auto rr = __builtin_amdgcn_permlane32_swap(__float_as_uint(v), __float_as_uint(v), false, false); return __uint_as_float(rr[0]) + __uint_as_float(rr[1]); }
__device__ __forceinline__ float xhalf_max(float v) { auto rr = __builtin_amdgcn_permlane32_swap(__float_as_uint(v), __float_as_uint(v), false, false); return fmaxf(__uint_as_float(rr[0]), __uint_as_float(rr[1])); }
__device__ __forceinline__ float wave_sum(float v) { v += SHX(v, 1); v += SHX(v, 2); v += SHX(v, 4); v += SHX(v, 8); v += SHX(v, 16); return xhalf_sum(v); }
__device__ __forceinline__ float bflo(unsigned w) { return __uint_as_float(w << 16); }
__device__ __forceinline__ float bfhi(unsigned w) { return __uint_as_float(w & 0xffff0000u); }
__device__ __forceinline__ void load8(const bf16* p, float* o) {
    const v4u w = *(const v4u*)p;
    o[0] = bflo(w.x); o[1] = bfhi(w.x); o[2] = bflo(w.y); o[3] = bfhi(w.y); o[4] = bflo(w.z); o[5] = bfhi(w.z); o[6] = bflo(w.w); o[7] = bfhi(w.w);
}
__device__ __forceinline__ void store8(bf16* p, const float* o) {
    v4u w; w.x = pk2(o[0], o[1]); w.y = pk2(o[2], o[3]); w.z = pk2(o[4], o[5]); w.w = pk2(o[6], o[7]); *(v4u*)p = w;
}
__device__ __forceinline__ float sigmoidf_(float x) { return 1.0f / (1.0f + __expf(-x)); }
__device__ __forceinline__ float gelu_tanh(float x) { const float y = 0.7978845608028654f * (x + 0.044715f * x * x * x); return x * sigmoidf_(2.0f * y); }
__device__ __forceinline__ float log_sigmoid(float x) { return fminf(x, 0.0f) - log1pf(expf(-fabsf(x))); }

__device__ __forceinline__ void p0_transpose_item(const float* W, int K, int N, bf16* WT, bool swiglu, LAS float* scr, int item, int lane) {
    const int nblk = N / 32, kb = item / nblk, nb = item % nblk, k0 = 64 * kb, n0 = 32 * nb;
    int d0 = n0;
    if (swiglu) { const int hid = n0 < DFF ? n0 : n0 - DFF; d0 = (hid >> 7) * 256 + (n0 < DFF ? 0 : 128) + (hid & 127); }
#pragma unroll 8
    for (int i = 0; i < 32; ++i) { const int kk = 2 * i + (lane >> 5); scr[kk * 33 + (lane & 31)] = W[(size_t)(k0 + kk) * N + n0 + (lane & 31)]; }
    LDS_WAIT(); asm volatile("" ::: "memory");
    const int c = lane & 7;
#pragma unroll
    for (int j = 0; j < 4; ++j) { const int n = (lane >> 3) + 8 * j; const LAS float* s = scr + (8 * c) * 33 + n;
        v4u o; o.x = pk2(s[0 * 33], s[1 * 33]); o.y = pk2(s[2 * 33], s[3 * 33]); o.z = pk2(s[4 * 33], s[5 * 33]); o.w = pk2(s[6 * 33], s[7 * 33]);
        *(GAS v4u*)(WT + (size_t)(d0 + n) * K + k0 + 8 * c) = o; }
    LDS_WAIT(); asm volatile("" ::: "memory");
}
struct In { const float *x, *c, *ctx, *c_ctx, *ada_w, *ada_b, *norm_w, *ffn_w1, *ffn_w2, *w_in, *w_out, *na_qn, *na_kn, *na_rpb, *sg_w, *sg_b, *sg_ln_w, *sg_ln_b, *ret_logit, *ret_gn_w; };

__device__ __forceinline__ void p0_prologue(const In& I, unsigned char* ws, LAS unsigned char* lds, int tid, int lane, int wave, int vcu, int G) {
    LAS float* scr = (LAS float*)(lds + wave * 16384);
    const int gw = vcu * NWAVES + wave, NGW = G * NWAVES;
    constexpr int I_W1 = (DM / 64) * (2 * DFF / 32), I_W2 = (DFF / 64) * (DM / 32), I_WIN = (DM / 64) * (INC / 32), I_WOUT = (DM / 64) * (DM / 32);
    constexpr int PER_L = 2 * I_W1 + 2 * I_W2 + I_WIN + I_WOUT;
    bf16* W1T = (bf16*)(ws + WS_W1T); bf16* W2T = (bf16*)(ws + WS_W2T); bf16* WINT = (bf16*)(ws + WS_WINT); bf16* WOUTT = (bf16*)(ws + WS_WOUTT);
    for (int it = gw; it < DEPTH * PER_L; it += NGW) {
        const int L = it / PER_L; int r = it % PER_L;
        if (r < 2 * I_W1) { const int i = r / I_W1; r %= I_W1; const size_t o = (size_t)(L * 2 + i) * DM * 2 * DFF; p0_transpose_item(I.ffn_w1 + o, DM, 2 * DFF, W1T + o, true, scr, r, lane); continue; } r -= 2 * I_W1;
        if (r < 2 * I_W2) { const int i = r / I_W2; r %= I_W2; const size_t o = (size_t)(L * 2 + i) * DFF * DM; p0_transpose_item(I.ffn_w2 + o, DFF, DM, W2T + o, false, scr, r, lane); continue; } r -= 2 * I_W2;
        if (r < I_WIN) { const size_t o = (size_t)L * DM * INC; p0_transpose_item(I.w_in + o, DM, INC, WINT + o, false, scr, r, lane); continue; } r -= I_WIN;
        { const size_t o = (size_t)L * DM * DM; p0_transpose_item(I.w_out + o, DM, DM, WOUTT + o, false, scr, r, lane); }
    }
    __syncthreads();
    LAS float* sc = (LAS float*)lds;
    LAS float* part = (LAS float*)(lds + 36864);
    float* mod = (float*)(ws + WS_MOD);
    for (int cb = blockIdx.x; cb < 256; cb += G) {
        for (int i = tid; i < 9 * 1024; i += 512) { const int mb = i >> 10, k = i & 1023; const float v = mb < 8 ? I.c[mb * 1024 + k] : I.c_ctx[k]; sc[i] = v * sigmoidf_(v); }
        __syncthreads();
        const int cc = tid % 72, kp = tid / 72, colg = cb * 72 + cc, L = colg / 9216, j = colg % 9216;
        if (kp < 7) {
            float acc[9];
#pragma unroll
            for (int mb = 0; mb < 9; ++mb) acc[mb] = 0.f;
            for (int k = kp; k < 1024; k += 7) { const float w = I.ada_w[((size_t)L * 1024 + k) * 9216 + j];
#pragma unroll
                for (int mb = 0; mb < 9; ++mb) acc[mb] += sc[mb * 1024 + k] * w; }
#pragma unroll
            for (int mb = 0; mb < 9; ++mb) part[(kp * 72 + cc) * 9 + mb] = acc[mb];
        }
        __syncthreads();
        for (int o = tid; o < 72 * 9; o += 512) { const int c2 = o / 9, mb = o % 9; const int colg2 = cb * 72 + c2, L2 = colg2 / 9216, j2 = colg2 % 9216;
            float s = I.ada_b[L2 * 9216 + j2];
#pragma unroll
            for (int p = 0; p < 7; ++p) s += part[(p * 72 + c2) * 9 + mb];
            mod[((size_t)L2 * 9 + mb) * 9216 + j2] = s; }
        __syncthreads();
    }
    { bf16* wsg = (bf16*)(ws + WS_WSG); for (int i = blockIdx.x * 512 + tid; i < DEPTH * 4 * 128 * 128 / 8; i += G * 512) { const f32x4 a = ((const f32x4*)I.sg_w)[2 * i], b = ((const f32x4*)I.sg_w)[2 * i + 1];
        v4u o; o.x = pk2(a.x, a.y); o.y = pk2(a.z, a.w); o.z = pk2(b.x, b.y); o.w = pk2(b.z, b.w); ((v4u*)wsg)[i] = o; } }
    if (blockIdx.x == (unsigned)(G - 1)) {
        float* tab = (float*)(ws + WS_ROPE);
        for (int i = tid; i < 128 * 16; i += 512) { const int n = i >> 4, f = i & 15; const float inv = exp2f(-(float)f * (13.287712379549449f / 16.0f)); const float ang = (float)n * inv;
            tab[2 * i] = cosf(ang); tab[2 * i + 1] = sinf(ang); }
    }
}

__device__ __forceinline__ void norm_phase(const float* xl, const float* xc, int nrows, const float* nw, const float* modL, int sidx, bf16* XN, int gw, int NGW, int lane) {
    const int rpw = (nrows + NGW - 1) / NGW; const int r0 = gw * rpw; int r1 = r0 + rpw; if (r1 > nrows) r1 = nrows;
    int cur = -1; f32x4 g[4], sh[4];
#pragma unroll
    for (int j = 0; j < 4; ++j) { g[j] = (f32x4){0.f, 0.f, 0.f, 0.f}; sh[j] = g[j]; }
#define NP_SRC(r) ((r) < TL ? xl + (size_t)(r) * DM : xc + (size_t)((r) - TL) * DM)
    f32x4 va[4], vb[4], vc[4];
    const int nr = (r1 - r0) * REP_NORM;
    if (nr > 0) { const float* s0 = NP_SRC(r0);
#pragma unroll
        for (int j = 0; j < 4; ++j) va[j] = ((const f32x4*)s0)[lane + 64 * j]; }
    if (nr > 1) { const float* s1 = NP_SRC(r0 + 1 % (r1 - r0));
#pragma unroll
        for (int j = 0; j < 4; ++j) vb[j] = ((const f32x4*)s1)[lane + 64 * j]; }
    for (int rr_ = 0; rr_ < nr; ++rr_) { const int r = r0 + rr_ % (r1 - r0);
        if (rr_ + 2 < nr) { const float* s2 = NP_SRC(r0 + (rr_ + 2) % (r1 - r0));
#pragma unroll
            for (int j = 0; j < 4; ++j) vc[j] = ((const f32x4*)s2)[lane + 64 * j]; }
        const int mb = r < TL ? (r >> 13) : 8;
        if (mb != cur) { cur = mb; const float* sf = modL + (size_t)mb * 9216 + sidx * 1024; const float* sl = sf + 1024;
#pragma unroll
            for (int j = 0; j < 4; ++j) { const f32x4 w = ((const f32x4*)nw)[lane + 64 * j], s1 = ((const f32x4*)sl)[lane + 64 * j]; g[j] = w * (s1 + 1.0f); sh[j] = ((const f32x4*)sf)[lane + 64 * j]; } }
        float s = 0.f;
#pragma unroll
        for (int j = 0; j < 4; ++j) s += (va[j].x * va[j].x + va[j].y * va[j].y) + (va[j].z * va[j].z + va[j].w * va[j].w);
        const float rstd = 1.0f / sqrtf(wave_sum(s) * (1.0f / DM) + 1e-6f);
        unsigned long long* o8 = (unsigned long long*)(XN + (size_t)r * DM) + lane;
#pragma unroll
        for (int j = 0; j < 4; ++j) { const f32x4 y = va[j] * rstd * g[j] + sh[j]; o8[64 * j] = (unsigned long long)pk2(y.x, y.y) | ((unsigned long long)pk2(y.z, y.w) << 32); }
#pragma unroll
        for (int j = 0; j < 4; ++j) { va[j] = vb[j]; vb[j] = vc[j]; }
    }
#undef NP_SRC
}

__device__ __forceinline__ void na_naive(const bf16* P, bf16* MIX, const float* wq, const float* wk, const float* rpb, bool with_ctx, int gtid, int nthreads) {
    float mq = 0.f, mk = 0.f, mr = 0.f;
    for (int d = 0; d < 64; ++d) { mq = fmaxf(mq, fabsf(wq[d])); mk = fmaxf(mk, fabsf(wk[d])); }
    for (int i = 0; i < 6 * 15 * 31; ++i) mr = fmaxf(mr, fabsf(rpb[i]));
    const float mbound = 8.0f * mq * mk + mr;
    const int nitems = (TL + (with_ctx ? TC : 0)) * 6;
    for (int item = gtid; item < nitems; item += nthreads) {
        int h, t; bool isctx;
        if (item < TL * 6) { h = item / TL; t = item % TL; isctx = false; } else { const int r = item - TL * 6; h = r / TC; t = TL + r % TC; isctx = true; }
        float q[64], o[64];
        { const bf16* qp = P + (size_t)t * INC + C_NAQ + h * 64; float ss = 0.f;
#pragma unroll
          for (int d8 = 0; d8 < 8; ++d8) { load8(qp + d8 * 8, q + d8 * 8); }
#pragma unroll
          for (int d = 0; d < 64; ++d) ss += q[d] * q[d];
          const float rstd = 1.0f / sqrtf(ss * (1.0f / 64.0f) + 1e-6f);
#pragma unroll
          for (int d = 0; d < 64; ++d) { q[d] = q[d] * rstd * wq[d] * wk[d] * 0.125f; o[d] = 0.f; } }
        float l = 0.f;
        int b, nloc, r = 0, c = 0, rs = 0, cs = 0;
        if (!isctx) { b = t >> 13; const int pos = t & 8191; r = pos >> 6; c = pos & 63; rs = min(max(r - 4, 0), 120); cs = min(max(c - 8, 0), 48); nloc = 128; }
        else { b = (t - TL) >> 8; nloc = 0; }
        for (int kk = 0; kk < nloc + 256; ++kk) {
            int tk; float bias = 0.f;
            if (kk < nloc) { const int i = kk >> 4, j = kk & 15; tk = b * SEQ + (rs + i) * 64 + cs + j; bias = rpb[(h * 15 + (rs + i - r + 7)) * 31 + (cs + j - c + 15)]; }
            else tk = TL + b * CTXL + (kk - nloc);
            const bf16* kp = P + (size_t)tk * INC + C_NAK + h * 64; const bf16* vp = P + (size_t)tk * INC + C_NAV + h * 64;
            float dot = 0.f, ss = 0.f;
#pragma unroll
            for (int d8 = 0; d8 < 8; ++d8) { float k8[8]; load8(kp + d8 * 8, k8);
#pragma unroll
                for (int e = 0; e < 8; ++e) { dot += q[d8 * 8 + e] * k8[e]; ss += k8[e] * k8[e]; } }
            const float s = dot / sqrtf(ss * (1.0f / 64.0f) + 1e-6f) + bias;
            const float p = __expf(s - mbound); l += p;
#pragma unroll
            for (int d8 = 0; d8 < 8; ++d8) { float v8[8]; load8(vp + d8 * 8, v8);
#pragma unroll
                for (int e = 0; e < 8; ++e) o[d8 * 8 + e] += p * v8[e]; }
        }
        const float il = 1.0f / l; bf16* op = MIX + (size_t)t * DM + M_NA + h * 64;
#pragma unroll
        for (int d8 = 0; d8 < 8; ++d8) { float t8[8];
#pragma unroll
            for (int e = 0; e < 8; ++e) t8[e] = o[d8 * 8 + e] * il;
            store8(op + d8 * 8, t8); }
    }
}

__device__ __forceinline__ void sg_naive(const bf16* P, bf16* MIX, const float* sgw, const float* sgb, const float* lnw, const float* lnb, LAS unsigned char* lds, int tid, int G) {
    LAS float* vn = (LAS float*)lds;
    const int tok = tid >> 2, part = tid & 3;
    for (int it = blockIdx.x; it < NCH * 4; it += G) {
        const int ch = it >> 2, g = it & 3, row0 = ch * 128;
        { const bf16* src = P + (size_t)(row0 + tok) * INC + C_SGV + g * 64 + part * 16; float v[16]; load8(src, v); load8(src + 8, v + 8);
          float s = 0.f;
#pragma unroll
          for (int k = 0; k < 16; ++k) { v[k] = gelu_tanh(v[k]); s += v[k]; }
          s += SHX(s, 1); s += SHX(s, 2); const float mu = s * (1.0f / 64.0f); float q = 0.f;
#pragma unroll
          for (int k = 0; k < 16; ++k) { v[k] -= mu; q += v[k] * v[k]; }
          q += SHX(q, 1); q += SHX(q, 2); const float rstd = 1.0f / sqrtf(q * (1.0f / 64.0f) + 1e-5f);
#pragma unroll
          for (int k = 0; k < 16; ++k) { const int cch = g * 64 + part * 16 + k; vn[tok * 64 + part * 16 + k] = v[k] * rstd * lnw[cch] + lnb[cch]; } }
        __syncthreads();
        { float acc[16];
#pragma unroll
          for (int k = 0; k < 16; ++k) acc[k] = 0.f;
          const float* wrow = sgw + ((size_t)g * 128 + tok) * 128;
          for (int q = 0; q < 128; ++q) { const float w = wrow[q];
#pragma unroll
              for (int k = 0; k < 16; ++k) acc[k] += w * vn[q * 64 + part * 16 + k]; }
          const float bias = sgb[g * 128 + tok];
          const bf16* up = P + (size_t)(row0 + tok) * INC + C_SGU + g * 64 + part * 16; float u[16]; load8(up, u); load8(up + 8, u + 8);
#pragma unroll
          for (int k = 0; k < 16; ++k) u[k] = gelu_tanh(u[k]) * (acc[k] + bias);
          bf16* op = MIX + (size_t)(row0 + tok) * DM + M_SG + g * 64 + part * 16; store8(op, u); store8(op + 8, u + 8); }
        __syncthreads();
    }
}

__device__ __forceinline__ void rope_load16(const bf16* P, int row, int colbase, int h, int part, bool latent, const float* ropetab, float* out) {
    const bf16* base = P + (size_t)row * INC + colbase + h * 64;
    float mine[16]; load8(base + part * 16, mine); load8(base + part * 16 + 8, mine + 8);
    if (!latent) {
#pragma unroll
        for (int f = 0; f < 16; ++f) out[f] = mine[f];
        return; }
    float oth[16]; load8(base + (part ^ 1) * 16, oth); load8(base + (part ^ 1) * 16 + 8, oth + 8);
    const int pos = row & (SEQ - 1); const int n = (part < 2) ? (pos >> 6) : (pos & 63);
    const float* tb = ropetab + n * 32;
#pragma unroll
    for (int f = 0; f < 16; ++f) { const float cs = tb[2 * f], sn = tb[2 * f + 1]; out[f] = (part & 1) ? (oth[f] * sn + mine[f] * cs) : (mine[f] * cs - oth[f] * sn); }
}
__device__ __forceinline__ void ret_kv_naive(const bf16* P, float* KV, const float* logit, const float* ropetab, LAS unsigned char* lds, int tid, int G) {
    LAS float* kS = (LAS float*)lds; LAS float* vS = kS + 128 * 64; LAS float* wt = vS + 128 * 64;
    const int tok = tid >> 2, part = tid & 3;
    for (int it = blockIdx.x; it < NCH * 6; it += G) {
        const int ch = it / 6, h = it % 6, row0 = ch * 128; const bool latent = ch < NCHL;
        { float k16[16]; rope_load16(P, row0 + tok, C_RK, h, part, latent, ropetab, k16);
#pragma unroll
          for (int f = 0; f < 16; ++f) kS[tok * 64 + part * 16 + f] = k16[f] * 0.125f;
          const bf16* vp = P + (size_t)(row0 + tok) * INC + C_RV + h * 64 + part * 16; float v16[16]; load8(vp, v16); load8(vp + 8, v16 + 8);
#pragma unroll
          for (int f = 0; f < 16; ++f) vS[tok * 64 + part * 16 + f] = v16[f]; }
        if (tid < 256) { const int dir = tid >> 7, j = tid & 127; const float lg = log_sigmoid(logit[dir * 6 + h]); wt[tid] = expf(lg * (float)(dir == 0 ? 127 - j : j)); }
        __syncthreads();
        { const int d = tid >> 3, e0 = (tid & 7) * 8; float af[8], ab[8];
#pragma unroll
          for (int k = 0; k < 8; ++k) { af[k] = 0.f; ab[k] = 0.f; }
          for (int j = 0; j < 128; ++j) { const float kd = kS[j * 64 + d]; const float a = kd * wt[j], b = kd * wt[128 + j];
#pragma unroll
              for (int k = 0; k < 8; ++k) { const float v = vS[j * 64 + e0 + k]; af[k] += a * v; ab[k] += b * v; } }
          float* of = KV + ((size_t)(ch * 6 + h) * 2 + 0) * 4096 + d * 64 + e0; float* ob = of + 4096;
#pragma unroll
          for (int k = 0; k < 8; ++k) { of[k] = af[k]; ob[k] = ab[k]; } }
        __syncthreads();
    }
}
__device__ __forceinline__ void ret_scan(const float* KV, float* PREV, const float* logit, int gtid, int nthreads) {
    for (int it = gtid; it < NB * 6 * 2 * 4096; it += nthreads) {
        const int idx = it & 4095, dir = (it >> 12) & 1, bh = it >> 13, h = bh % 6, b = bh / 6;
        const float cd = expf(128.0f * log_sigmoid(logit[dir * 6 + h]));
#define KVI(ch) (((size_t)((ch) * 6 + h) * 2 + dir) * 4096 + idx)
        const int c0 = NCHL + 2 * b, c1 = c0 + 1;
        const float k0 = KV[KVI(c0)], k1 = KV[KVI(c1)];
        if (dir == 0) { PREV[KVI(c0)] = 0.f; PREV[KVI(c1)] = k0; float s = cd * k0 + k1;
            for (int n = 0; n < 64; ++n) { const int ch = b * 64 + n; PREV[KVI(ch)] = s; s = cd * s + KV[KVI(ch)]; } }
        else { PREV[KVI(c0)] = k1; PREV[KVI(c1)] = 0.f; float s = k0 + cd * k1;
            for (int n = 63; n >= 0; --n) { const int ch = b * 64 + n; PREV[KVI(ch)] = s; s = cd * s + KV[KVI(ch)]; } }
#undef KVI
    }
}
__device__ __forceinline__ void ret_out_naive(const bf16* P, const float* PREV, bf16* MIX, const float* logit, const float* gnw, const float* ropetab, LAS unsigned char* lds, int tid, int G) {
    LAS bf16* qS = (LAS bf16*)lds; LAS bf16* kS = qS + 128 * 64; LAS bf16* vS = kS + 128 * 64;
    LAS float* S = (LAS float*)(lds + 49152);
    LAS float* dec = (LAS float*)(lds + 49152 + 65536);
    const int tok = tid >> 2, part = tid & 3;
    for (int it = blockIdx.x; it < NCH * 6; it += G) {
        const int ch = it / 6, h = it % 6, row0 = ch * 128; const bool latent = ch < NCHL;
        { float t16[16]; rope_load16(P, row0 + tok, C_RQ, h, part, latent, ropetab, t16);
#pragma unroll
          for (int f = 0; f < 16; ++f) qS[tok * 64 + part * 16 + f] = (bf16)f2bf(t16[f]);
          rope_load16(P, row0 + tok, C_RK, h, part, latent, ropetab, t16);
#pragma unroll
          for (int f = 0; f < 16; ++f) kS[tok * 64 + part * 16 + f] = (bf16)f2bf(t16[f] * 0.125f);
          const bf16* vp = P + (size_t)(row0 + tok) * INC + C_RV + h * 64 + part * 16; const v4u a = *(const v4u*)vp, b = *(const v4u*)(vp + 8);
          *(LAS v4u*)(vS + tok * 64 + part * 16) = a; *(LAS v4u*)(vS + tok * 64 + part * 16 + 8) = b; }
        if (tid < 258) { const int dir = tid / 129, k = tid % 129; dec[tid] = expf(log_sigmoid(logit[dir * 6 + h]) * (float)k); }
        __syncthreads();
        { float q[64];
#pragma unroll
          for (int d = 0; d < 64; ++d) q[d] = __uint_as_float((unsigned)qS[tok * 64 + d] << 16);
          for (int jj = 0; jj < 32; ++jj) { const int j = part + 4 * jj; float dot = 0.f;
#pragma unroll
              for (int d = 0; d < 64; ++d) dot += q[d] * __uint_as_float((unsigned)kS[j * 64 + d] << 16);
              S[tok * 128 + j] = dot; } }
        __syncthreads();
        { const int i = tok, e0 = part * 16; float of[16], ob[16], cf[16], cb[16];
#pragma unroll
          for (int k = 0; k < 16; ++k) { of[k] = 0.f; ob[k] = 0.f; cf[k] = 0.f; cb[k] = 0.f; }
          for (int j = 0; j < 128; ++j) { const float s = S[i * 128 + j]; const float wf = (j <= i) ? s * dec[i - j] : 0.f, wb = (j >= i) ? s * dec[129 + j - i] : 0.f;
#pragma unroll
              for (int k = 0; k < 16; ++k) { const float v = __uint_as_float((unsigned)vS[j * 64 + e0 + k] << 16); of[k] += wf * v; ob[k] += wb * v; } }
          const float* pf = PREV + ((size_t)(ch * 6 + h) * 2) * 4096 + e0; const float* pb = pf + 4096;
          for (int d = 0; d < 64; ++d) { const float qd = __uint_as_float((unsigned)qS[i * 64 + d] << 16);
#pragma unroll
              for (int k = 0; k < 16; ++k) { cf[k] += qd * pf[d * 64 + k]; cb[k] += qd * pb[d * 64 + k]; } }
          const float df = dec[i + 1], db = dec[129 + 128 - i];
          float sf = 0.f, sb = 0.f;
#pragma unroll
          for (int k = 0; k < 16; ++k) { of[k] += df * cf[k]; ob[k] += db * cb[k]; sf += of[k]; sb += ob[k]; }
          sf += SHX(sf, 1); sf += SHX(sf, 2); sb += SHX(sb, 1); sb += SHX(sb, 2);
          const float muf = sf * (1.0f / 64.0f), mub = sb * (1.0f / 64.0f); float qf = 0.f, qb = 0.f;
#pragma unroll
          for (int k = 0; k < 16; ++k) { of[k] -= muf; ob[k] -= mub; qf += of[k] * of[k]; qb += ob[k] * ob[k]; }
          qf += SHX(qf, 1); qf += SHX(qf, 2); qb += SHX(qb, 1); qb += SHX(qb, 2);
          const float rf = 1.0f / sqrtf(qf * (1.0f / 64.0f) + 1e-5f), rb = 1.0f / sqrtf(qb * (1.0f / 64.0f) + 1e-5f);
          const bf16* gp = P + (size_t)(row0 + i) * INC + C_GF + h * 64 + e0; float gf[16], gb[16]; load8(gp, gf); load8(gp + 8, gf + 8); load8(gp + (C_GB - C_GF), gb); load8(gp + (C_GB - C_GF) + 8, gb + 8);
          float y[16];
#pragma unroll
          for (int k = 0; k < 16; ++k) y[k] = (of[k] * rf * (gf[k] * sigmoidf_(gf[k])) + ob[k] * rb * (gb[k] * sigmoidf_(gb[k]))) * gnw[h * 64 + e0 + k];
          bf16* op = MIX + (size_t)(row0 + i) * DM + M_RET + h * 64 + e0; store8(op, y); store8(op + 8, y + 8); }
        __syncthreads();
    }
}
#ifndef REP_KV
#define REP_KV 1
#endif
#ifndef REP_RETO
#define REP_RETO 1
#endif

typedef short s16x4 __attribute__((ext_vector_type(4)));
typedef float f32x16 __attribute__((ext_vector_type(16)));
typedef float f32x2_t __attribute__((ext_vector_type(2)));
typedef __bf16 bf16x2_t __attribute__((ext_vector_type(2)));
#define MFMA32(a, b, c) __builtin_amdgcn_mfma_f32_32x32x16_bf16((a), (b), (c), 0, 0, 0)
#define LOG2E 1.4426950408889634f
#define LDS_BARRIER() do { asm volatile("s_waitcnt lgkmcnt(0)" ::: "memory"); __builtin_amdgcn_s_barrier(); asm volatile("" ::: "memory"); } while (0)
#define OPQV(x) ({ int _t = (x); asm volatile("" : "+v"(_t)); _t; })
#define FRESH_TID(w) ({ int _t; asm volatile("v_mbcnt_lo_u32_b32 %0, -1, 0\n\tv_mbcnt_hi_u32_b32 %0, -1, %0" : "=v"(_t)); _t | ((w) << 6); })
__device__ __forceinline__ unsigned cvtpk(float lo, float hi) { f32x2_t v = {lo, hi}; bf16x2_t b = __builtin_convertvector(v, bf16x2_t); return __builtin_bit_cast(unsigned, b); }
__device__ __forceinline__ int crow0(int reg) { return (reg & 3) + 8 * (reg >> 2); }
__device__ __forceinline__ int swz64(int row) { return (((row >> 1) & 1) << 2) | (((row >> 3) & 1) << 1) | ((row >> 2) & 1); }
__device__ __forceinline__ int off64(int row, int ch) { return 128 * row + 16 * (ch ^ swz64(row)); }
__device__ __forceinline__ bf16x8 rowfrag(LAS unsigned char* img, int row, int ch) { return *(const LAS bf16x8*)(img + off64(row, ch)); }
__device__ __forceinline__ s16x4 tr4(LAS unsigned char* img, int krow, int ct, int lane) {
    const int q = (lane & 15) >> 2, p = lane & 3, blk = (lane >> 4) & 1;
    return __builtin_bit_cast(s16x4, __builtin_amdgcn_ds_read_tr16_b64_v4i16((LAS s16x4*)(img + off64(krow + q, 4 * ct + 2 * blk + (p >> 1)) + 8 * (p & 1))));
}
__device__ __forceinline__ bf16x8 trfrag(LAS unsigned char* img, int krow_lo, int krow_hi, int ct, int lane) {
    const s16x4 lo = tr4(img, krow_lo, ct, lane), hi = tr4(img, krow_hi, ct, lane);
    return (bf16x8){lo[0], lo[1], lo[2], lo[3], hi[0], hi[1], hi[2], hi[3]};
}
__device__ __forceinline__ void st_chunk(LAS unsigned char* img, int row, int ch, const float* v8) {
    v4u w; w.x = cvtpk(v8[0], v8[1]); w.y = cvtpk(v8[2], v8[3]); w.z = cvtpk(v8[4], v8[5]); w.w = cvtpk(v8[6], v8[7]); *(LAS v4u*)(img + off64(row, ch)) = w;
}
#define PACK8(x, s) __builtin_bit_cast(bf16x8, (v4u){cvtpk((x)[8 * (s)], (x)[8 * (s) + 1]), cvtpk((x)[8 * (s) + 2], (x)[8 * (s) + 3]), cvtpk((x)[8 * (s) + 4], (x)[8 * (s) + 5]), cvtpk((x)[8 * (s) + 6], (x)[8 * (s) + 7])})
__device__ __forceinline__ f32x16 zero16() { f32x16 z;
#pragma unroll
    for (int i = 0; i < 16; ++i) z[i] = 0.f;
    return z; }
__device__ __forceinline__ float wave_max(float v) { v = fmaxf(v, SHX(v, 1)); v = fmaxf(v, SHX(v, 2)); v = fmaxf(v, SHX(v, 4)); v = fmaxf(v, SHX(v, 8)); v = fmaxf(v, SHX(v, 16)); return xhalf_max(v); }

__device__ __forceinline__ void na_mfma(const bf16* P, bf16* MIX, const float* wq, const float* wk, const float* rpb, bool with_ctx, LAS unsigned char* lds, int tid_in, int G) {
    const int wave = __builtin_amdgcn_readfirstlane(tid_in >> 6); int tid = tid_in, lane = tid & 63;
    LAS unsigned char* Kimg = lds; LAS unsigned char* Vimg = lds + 16384;
    LAS float* tab = (LAS float*)(lds + 32768) + 64;
    const float mq = wave_max(fabsf(wq[lane])), mk = wave_max(fabsf(wk[lane]));
    const int nunits = NB * 6 * 32 + (with_ctx ? NB * 6 : 0);
    for (int u = blockIdx.x; u < nunits; u += G) {
        tid = FRESH_TID(wave); lane = tid & 63; const int r32 = lane & 31, hh = lane >> 5;
        const int skey = tid >> 3, spart = tid & 7;
        float wk8[8];
#pragma unroll
        for (int j = 0; j < 8; ++j) wk8[j] = wk[8 * spart + j];
        const bool isctx = u >= NB * 6 * 32; int b, h, r0 = 0;
        if (!isctx) { b = u / 192; h = (u >> 5) % 6; r0 = 4 * (u & 31); } else { const int v = u - NB * 6 * 32; b = v / 6; h = v % 6; }
        float mr = 0.f;
        for (int i = lane; i < 465; i += 64) mr = fmaxf(mr, fabsf(rpb[h * 465 + i]));
        mr = wave_max(mr);
        const float mbound = 8.0f * mq * mk + mr, negmb = -mbound * LOG2E;
        if (!isctx) for (int i = tid; i < 465; i += 512) tab[i] = (rpb[h * 465 + i] - mbound) * LOG2E;
        int r = 0, c = 0, tq;
        if (!isctx) { r = r0 + (wave >> 1); c = 32 * (wave & 1) + r32; tq = b * SEQ + r * 64 + c; } else tq = TL + b * CTXL + wave * 32 + r32;
        bf16x8 qf[4];
        { float qv[32]; float ss = 0.f; const bf16* qp = P + (size_t)tq * INC + C_NAQ + h * 64 + 8 * hh;
#pragma unroll
          for (int s = 0; s < 4; ++s) load8(qp + 16 * s, qv + 8 * s);
#pragma unroll
          for (int i = 0; i < 32; ++i) ss += qv[i] * qv[i];
          ss = xhalf_sum(ss);
          const float rstd = (1.0f / sqrtf(ss * (1.0f / 64.0f) + 1e-6f)) * (0.125f * LOG2E);
#pragma unroll
          for (int s = 0; s < 4; ++s) { float t8[8];
#pragma unroll
              for (int j = 0; j < 8; ++j) { const int d = 16 * s + 8 * hh + j; t8[j] = qv[8 * s + j] * rstd * wq[d] * wk[d]; }
              qf[s] = __builtin_bit_cast(bf16x8, (v4u){cvtpk(t8[0], t8[1]), cvtpk(t8[2], t8[3]), cvtpk(t8[4], t8[5]), cvtpk(t8[6], t8[7])}); } }
        const int rs0 = min(max(r0 - 4, 0), 120);
        const int nl = isctx ? 0 : (min(max(r0 + 3 - 4, 0), 120) + 8 - rs0), nchunks = nl + 4;
        const int rs = min(max(r - 4, 0), 120);
#define NA_TOK(ci) ((ci) < nl ? b * SEQ + (rs0 + (ci)) * 64 + skey : TL + b * CTXL + ((ci) - nl) * 64 + skey)
#define NA_STAGE(buf, kw, vw) do { float k8[8]; k8[0] = bflo(kw.x); k8[1] = bfhi(kw.x); k8[2] = bflo(kw.y); k8[3] = bfhi(kw.y); k8[4] = bflo(kw.z); k8[5] = bfhi(kw.z); k8[6] = bflo(kw.w); k8[7] = bfhi(kw.w); \
            float ss_ = 0.f; _Pragma("unroll") for (int j = 0; j < 8; ++j) ss_ += k8[j] * k8[j]; \
            ss_ += SHX(ss_, 1); ss_ += SHX(ss_, 2); ss_ += SHX(ss_, 4); \
            const float rk_ = 1.0f / sqrtf(ss_ * (1.0f / 64.0f) + 1e-6f); \
            _Pragma("unroll") for (int j = 0; j < 8; ++j) k8[j] *= rk_ * wk8[j]; \
            st_chunk(Kimg + (buf) * 8192, skey, spart, k8); *(LAS v4u*)(Vimg + (buf) * 8192 + off64(skey, spart)) = vw; } while (0)
        v4u kw, vw;
        { const bf16* src = P + (size_t)NA_TOK(0) * INC + h * 64 + 8 * spart; kw = *(const v4u*)(src + C_NAK); vw = *(const v4u*)(src + C_NAV); }
        NA_STAGE(0, kw, vw);
        __syncthreads();
        f32x16 o0 = zero16(), o1 = zero16(); float lsum = 0.f;
        for (int ci = 0; ci < nchunks; ++ci) {
            const int buf = ci & 1;
            if (ci + 1 < nchunks) { const bf16* src = P + (size_t)NA_TOK(ci + 1) * INC + h * 64 + 8 * spart; kw = *(const v4u*)(src + C_NAK); vw = *(const v4u*)(src + C_NAV); }
            const bool local = ci < nl; const int kr = rs0 + ci;
            const bool active = local ? (kr >= rs && kr < rs + 8) : true;
            if (active) {
                const int c_o = OPQV(c), cs_o = min(max(c_o - 8, 0), 48);
                LAS unsigned char* Kb = Kimg + buf * 8192; LAS unsigned char* Vb = Vimg + buf * 8192;
#pragma unroll
                for (int kt = 0; kt < 2; ++kt) {
                    f32x16 x;
                    if (local) { const int bidx = (kr - r + 7) * 31 + 32 * kt + 4 * hh - c_o + 15, t0 = 32 * kt + 4 * hh - cs_o;
#pragma unroll
                        for (int i = 0; i < 16; ++i) { const float tv = tab[bidx + crow0(i)]; x[i] = ((unsigned)(t0 + crow0(i)) < 16u) ? tv : -INFINITY; } }
                    else {
#pragma unroll
                        for (int i = 0; i < 16; ++i) x[i] = negmb; }
#pragma unroll
                    for (int s = 0; s < 4; ++s) x = MFMA32(rowfrag(Kb, 32 * kt + r32, 2 * s + hh), qf[s], x);
#pragma unroll
                    for (int i = 0; i < 16; ++i) { x[i] = __builtin_amdgcn_exp2f(x[i]); lsum += x[i]; }
                    const bf16x8 pa0 = PACK8(x, 0), pa1 = PACK8(x, 1);
                    o0 = MFMA32(trfrag(Vb, 32 * kt + 4 * hh, 32 * kt + 8 + 4 * hh, 0, lane), pa0, o0);
                    o0 = MFMA32(trfrag(Vb, 32 * kt + 16 + 4 * hh, 32 * kt + 24 + 4 * hh, 0, lane), pa1, o0);
                    o1 = MFMA32(trfrag(Vb, 32 * kt + 4 * hh, 32 * kt + 8 + 4 * hh, 1, lane), pa0, o1);
                    o1 = MFMA32(trfrag(Vb, 32 * kt + 16 + 4 * hh, 32 * kt + 24 + 4 * hh, 1, lane), pa1, o1);
                }
            }
            if (ci + 1 < nchunks) NA_STAGE(buf ^ 1, kw, vw);
            __syncthreads();
        }
#undef NA_TOK
#undef NA_STAGE
        lsum = xhalf_sum(lsum);
        const float il = 1.0f / lsum; bf16* op = MIX + (size_t)tq * DM + M_NA + h * 64 + 4 * hh;
#pragma unroll
        for (int g4 = 0; g4 < 4; ++g4) {
            u32x2 w0; w0.x = cvtpk(o0[4 * g4] * il, o0[4 * g4 + 1] * il); w0.y = cvtpk(o0[4 * g4 + 2] * il, o0[4 * g4 + 3] * il); *(u32x2*)(op + 8 * g4) = w0;
            u32x2 w1; w1.x = cvtpk(o1[4 * g4] * il, o1[4 * g4 + 1] * il); w1.y = cvtpk(o1[4 * g4 + 2] * il, o1[4 * g4 + 3] * il); *(u32x2*)(op + 32 + 8 * g4) = w1; }
    }
}

__device__ __forceinline__ void sg_mfma(const bf16* P, bf16* MIX, const bf16* Wsg, const float* sgb, const float* lnw, const float* lnb, LAS unsigned char* lds, int tid_in, int G) {
    const int wave = __builtin_amdgcn_readfirstlane(tid_in >> 6);
    for (int ch = blockIdx.x; ch < NCH; ch += G) {
        const int tid = FRESH_TID(wave), lane = tid & 63, r32 = lane & 31, hh = lane >> 5, tok = tid >> 2, sg = tid & 3;
        const int row0 = ch * 128;
        { const bf16* src = P + (size_t)(row0 + tok) * INC + C_SGV + sg * 64; float v[64]; float s = 0.f;
#pragma unroll
          for (int k8 = 0; k8 < 8; ++k8) load8(src + 8 * k8, v + 8 * k8);
#pragma unroll
          for (int k = 0; k < 64; ++k) { v[k] = gelu_tanh(v[k]); s += v[k]; }
          const float mu = s * (1.0f / 64.0f); float q = 0.f;
#pragma unroll
          for (int k = 0; k < 64; ++k) { v[k] -= mu; q += v[k] * v[k]; }
          const float rstd = 1.0f / sqrtf(q * (1.0f / 64.0f) + 1e-5f);
#pragma unroll
          for (int k8 = 0; k8 < 8; ++k8) { float t8[8];
#pragma unroll
              for (int j = 0; j < 8; ++j) { const int cch = sg * 64 + 8 * k8 + j; t8[j] = v[8 * k8 + j] * rstd * lnw[cch] + lnb[cch]; }
              st_chunk(lds + sg * 16384, tok, k8, t8); } }
        __syncthreads();
        { const int g = wave >> 1; LAS unsigned char* img = lds + g * 16384;
#pragma unroll
          for (int pp = 0; pp < 2; ++pp) { const int pt = 2 * (wave & 1) + pp, p = 32 * pt + r32;
            f32x16 a0 = zero16(), a1 = zero16();
            const bf16* wrow = Wsg + ((size_t)g * 128 + p) * 128 + 8 * hh;
#pragma unroll
            for (int ks = 0; ks < 8; ++ks) { const bf16x8 wf = *(const bf16x8*)(wrow + 16 * ks);
                a0 = MFMA32(trfrag(img, 16 * ks + 8 * hh, 16 * ks + 8 * hh + 4, 0, lane), wf, a0);
                a1 = MFMA32(trfrag(img, 16 * ks + 8 * hh, 16 * ks + 8 * hh + 4, 1, lane), wf, a1); }
            const float bias = sgb[g * 128 + p]; const size_t trow = (size_t)(row0 + p);
            const bf16* up = P + trow * INC + C_SGU + g * 64 + 4 * hh; bf16* op = MIX + trow * DM + M_SG + g * 64 + 4 * hh;
#pragma unroll
            for (int g4 = 0; g4 < 4; ++g4) {
                const u32x2 u0 = *(const u32x2*)(up + 8 * g4), u1 = *(const u32x2*)(up + 32 + 8 * g4);
                u32x2 w0, w1;
                w0.x = cvtpk(gelu_tanh(bflo(u0.x)) * (a0[4 * g4] + bias), gelu_tanh(bfhi(u0.x)) * (a0[4 * g4 + 1] + bias)); w0.y = cvtpk(gelu_tanh(bflo(u0.y)) * (a0[4 * g4 + 2] + bias), gelu_tanh(bfhi(u0.y)) * (a0[4 * g4 + 3] + bias));
                w1.x = cvtpk(gelu_tanh(bflo(u1.x)) * (a1[4 * g4] + bias), gelu_tanh(bfhi(u1.x)) * (a1[4 * g4 + 1] + bias)); w1.y = cvtpk(gelu_tanh(bflo(u1.y)) * (a1[4 * g4 + 2] + bias), gelu_tanh(bfhi(u1.y)) * (a1[4 * g4 + 3] + bias));
                *(u32x2*)(op + 8 * g4) = w0; *(u32x2*)(op + 32 + 8 * g4) = w1; } } }
        __syncthreads();
    }
}

__device__ __forceinline__ void ret_kv_mfma(const bf16* P, float* KV, const float* logit, const float* ropetab, LAS unsigned char* lds, int tid_in, int G) {
    const int wave = __builtin_amdgcn_readfirstlane(tid_in >> 6);
    LAS unsigned char* Kf = lds; LAS unsigned char* Kb = lds + 16384; LAS unsigned char* Vi = lds + 32768;
    for (int it_r = blockIdx.x; it_r < NCH * 6 * REP_KV; it_r += G) { const int it = it_r % (NCH * 6);
        const int tid = FRESH_TID(wave), lane = tid & 63, r32 = lane & 31, hh = lane >> 5, tok = tid >> 2, part = tid & 3;
        const int ch = it / 6, h = it % 6, row0 = ch * 128; const bool latent = ch < NCHL;
        { const float lgf = log_sigmoid(logit[h]) * LOG2E, lgb = log_sigmoid(logit[6 + h]) * LOG2E;
          const float wf = __builtin_amdgcn_exp2f(lgf * (float)(127 - tok)) * 0.125f, wb = __builtin_amdgcn_exp2f(lgb * (float)tok) * 0.125f;
          float k16[16], t8[8]; rope_load16(P, row0 + tok, C_RK, h, part, latent, ropetab, k16);
#pragma unroll
          for (int c2 = 0; c2 < 2; ++c2) {
#pragma unroll
              for (int j = 0; j < 8; ++j) t8[j] = k16[8 * c2 + j] * wf;
              st_chunk(Kf, tok, 2 * part + c2, t8);
#pragma unroll
              for (int j = 0; j < 8; ++j) t8[j] = k16[8 * c2 + j] * wb;
              st_chunk(Kb, tok, 2 * part + c2, t8); }
          const bf16* vp = P + (size_t)(row0 + tok) * INC + C_RV + h * 64 + part * 16;
          *(LAS v4u*)(Vi + off64(tok, 2 * part)) = *(const v4u*)vp; *(LAS v4u*)(Vi + off64(tok, 2 * part + 1)) = *(const v4u*)(vp + 8); }
        __syncthreads();
        { const int dir = wave >> 2, et = (wave >> 1) & 1, dt = wave & 1; LAS unsigned char* Kd = dir ? Kb : Kf;
          f32x16 acc = zero16();
#pragma unroll
          for (int ks = 0; ks < 8; ++ks)
              acc = MFMA32(trfrag(Vi, 16 * ks + 8 * hh, 16 * ks + 8 * hh + 4, et, lane), trfrag(Kd, 16 * ks + 8 * hh, 16 * ks + 8 * hh + 4, dt, lane), acc);
          float* o = KV + ((size_t)(ch * 6 + h) * 2 + dir) * 4096 + (size_t)(32 * et + 4 * hh) * 64 + 32 * dt + r32;
#pragma unroll
          for (int i = 0; i < 16; ++i) o[crow0(i) * 64] = acc[i]; }
        __syncthreads();
    }
}
__device__ __forceinline__ void ret_scan2(const float* KV, bf16* PREV, const float* logit, int gtid, int nthreads) {
    for (int it = gtid; it < NB * 6 * 2 * 4096; it += nthreads) {
        const int idx = it & 4095, dir = (it >> 12) & 1, bh = it >> 13, h = bh % 6, b = bh / 6;
        const float cd = expf(128.0f * log_sigmoid(logit[dir * 6 + h]));
#define KVI(ch) (((size_t)((ch) * 6 + h) * 2 + dir) * 4096 + idx)
        const int c0 = NCHL + 2 * b, c1 = c0 + 1;
        const float k0 = KV[KVI(c0)], k1 = KV[KVI(c1)];
        if (dir == 0) { PREV[KVI(c0)] = 0; PREV[KVI(c1)] = (bf16)f2bf(k0); float s = cd * k0 + k1;
            for (int n = 0; n < 64; ++n) { const int ch = b * 64 + n; PREV[KVI(ch)] = (bf16)f2bf(s); s = cd * s + KV[KVI(ch)]; } }
        else { PREV[KVI(c0)] = (bf16)f2bf(k1); PREV[KVI(c1)] = 0; float s = k0 + cd * k1;
            for (int n = 63; n >= 0; --n) { const int ch = b * 64 + n; PREV[KVI(ch)] = (bf16)f2bf(s); s = cd * s + KV[KVI(ch)]; } }
#undef KVI
    }
}
__device__ __forceinline__ void ret_out_mfma(const bf16* P, const bf16* PREV, bf16* MIX, const float* logit, const float* gnw, const float* ropetab, LAS unsigned char* lds, int tid_in, int G) {
    const int wave = __builtin_amdgcn_readfirstlane(tid_in >> 6);
    LAS unsigned char* Qi = lds; LAS unsigned char* Ki = lds + 16384; LAS unsigned char* Vi = lds + 32768;
    LAS float* st = (LAS float*)(lds + 49152);
    const int it_ = wave >> 1, et = wave & 1;
    for (int itm_r = blockIdx.x; itm_r < NCH * 6 * REP_RETO; itm_r += G) { const int itm = itm_r % (NCH * 6);
        const int tid = FRESH_TID(wave), lane = tid & 63, r32 = lane & 31, hh = lane >> 5, tok = tid >> 2, part = tid & 3;
        const int ch = itm / 6, h = itm % 6, row0 = ch * 128; const bool latent = ch < NCHL;
        { float t16[16], t8[8]; rope_load16(P, row0 + tok, C_RQ, h, part, latent, ropetab, t16);
          st_chunk(Qi, tok, 2 * part, t16); st_chunk(Qi, tok, 2 * part + 1, t16 + 8);
          rope_load16(P, row0 + tok, C_RK, h, part, latent, ropetab, t16);
#pragma unroll
          for (int c2 = 0; c2 < 2; ++c2) {
#pragma unroll
              for (int j = 0; j < 8; ++j) t8[j] = t16[8 * c2 + j] * 0.125f;
              st_chunk(Ki, tok, 2 * part + c2, t8); }
          const bf16* vp = P + (size_t)(row0 + tok) * INC + C_RV + h * 64 + part * 16;
          *(LAS v4u*)(Vi + off64(tok, 2 * part)) = *(const v4u*)vp; *(LAS v4u*)(Vi + off64(tok, 2 * part + 1)) = *(const v4u*)(vp + 8); }
        __syncthreads();
        const float lgf = log_sigmoid(logit[h]) * LOG2E, lgb = log_sigmoid(logit[6 + h]) * LOG2E;
        const int il = 32 * it_ + r32;
        bf16x8 qf[4];
#pragma unroll
        for (int s = 0; s < 4; ++s) qf[s] = rowfrag(Qi, il, 2 * s + hh);
        f32x16 of = zero16(), ob = zero16();
#pragma unroll
        for (int jt = 0; jt < 4; ++jt) {
            f32x16 x = zero16();
#pragma unroll
            for (int s = 0; s < 4; ++s) x = MFMA32(rowfrag(Ki, 32 * jt + r32, 2 * s + hh), qf[s], x);
            if (jt <= it_) { f32x16 w;
#pragma unroll
                for (int i = 0; i < 16; ++i) { const int jl = 32 * jt + crow0(i) + 4 * hh; w[i] = (jl <= il) ? x[i] * __builtin_amdgcn_exp2f(lgf * (float)(il - jl)) : 0.f; }
                const bf16x8 p0 = PACK8(w, 0), p1 = PACK8(w, 1);
                of = MFMA32(trfrag(Vi, 32 * jt + 4 * hh, 32 * jt + 8 + 4 * hh, et, lane), p0, of);
                of = MFMA32(trfrag(Vi, 32 * jt + 16 + 4 * hh, 32 * jt + 24 + 4 * hh, et, lane), p1, of); }
            if (jt >= it_) { f32x16 w;
#pragma unroll
                for (int i = 0; i < 16; ++i) { const int jl = 32 * jt + crow0(i) + 4 * hh; w[i] = (jl >= il) ? x[i] * __builtin_amdgcn_exp2f(lgb * (float)(jl - il)) : 0.f; }
                const bf16x8 p0 = PACK8(w, 0), p1 = PACK8(w, 1);
                ob = MFMA32(trfrag(Vi, 32 * jt + 4 * hh, 32 * jt + 8 + 4 * hh, et, lane), p0, ob);
                ob = MFMA32(trfrag(Vi, 32 * jt + 16 + 4 * hh, 32 * jt + 24 + 4 * hh, et, lane), p1, ob); }
        }
        { const bf16* pf = PREV + ((size_t)(ch * 6 + h) * 2) * 4096 + (size_t)(32 * et + r32) * 64 + 8 * hh; const bf16* pb = pf + 4096;
          f32x16 cf = zero16(), cb = zero16();
#pragma unroll
          for (int s = 0; s < 4; ++s) { cf = MFMA32(*(const bf16x8*)(pf + 16 * s), qf[s], cf); cb = MFMA32(*(const bf16x8*)(pb + 16 * s), qf[s], cb); }
          const float df = __builtin_amdgcn_exp2f(lgf * (float)(il + 1)), db = __builtin_amdgcn_exp2f(lgb * (float)(128 - il));
#pragma unroll
          for (int i = 0; i < 16; ++i) { of[i] += df * cf[i]; ob[i] += db * cb[i]; } }
        float s1f = 0.f, s2f = 0.f, s1b = 0.f, s2b = 0.f;
#pragma unroll
        for (int i = 0; i < 16; ++i) { s1f += of[i]; s2f += of[i] * of[i]; s1b += ob[i]; s2b += ob[i] * ob[i]; }
        s1f = xhalf_sum(s1f); s2f = xhalf_sum(s2f); s1b = xhalf_sum(s1b); s2b = xhalf_sum(s2b);
        if (hh == 0) { LAS float* sp = st + (wave * 32 + r32) * 4; sp[0] = s1f; sp[1] = s2f; sp[2] = s1b; sp[3] = s2b; }
        __syncthreads();
        { const LAS float* sp = st + ((wave ^ 1) * 32 + r32) * 4; s1f += sp[0]; s2f += sp[1]; s1b += sp[2]; s2b += sp[3]; }
        const float muf = s1f * (1.0f / 64.0f), mub = s1b * (1.0f / 64.0f);
        const float rf = 1.0f / sqrtf(fmaxf(s2f * (1.0f / 64.0f) - muf * muf, 0.f) + 1e-5f), rb = 1.0f / sqrtf(fmaxf(s2b * (1.0f / 64.0f) - mub * mub, 0.f) + 1e-5f);
        { const size_t trow = (size_t)(row0 + il); const int e0 = h * 64 + 32 * et + 4 * hh;
          const bf16* gp = P + trow * INC + C_GF + e0; bf16* op = MIX + trow * DM + M_RET + e0;
#pragma unroll
          for (int g4 = 0; g4 < 4; ++g4) { const u32x2 gfw = *(const u32x2*)(gp + 8 * g4), gbw = *(const u32x2*)(gp + (C_GB - C_GF) + 8 * g4);
              const float gfv[4] = {bflo(gfw.x), bfhi(gfw.x), bflo(gfw.y), bfhi(gfw.y)}, gbv[4] = {bflo(gbw.x), bfhi(gbw.x), bflo(gbw.y), bfhi(gbw.y)};
              float y[4];
#pragma unroll
              for (int k = 0; k < 4; ++k) { const int i = 4 * g4 + k;
                  y[k] = ((of[i] - muf) * rf * (gfv[k] * sigmoidf_(gfv[k])) + (ob[i] - mub) * rb * (gbv[k] * sigmoidf_(gbv[k]))) * gnw[e0 + 8 * g4 + k]; }
              u32x2 w; w.x = cvtpk(y[0], y[1]); w.y = cvtpk(y[2], y[3]); *(u32x2*)(op + 8 * g4) = w; } }
        __syncthreads();
    }
}

__device__ __forceinline__ void ret_out_mfma2(const bf16* P, const bf16* PREV, bf16* MIX, const float* logit, const float* gnw, const float* ropetab, LAS unsigned char* lds, int tid_in, int G) {
    const int wave = __builtin_amdgcn_readfirstlane(tid_in >> 6);
    const int it_ = wave >> 1, et = wave & 1;
    LAS float* tabL = (LAS float*)(lds + 98304);
    LAS float* stL = (LAS float*)(lds + 98304 + 16384);
    { const int t0 = FRESH_TID(wave); for (int i = t0; i < 1024; i += 512) ((LAS f32x4*)tabL)[i] = ((const f32x4*)ropetab)[i]; }
    __syncthreads();
    v4u rq0, rq1, rk0, rk1, rv0, rv1, rg00, rg01, rg10, rg11;
    LAS unsigned char* gs = lds + 98304 + 16384 + 8192 + wave * 4096;
#define RO_LOAD(uu) do { const int t_ = FRESH_TID(wave); const int ch_ = (uu) / 6, h_ = (uu) % 6, pt_ = t_ & 3; \
        const bf16* b_ = P + (size_t)(ch_ * 128 + (t_ >> 2)) * INC + h_ * 64 + 32 * (pt_ >> 1) + 8 * (pt_ & 1); \
        rq0 = *(const v4u*)(b_ + C_RQ); rq1 = *(const v4u*)(b_ + C_RQ + 16); rk0 = *(const v4u*)(b_ + C_RK); rk1 = *(const v4u*)(b_ + C_RK + 16); rv0 = *(const v4u*)(b_ + C_RV); rv1 = *(const v4u*)(b_ + C_RV + 16); \
        const int l_ = t_ & 63; const bf16* g_ = P + (size_t)(ch_ * 128 + 32 * it_ + (l_ >> 2)) * INC + C_GF + h_ * 64 + 32 * et + 8 * (l_ & 3); \
        rg00 = *(const v4u*)g_; rg01 = *(const v4u*)(g_ + (size_t)16 * INC); rg10 = *(const v4u*)(g_ + (C_GB - C_GF)); rg11 = *(const v4u*)(g_ + (C_GB - C_GF) + (size_t)16 * INC); } while (0)
    int u = blockIdx.x;
    if (u < NCH * 6 * REP_RETO) RO_LOAD(u % (NCH * 6));
    for (int n = 0; u < NCH * 6 * REP_RETO; u += G, ++n) {
        const int itm = u % (NCH * 6);
        const int tid = FRESH_TID(wave), lane = tid & 63, r32 = lane & 31, hh = lane >> 5, tok = tid >> 2, part = tid & 3;
        const int ch = itm / 6, h = itm % 6, row0 = ch * 128; const bool latent = ch < NCHL;
        LAS unsigned char* Qi = lds + (n & 1) * 49152; LAS unsigned char* Ki = Qi + 16384; LAS unsigned char* Vi = Qi + 32768;
        LAS float* st = stL + (n & 1) * 1024;
        { const int c1 = 4 * (part >> 1) + (part & 1), c2 = c1 + 2;
          float q1[8], q2[8], k1[8], k2[8];
          q1[0] = bflo(rq0.x); q1[1] = bfhi(rq0.x); q1[2] = bflo(rq0.y); q1[3] = bfhi(rq0.y); q1[4] = bflo(rq0.z); q1[5] = bfhi(rq0.z); q1[6] = bflo(rq0.w); q1[7] = bfhi(rq0.w);
          q2[0] = bflo(rq1.x); q2[1] = bfhi(rq1.x); q2[2] = bflo(rq1.y); q2[3] = bfhi(rq1.y); q2[4] = bflo(rq1.z); q2[5] = bfhi(rq1.z); q2[6] = bflo(rq1.w); q2[7] = bfhi(rq1.w);
          k1[0] = bflo(rk0.x); k1[1] = bfhi(rk0.x); k1[2] = bflo(rk0.y); k1[3] = bfhi(rk0.y); k1[4] = bflo(rk0.z); k1[5] = bfhi(rk0.z); k1[6] = bflo(rk0.w); k1[7] = bfhi(rk0.w);
          k2[0] = bflo(rk1.x); k2[1] = bfhi(rk1.x); k2[2] = bflo(rk1.y); k2[3] = bfhi(rk1.y); k2[4] = bflo(rk1.z); k2[5] = bfhi(rk1.z); k2[6] = bflo(rk1.w); k2[7] = bfhi(rk1.w);
          if (latent) { const int pos = (row0 + tok) & (SEQ - 1); const int nn = (part >> 1) ? (pos & 63) : (pos >> 6);
              const LAS f32x2_t* tb = (const LAS f32x2_t*)tabL + nn * 16 + 8 * (part & 1);
#pragma unroll
              for (int j = 0; j < 8; ++j) { const f32x2_t cs = tb[j]; const float a = q1[j], b = q2[j], c = k1[j], d = k2[j];
                  q1[j] = a * cs.x - b * cs.y; q2[j] = a * cs.y + b * cs.x; k1[j] = c * cs.x - d * cs.y; k2[j] = c * cs.y + d * cs.x; } }
#pragma unroll
          for (int j = 0; j < 8; ++j) { k1[j] *= 0.125f; k2[j] *= 0.125f; }
          st_chunk(Qi, tok, c1, q1); st_chunk(Qi, tok, c2, q2); st_chunk(Ki, tok, c1, k1); st_chunk(Ki, tok, c2, k2);
          *(LAS v4u*)(Vi + off64(tok, c1)) = rv0; *(LAS v4u*)(Vi + off64(tok, c2)) = rv1; }
        { const int tk = lane >> 2, pc = lane & 3;
          *(LAS v4u*)(gs + tk * 64 + ((pc ^ ((tk >> 1) & 3)) * 16)) = rg00; *(LAS v4u*)(gs + (tk + 16) * 64 + ((pc ^ (((tk + 16) >> 1) & 3)) * 16)) = rg01;
          *(LAS v4u*)(gs + 2048 + tk * 64 + ((pc ^ ((tk >> 1) & 3)) * 16)) = rg10; *(LAS v4u*)(gs + 2048 + (tk + 16) * 64 + ((pc ^ (((tk + 16) >> 1) & 3)) * 16)) = rg11; }
        if (u + G < NCH * 6 * REP_RETO) RO_LOAD((u + G) % (NCH * 6));
        const int il = 32 * it_ + r32;
        const bf16* pf = PREV + ((size_t)(ch * 6 + h) * 2) * 4096 + (size_t)(32 * et + r32) * 64 + 8 * hh;
        bf16x8 pff[4], pfb[4];
#pragma unroll
        for (int s = 0; s < 4; ++s) { pff[s] = *(const bf16x8*)(pf + 16 * s); pfb[s] = *(const bf16x8*)(pf + 4096 + 16 * s); }
        const size_t trow = (size_t)(row0 + il); const int e0 = h * 64 + 32 * et + 4 * hh;
        const float lgf = log_sigmoid(logit[h]) * LOG2E, lgb = log_sigmoid(logit[6 + h]) * LOG2E;
        float af[4], bfv[4], ab[4], bb[4];
#pragma unroll
        for (int k = 0; k < 4; ++k) { af[k] = __builtin_amdgcn_exp2f(-lgf * (float)k); bfv[k] = __builtin_amdgcn_exp2f(-lgf * (float)(8 * k)); ab[k] = __builtin_amdgcn_exp2f(lgb * (float)k); bb[k] = __builtin_amdgcn_exp2f(lgb * (float)(8 * k)); }
        LDS_BARRIER();
        bf16x8 qf[4];
#pragma unroll
        for (int s = 0; s < 4; ++s) qf[s] = rowfrag(Qi, il, 2 * s + hh);
        f32x16 of = zero16(), ob = zero16();
#pragma unroll
        for (int jt = 0; jt < 4; ++jt) {
            f32x16 x = zero16();
#pragma unroll
            for (int s = 0; s < 4; ++s) x = MFMA32(rowfrag(Ki, 32 * jt + r32, 2 * s + hh), qf[s], x);
            if (jt <= it_) { f32x16 w; const float lf = __builtin_amdgcn_exp2f(lgf * (float)(il - 32 * jt - 4 * hh));
#pragma unroll
                for (int g = 0; g < 4; ++g) { const float lg = lf * bfv[g];
#pragma unroll
                    for (int k = 0; k < 4; ++k) { const int i = 4 * g + k; const float v = x[i] * (lg * af[k]); w[i] = (jt < it_ || crow0(i) + 4 * hh <= r32) ? v : 0.f; } }
                const bf16x8 p0 = PACK8(w, 0), p1 = PACK8(w, 1);
                of = MFMA32(trfrag(Vi, 32 * jt + 4 * hh, 32 * jt + 8 + 4 * hh, et, lane), p0, of);
                of = MFMA32(trfrag(Vi, 32 * jt + 16 + 4 * hh, 32 * jt + 24 + 4 * hh, et, lane), p1, of); }
            if (jt >= it_) { f32x16 w; const float lb = __builtin_amdgcn_exp2f(lgb * (float)(32 * jt + 4 * hh - il));
#pragma unroll
                for (int g = 0; g < 4; ++g) { const float lg = lb * bb[g];
#pragma unroll
                    for (int k = 0; k < 4; ++k) { const int i = 4 * g + k; const float v = x[i] * (lg * ab[k]); w[i] = (jt > it_ || crow0(i) + 4 * hh >= r32) ? v : 0.f; } }
                const bf16x8 p0 = PACK8(w, 0), p1 = PACK8(w, 1);
                ob = MFMA32(trfrag(Vi, 32 * jt + 4 * hh, 32 * jt + 8 + 4 * hh, et, lane), p0, ob);
                ob = MFMA32(trfrag(Vi, 32 * jt + 16 + 4 * hh, 32 * jt + 24 + 4 * hh, et, lane), p1, ob); }
        }
        { f32x16 cf = zero16(), cb = zero16();
#pragma unroll
          for (int s = 0; s < 4; ++s) { cf = MFMA32(pff[s], qf[s], cf); cb = MFMA32(pfb[s], qf[s], cb); }
          const float df = __builtin_amdgcn_exp2f(lgf * (float)(il + 1)), db = __builtin_amdgcn_exp2f(lgb * (float)(128 - il));
#pragma unroll
          for (int i = 0; i < 16; ++i) { of[i] += df * cf[i]; ob[i] += db * cb[i]; } }
        float s1f = 0.f, s2f = 0.f, s1b = 0.f, s2b = 0.f;
#pragma unroll
        for (int i = 0; i < 16; ++i) { s1f += of[i]; s2f += of[i] * of[i]; s1b += ob[i]; s2b += ob[i] * ob[i]; }
        s1f = xhalf_sum(s1f); s2f = xhalf_sum(s2f); s1b = xhalf_sum(s1b); s2b = xhalf_sum(s2b);
        if (hh == 0) { LAS float* sp = st + (wave * 32 + r32) * 4; sp[0] = s1f; sp[1] = s2f; sp[2] = s1b; sp[3] = s2b; }
        LDS_BARRIER();
        { const LAS float* sp = st + ((wave ^ 1) * 32 + r32) * 4; s1f += sp[0]; s2f += sp[1]; s1b += sp[2]; s2b += sp[3]; }
        const float muf = s1f * (1.0f / 64.0f), mub = s1b * (1.0f / 64.0f);
        const float rf = __builtin_amdgcn_rsqf(fmaxf(s2f * (1.0f / 64.0f) - muf * muf, 0.f) + 1e-5f), rb = __builtin_amdgcn_rsqf(fmaxf(s2b * (1.0f / 64.0f) - mub * mub, 0.f) + 1e-5f);
        { const int sw = (r32 >> 1) & 3; u32x2 gfw[4], gbw[4];
#pragma unroll
          for (int g4 = 0; g4 < 4; ++g4) { gfw[g4] = *(const LAS u32x2*)(gs + r32 * 64 + ((g4 ^ sw) * 16) + 8 * hh); gbw[g4] = *(const LAS u32x2*)(gs + 2048 + r32 * 64 + ((g4 ^ sw) * 16) + 8 * hh); }
#pragma unroll
          for (int g4 = 0; g4 < 4; ++g4) {
              const float gfv[4] = {bflo(gfw[g4].x), bfhi(gfw[g4].x), bflo(gfw[g4].y), bfhi(gfw[g4].y)}, gbv[4] = {bflo(gbw[g4].x), bfhi(gbw[g4].x), bflo(gbw[g4].y), bfhi(gbw[g4].y)};
              float y[4];
#pragma unroll
              for (int k = 0; k < 4; ++k) { const int i = 4 * g4 + k;
                  const float sf = gfv[k] * __builtin_amdgcn_rcpf(1.0f + __builtin_amdgcn_exp2f(-LOG2E * gfv[k])), sb = gbv[k] * __builtin_amdgcn_rcpf(1.0f + __builtin_amdgcn_exp2f(-LOG2E * gbv[k]));
                  y[k] = ((of[i] - muf) * rf * sf + (ob[i] - mub) * rb * sb) * gnw[e0 + 8 * g4 + k]; }
              u32x2 w; w.x = cvtpk(y[0], y[1]); w.y = cvtpk(y[2], y[3]); *(LAS u32x2*)(gs + r32 * 64 + ((g4 ^ sw) * 16) + 8 * hh) = w; }
          const int tk = lane >> 2, pc = lane & 3; bf16* op = MIX + (size_t)(row0 + 32 * it_ + tk) * DM + M_RET + h * 64 + 32 * et + 8 * pc;
          const v4u o0 = *(const LAS v4u*)(gs + tk * 64 + ((pc ^ ((tk >> 1) & 3)) * 16)), o1 = *(const LAS v4u*)(gs + (tk + 16) * 64 + ((pc ^ (((tk + 16) >> 1) & 3)) * 16));
          *(v4u*)op = o0; *(v4u*)(op + (size_t)16 * DM) = o1; }
    }
#undef RO_LOAD
    __syncthreads();
}

#ifndef REP_NORM
#define REP_NORM 1
#endif
#ifndef REP_UP
#define REP_UP 1
#endif
#ifndef REP_WIN
#define REP_WIN 1
#endif
#ifndef REP_NA
#define REP_NA 1
#endif
#ifndef REP_SG
#define REP_SG 1
#endif
#ifndef REP_KV
#define REP_KV 1
#endif
#ifndef REP_SCAN
#define REP_SCAN 1
#endif
#ifndef REP_RETO
#define REP_RETO 1
#endif
#ifndef REP_PRO
#define REP_PRO 1
#endif

struct Args { In in; float* out; unsigned char* ws; int ph_lo, ph_hi; };
__global__ void __launch_bounds__(NWAVES * 64, 2) hybrid_fwd(Args args) {
    extern __shared__ __attribute__((aligned(16))) unsigned char lds_raw[];
    LAS unsigned char* lds = (LAS unsigned char*)lds_raw;
    volatile LAS unsigned* MISC = (volatile LAS unsigned*)(lds + MISC_OFF);
    const int tid = threadIdx.x, lane = tid & 63, wave = __builtin_amdgcn_readfirstlane(tid >> 6);
    const int G = gridDim.x; const int bx = blockIdx.x; const int vcu = (G % 8 == 0) ? (bx % 8) * (G / 8) + bx / 8 : bx;
    const int NGW = G * NWAVES, nthreads = G * NWAVES * 64;
    unsigned char* ws = args.ws; const In& I = args.in;
    gu32* ctl = (gu32*)(ws + WS_CTL);
    for (int u = tid; u < (LDS_BYTES - LDSCTL_OFF) / 4; u += NWAVES * 64) ((LAS unsigned*)(lds + LDSCTL_OFF))[u] = 0u;
    __syncthreads();
    XcdBarrier bar; bar.bar = (unsigned*)(ctl + CW_BAR); bar.x = 0; bar.st = nullptr;
    if (MK_ONE_LAUNCH) bar = xcd_barrier_post((unsigned*)(ctl + CW_BAR), MISC + 8);
    const int lo = args.ph_lo, hi = args.ph_hi; int ph = 0;
#define PH_ON (ph >= lo && ph < hi)
#define OPQ(x) ({ int _t; asm volatile("v_mbcnt_lo_u32_b32 %0, -1, 0\n\tv_mbcnt_hi_u32_b32 %0, -1, %0" : "=v"(_t)); _t | (wave << 6); })
#define PH_END do { if (MK_ONE_LAUNCH && ph >= lo && ph + 1 < hi) xcd_barrier(bar); ++ph; } while (0)

    float* mod = (float*)(ws + WS_MOD); const float* ropetab = (const float*)(ws + WS_ROPE);
    bf16* W1T = (bf16*)(ws + WS_W1T); bf16* W2T = (bf16*)(ws + WS_W2T); bf16* WINT = (bf16*)(ws + WS_WINT); bf16* WOUTT = (bf16*)(ws + WS_WOUTT);
    float* ctxbuf = (float*)(ws + WS_CTXBUF); bf16* XN = (bf16*)(ws + WS_XN); bf16* PB = (bf16*)(ws + WS_P); bf16* HB = (bf16*)(ws + WS_P);
    float* KV = (float*)(ws + WS_KV); float* PREV = (float*)(ws + WS_PREV);

    if (PH_ON) for (int rep_ = 0; rep_ < REP_PRO; ++rep_) p0_prologue(I, ws, lds, tid, lane, wave, vcu, G);
    PH_END;

    for (int hs = 0; hs < 2 * DEPTH; ++hs) {
        const int L = hs >> 1, half = hs & 1; const bool last = (L == DEPTH - 1), first = (hs == 0);
        const int Mrows = (last && half == 1) ? TL : TT;
        const float* modL = mod + (size_t)L * 9 * 9216;
        const float* xl = first ? I.x : args.out; const float* xc = first ? I.ctx : ctxbuf;
        if (PH_ON) { const int t_ = OPQ(threadIdx.x); norm_phase(xl, xc, Mrows, I.norm_w + (size_t)(L * 3 + (half ? 2 : 0)) * DM, modL, half ? 6 : 0, XN, vcu * NWAVES + (t_ >> 6), NGW, t_ & 63); }
        PH_END;
        if (PH_ON) for (int rep_ = 0; rep_ < REP_UP; ++rep_) { pg8::Gemm g{XN, W1T + (size_t)(L * 2 + half) * DM * 2 * DFF, Mrows, 2 * DFF, DM}; pg8::StaticOrder S; S.init(Mrows, 2 * DFF, G, bx);
            pg8::EpiSwiGLU E{HB, DFF};
            pg8::gemm_phase<pg8::EpiSwiGLU, pg8::StaticOrder, true, true>(lds, g, S, E, wave); }
        PH_END;
        if (PH_ON) { pg8::Gemm g{HB, W2T + (size_t)(L * 2 + half) * DFF * DM, Mrows, DM, DFF}; pg8::StaticOrder S; S.init(Mrows, DM, G, bx);
            pg8::EpiResGate E{xl, xc, args.out, ctxbuf, modL + (half ? 8 : 2) * 1024, 0.5f};
            pg8::gemm_phase<pg8::EpiResGate, pg8::StaticOrder, true, true>(lds, g, S, E, wave); }
        PH_END;
        if (half == 0) {
            if (PH_ON) { const int t_ = OPQ(threadIdx.x); norm_phase(args.out, ctxbuf, TT, I.norm_w + (size_t)(L * 3 + 1) * DM, modL, 3, XN, vcu * NWAVES + (t_ >> 6), NGW, t_ & 63); }
            PH_END;
            if (PH_ON) for (int rep_ = 0; rep_ < REP_WIN; ++rep_) { pg8::Gemm g{XN, WINT + (size_t)L * DM * INC, TT, INC, DM}; pg8::StaticOrder S; S.init(TT, INC, G, bx);
                pg8::EpiStoreBf16 E{PB, INC};
                pg8::gemm_phase<pg8::EpiStoreBf16, pg8::StaticOrder, true, true>(lds, g, S, E, wave); }
            PH_END;
            const float* logit = I.ret_logit + L * 12;
            if (PH_ON) { const int t_ = OPQ(threadIdx.x);
                for (int rep_ = 0; rep_ < REP_NA; ++rep_) na_mfma(PB, XN, I.na_qn + L * 64, I.na_kn + L * 64, I.na_rpb + (size_t)L * 6 * 15 * 31, !last, lds, t_, G);
                for (int rep_ = 0; rep_ < REP_SG; ++rep_) sg_mfma(PB, XN, (const bf16*)(ws + WS_WSG) + (size_t)L * 4 * 128 * 128, I.sg_b + L * 4 * 128, I.sg_ln_w + L * 256, I.sg_ln_b + L * 256, lds, t_, G);
                ret_kv_mfma(PB, KV, logit, ropetab, lds, t_, G);
            }
            PH_END;
            if (PH_ON) for (int rep_ = 0; rep_ < REP_SCAN; ++rep_) { const int t_ = OPQ(threadIdx.x); ret_scan2(KV, (bf16*)PREV, logit, bx * (NWAVES * 64) + t_, nthreads); }
            PH_END;
            if (PH_ON) { const int t_ = OPQ(threadIdx.x); ret_out_mfma2(PB, (const bf16*)PREV, XN, logit, I.ret_gn_w + L * 384, ropetab, lds, t_, G); }
            PH_END;
            const int Mo = last ? TL : TT;
            if (PH_ON) { pg8::Gemm g{XN, WOUTT + (size_t)L * DM * DM, Mo, DM, DM}; pg8::StaticOrder S; S.init(Mo, DM, G, bx);
                pg8::EpiResGate E{args.out, ctxbuf, args.out, ctxbuf, modL + 5 * 1024, 1.0f};
                pg8::gemm_phase<pg8::EpiResGate, pg8::StaticOrder, true, true>(lds, g, S, E, wave); }
            PH_END;
        }
    }
#undef PH_ON
#undef PH_END
}

extern "C" void kernel_launch(void* const* d_in, const int* in_sizes, int n_in, void* d_out, int out_size, void* d_ws, size_t ws_size, hipStream_t stream) {
    static int grid = 0;
    if (grid == 0) {
        if (n_in != 20 || in_sizes[0] != TL * DM || out_size != TL * DM || ws_size < WS_END) { fprintf(stderr, "kernel_launch: unexpected shapes (n_in %d, in0 %d, out %d, ws %zu); nothing launched\n", n_in, n_in > 0 ? in_sizes[0] : -1, out_size, ws_size); grid = -1; return; }
        int dev = 0, cus = 0, per_cu = 0;
        if (hipGetDevice(&dev) != hipSuccess || hipDeviceGetAttribute(&cus, hipDeviceAttributeMultiprocessorCount, dev) != hipSuccess) { grid = -1; return; }
        if (hipFuncSetAttribute((const void*)hybrid_fwd, hipFuncAttributeMaxDynamicSharedMemorySize, LDS_BYTES) != hipSuccess) { fprintf(stderr, "kernel_launch: hipFuncSetAttribute failed\n"); grid = -1; return; }
        if (hipOccupancyMaxActiveBlocksPerMultiprocessor(&per_cu, (const void*)hybrid_fwd, NWAVES * 64, LDS_BYTES) != hipSuccess || per_cu < 1)
            fprintf(stderr, "kernel_launch: note: occupancy query reports %d workgroups per CU\n", per_cu);
        (void)hipGetLastError();
        grid = cus;
    }
    if (grid < 0) return;
    if (hipMemsetAsync((char*)d_ws + WS_CTL, 0, CTL_ZERO_BYTES, stream) != hipSuccess) return;
    Args a{};
    const float** ip = (const float**)&a.in;
    for (int i = 0; i < 20; ++i) ip[i] = (const float*)d_in[i];
    a.out = (float*)d_out; a.ws = (unsigned char*)d_ws;
#if MK_ONE_LAUNCH
    a.ph_lo = 0; a.ph_hi = NPH;
    hipLaunchKernelGGL(hybrid_fwd, dim3(grid), dim3(NWAVES * 64), LDS_BYTES, stream, a);
#else
    for (int li = 0; li < NPH; ++li) { a.ph_lo = li; a.ph_hi = li + 1; hipLaunchKernelGGL(hybrid_fwd, dim3(grid), dim3(NWAVES * 64), LDS_BYTES, stream, a); }
#endif
}
```

```cpp
#include <hip/hip_runtime.h>
#include <cstdio>
#include <cstdint>
namespace pg8 {
#define PG8_LAS __attribute__((address_space(3)))
typedef unsigned short bf16_t;
typedef short bf16x8 __attribute__((ext_vector_type(8)));
typedef float f32x4 __attribute__((ext_vector_type(4)));
typedef unsigned u32x4 __attribute__((ext_vector_type(4)));
constexpr int BM = 256, BK = 64, HALF = 128, HTB = HALF * BK * 2  , STAGE_BYTES = 8 * HTB, NXCD = 8, WGM = 8;

__host__ __device__ __forceinline__ int lds_byte(int r, int c) { const int st = (r >> 4) * 2 + (c >> 5), rr = r & 15, cc = c & 31, ob = rr * 64 + cc * 2; return st * 1024 + (ob ^ (((ob >> 9) & 1) << 5)); }
__host__ __device__ __forceinline__ void stage_rc(int b, int& R, int& C) { const int st = b / 1024, sb = b % 1024, swz = sb ^ (((sb >> 9) & 1) << 5); R = (st >> 1) * 16 + swz / 64; C = (st & 1) * 32 + (swz % 64) / 2; }
__host__ __device__ __forceinline__ int perm32(int rho) { const int n = rho >> 4, i = rho & 15; return 8 * (i >> 2) + 4 * n + (i & 3); }

struct Unit { int pm, pn; };
struct Gemm { const bf16_t* A; const bf16_t* Bt; int M, N, K; int pa, pb; size_t ksa, ksb; };

struct StaticOrder {
    int nM, nN, nwg, G, c, wgm, pm0;
    __host__ __device__ void init(int M, int N, int G_, int c_, int wgm_ = WGM, int pm0_ = 0) { nM = M / BM; nN = N / BM; nwg = nM * nN; G = G_; c = c_; wgm = wgm_; pm0 = pm0_; }
    __host__ __device__ bool next(int i, Unit& u) const {
        const long L = (long)i * G + c; if (L >= nwg) return false;
        int wgid = (int)L; { const int q = nwg / NXCD, r = nwg % NXCD, xcd = wgid % NXCD, off = wgid / NXCD; wgid = (xcd < r ? xcd * (q + 1) : r * (q + 1) + (xcd - r) * q) + off; }
        const int nig = wgm * nN, gid = wgid / nig, fm = gid * wgm, gsz = (nM - fm) < wgm ? (nM - fm) : wgm;
        u.pm = pm0 + fm + ((wgid % nig) % gsz); u.pn = (wgid % nig) / gsz; return true;
    }
    __device__ __forceinline__ void a_ready(const Unit&) const {}
    __device__ __forceinline__ void done(const Unit&) const {}
};
__device__ __forceinline__ unsigned cvt_pk_bf16(float lo, float hi) { unsigned r; asm volatile("v_cvt_pk_bf16_f32 %0, %1, %2" : "=v"(r) : "v"(lo), "v"(hi)); return r; }
typedef float f32x2 __attribute__((ext_vector_type(2)));
template <class Epi, class Sched, bool ALIGN_EPI = false, bool SP2 = false>
__device__ __forceinline__ void gemm_phase(PG8_LAS unsigned char* lds, const Gemm g, const Sched& S, const Epi& E, const int wave_s) {
    int tid_o; asm volatile("v_mbcnt_lo_u32_b32 %0, -1, 0\n\tv_mbcnt_hi_u32_b32 %0, -1, %0" : "=v"(tid_o)); tid_o |= wave_s << 6;
    const int tid = tid_o, wid = __builtin_amdgcn_readfirstlane(tid >> 6), lane = tid & 63, wr = wid >> 2, wc = wid & 3, fr = lane & 15, fq = lane >> 4;
    const int K = g.K, nt = K / BK;
    const int pa = g.pa ? g.pa : K, pb = g.pb ? g.pb : K;
    unsigned voffA[2], voffB[2];
#pragma unroll
    for (int i = 0; i < 2; ++i) { int R, C; stage_rc(tid * 16 + i * 8192, R, C); const int Rb = Epi::PERM ? ((R & ~31) + perm32(R & 31)) : R;
        voffA[i] = (unsigned)(R * pa + C) * 2u; voffB[i] = (unsigned)(Rb * pb + C) * 2u; }
    const size_t kstepA = g.ksa ? g.ksa : (size_t)(BK * 2), kstepB = g.ksb ? g.ksb : (size_t)(BK * 2);
    const size_t hstepA = (size_t)HALF * pa * 2, hstepB = (size_t)HALF * pb * 2;
    const size_t tstepA = 2 * hstepA, tstepB = 2 * hstepB;
    const unsigned ldsw = (unsigned)wid * 1024u;
    const int aoff = lds_byte(wr * 64 + fr, fq * 8), boff = lds_byte(wc * 32 + fr, fq * 8);
#define PG8_SA(b, h) (((b) * 2 + (h)) * HTB)
#define PG8_SB(b, h) ((4 + (b) * 2 + (h)) * HTB)
#define PG8_STAGE(bufoff, gbase, voff) do { _Pragma("unroll") for (int _i = 0; _i < 2; ++_i) \
        __builtin_amdgcn_global_load_lds((const unsigned*)((const char*)(gbase) + (voff)[_i]), (PG8_LAS unsigned*)(lds + (bufoff) + ldsw + _i * 8192), 16, 0, 0); } while (0)
#define PG8_LDA(dst, b, h) do { _Pragma("unroll") for (int m = 0; m < 4; ++m) _Pragma("unroll") for (int k = 0; k < 2; ++k) dst[m][k] = *(const PG8_LAS bf16x8*)(lds + PG8_SA(b, h) + aoff + m * 2048 + k * 1024); } while (0)
#define PG8_LDB(dst, b, h) do { _Pragma("unroll") for (int n = 0; n < 2; ++n) _Pragma("unroll") for (int k = 0; k < 2; ++k) dst[n][k] = *(const PG8_LAS bf16x8*)(lds + PG8_SB(b, h) + boff + n * 2048 + k * 1024); } while (0)
#define PG8_MMA(ai, bj, At, Bt) do { __builtin_amdgcn_s_setprio(1); _Pragma("unroll") for (int m = 0; m < 4; ++m) _Pragma("unroll") for (int n = 0; n < 2; ++n) _Pragma("unroll") for (int k = 0; k < 2; ++k) \
        acc[ai][bj][m][n] = __builtin_amdgcn_mfma_f32_16x16x32_bf16(Bt[n][k], At[m][k], acc[ai][bj][m][n], 0, 0, 0); __builtin_amdgcn_s_setprio(0); } while (0)
#define PG8_WAIT_V(n) asm volatile("s_waitcnt vmcnt(" #n ")" ::: "memory")
#define PG8_WAIT_L(n) asm volatile("s_waitcnt lgkmcnt(" #n ")" ::: "memory")
#define PG8_BAR __builtin_amdgcn_s_barrier()
#define PG8_SCHED __builtin_amdgcn_sched_barrier(0)
    Unit cur, nxt; int ui = 0;
    if (!S.next(0, cur)) return;
    f32x4 acc[2][2][4][2];
#pragma unroll
    for (int a = 0; a < 2; ++a)
#pragma unroll
        for (int b = 0; b < 2; ++b)
#pragma unroll
            for (int m = 0; m < 4; ++m)
#pragma unroll
                for (int n = 0; n < 2; ++n) acc[a][b][m][n] = (f32x4){0.f, 0.f, 0.f, 0.f};
    bf16x8 At[4][2], B0[2][2], B1[2][2];
    const char* cA = (const char*)g.A + (size_t)cur.pm * tstepA; const char* cB = (const char*)g.Bt + (size_t)cur.pn * tstepB;
    S.a_ready(cur);
    if constexpr (SP2) {
        PG8_STAGE(PG8_SB(0, 0), cB, voffB); PG8_STAGE(PG8_SB(0, 1), cB + hstepB, voffB); PG8_STAGE(PG8_SA(0, 0), cA, voffA); PG8_STAGE(PG8_SA(0, 1), cA + hstepA, voffA);
        if (wr == 1) PG8_BAR;
        PG8_WAIT_V(2); PG8_BAR;
        PG8_STAGE(PG8_SB(1, 0), cB + kstepB, voffB); PG8_STAGE(PG8_SA(1, 0), cA + kstepA, voffA); PG8_STAGE(PG8_SB(1, 1), cB + hstepB + kstepB, voffB);
        PG8_WAIT_V(6); PG8_BAR;
    } else {
        PG8_STAGE(PG8_SB(0, 0), cB, voffB); PG8_STAGE(PG8_SA(0, 0), cA, voffA); PG8_STAGE(PG8_SB(0, 1), cB + hstepB, voffB); PG8_STAGE(PG8_SA(0, 1), cA + hstepA, voffA);
        if (wr == 1) PG8_BAR;
        PG8_WAIT_V(4); PG8_BAR;
        PG8_STAGE(PG8_SB(1, 0), cB + kstepB, voffB); PG8_STAGE(PG8_SA(1, 0), cA + kstepA, voffA); PG8_STAGE(PG8_SB(1, 1), cB + hstepB + kstepB, voffB);
        PG8_WAIT_V(6); PG8_BAR;
    }
    for (;;) {
        const bool has_next = S.next(ui + 1, nxt);
        const char* nA = has_next ? (const char*)g.A + (size_t)nxt.pm * tstepA : cA; const char* nB = has_next ? (const char*)g.Bt + (size_t)nxt.pn * tstepB : cB;
        for (int t = 0; t < nt; t += 2) {
            const bool last = (t == nt - 2);
            const char* a1 = cA + (size_t)(t + 1) * kstepA;
            const char* a2 = last ? nA : cA + (size_t)(t + 2) * kstepA; const char* b2 = last ? nB : cB + (size_t)(t + 2) * kstepB;
            const char* a3 = a2 + kstepA; const char* b3 = b2 + kstepB;
            if (last && has_next) S.a_ready(nxt);
            if constexpr (SP2) {
            PG8_LDB(B0, 0, 0); PG8_LDB(B1, 0, 1); PG8_SCHED; PG8_LDA(At, 0, 0); PG8_STAGE(PG8_SA(1, 1), a1 + hstepA, voffA);
            PG8_WAIT_V(8); PG8_WAIT_L(0); PG8_BAR; PG8_MMA(0, 0, At, B0); PG8_MMA(0, 1, At, B1); PG8_BAR; PG8_SCHED;
            PG8_LDA(At, 0, 1); PG8_STAGE(PG8_SB(0, 0), b2, voffB); PG8_STAGE(PG8_SB(0, 1), b2 + hstepB, voffB); PG8_STAGE(PG8_SA(0, 0), a2, voffA);
            PG8_WAIT_V(8); PG8_WAIT_L(0); PG8_BAR; PG8_MMA(1, 0, At, B0); PG8_MMA(1, 1, At, B1); PG8_BAR; PG8_SCHED;
            PG8_LDB(B0, 1, 0); PG8_LDB(B1, 1, 1); PG8_SCHED; PG8_LDA(At, 1, 0); PG8_STAGE(PG8_SA(0, 1), a2 + hstepA, voffA);
            PG8_WAIT_V(8); PG8_WAIT_L(0); PG8_BAR; PG8_MMA(0, 0, At, B0); PG8_MMA(0, 1, At, B1); PG8_BAR; PG8_SCHED;
            PG8_LDA(At, 1, 1); PG8_STAGE(PG8_SB(1, 0), b3, voffB); PG8_STAGE(PG8_SB(1, 1), b3 + hstepB, voffB); PG8_STAGE(PG8_SA(1, 0), a3, voffA);
            PG8_WAIT_V(8); PG8_WAIT_L(0); PG8_BAR; PG8_MMA(1, 0, At, B0); PG8_MMA(1, 1, At, B1); PG8_BAR; PG8_SCHED;
            } else {
            PG8_LDB(B0, 0, 0); PG8_SCHED; PG8_LDA(At, 0, 0); PG8_STAGE(PG8_SA(1, 1), a1 + hstepA, voffA);
            PG8_WAIT_L(8); PG8_BAR; PG8_WAIT_L(0); PG8_MMA(0, 0, At, B0); PG8_BAR; PG8_SCHED;
            PG8_LDB(B1, 0, 1); PG8_STAGE(PG8_SB(0, 0), b2, voffB);
            PG8_BAR; PG8_WAIT_L(0); PG8_MMA(0, 1, At, B1); PG8_BAR;
            PG8_LDA(At, 0, 1); PG8_STAGE(PG8_SA(0, 0), a2, voffA);
            PG8_BAR; PG8_WAIT_L(0); PG8_MMA(1, 0, At, B0); PG8_BAR; PG8_SCHED;
            PG8_STAGE(PG8_SB(0, 1), b2 + hstepB, voffB);
            PG8_WAIT_V(6); PG8_BAR; PG8_MMA(1, 1, At, B1); PG8_BAR;
            PG8_LDB(B0, 1, 0); PG8_SCHED; PG8_LDA(At, 1, 0); PG8_STAGE(PG8_SA(0, 1), a2 + hstepA, voffA);
            PG8_WAIT_L(8); PG8_BAR; PG8_WAIT_L(0); PG8_MMA(0, 0, At, B0); PG8_BAR; PG8_SCHED;
            PG8_LDB(B1, 1, 1); PG8_STAGE(PG8_SB(1, 0), b3, voffB);
            PG8_BAR; PG8_WAIT_L(0); PG8_MMA(0, 1, At, B1); PG8_BAR;
            PG8_LDA(At, 1, 1); PG8_STAGE(PG8_SA(1, 0), a3, voffA);
            PG8_BAR; PG8_WAIT_L(0); PG8_MMA(1, 0, At, B0); PG8_BAR; PG8_SCHED;
            PG8_STAGE(PG8_SB(1, 1), b3 + hstepB, voffB);
            PG8_WAIT_V(6); PG8_BAR; PG8_MMA(1, 1, At, B1); PG8_BAR;
            }
        }
        if constexpr (ALIGN_EPI) { if (wr == 0) PG8_BAR; }
        if constexpr (!Epi::AFTER_DRAIN) { E(acc, cur, wr, wc, fr, fq); S.done(cur); }
        if (!has_next) break;
#pragma unroll
        for (int a = 0; a < 2; ++a)
#pragma unroll
            for (int b = 0; b < 2; ++b)
#pragma unroll
                for (int m = 0; m < 4; ++m)
#pragma unroll
                    for (int n = 0; n < 2; ++n) acc[a][b][m][n] = (f32x4){0.f, 0.f, 0.f, 0.f};
        cur = nxt; cA = nA; cB = nB; ++ui;
        if constexpr (ALIGN_EPI) { if (wr == 1) PG8_BAR; }
    }
    PG8_WAIT_V(0);
    if constexpr (!ALIGN_EPI) { if (wr == 0) PG8_BAR; }
    PG8_BAR;
    if constexpr (Epi::AFTER_DRAIN) { E.fused(acc, cur, wr, wc, fr, fq, lds, wid, lane); S.done(cur); }
#undef PG8_SA
#undef PG8_SB
#undef PG8_STAGE
#undef PG8_LDA
#undef PG8_LDB
#undef PG8_MMA
#undef PG8_WAIT_V
#undef PG8_WAIT_L
#undef PG8_BAR
#undef PG8_SCHED
}
}

namespace pg8 {
struct EpiSwiGLU {
    static constexpr bool PERM = true, AFTER_DRAIN = false;
    bf16_t* H; int ldc;
    __device__ __forceinline__ void operator()(const f32x4 (&acc)[2][2][4][2], const Unit& u, int wr, int wc, int fr, int fq) const {
        const int row0 = u.pm * BM + wr * 64 + fr, col0 = u.pn * HALF + wc * 32 + 8 * fq;
#pragma unroll
        for (int ai = 0; ai < 2; ++ai)
#pragma unroll
            for (int m = 0; m < 4; ++m) {
                bf16_t* rowp = H + ((size_t)(col0 >> 6) * ldc   + (row0 + ai * HALF + m * 16)) * 64 + (col0 & 63);
                float h[8];
#pragma unroll
                for (int n = 0; n < 2; ++n)
#pragma unroll
                    for (int i = 0; i < 4; ++i) { const float g = acc[ai][0][m][n][i], uu = acc[ai][1][m][n][i];
                        const float e = __builtin_amdgcn_exp2f(g * -1.4426950408889634f);
                        h[n * 4 + i] = g * uu * __builtin_amdgcn_rcpf(1.0f + e); }
                u32x4 w; w.x = cvt_pk_bf16(h[0], h[1]); w.y = cvt_pk_bf16(h[2], h[3]); w.z = cvt_pk_bf16(h[4], h[5]); w.w = cvt_pk_bf16(h[6], h[7]);
                *(u32x4*)rowp = w;
            }
    }
};
struct EpiResGate {
    static constexpr bool PERM = false, AFTER_DRAIN = false;
    const float* base_lat; const float* base_ctx; float* out_lat; float* out_ctx; const float* gate; float f;
    __device__ __forceinline__ void operator()(const f32x4 (&acc)[2][2][4][2], const Unit& u, int wr, int wc, int fr, int fq) const {
        const bool lat = u.pm < 256; const int mb = lat ? (u.pm >> 5) : 8; const int prow = lat ? u.pm : (u.pm - 256);
        const float* base = (lat ? base_lat : base_ctx) + (size_t)prow * BM * 1024; float* out = (lat ? out_lat : out_ctx) + (size_t)prow * BM * 1024;
        const int col0 = u.pn * BM + wc * 32 + 4 * fq;
        f32x4 gv[2][2];
#pragma unroll
        for (int bj = 0; bj < 2; ++bj)
#pragma unroll
            for (int n = 0; n < 2; ++n) gv[bj][n] = *(const f32x4*)(gate + (size_t)mb * 9216 + col0 + bj * HALF + n * 16) * f;
#pragma unroll
        for (int ai = 0; ai < 2; ++ai)
#pragma unroll
            for (int m = 0; m < 4; ++m) { const size_t off = (size_t)(wr * 64 + fr + ai * HALF + m * 16) * 1024 + col0;
#pragma unroll
                for (int bj = 0; bj < 2; ++bj)
#pragma unroll
                    for (int n = 0; n < 2; ++n) { const f32x4 b = *(const f32x4*)(base + off + bj * HALF + n * 16);
                        *(f32x4*)(out + off + bj * HALF + n * 16) = b + gv[bj][n] * acc[ai][bj][m][n]; } }
    }
};
struct EpiStoreBf16 {
    static constexpr bool PERM = true, AFTER_DRAIN = false;
    bf16_t* O; int ldc;
    __device__ __forceinline__ void operator()(const f32x4 (&acc)[2][2][4][2], const Unit& u, int wr, int wc, int fr, int fq) const {
        const int row0 = u.pm * BM + wr * 64 + fr, col0 = u.pn * BM + wc * 32 + 8 * fq;
#pragma unroll
        for (int ai = 0; ai < 2; ++ai)
#pragma unroll
            for (int m = 0; m < 4; ++m) { bf16_t* rowp = O + (size_t)(row0 + ai * HALF + m * 16) * ldc + col0;
#pragma unroll
                for (int bj = 0; bj < 2; ++bj) { const f32x4 v0 = acc[ai][bj][m][0], v1 = acc[ai][bj][m][1];
                    u32x4 w; w.x = cvt_pk_bf16(v0[0], v0[1]); w.y = cvt_pk_bf16(v0[2], v0[3]); w.z = cvt_pk_bf16(v1[0], v1[1]); w.w = cvt_pk_bf16(v1[2], v1[3]);
                    *(u32x4*)(rowp + bj * HALF) = w; } }
    }
};
}

constexpr int NB = 8, SEQ = 8192, DM = 1024, CTXL = 256, DEPTH = 2, DFF = 2816, NMOD = 9, INC = 3584;
constexpr int TL = NB * SEQ, TC = NB * CTXL, TT = TL + TC;
constexpr int C_NAQ = 0, C_NAK = 384, C_NAV = 768, C_SGU = 1152, C_SGV = 1408, C_RQ = 1664, C_RK = 2048, C_RV = 2432, C_GF = 2816, C_GB = 3200;
constexpr int M_NA = 0, M_SG = 384, M_RET = 640;
constexpr int NCH = TT / 128, NCHL = TL / 128;
constexpr int NWAVES = 8;
#ifndef MK_ONE_LAUNCH
#define MK_ONE_LAUNCH 1
#endif
constexpr int NPH = 1 + DEPTH * 20;

constexpr size_t MiB = 1u << 20;
constexpr size_t WS_CTL = 0, CTL_ZERO_BYTES = 1 * MiB;
constexpr size_t WS_MOD = 1 * MiB;
constexpr size_t WS_ROPE = 2 * MiB;
constexpr size_t WS_WSG = 3 * MiB;
constexpr size_t WS_W1T = 4 * MiB, WS_W2T = 48 * MiB, WS_WINT = 70 * MiB, WS_WOUTT = 84 * MiB;
constexpr size_t WS_CTXBUF = 88 * MiB;
constexpr size_t WS_XN = 96 * MiB;
constexpr size_t WS_P = 228 * MiB;
constexpr size_t WS_KV = 690 * MiB;
constexpr size_t WS_PREV = 789 * MiB;
constexpr size_t WS_END = 888 * MiB;
constexpr int CW_BAR = 4096;

constexpr int RING_BYTES = 131072, LDSCTL_OFF = 163840 - 512, MISC_OFF = LDSCTL_OFF + 320, LDS_BYTES = 163840;
#define GAS __attribute__((address_space(1)))
#define LAS __attribute__((address_space(3)))
typedef unsigned short bf16;
typedef unsigned v4u __attribute__((ext_vector_type(4)));
typedef float f32x4 __attribute__((ext_vector_type(4)));
typedef short bf16x8 __attribute__((ext_vector_type(8)));
typedef GAS unsigned gu32;
typedef GAS unsigned long long gu64;
#define RLX_AGENT __ATOMIC_RELAXED, __HIP_MEMORY_SCOPE_AGENT
#define LDS_WAIT() asm volatile("s_waitcnt lgkmcnt(0)" ::: "memory")
#define VM_WAIT() asm volatile("s_waitcnt vmcnt(0)" ::: "memory")
__device__ __forceinline__ unsigned long long rt() { return __builtin_amdgcn_s_memrealtime(); }
__device__ __forceinline__ unsigned f2bf(float f) { unsigned u = __builtin_bit_cast(unsigned, f); return (u + 0x7fffu + ((u >> 16) & 1u)) >> 16; }
__device__ __forceinline__ unsigned pk2(float lo, float hi) { return f2bf(lo) | (f2bf(hi) << 16); }
#define XB_TMO      128
#define XB_XCNT(j)  (256  + 64 * (j))
#define XB_XSUB(j)  (1280 + 64 * (j))
#define XB_XGEN(j)  (2304 + 64 * (j))
#define XB_TOP      3328
#define XB_TOPGEN   3392
#define XCD_BAR_WORDS 3456
#define XB_SPIN_CAP (1u << 18)

__device__ __forceinline__ unsigned xb_ld(unsigned* p)              { return __hip_atomic_load(p, __ATOMIC_RELAXED, __HIP_MEMORY_SCOPE_AGENT); }
__device__ __forceinline__ unsigned xb_add(unsigned* p, unsigned v) { return __hip_atomic_fetch_add(p, v, __ATOMIC_RELAXED, __HIP_MEMORY_SCOPE_AGENT); }
__device__ __forceinline__ unsigned xb_xcc_id() { return (unsigned)__builtin_amdgcn_s_getreg((3 << 11) | 20) & 0xFu; }
#define XB_SPIN(cond, bar) do { unsigned _sp = 0; while (cond) { __builtin_amdgcn_s_sleep(1); \
    if ((++_sp & 255u) == 0u) { if (xb_ld(&(bar)[XB_TMO])) break; if (_sp > XB_SPIN_CAP) { atomicAdd(&(bar)[XB_TMO], 1u); break; } } } } while (0)

struct XcdBarrier {
    unsigned* bar; unsigned x;
    volatile LAS unsigned* st;
};

__device__ __forceinline__ XcdBarrier xcd_barrier_post(unsigned* bar, volatile LAS unsigned* st) {
    XcdBarrier b; b.bar = bar; b.x = xb_xcc_id(); b.st = st;
    if (threadIdx.x == 0) (void)xb_add(&bar[XB_XCNT(b.x)], 1u);
    return b;
}
__device__ __forceinline__ void xcd_barrier_complete(unsigned* bar, unsigned x, unsigned& nloc, unsigned& nx) {
    const unsigned G = gridDim.x * gridDim.y * gridDim.z;
    unsigned sum, cnt, mine, sp = 0u;
    for (;;) {
        sum = 0u; cnt = 0u; mine = 0u;
#pragma unroll
        for (unsigned j = 0; j < 16; ++j) { const unsigned c = xb_ld(&bar[XB_XCNT(j)]); sum += c; cnt += (c > 0u) ? 1u : 0u; mine = (j == x) ? c : mine; }
        if (sum == G) break;
        __builtin_amdgcn_s_sleep(1);
        if ((++sp & 255u) == 0u) { if (xb_ld(&bar[XB_TMO])) break; if (sp > XB_SPIN_CAP) { atomicAdd(&bar[XB_TMO], 1u); break; } }
    }
    nloc = mine > 0u ? mine : 1u; nx = cnt > 0u ? cnt : 1u;
}

__device__ __forceinline__ void xcd_barrier(const XcdBarrier& b) {
    asm volatile("s_waitcnt vmcnt(0)" ::: "memory");
    __syncthreads();
    if (threadIdx.x == 0) {
        unsigned* bar = b.bar;
        __builtin_amdgcn_s_waitcnt(0);
        unsigned nloc = b.st[0], nx = b.st[1];
        if (nloc == 0u) { xcd_barrier_complete(bar, b.x, nloc, nx); b.st[0] = nloc; b.st[1] = nx; }
        const unsigned old = xb_add(&bar[XB_XSUB(b.x)], 1u);
        const unsigned gen = old / nloc;
        if (old + 1u == (gen + 1u) * nloc) {
            __builtin_amdgcn_fence(__ATOMIC_RELEASE, "agent");
            asm volatile("s_waitcnt vmcnt(0)" ::: "memory");
            const unsigned og = xb_add(&bar[XB_TOP], 1u);
            const unsigned tg = og / nx;
            if (og + 1u == (tg + 1u) * nx) xb_add(&bar[XB_TOPGEN], 1u);
            else XB_SPIN(xb_ld(&bar[XB_TOPGEN]) == tg, bar);
            __builtin_amdgcn_fence(__ATOMIC_ACQUIRE, "agent");
            xb_add(&bar[XB_XGEN(b.x)], 1u);
            asm volatile("s_waitcnt vmcnt(0)" ::: "memory");
        } else {
            XB_SPIN(xb_ld(&bar[XB_XGEN(b.x)]) == gen, bar);
            __builtin_amdgcn_fence(__ATOMIC_ACQUIRE, "agent");
            asm volatile("s_waitcnt vmcnt(0)" ::: "memory");
        }
    }
    __syncthreads();
}
#ifndef REP_NORM
#define REP_NORM 1
#endif

typedef unsigned u32x2 __attribute__((ext_vector_type(2)));

#define SHX(v, o) __builtin_bit_cast(float, __builtin_amdgcn_ds_swizzle(__builtin_bit_cast(int, (float)(v)), ((o) << 10) | 0x1f))
__device__ __forceinline__ float xhalf_sum(float v) { auto rr = __builtin_amdgcn_permlane32_swap(__float_as_uint(v), __float_as_uint(v), false, false); return __uint_as_float(rr[0]) + __uint_as_float(rr[1]); }
__device__ __forceinline__ float xhalf_max(float v) { auto rr = __builtin_amdgcn_permlane32_swap(__float_as_uint(v), __float_as_uint(v), false, false); return fmaxf(__uint_as_float(rr[0]), __uint_as_float(rr[1])); }
__device__ __forceinline__ float wave_sum(float v) { v += SHX(v, 1); v += SHX(v, 2); v += SHX(v, 4); v += SHX(v, 8); v += SHX(v, 16); return xhalf_sum(v); }
__device__ __forceinline__ float bflo(unsigned w) { return __uint_as_float(w << 16); }
__device__ __forceinline__ float bfhi(unsigned w) { return __uint_as_float(w & 0xffff0000u); }
__device__ __forceinline__ void load8(const bf16* p, float* o) {
    const v4u w = *(const v4u*)p;
    o[0] = bflo(w.x); o[1] = bfhi(w.x); o[2] = bflo(w.y); o[3] = bfhi(w.y); o[4] = bflo(w.z); o[5] = bfhi(w.z); o[6] = bflo(w.w); o[7] = bfhi(w.w);
}
__device__ __forceinline__ void store8(bf16* p, const float* o) {
    v4u w; w.x = pk2(o[0], o[1]); w.y = pk2(o[2], o[3]); w.z = pk2(o[4], o[5]); w.w = pk2(o[6], o[7]); *(v4u*)p = w;
}
__device__ __forceinline__ float sigmoidf_(float x) { return __builtin_amdgcn_rcpf(1.0f + __builtin_amdgcn_exp2f(-1.4426950408889634f * x)); }
__device__ __forceinline__ float gelu_tanh(float x) { const float y = 0.7978845608028654f * (x + 0.044715f * x * x * x); return x * sigmoidf_(2.0f * y); }
__device__ __forceinline__ float log_sigmoid(float x) { return fminf(x, 0.0f) - log1pf(expf(-fabsf(x))); }

__device__ __forceinline__ void p0_transpose_item(const float* W, int K, int N, bf16* WT, bool swiglu, LAS float* scr, int item, int lane, bool kblocked = false) {
    const int nblk = N / 32, kb = item / nblk, nb = item % nblk, k0 = 64 * kb, n0 = 32 * nb;
    int d0 = n0;
    if (swiglu) { const int hid = n0 < DFF ? n0 : n0 - DFF; d0 = (hid >> 7) * 256 + (n0 < DFF ? 0 : 128) + (hid & 127); }
#pragma unroll 8
    for (int i = 0; i < 32; ++i) { const int kk = 2 * i + (lane >> 5); scr[kk * 33 + (lane & 31)] = W[(size_t)(k0 + kk) * N + n0 + (lane & 31)]; }
    LDS_WAIT(); asm volatile("" ::: "memory");
    const int c = lane & 7;
#pragma unroll
    for (int j = 0; j < 4; ++j) { const int n = (lane >> 3) + 8 * j; const LAS float* s = scr + (8 * c) * 33 + n;
        v4u o; o.x = pk2(s[0 * 33], s[1 * 33]); o.y = pk2(s[2 * 33], s[3 * 33]); o.z = pk2(s[4 * 33], s[5 * 33]); o.w = pk2(s[6 * 33], s[7 * 33]);
        *(GAS v4u*)(WT + (kblocked ? ((size_t)kb * N + d0 + n) * 64 + 8 * c : (size_t)(d0 + n) * K + k0 + 8 * c)) = o; }
    LDS_WAIT(); asm volatile("" ::: "memory");
}
struct In { const float *x, *c, *ctx, *c_ctx, *ada_w, *ada_b, *norm_w, *ffn_w1, *ffn_w2, *w_in, *w_out, *na_qn, *na_kn, *na_rpb, *sg_w, *sg_b, *sg_ln_w, *sg_ln_b, *ret_logit, *ret_gn_w; };

__device__ __forceinline__ void p0_prologue(const In& I, unsigned char* ws, LAS unsigned char* lds, int tid, int lane, int wave, int vcu, int G) {
    LAS float* scr = (LAS float*)(lds + wave * 16384);
    const int gw = vcu * NWAVES + wave, NGW = G * NWAVES;
    constexpr int I_W1 = (DM / 64) * (2 * DFF / 32), I_W2 = (DFF / 64) * (DM / 32), I_WIN = (DM / 64) * (INC / 32), I_WOUT = (DM / 64) * (DM / 32);
    constexpr int PER_L = 2 * I_W1 + 2 * I_W2 + I_WIN + I_WOUT;
    bf16* W1T = (bf16*)(ws + WS_W1T); bf16* W2T = (bf16*)(ws + WS_W2T); bf16* WINT = (bf16*)(ws + WS_WINT); bf16* WOUTT = (bf16*)(ws + WS_WOUTT);
    for (int it = gw; it < DEPTH * PER_L; it += NGW) {
        const int L = it / PER_L; int r = it % PER_L;
        if (r < 2 * I_W1) { const int i = r / I_W1; r %= I_W1; const size_t o = (size_t)(L * 2 + i) * DM * 2 * DFF; p0_transpose_item(I.ffn_w1 + o, DM, 2 * DFF, W1T + o, true, scr, r, lane); continue; } r -= 2 * I_W1;
        if (r < 2 * I_W2) { const int i = r / I_W2; r %= I_W2; const size_t o = (size_t)(L * 2 + i) * DFF * DM; p0_transpose_item(I.ffn_w2 + o, DFF, DM, W2T + o, false, scr, r, lane, true); continue; } r -= 2 * I_W2;
        if (r < I_WIN) { const size_t o = (size_t)L * DM * INC; p0_transpose_item(I.w_in + o, DM, INC, WINT + o, false, scr, r, lane); continue; } r -= I_WIN;
        { const size_t o = (size_t)L * DM * DM; p0_transpose_item(I.w_out + o, DM, DM, WOUTT + o, false, scr, r, lane); }
    }
    __syncthreads();
    LAS float* sc = (LAS float*)lds;
    LAS float* part = (LAS float*)(lds + 36864);
    float* mod = (float*)(ws + WS_MOD);
    for (int cb = blockIdx.x; cb < 256; cb += G) {
        for (int i = tid; i < 9 * 1024; i += 512) { const int mb = i >> 10, k = i & 1023; const float v = mb < 8 ? I.c[mb * 1024 + k] : I.c_ctx[k]; sc[i] = v * sigmoidf_(v); }
        __syncthreads();
        const int cc = tid % 72, kp = tid / 72, colg = cb * 72 + cc, L = colg / 9216, j = colg % 9216;
        if (kp < 7) {
            float acc[9];
#pragma unroll
            for (int mb = 0; mb < 9; ++mb) acc[mb] = 0.f;
            for (int k = kp; k < 1024; k += 7) { const float w = I.ada_w[((size_t)L * 1024 + k) * 9216 + j];
#pragma unroll
                for (int mb = 0; mb < 9; ++mb) acc[mb] += sc[mb * 1024 + k] * w; }
#pragma unroll
            for (int mb = 0; mb < 9; ++mb) part[(kp * 72 + cc) * 9 + mb] = acc[mb];
        }
        __syncthreads();
        for (int o = tid; o < 72 * 9; o += 512) { const int c2 = o / 9, mb = o % 9; const int colg2 = cb * 72 + c2, L2 = colg2 / 9216, j2 = colg2 % 9216;
            float s = I.ada_b[L2 * 9216 + j2];
#pragma unroll
            for (int p = 0; p < 7; ++p) s += part[(p * 72 + c2) * 9 + mb];
            mod[((size_t)L2 * 9 + mb) * 9216 + j2] = s; }
        __syncthreads();
    }
    { bf16* wsg = (bf16*)(ws + WS_WSG); for (int i = blockIdx.x * 512 + tid; i < DEPTH * 4 * 128 * 128 / 8; i += G * 512) { const f32x4 a = ((const f32x4*)I.sg_w)[2 * i], b = ((const f32x4*)I.sg_w)[2 * i + 1];
        v4u o; o.x = pk2(a.x, a.y); o.y = pk2(a.z, a.w); o.z = pk2(b.x, b.y); o.w = pk2(b.z, b.w); ((v4u*)wsg)[i] = o; } }
    if (blockIdx.x == (unsigned)(G - 1)) {
        float* tab = (float*)(ws + WS_ROPE);
        for (int i = tid; i < 128 * 16; i += 512) { const int n = i >> 4, f = i & 15; const float inv = exp2f(-(float)f * (13.287712379549449f / 16.0f)); const float ang = (float)n * inv;
            tab[2 * i] = cosf(ang); tab[2 * i + 1] = sinf(ang); }
    }
}

__device__ __forceinline__ void norm_phase(const float* xl, const float* xc, int nrows, const float* nw, const float* modL, int sidx, bf16* XN, int gw, int NGW, int lane) {
    const int rpw = (nrows + NGW - 1) / NGW; const int r0 = gw * rpw; int r1 = r0 + rpw; if (r1 > nrows) r1 = nrows;
    int cur = -1; f32x4 g[4], sh[4];
#pragma unroll
    for (int j = 0; j < 4; ++j) { g[j] = (f32x4){0.f, 0.f, 0.f, 0.f}; sh[j] = g[j]; }
#define NP_SRC(r) ((r) < TL ? xl + (size_t)(r) * DM : xc + (size_t)((r) - TL) * DM)
    f32x4 va[4], vb[4], vc[4];
    const int nr = (r1 - r0) * REP_NORM;
    if (nr > 0) { const float* s0 = NP_SRC(r0);
#pragma unroll
        for (int j = 0; j < 4; ++j) va[j] = ((const f32x4*)s0)[lane + 64 * j]; }
    if (nr > 1) { const float* s1 = NP_SRC(r0 + 1 % (r1 - r0));
#pragma unroll
        for (int j = 0; j < 4; ++j) vb[j] = ((const f32x4*)s1)[lane + 64 * j]; }
    for (int rr_ = 0; rr_ < nr; ++rr_) { const int r = r0 + rr_ % (r1 - r0);
        if (rr_ + 2 < nr) { const float* s2 = NP_SRC(r0 + (rr_ + 2) % (r1 - r0));
#pragma unroll
            for (int j = 0; j < 4; ++j) vc[j] = ((const f32x4*)s2)[lane + 64 * j]; }
        const int mb = r < TL ? (r >> 13) : 8;
        if (mb != cur) { cur = mb; const float* sf = modL + (size_t)mb * 9216 + sidx * 1024; const float* sl = sf + 1024;
#pragma unroll
            for (int j = 0; j < 4; ++j) { const f32x4 w = ((const f32x4*)nw)[lane + 64 * j], s1 = ((const f32x4*)sl)[lane + 64 * j]; g[j] = w * (s1 + 1.0f); sh[j] = ((const f32x4*)sf)[lane + 64 * j]; } }
        float s = 0.f;
#pragma unroll
        for (int j = 0; j < 4; ++j) s += (va[j].x * va[j].x + va[j].y * va[j].y) + (va[j].z * va[j].z + va[j].w * va[j].w);
        const float rstd = 1.0f / sqrtf(wave_sum(s) * (1.0f / DM) + 1e-6f);
        unsigned long long* o8 = (unsigned long long*)(XN + (size_t)r * DM) + lane;
#pragma unroll
        for (int j = 0; j < 4; ++j) { const f32x4 y = va[j] * rstd * g[j] + sh[j]; o8[64 * j] = (unsigned long long)pk2(y.x, y.y) | ((unsigned long long)pk2(y.z, y.w) << 32); }
#pragma unroll
        for (int j = 0; j < 4; ++j) { va[j] = vb[j]; vb[j] = vc[j]; }
    }
#undef NP_SRC
}

__device__ __forceinline__ void na_naive(const bf16* P, bf16* MIX, const float* wq, const float* wk, const float* rpb, bool with_ctx, int gtid, int nthreads) {
    float mq = 0.f, mk = 0.f, mr = 0.f;
    for (int d = 0; d < 64; ++d) { mq = fmaxf(mq, fabsf(wq[d])); mk = fmaxf(mk, fabsf(wk[d])); }
    for (int i = 0; i < 6 * 15 * 31; ++i) mr = fmaxf(mr, fabsf(rpb[i]));
    const float mbound = 8.0f * mq * mk + mr;
    const int nitems = (TL + (with_ctx ? TC : 0)) * 6;
    for (int item = gtid; item < nitems; item += nthreads) {
        int h, t; bool isctx;
        if (item < TL * 6) { h = item / TL; t = item % TL; isctx = false; } else { const int r = item - TL * 6; h = r / TC; t = TL + r % TC; isctx = true; }
        float q[64], o[64];
        { const bf16* qp = P + (size_t)t * INC + C_NAQ + h * 64; float ss = 0.f;
#pragma unroll
          for (int d8 = 0; d8 < 8; ++d8) { load8(qp + d8 * 8, q + d8 * 8); }
#pragma unroll
          for (int d = 0; d < 64; ++d) ss += q[d] * q[d];
          const float rstd = 1.0f / sqrtf(ss * (1.0f / 64.0f) + 1e-6f);
#pragma unroll
          for (int d = 0; d < 64; ++d) { q[d] = q[d] * rstd * wq[d] * wk[d] * 0.125f; o[d] = 0.f; } }
        float l = 0.f;
        int b, nloc, r = 0, c = 0, rs = 0, cs = 0;
        if (!isctx) { b = t >> 13; const int pos = t & 8191; r = pos >> 6; c = pos & 63; rs = min(max(r - 4, 0), 120); cs = min(max(c - 8, 0), 48); nloc = 128; }
        else { b = (t - TL) >> 8; nloc = 0; }
        for (int kk = 0; kk < nloc + 256; ++kk) {
            int tk; float bias = 0.f;
            if (kk < nloc) { const int i = kk >> 4, j = kk & 15; tk = b * SEQ + (rs + i) * 64 + cs + j; bias = rpb[(h * 15 + (rs + i - r + 7)) * 31 + (cs + j - c + 15)]; }
            else tk = TL + b * CTXL + (kk - nloc);
            const bf16* kp = P + (size_t)tk * INC + C_NAK + h * 64; const bf16* vp = P + (size_t)tk * INC + C_NAV + h * 64;
            float dot = 0.f, ss = 0.f;
#pragma unroll
            for (int d8 = 0; d8 < 8; ++d8) { float k8[8]; load8(kp + d8 * 8, k8);
#pragma unroll
                for (int e = 0; e < 8; ++e) { dot += q[d8 * 8 + e] * k8[e]; ss += k8[e] * k8[e]; } }
            const float s = dot / sqrtf(ss * (1.0f / 64.0f) + 1e-6f) + bias;
            const float p = __expf(s - mbound); l += p;
#pragma unroll
            for (int d8 = 0; d8 < 8; ++d8) { float v8[8]; load8(vp + d8 * 8, v8);
#pragma unroll
                for (int e = 0; e < 8; ++e) o[d8 * 8 + e] += p * v8[e]; }
        }
        const float il = 1.0f / l; bf16* op = MIX + (size_t)t * DM + M_NA + h * 64;
#pragma unroll
        for (int d8 = 0; d8 < 8; ++d8) { float t8[8];
#pragma unroll
            for (int e = 0; e < 8; ++e) t8[e] = o[d8 * 8 + e] * il;
            store8(op + d8 * 8, t8); }
    }
}

__device__ __forceinline__ void sg_naive(const bf16* P, bf16* MIX, const float* sgw, const float* sgb, const float* lnw, const float* lnb, LAS unsigned char* lds, int tid, int G) {
    LAS float* vn = (LAS float*)lds;
    const int tok = tid >> 2, part = tid & 3;
    for (int it = blockIdx.x; it < NCH * 4; it += G) {
        const int ch = it >> 2, g = it & 3, row0 = ch * 128;
        { const bf16* src = P + (size_t)(row0 + tok) * INC + C_SGV + g * 64 + part * 16; float v[16]; load8(src, v); load8(src + 8, v + 8);
          float s = 0.f;
#pragma unroll
          for (int k = 0; k < 16; ++k) { v[k] = gelu_tanh(v[k]); s += v[k]; }
          s += SHX(s, 1); s += SHX(s, 2); const float mu = s * (1.0f / 64.0f); float q = 0.f;
#pragma unroll
          for (int k = 0; k < 16; ++k) { v[k] -= mu; q += v[k] * v[k]; }
          q += SHX(q, 1); q += SHX(q, 2); const float rstd = 1.0f / sqrtf(q * (1.0f / 64.0f) + 1e-5f);
#pragma unroll
          for (int k = 0; k < 16; ++k) { const int cch = g * 64 + part * 16 + k; vn[tok * 64 + part * 16 + k] = v[k] * rstd * lnw[cch] + lnb[cch]; } }
        __syncthreads();
        { float acc[16];
#pragma unroll
          for (int k = 0; k < 16; ++k) acc[k] = 0.f;
          const float* wrow = sgw + ((size_t)g * 128 + tok) * 128;
          for (int q = 0; q < 128; ++q) { const float w = wrow[q];
#pragma unroll
              for (int k = 0; k < 16; ++k) acc[k] += w * vn[q * 64 + part * 16 + k]; }
          const float bias = sgb[g * 128 + tok];
          const bf16* up = P + (size_t)(row0 + tok) * INC + C_SGU + g * 64 + part * 16; float u[16]; load8(up, u); load8(up + 8, u + 8);
#pragma unroll
          for (int k = 0; k < 16; ++k) u[k] = gelu_tanh(u[k]) * (acc[k] + bias);
          bf16* op = MIX + (size_t)(row0 + tok) * DM + M_SG + g * 64 + part * 16; store8(op, u); store8(op + 8, u + 8); }
        __syncthreads();
    }
}

__device__ __forceinline__ void rope_load16(const bf16* P, int row, int colbase, int h, int part, bool latent, const float* ropetab, float* out) {
    const bf16* base = P + (size_t)row * INC + colbase + h * 64;
    float mine[16]; load8(base + part * 16, mine); load8(base + part * 16 + 8, mine + 8);
    if (!latent) {
#pragma unroll
        for (int f = 0; f < 16; ++f) out[f] = mine[f];
        return; }
    float oth[16]; load8(base + (part ^ 1) * 16, oth); load8(base + (part ^ 1) * 16 + 8, oth + 8);
    const int pos = row & (SEQ - 1); const int n = (part < 2) ? (pos >> 6) : (pos & 63);
    const float* tb = ropetab + n * 32;
#pragma unroll
    for (int f = 0; f < 16; ++f) { const float cs = tb[2 * f], sn = tb[2 * f + 1]; out[f] = (part & 1) ? (oth[f] * sn + mine[f] * cs) : (mine[f] * cs - oth[f] * sn); }
}
__device__ __forceinline__ void ret_kv_naive(const bf16* P, float* KV, const float* logit, const float* ropetab, LAS unsigned char* lds, int tid, int G) {
    LAS float* kS = (LAS float*)lds; LAS float* vS = kS + 128 * 64; LAS float* wt = vS + 128 * 64;
    const int tok = tid >> 2, part = tid & 3;
    for (int it = blockIdx.x; it < NCH * 6; it += G) {
        const int ch = it / 6, h = it % 6, row0 = ch * 128; const bool latent = ch < NCHL;
        { float k16[16]; rope_load16(P, row0 + tok, C_RK, h, part, latent, ropetab, k16);
#pragma unroll
          for (int f = 0; f < 16; ++f) kS[tok * 64 + part * 16 + f] = k16[f] * 0.125f;
          const bf16* vp = P + (size_t)(row0 + tok) * INC + C_RV + h * 64 + part * 16; float v16[16]; load8(vp, v16); load8(vp + 8, v16 + 8);
#pragma unroll
          for (int f = 0; f < 16; ++f) vS[tok * 64 + part * 16 + f] = v16[f]; }
        if (tid < 256) { const int dir = tid >> 7, j = tid & 127; const float lg = log_sigmoid(logit[dir * 6 + h]); wt[tid] = expf(lg * (float)(dir == 0 ? 127 - j : j)); }
        __syncthreads();
        { const int d = tid >> 3, e0 = (tid & 7) * 8; float af[8], ab[8];
#pragma unroll
          for (int k = 0; k < 8; ++k) { af[k] = 0.f; ab[k] = 0.f; }
          for (int j = 0; j < 128; ++j) { const float kd = kS[j * 64 + d]; const float a = kd * wt[j], b = kd * wt[128 + j];
#pragma unroll
              for (int k = 0; k < 8; ++k) { const float v = vS[j * 64 + e0 + k]; af[k] += a * v; ab[k] += b * v; } }
          float* of = KV + ((size_t)(ch * 6 + h) * 2 + 0) * 4096 + d * 64 + e0; float* ob = of + 4096;
#pragma unroll
          for (int k = 0; k < 8; ++k) { of[k] = af[k]; ob[k] = ab[k]; } }
        __syncthreads();
    }
}
__device__ __forceinline__ void ret_scan(const float* KV, float* PREV, const float* logit, int gtid, int nthreads) {
    for (int it = gtid; it < NB * 6 * 2 * 4096; it += nthreads) {
        const int idx = it & 4095, dir = (it >> 12) & 1, bh = it >> 13, h = bh % 6, b = bh / 6;
        const float cd = expf(128.0f * log_sigmoid(logit[dir * 6 + h]));
#define KVI(ch) (((size_t)((ch) * 6 + h) * 2 + dir) * 4096 + idx)
        const int c0 = NCHL + 2 * b, c1 = c0 + 1;
        const float k0 = KV[KVI(c0)], k1 = KV[KVI(c1)];
        if (dir == 0) { PREV[KVI(c0)] = 0.f; PREV[KVI(c1)] = k0; float s = cd * k0 + k1;
            for (int n = 0; n < 64; ++n) { const int ch = b * 64 + n; PREV[KVI(ch)] = s; s = cd * s + KV[KVI(ch)]; } }
        else { PREV[KVI(c0)] = k1; PREV[KVI(c1)] = 0.f; float s = k0 + cd * k1;
            for (int n = 63; n >= 0; --n) { const int ch = b * 64 + n; PREV[KVI(ch)] = s; s = cd * s + KV[KVI(ch)]; } }
#undef KVI
    }
}
__device__ __forceinline__ void ret_out_naive(const bf16* P, const float* PREV, bf16* MIX, const float* logit, const float* gnw, const float* ropetab, LAS unsigned char* lds, int tid, int G) {
    LAS bf16* qS = (LAS bf16*)lds; LAS bf16* kS = qS + 128 * 64; LAS bf16* vS = kS + 128 * 64;
    LAS float* S = (LAS float*)(lds + 49152);
    LAS float* dec = (LAS float*)(lds + 49152 + 65536);
    const int tok = tid >> 2, part = tid & 3;
    for (int it = blockIdx.x; it < NCH * 6; it += G) {
        const int ch = it / 6, h = it % 6, row0 = ch * 128; const bool latent = ch < NCHL;
        { float t16[16]; rope_load16(P, row0 + tok, C_RQ, h, part, latent, ropetab, t16);
#pragma unroll
          for (int f = 0; f < 16; ++f) qS[tok * 64 + part * 16 + f] = (bf16)f2bf(t16[f]);
          rope_load16(P, row0 + tok, C_RK, h, part, latent, ropetab, t16);
#pragma unroll
          for (int f = 0; f < 16; ++f) kS[tok * 64 + part * 16 + f] = (bf16)f2bf(t16[f] * 0.125f);
          const bf16* vp = P + (size_t)(row0 + tok) * INC + C_RV + h * 64 + part * 16; const v4u a = *(const v4u*)vp, b = *(const v4u*)(vp + 8);
          *(LAS v4u*)(vS + tok * 64 + part * 16) = a; *(LAS v4u*)(vS + tok * 64 + part * 16 + 8) = b; }
        if (tid < 258) { const int dir = tid / 129, k = tid % 129; dec[tid] = expf(log_sigmoid(logit[dir * 6 + h]) * (float)k); }
        __syncthreads();
        { float q[64];
#pragma unroll
          for (int d = 0; d < 64; ++d) q[d] = __uint_as_float((unsigned)qS[tok * 64 + d] << 16);
          for (int jj = 0; jj < 32; ++jj) { const int j = part + 4 * jj; float dot = 0.f;
#pragma unroll
              for (int d = 0; d < 64; ++d) dot += q[d] * __uint_as_float((unsigned)kS[j * 64 + d] << 16);
              S[tok * 128 + j] = dot; } }
        __syncthreads();
        { const int i = tok, e0 = part * 16; float of[16], ob[16], cf[16], cb[16];
#pragma unroll
          for (int k = 0; k < 16; ++k) { of[k] = 0.f; ob[k] = 0.f; cf[k] = 0.f; cb[k] = 0.f; }
          for (int j = 0; j < 128; ++j) { const float s = S[i * 128 + j]; const float wf = (j <= i) ? s * dec[i - j] : 0.f, wb = (j >= i) ? s * dec[129 + j - i] : 0.f;
#pragma unroll
              for (int k = 0; k < 16; ++k) { const float v = __uint_as_float((unsigned)vS[j * 64 + e0 + k] << 16); of[k] += wf * v; ob[k] += wb * v; } }
          const float* pf = PREV + ((size_t)(ch * 6 + h) * 2) * 4096 + e0; const float* pb = pf + 4096;
          for (int d = 0; d < 64; ++d) { const float qd = __uint_as_float((unsigned)qS[i * 64 + d] << 16);
#pragma unroll
              for (int k = 0; k < 16; ++k) { cf[k] += qd * pf[d * 64 + k]; cb[k] += qd * pb[d * 64 + k]; } }
          const float df = dec[i + 1], db = dec[129 + 128 - i];
          float sf = 0.f, sb = 0.f;
#pragma unroll
          for (int k = 0; k < 16; ++k) { of[k] += df * cf[k]; ob[k] += db * cb[k]; sf += of[k]; sb += ob[k]; }
          sf += SHX(sf, 1); sf += SHX(sf, 2); sb += SHX(sb, 1); sb += SHX(sb, 2);
          const float muf = sf * (1.0f / 64.0f), mub = sb * (1.0f / 64.0f); float qf = 0.f, qb = 0.f;
#pragma unroll
          for (int k = 0; k < 16; ++k) { of[k] -= muf; ob[k] -= mub; qf += of[k] * of[k]; qb += ob[k] * ob[k]; }
          qf += SHX(qf, 1); qf += SHX(qf, 2); qb += SHX(qb, 1); qb += SHX(qb, 2);
          const float rf = 1.0f / sqrtf(qf * (1.0f / 64.0f) + 1e-5f), rb = 1.0f / sqrtf(qb * (1.0f / 64.0f) + 1e-5f);
          const bf16* gp = P + (size_t)(row0 + i) * INC + C_GF + h * 64 + e0; float gf[16], gb[16]; load8(gp, gf); load8(gp + 8, gf + 8); load8(gp + (C_GB - C_GF), gb); load8(gp + (C_GB - C_GF) + 8, gb + 8);
          float y[16];
#pragma unroll
          for (int k = 0; k < 16; ++k) y[k] = (of[k] * rf * (gf[k] * sigmoidf_(gf[k])) + ob[k] * rb * (gb[k] * sigmoidf_(gb[k]))) * gnw[h * 64 + e0 + k];
          bf16* op = MIX + (size_t)(row0 + i) * DM + M_RET + h * 64 + e0; store8(op, y); store8(op + 8, y + 8); }
        __syncthreads();
    }
}
#ifndef REP_KV
#define REP_KV 1
#endif
#ifndef REP_RETO
#define REP_RETO 1
#endif

typedef short s16x4 __attribute__((ext_vector_type(4)));
typedef float f32x16 __attribute__((ext_vector_type(16)));
typedef float f32x2_t __attribute__((ext_vector_type(2)));
typedef __bf16 bf16x2_t __attribute__((ext_vector_type(2)));
#define MFMA32(a, b, c) __builtin_amdgcn_mfma_f32_32x32x16_bf16((a), (b), (c), 0, 0, 0)
#define LOG2E 1.4426950408889634f
#define LDS_BARRIER() do { asm volatile("s_waitcnt lgkmcnt(0)" ::: "memory"); __builtin_amdgcn_s_barrier(); asm volatile("" ::: "memory"); } while (0)
#define OPQV(x) ({ int _t = (x); asm volatile("" : "+v"(_t)); _t; })
#define FRESH_TID(w) ({ int _t; asm volatile("v_mbcnt_lo_u32_b32 %0, -1, 0\n\tv_mbcnt_hi_u32_b32 %0, -1, %0" : "=v"(_t)); _t | ((w) << 6); })
__device__ __forceinline__ unsigned cvtpk(float lo, float hi) { f32x2_t v = {lo, hi}; bf16x2_t b = __builtin_convertvector(v, bf16x2_t); return __builtin_bit_cast(unsigned, b); }
__device__ __forceinline__ int crow0(int reg) { return (reg & 3) + 8 * (reg >> 2); }
__device__ __forceinline__ int swz64(int row) { return (((row >> 1) & 1) << 2) | (((row >> 3) & 1) << 1) | ((row >> 2) & 1); }
__device__ __forceinline__ int off64(int row, int ch) { return 128 * row + 16 * (ch ^ swz64(row)); }
__device__ __forceinline__ bf16x8 rowfrag(LAS unsigned char* img, int row, int ch) { return *(const LAS bf16x8*)(img + off64(row, ch)); }
__device__ __forceinline__ s16x4 tr4(LAS unsigned char* img, int krow, int ct, int lane) {
    const int q = (lane & 15) >> 2, p = lane & 3, blk = (lane >> 4) & 1;
    return __builtin_bit_cast(s16x4, __builtin_amdgcn_ds_read_tr16_b64_v4i16((LAS s16x4*)(img + off64(krow + q, 4 * ct + 2 * blk + (p >> 1)) + 8 * (p & 1))));
}
__device__ __forceinline__ bf16x8 trfrag(LAS unsigned char* img, int krow_lo, int krow_hi, int ct, int lane) {
    const s16x4 lo = tr4(img, krow_lo, ct, lane), hi = tr4(img, krow_hi, ct, lane);
    return (bf16x8){lo[0], lo[1], lo[2], lo[3], hi[0], hi[1], hi[2], hi[3]};
}
__device__ __forceinline__ void st_chunk(LAS unsigned char* img, int row, int ch, const float* v8) {
    v4u w; w.x = cvtpk(v8[0], v8[1]); w.y = cvtpk(v8[2], v8[3]); w.z = cvtpk(v8[4], v8[5]); w.w = cvtpk(v8[6], v8[7]); *(LAS v4u*)(img + off64(row, ch)) = w;
}
#define PACK8(x, s) __builtin_bit_cast(bf16x8, (v4u){cvtpk((x)[8 * (s)], (x)[8 * (s) + 1]), cvtpk((x)[8 * (s) + 2], (x)[8 * (s) + 3]), cvtpk((x)[8 * (s) + 4], (x)[8 * (s) + 5]), cvtpk((x)[8 * (s) + 6], (x)[8 * (s) + 7])})
__device__ __forceinline__ f32x16 zero16() { f32x16 z;
#pragma unroll
    for (int i = 0; i < 16; ++i) z[i] = 0.f;
    return z; }
__device__ __forceinline__ float wave_max(float v) { v = fmaxf(v, SHX(v, 1)); v = fmaxf(v, SHX(v, 2)); v = fmaxf(v, SHX(v, 4)); v = fmaxf(v, SHX(v, 8)); v = fmaxf(v, SHX(v, 16)); return xhalf_max(v); }

__device__ __forceinline__ void na_mfma(const bf16* P, bf16* MIX, const float* wq, const float* wk, const float* rpb, bool with_ctx, LAS unsigned char* lds, int tid_in, int G) {
    const int wave = __builtin_amdgcn_readfirstlane(tid_in >> 6); int tid = tid_in, lane = tid & 63;
    LAS unsigned char* Kimg = lds; LAS unsigned char* Vimg = lds + 16384;
    LAS float* tab = (LAS float*)(lds + 32768) + 64;
    const float mq = wave_max(fabsf(wq[lane])), mk = wave_max(fabsf(wk[lane]));
    const int nunits = NB * 6 * 32 + (with_ctx ? NB * 6 : 0);
    for (int u = blockIdx.x; u < nunits; u += G) {
        tid = FRESH_TID(wave); lane = tid & 63; const int r32 = lane & 31, hh = lane >> 5;
        const int skey = tid >> 3, spart = tid & 7;
        float wk8[8];
#pragma unroll
        for (int j = 0; j < 8; ++j) wk8[j] = wk[8 * spart + j];
        const bool isctx = u >= NB * 6 * 32; int b, h, r0 = 0;
        if (!isctx) { b = u / 192; h = (u >> 5) % 6; r0 = 4 * (u & 31); } else { const int v = u - NB * 6 * 32; b = v / 6; h = v % 6; }
        float mr = 0.f;
        for (int i = lane; i < 465; i += 64) mr = fmaxf(mr, fabsf(rpb[h * 465 + i]));
        mr = wave_max(mr);
        const float mbound = 8.0f * mq * mk + mr, negmb = -mbound * LOG2E;
        if (!isctx) for (int i = tid; i < 465; i += 512) tab[i] = (rpb[h * 465 + i] - mbound) * LOG2E;
        int r = 0, c = 0, tq;
        if (!isctx) { r = r0 + (wave >> 1); c = 32 * (wave & 1) + r32; tq = b * SEQ + r * 64 + c; } else tq = TL + b * CTXL + wave * 32 + r32;
        bf16x8 qf[4];
        { float qv[32]; float ss = 0.f; const bf16* qp = P + (size_t)tq * INC + C_NAQ + h * 64 + 8 * hh;
#pragma unroll
          for (int s = 0; s < 4; ++s) load8(qp + 16 * s, qv + 8 * s);
#pragma unroll
          for (int i = 0; i < 32; ++i) ss += qv[i] * qv[i];
          ss = xhalf_sum(ss);
          const float rstd = (1.0f / sqrtf(ss * (1.0f / 64.0f) + 1e-6f)) * (0.125f * LOG2E);
#pragma unroll
          for (int s = 0; s < 4; ++s) { float t8[8];
#pragma unroll
              for (int j = 0; j < 8; ++j) { const int d = 16 * s + 8 * hh + j; t8[j] = qv[8 * s + j] * rstd * wq[d] * wk[d]; }
              qf[s] = __builtin_bit_cast(bf16x8, (v4u){cvtpk(t8[0], t8[1]), cvtpk(t8[2], t8[3]), cvtpk(t8[4], t8[5]), cvtpk(t8[6], t8[7])}); } }
        const int rs0 = min(max(r0 - 4, 0), 120);
        const int nl = isctx ? 0 : (min(max(r0 + 3 - 4, 0), 120) + 8 - rs0), nchunks = nl + 4;
        const int rs = min(max(r - 4, 0), 120);
#define NA_TOK(ci) ((ci) < nl ? b * SEQ + (rs0 + (ci)) * 64 + skey : TL + b * CTXL + ((ci) - nl) * 64 + skey)
#define NA_STAGE(buf, kw, vw) do { float k8[8]; k8[0] = bflo(kw.x); k8[1] = bfhi(kw.x); k8[2] = bflo(kw.y); k8[3] = bfhi(kw.y); k8[4] = bflo(kw.z); k8[5] = bfhi(kw.z); k8[6] = bflo(kw.w); k8[7] = bfhi(kw.w); \
            float ss_ = 0.f; _Pragma("unroll") for (int j = 0; j < 8; ++j) ss_ += k8[j] * k8[j]; \
            ss_ += SHX(ss_, 1); ss_ += SHX(ss_, 2); ss_ += SHX(ss_, 4); \
            const float rk_ = 1.0f / sqrtf(ss_ * (1.0f / 64.0f) + 1e-6f); \
            _Pragma("unroll") for (int j = 0; j < 8; ++j) k8[j] *= rk_ * wk8[j]; \
            st_chunk(Kimg + (buf) * 8192, skey, spart, k8); *(LAS v4u*)(Vimg + (buf) * 8192 + off64(skey, spart)) = vw; } while (0)
        v4u kw, vw;
        { const bf16* src = P + (size_t)NA_TOK(0) * INC + h * 64 + 8 * spart; kw = *(const v4u*)(src + C_NAK); vw = *(const v4u*)(src + C_NAV); }
        NA_STAGE(0, kw, vw);
        __syncthreads();
        f32x16 o0 = zero16(), o1 = zero16(); float lsum = 0.f;
        for (int ci = 0; ci < nchunks; ++ci) {
            const int buf = ci & 1;
            if (ci + 1 < nchunks) { const bf16* src = P + (size_t)NA_TOK(ci + 1) * INC + h * 64 + 8 * spart; kw = *(const v4u*)(src + C_NAK); vw = *(const v4u*)(src + C_NAV); }
            const bool local = ci < nl; const int kr = rs0 + ci;
            const bool active = local ? (kr >= rs && kr < rs + 8) : true;
            if (active) {
                const int c_o = OPQV(c), cs_o = min(max(c_o - 8, 0), 48);
                const int lane_c = OPQV(lane), r32c = lane_c & 31, hhc = lane_c >> 5;
                LAS unsigned char* Kb = Kimg + buf * 8192; LAS unsigned char* Vb = Vimg + buf * 8192;
#pragma unroll
                for (int kt = 0; kt < 2; ++kt) {
                    f32x16 x;
                    if (local) { const int bidx = (kr - r + 7) * 31 + 32 * kt + 4 * hhc - c_o + 15, t0 = 32 * kt + 4 * hhc - cs_o;
#pragma unroll
                        for (int i = 0; i < 16; ++i) { const float tv = tab[bidx + crow0(i)]; x[i] = ((unsigned)(t0 + crow0(i)) < 16u) ? tv : -INFINITY; } }
                    else {
#pragma unroll
                        for (int i = 0; i < 16; ++i) x[i] = negmb; }
#pragma unroll
                    for (int s = 0; s < 4; ++s) x = MFMA32(rowfrag(Kb, 32 * kt + r32c, 2 * s + hhc), qf[s], x);
#pragma unroll
                    for (int i = 0; i < 16; ++i) { x[i] = __builtin_amdgcn_exp2f(x[i]); lsum += x[i]; }
                    const bf16x8 pa0 = PACK8(x, 0), pa1 = PACK8(x, 1);
                    o0 = MFMA32(trfrag(Vb, 32 * kt + 4 * hhc, 32 * kt + 8 + 4 * hhc, 0, lane_c), pa0, o0);
                    o0 = MFMA32(trfrag(Vb, 32 * kt + 16 + 4 * hhc, 32 * kt + 24 + 4 * hhc, 0, lane_c), pa1, o0);
                    o1 = MFMA32(trfrag(Vb, 32 * kt + 4 * hhc, 32 * kt + 8 + 4 * hhc, 1, lane_c), pa0, o1);
                    o1 = MFMA32(trfrag(Vb, 32 * kt + 16 + 4 * hhc, 32 * kt + 24 + 4 * hhc, 1, lane_c), pa1, o1);
                }
            }
            if (ci + 1 < nchunks) NA_STAGE(buf ^ 1, kw, vw);
            __syncthreads();
        }
#undef NA_TOK
#undef NA_STAGE
        lsum = xhalf_sum(lsum);
        const float il = 1.0f / lsum; bf16* op = MIX + (size_t)tq * DM + M_NA + h * 64 + 4 * hh;
#pragma unroll
        for (int g4 = 0; g4 < 4; ++g4) {
            u32x2 w0; w0.x = cvtpk(o0[4 * g4] * il, o0[4 * g4 + 1] * il); w0.y = cvtpk(o0[4 * g4 + 2] * il, o0[4 * g4 + 3] * il); *(u32x2*)(op + 8 * g4) = w0;
            u32x2 w1; w1.x = cvtpk(o1[4 * g4] * il, o1[4 * g4 + 1] * il); w1.y = cvtpk(o1[4 * g4 + 2] * il, o1[4 * g4 + 3] * il); *(u32x2*)(op + 32 + 8 * g4) = w1; }
    }
}

__device__ __forceinline__ void sg_mfma(const bf16* P, bf16* MIX, const bf16* Wsg, const float* sgb, const float* lnw, const float* lnb, LAS unsigned char* lds, int tid_in, int G) {
    const int wave = __builtin_amdgcn_readfirstlane(tid_in >> 6);
    for (int ch = blockIdx.x; ch < NCH; ch += G) {
        const int tid = FRESH_TID(wave), lane = tid & 63, r32 = lane & 31, hh = lane >> 5, tok = tid >> 2, sg = tid & 3;
        const int row0 = ch * 128;
        { const bf16* src = P + (size_t)(row0 + tok) * INC + C_SGV + sg * 64; float v[64]; float s = 0.f;
#pragma unroll
          for (int k8 = 0; k8 < 8; ++k8) load8(src + 8 * k8, v + 8 * k8);
#pragma unroll
          for (int k = 0; k < 64; ++k) { v[k] = gelu_tanh(v[k]); s += v[k]; }
          const float mu = s * (1.0f / 64.0f); float q = 0.f;
#pragma unroll
          for (int k = 0; k < 64; ++k) { v[k] -= mu; q += v[k] * v[k]; }
          const float rstd = __builtin_amdgcn_rsqf(q * (1.0f / 64.0f) + 1e-5f);
#pragma unroll
          for (int k8 = 0; k8 < 8; ++k8) { float t8[8];
#pragma unroll
              for (int j = 0; j < 8; ++j) { const int cch = sg * 64 + 8 * k8 + j; t8[j] = v[8 * k8 + j] * rstd * lnw[cch] + lnb[cch]; }
              st_chunk(lds + sg * 16384, tok, k8, t8); } }
        __syncthreads();
        { const int g = wave >> 1; LAS unsigned char* img = lds + g * 16384;
#pragma unroll
          for (int pp = 0; pp < 2; ++pp) { const int pt = 2 * (wave & 1) + pp, p = 32 * pt + r32;
            f32x16 a0 = zero16(), a1 = zero16();
            const bf16* wrow = Wsg + ((size_t)g * 128 + p) * 128 + 8 * hh;
#pragma unroll
            for (int ks = 0; ks < 8; ++ks) { const bf16x8 wf = *(const bf16x8*)(wrow + 16 * ks);
                a0 = MFMA32(trfrag(img, 16 * ks + 8 * hh, 16 * ks + 8 * hh + 4, 0, lane), wf, a0);
                a1 = MFMA32(trfrag(img, 16 * ks + 8 * hh, 16 * ks + 8 * hh + 4, 1, lane), wf, a1); }
            const float bias = sgb[g * 128 + p]; const size_t trow = (size_t)(row0 + p);
            const bf16* up = P + trow * INC + C_SGU + g * 64 + 4 * hh; bf16* op = MIX + trow * DM + M_SG + g * 64 + 4 * hh;
#pragma unroll
            for (int g4 = 0; g4 < 4; ++g4) {
                const u32x2 u0 = *(const u32x2*)(up + 8 * g4), u1 = *(const u32x2*)(up + 32 + 8 * g4);
                u32x2 w0, w1;
                w0.x = cvtpk(gelu_tanh(bflo(u0.x)) * (a0[4 * g4] + bias), gelu_tanh(bfhi(u0.x)) * (a0[4 * g4 + 1] + bias)); w0.y = cvtpk(gelu_tanh(bflo(u0.y)) * (a0[4 * g4 + 2] + bias), gelu_tanh(bfhi(u0.y)) * (a0[4 * g4 + 3] + bias));
                w1.x = cvtpk(gelu_tanh(bflo(u1.x)) * (a1[4 * g4] + bias), gelu_tanh(bfhi(u1.x)) * (a1[4 * g4 + 1] + bias)); w1.y = cvtpk(gelu_tanh(bflo(u1.y)) * (a1[4 * g4 + 2] + bias), gelu_tanh(bfhi(u1.y)) * (a1[4 * g4 + 3] + bias));
                *(u32x2*)(op + 8 * g4) = w0; *(u32x2*)(op + 32 + 8 * g4) = w1; asm volatile("" ::: "memory"); } } }
        __syncthreads();
    }
}

__device__ __forceinline__ void ret_kv_mfma(const bf16* P, float* KV, const float* logit, const float* ropetab, LAS unsigned char* lds, int tid_in, int G) {
    const int wave = __builtin_amdgcn_readfirstlane(tid_in >> 6);
    LAS unsigned char* Kf = lds; LAS unsigned char* Kb = lds + 16384; LAS unsigned char* Vi = lds + 32768;
    for (int it_r = blockIdx.x; it_r < NCH * 6 * REP_KV; it_r += G) { const int it = it_r % (NCH * 6);
        const int tid = FRESH_TID(wave), lane = tid & 63, r32 = lane & 31, hh = lane >> 5, tok = tid >> 2, part = tid & 3;
        const int ch = it / 6, h = it % 6, row0 = ch * 128; const bool latent = ch < NCHL;
        { const float lgf = log_sigmoid(logit[h]) * LOG2E, lgb = log_sigmoid(logit[6 + h]) * LOG2E;
          const float wf = __builtin_amdgcn_exp2f(lgf * (float)(127 - tok)) * 0.125f, wb = __builtin_amdgcn_exp2f(lgb * (float)tok) * 0.125f;
          float k16[16], t8[8]; rope_load16(P, row0 + tok, C_RK, h, part, latent, ropetab, k16);
#pragma unroll
          for (int c2 = 0; c2 < 2; ++c2) {
#pragma unroll
              for (int j = 0; j < 8; ++j) t8[j] = k16[8 * c2 + j] * wf;
              st_chunk(Kf, tok, 2 * part + c2, t8);
#pragma unroll
              for (int j = 0; j < 8; ++j) t8[j] = k16[8 * c2 + j] * wb;
              st_chunk(Kb, tok, 2 * part + c2, t8); }
          const bf16* vp = P + (size_t)(row0 + tok) * INC + C_RV + h * 64 + part * 16;
          *(LAS v4u*)(Vi + off64(tok, 2 * part)) = *(const v4u*)vp; *(LAS v4u*)(Vi + off64(tok, 2 * part + 1)) = *(const v4u*)(vp + 8); }
        __syncthreads();
        { const int dir = wave >> 2, et = (wave >> 1) & 1, dt = wave & 1; LAS unsigned char* Kd = dir ? Kb : Kf;
          f32x16 acc = zero16();
#pragma unroll
          for (int ks = 0; ks < 8; ++ks)
              acc = MFMA32(trfrag(Vi, 16 * ks + 8 * hh, 16 * ks + 8 * hh + 4, et, lane), trfrag(Kd, 16 * ks + 8 * hh, 16 * ks + 8 * hh + 4, dt, lane), acc);
          float* o = KV + ((size_t)(ch * 6 + h) * 2 + dir) * 4096 + (size_t)(32 * et + 4 * hh) * 64 + 32 * dt + r32;
#pragma unroll
          for (int i = 0; i < 16; ++i) o[crow0(i) * 64] = acc[i]; }
        __syncthreads();
    }
}
__device__ __forceinline__ void ret_scan2(const float* KV, bf16* PREV, const float* logit, int gtid, int nthreads) {
    for (int it = gtid; it < NB * 6 * 2 * 4096; it += nthreads) {
        const int idx = it & 4095, dir = (it >> 12) & 1, bh = it >> 13, h = bh % 6, b = bh / 6;
        const float cd = expf(128.0f * log_sigmoid(logit[dir * 6 + h]));
#define KVI(ch) (((size_t)((ch) * 6 + h) * 2 + dir) * 4096 + idx)
        const int c0 = NCHL + 2 * b, c1 = c0 + 1;
        const float k0 = KV[KVI(c0)], k1 = KV[KVI(c1)];
        if (dir == 0) { PREV[KVI(c0)] = 0; PREV[KVI(c1)] = (bf16)f2bf(k0); float s = cd * k0 + k1;
            for (int n = 0; n < 64; ++n) { const int ch = b * 64 + n; PREV[KVI(ch)] = (bf16)f2bf(s); s = cd * s + KV[KVI(ch)]; } }
        else { PREV[KVI(c0)] = (bf16)f2bf(k1); PREV[KVI(c1)] = 0; float s = k0 + cd * k1;
            for (int n = 63; n >= 0; --n) { const int ch = b * 64 + n; PREV[KVI(ch)] = (bf16)f2bf(s); s = cd * s + KV[KVI(ch)]; } }
#undef KVI
    }
}
__device__ __forceinline__ void ret_out_mfma(const bf16* P, const bf16* PREV, bf16* MIX, const float* logit, const float* gnw, const float* ropetab, LAS unsigned char* lds, int tid_in, int G) {
    const int wave = __builtin_amdgcn_readfirstlane(tid_in >> 6);
    LAS unsigned char* Qi = lds; LAS unsigned char* Ki = lds + 16384; LAS unsigned char* Vi = lds + 32768;
    LAS float* st = (LAS float*)(lds + 49152);
    const int it_ = wave >> 1, et = wave & 1;
    for (int itm_r = blockIdx.x; itm_r < NCH * 6 * REP_RETO; itm_r += G) { const int itm = itm_r % (NCH * 6);
        const int tid = FRESH_TID(wave), lane = tid & 63, r32 = lane & 31, hh = lane >> 5, tok = tid >> 2, part = tid & 3;
        const int ch = itm / 6, h = itm % 6, row0 = ch * 128; const bool latent = ch < NCHL;
        { float t16[16], t8[8]; rope_load16(P, row0 + tok, C_RQ, h, part, latent, ropetab, t16);
          st_chunk(Qi, tok, 2 * part, t16); st_chunk(Qi, tok, 2 * part + 1, t16 + 8);
          rope_load16(P, row0 + tok, C_RK, h, part, latent, ropetab, t16);
#pragma unroll
          for (int c2 = 0; c2 < 2; ++c2) {
#pragma unroll
              for (int j = 0; j < 8; ++j) t8[j] = t16[8 * c2 + j] * 0.125f;
              st_chunk(Ki, tok, 2 * part + c2, t8); }
          const bf16* vp = P + (size_t)(row0 + tok) * INC + C_RV + h * 64 + part * 16;
          *(LAS v4u*)(Vi + off64(tok, 2 * part)) = *(const v4u*)vp; *(LAS v4u*)(Vi + off64(tok, 2 * part + 1)) = *(const v4u*)(vp + 8); }
        __syncthreads();
        const float lgf = log_sigmoid(logit[h]) * LOG2E, lgb = log_sigmoid(logit[6 + h]) * LOG2E;
        const int il = 32 * it_ + r32;
        bf16x8 qf[4];
#pragma unroll
        for (int s = 0; s < 4; ++s) qf[s] = rowfrag(Qi, il, 2 * s + hh);
        f32x16 of = zero16(), ob = zero16();
#pragma unroll
        for (int jt = 0; jt < 4; ++jt) {
            f32x16 x = zero16();
#pragma unroll
            for (int s = 0; s < 4; ++s) x = MFMA32(rowfrag(Ki, 32 * jt + r32, 2 * s + hh), qf[s], x);
            if (jt <= it_) { f32x16 w;
#pragma unroll
                for (int i = 0; i < 16; ++i) { const int jl = 32 * jt + crow0(i) + 4 * hh; w[i] = (jl <= il) ? x[i] * __builtin_amdgcn_exp2f(lgf * (float)(il - jl)) : 0.f; }
                const bf16x8 p0 = PACK8(w, 0), p1 = PACK8(w, 1);
                of = MFMA32(trfrag(Vi, 32 * jt + 4 * hh, 32 * jt + 8 + 4 * hh, et, lane), p0, of);
                of = MFMA32(trfrag(Vi, 32 * jt + 16 + 4 * hh, 32 * jt + 24 + 4 * hh, et, lane), p1, of); }
            if (jt >= it_) { f32x16 w;
#pragma unroll
                for (int i = 0; i < 16; ++i) { const int jl = 32 * jt + crow0(i) + 4 * hh; w[i] = (jl >= il) ? x[i] * __builtin_amdgcn_exp2f(lgb * (float)(jl - il)) : 0.f; }
                const bf16x8 p0 = PACK8(w, 0), p1 = PACK8(w, 1);
                ob = MFMA32(trfrag(Vi, 32 * jt + 4 * hh, 32 * jt + 8 + 4 * hh, et, lane), p0, ob);
                ob = MFMA32(trfrag(Vi, 32 * jt + 16 + 4 * hh, 32 * jt + 24 + 4 * hh, et, lane), p1, ob); }
        }
        { const bf16* pf = PREV + ((size_t)(ch * 6 + h) * 2) * 4096 + (size_t)(32 * et + r32) * 64 + 8 * hh; const bf16* pb = pf + 4096;
          f32x16 cf = zero16(), cb = zero16();
#pragma unroll
          for (int s = 0; s < 4; ++s) { cf = MFMA32(*(const bf16x8*)(pf + 16 * s), qf[s], cf); cb = MFMA32(*(const bf16x8*)(pb + 16 * s), qf[s], cb); }
          const float df = __builtin_amdgcn_exp2f(lgf * (float)(il + 1)), db = __builtin_amdgcn_exp2f(lgb * (float)(128 - il));
#pragma unroll
          for (int i = 0; i < 16; ++i) { of[i] += df * cf[i]; ob[i] += db * cb[i]; } }
        float s1f = 0.f, s2f = 0.f, s1b = 0.f, s2b = 0.f;
#pragma unroll
        for (int i = 0; i < 16; ++i) { s1f += of[i]; s2f += of[i] * of[i]; s1b += ob[i]; s2b += ob[i] * ob[i]; }
        s1f = xhalf_sum(s1f); s2f = xhalf_sum(s2f); s1b = xhalf_sum(s1b); s2b = xhalf_sum(s2b);
        if (hh == 0) { LAS float* sp = st + (wave * 32 + r32) * 4; sp[0] = s1f; sp[1] = s2f; sp[2] = s1b; sp[3] = s2b; }
        __syncthreads();
        { const LAS float* sp = st + ((wave ^ 1) * 32 + r32) * 4; s1f += sp[0]; s2f += sp[1]; s1b += sp[2]; s2b += sp[3]; }
        const float muf = s1f * (1.0f / 64.0f), mub = s1b * (1.0f / 64.0f);
        const float rf = 1.0f / sqrtf(fmaxf(s2f * (1.0f / 64.0f) - muf * muf, 0.f) + 1e-5f), rb = 1.0f / sqrtf(fmaxf(s2b * (1.0f / 64.0f) - mub * mub, 0.f) + 1e-5f);
        { const size_t trow = (size_t)(row0 + il); const int e0 = h * 64 + 32 * et + 4 * hh;
          const bf16* gp = P + trow * INC + C_GF + e0; bf16* op = MIX + trow * DM + M_RET + e0;
#pragma unroll
          for (int g4 = 0; g4 < 4; ++g4) { const u32x2 gfw = *(const u32x2*)(gp + 8 * g4), gbw = *(const u32x2*)(gp + (C_GB - C_GF) + 8 * g4);
              const float gfv[4] = {bflo(gfw.x), bfhi(gfw.x), bflo(gfw.y), bfhi(gfw.y)}, gbv[4] = {bflo(gbw.x), bfhi(gbw.x), bflo(gbw.y), bfhi(gbw.y)};
              float y[4];
#pragma unroll
              for (int k = 0; k < 4; ++k) { const int i = 4 * g4 + k;
                  y[k] = ((of[i] - muf) * rf * (gfv[k] * sigmoidf_(gfv[k])) + (ob[i] - mub) * rb * (gbv[k] * sigmoidf_(gbv[k]))) * gnw[e0 + 8 * g4 + k]; }
              u32x2 w; w.x = cvtpk(y[0], y[1]); w.y = cvtpk(y[2], y[3]); *(u32x2*)(op + 8 * g4) = w; } }
        __syncthreads();
    }
}

__device__ __forceinline__ void ret_out_mfma2(const bf16* P, const bf16* PREV, bf16* MIX, const float* logit, const float* gnw, const float* ropetab, LAS unsigned char* lds, int tid_in, int G) {
    const int wave = __builtin_amdgcn_readfirstlane(tid_in >> 6);
    const int it_ = wave >> 1, et = wave & 1;
    LAS float* tabL = (LAS float*)(lds + 98304);
    LAS float* stL = (LAS float*)(lds + 98304 + 16384);
    { const int t0 = FRESH_TID(wave); for (int i = t0; i < 1024; i += 512) ((LAS f32x4*)tabL)[i] = ((const f32x4*)ropetab)[i]; }
    __syncthreads();
    v4u rq0, rq1, rk0, rk1, rv0, rv1, rg00, rg01, rg10, rg11;
    LAS unsigned char* gs = lds + 98304 + 16384 + 8192 + wave * 4096;
#define RO_LOAD(uu) do { const int t_ = FRESH_TID(wave); const int ch_ = (uu) / 6, h_ = (uu) % 6, pt_ = t_ & 3; \
        const bf16* b_ = P + (size_t)(ch_ * 128 + (t_ >> 2)) * INC + h_ * 64 + 32 * (pt_ >> 1) + 8 * (pt_ & 1); \
        rq0 = *(const v4u*)(b_ + C_RQ); rq1 = *(const v4u*)(b_ + C_RQ + 16); rk0 = *(const v4u*)(b_ + C_RK); rk1 = *(const v4u*)(b_ + C_RK + 16); rv0 = *(const v4u*)(b_ + C_RV); rv1 = *(const v4u*)(b_ + C_RV + 16); \
        const int l_ = t_ & 63; const bf16* g_ = P + (size_t)(ch_ * 128 + 32 * it_ + (l_ >> 2)) * INC + C_GF + h_ * 64 + 32 * et + 8 * (l_ & 3); \
        rg00 = *(const v4u*)g_; rg01 = *(const v4u*)(g_ + (size_t)16 * INC); rg10 = *(const v4u*)(g_ + (C_GB - C_GF)); rg11 = *(const v4u*)(g_ + (C_GB - C_GF) + (size_t)16 * INC); } while (0)
    int u = blockIdx.x;
    if (u < NCH * 6 * REP_RETO) RO_LOAD(u % (NCH * 6));
    for (int n = 0; u < NCH * 6 * REP_RETO; u += G, ++n) {
        const int itm = u % (NCH * 6);
        const int tid = FRESH_TID(wave), lane = tid & 63, r32 = lane & 31, hh = lane >> 5, tok = tid >> 2, part = tid & 3;
        const int ch = itm / 6, h = itm % 6, row0 = ch * 128; const bool latent = ch < NCHL;
        LAS unsigned char* Qi = lds + (n & 1) * 49152; LAS unsigned char* Ki = Qi + 16384; LAS unsigned char* Vi = Qi + 32768;
        LAS float* st = stL + (n & 1) * 1024;
        { const int c1 = 4 * (part >> 1) + (part & 1), c2 = c1 + 2;
          float q1[8], q2[8], k1[8], k2[8];
          q1[0] = bflo(rq0.x); q1[1] = bfhi(rq0.x); q1[2] = bflo(rq0.y); q1[3] = bfhi(rq0.y); q1[4] = bflo(rq0.z); q1[5] = bfhi(rq0.z); q1[6] = bflo(rq0.w); q1[7] = bfhi(rq0.w);
          q2[0] = bflo(rq1.x); q2[1] = bfhi(rq1.x); q2[2] = bflo(rq1.y); q2[3] = bfhi(rq1.y); q2[4] = bflo(rq1.z); q2[5] = bfhi(rq1.z); q2[6] = bflo(rq1.w); q2[7] = bfhi(rq1.w);
          k1[0] = bflo(rk0.x); k1[1] = bfhi(rk0.x); k1[2] = bflo(rk0.y); k1[3] = bfhi(rk0.y); k1[4] = bflo(rk0.z); k1[5] = bfhi(rk0.z); k1[6] = bflo(rk0.w); k1[7] = bfhi(rk0.w);
          k2[0] = bflo(rk1.x); k2[1] = bfhi(rk1.x); k2[2] = bflo(rk1.y); k2[3] = bfhi(rk1.y); k2[4] = bflo(rk1.z); k2[5] = bfhi(rk1.z); k2[6] = bflo(rk1.w); k2[7] = bfhi(rk1.w);
          if (latent) { const int pos = (row0 + tok) & (SEQ - 1); const int nn = (part >> 1) ? (pos & 63) : (pos >> 6);
              const LAS f32x2_t* tb = (const LAS f32x2_t*)tabL + nn * 16 + 8 * (part & 1);
#pragma unroll
              for (int j = 0; j < 8; ++j) { const f32x2_t cs = tb[j]; const float a = q1[j], b = q2[j], c = k1[j], d = k2[j];
                  q1[j] = a * cs.x - b * cs.y; q2[j] = a * cs.y + b * cs.x; k1[j] = c * cs.x - d * cs.y; k2[j] = c * cs.y + d * cs.x; } }
#pragma unroll
          for (int j = 0; j < 8; ++j) { k1[j] *= 0.125f; k2[j] *= 0.125f; }
          st_chunk(Qi, tok, c1, q1); st_chunk(Qi, tok, c2, q2); st_chunk(Ki, tok, c1, k1); st_chunk(Ki, tok, c2, k2);
          *(LAS v4u*)(Vi + off64(tok, c1)) = rv0; *(LAS v4u*)(Vi + off64(tok, c2)) = rv1; }
        { const int tk = lane >> 2, pc = lane & 3;
          *(LAS v4u*)(gs + tk * 64 + ((pc ^ ((tk >> 1) & 3)) * 16)) = rg00; *(LAS v4u*)(gs + (tk + 16) * 64 + ((pc ^ (((tk + 16) >> 1) & 3)) * 16)) = rg01;
          *(LAS v4u*)(gs + 2048 + tk * 64 + ((pc ^ ((tk >> 1) & 3)) * 16)) = rg10; *(LAS v4u*)(gs + 2048 + (tk + 16) * 64 + ((pc ^ (((tk + 16) >> 1) & 3)) * 16)) = rg11; }
        if (u + G < NCH * 6 * REP_RETO) RO_LOAD((u + G) % (NCH * 6));
        const int il = 32 * it_ + r32;
        const bf16* pf = PREV + ((size_t)(ch * 6 + h) * 2) * 4096 + (size_t)(32 * et + r32) * 64 + 8 * hh;
        bf16x8 pff[4], pfb[4];
#pragma unroll
        for (int s = 0; s < 4; ++s) { pff[s] = *(const bf16x8*)(pf + 16 * s); pfb[s] = *(const bf16x8*)(pf + 4096 + 16 * s); }
        const size_t trow = (size_t)(row0 + il); const int e0 = h * 64 + 32 * et + 4 * hh;
        const float lgf = log_sigmoid(logit[h]) * LOG2E, lgb = log_sigmoid(logit[6 + h]) * LOG2E;
        float af[4], bfv[4], ab[4], bb[4];
#pragma unroll
        for (int k = 0; k < 4; ++k) { af[k] = __builtin_amdgcn_exp2f(-lgf * (float)k); bfv[k] = __builtin_amdgcn_exp2f(-lgf * (float)(8 * k)); ab[k] = __builtin_amdgcn_exp2f(lgb * (float)k); bb[k] = __builtin_amdgcn_exp2f(lgb * (float)(8 * k)); }
        LDS_BARRIER();
        bf16x8 qf[4];
#pragma unroll
        for (int s = 0; s < 4; ++s) qf[s] = rowfrag(Qi, il, 2 * s + hh);
        f32x16 of = zero16(), ob = zero16();
#pragma unroll
        for (int jt = 0; jt < 4; ++jt) {
            f32x16 x = zero16();
#pragma unroll
            for (int s = 0; s < 4; ++s) x = MFMA32(rowfrag(Ki, 32 * jt + r32, 2 * s + hh), qf[s], x);
            if (jt <= it_) { f32x16 w; const float lf = __builtin_amdgcn_exp2f(lgf * (float)(il - 32 * jt - 4 * hh));
#pragma unroll
                for (int g = 0; g < 4; ++g) { const float lg = lf * bfv[g];
#pragma unroll
                    for (int k = 0; k < 4; ++k) { const int i = 4 * g + k; const float v = x[i] * (lg * af[k]); w[i] = (jt < it_ || crow0(i) + 4 * hh <= r32) ? v : 0.f; } }
                const bf16x8 p0 = PACK8(w, 0), p1 = PACK8(w, 1);
                of = MFMA32(trfrag(Vi, 32 * jt + 4 * hh, 32 * jt + 8 + 4 * hh, et, lane), p0, of);
                of = MFMA32(trfrag(Vi, 32 * jt + 16 + 4 * hh, 32 * jt + 24 + 4 * hh, et, lane), p1, of); }
            if (jt >= it_) { f32x16 w; const float lb = __builtin_amdgcn_exp2f(lgb * (float)(32 * jt + 4 * hh - il));
#pragma unroll
                for (int g = 0; g < 4; ++g) { const float lg = lb * bb[g];
#pragma unroll
                    for (int k = 0; k < 4; ++k) { const int i = 4 * g + k; const float v = x[i] * (lg * ab[k]); w[i] = (jt > it_ || crow0(i) + 4 * hh >= r32) ? v : 0.f; } }
                const bf16x8 p0 = PACK8(w, 0), p1 = PACK8(w, 1);
                ob = MFMA32(trfrag(Vi, 32 * jt + 4 * hh, 32 * jt + 8 + 4 * hh, et, lane), p0, ob);
                ob = MFMA32(trfrag(Vi, 32 * jt + 16 + 4 * hh, 32 * jt + 24 + 4 * hh, et, lane), p1, ob); }
        }
        { f32x16 cf = zero16(), cb = zero16();
#pragma unroll
          for (int s = 0; s < 4; ++s) { cf = MFMA32(pff[s], qf[s], cf); cb = MFMA32(pfb[s], qf[s], cb); }
          const float df = __builtin_amdgcn_exp2f(lgf * (float)(il + 1)), db = __builtin_amdgcn_exp2f(lgb * (float)(128 - il));
#pragma unroll
          for (int i = 0; i < 16; ++i) { of[i] += df * cf[i]; ob[i] += db * cb[i]; } }
        float s1f = 0.f, s2f = 0.f, s1b = 0.f, s2b = 0.f;
#pragma unroll
        for (int i = 0; i < 16; ++i) { s1f += of[i]; s2f += of[i] * of[i]; s1b += ob[i]; s2b += ob[i] * ob[i]; }
        s1f = xhalf_sum(s1f); s2f = xhalf_sum(s2f); s1b = xhalf_sum(s1b); s2b = xhalf_sum(s2b);
        if (hh == 0) { LAS float* sp = st + (wave * 32 + r32) * 4; sp[0] = s1f; sp[1] = s2f; sp[2] = s1b; sp[3] = s2b; }
        LDS_BARRIER();
        { const LAS float* sp = st + ((wave ^ 1) * 32 + r32) * 4; s1f += sp[0]; s2f += sp[1]; s1b += sp[2]; s2b += sp[3]; }
        const float muf = s1f * (1.0f / 64.0f), mub = s1b * (1.0f / 64.0f);
        const float rf = __builtin_amdgcn_rsqf(fmaxf(s2f * (1.0f / 64.0f) - muf * muf, 0.f) + 1e-5f), rb = __builtin_amdgcn_rsqf(fmaxf(s2b * (1.0f / 64.0f) - mub * mub, 0.f) + 1e-5f);
        { const int sw = (r32 >> 1) & 3; u32x2 gfw[4], gbw[4];
#pragma unroll
          for (int g4 = 0; g4 < 4; ++g4) { gfw[g4] = *(const LAS u32x2*)(gs + r32 * 64 + ((g4 ^ sw) * 16) + 8 * hh); gbw[g4] = *(const LAS u32x2*)(gs + 2048 + r32 * 64 + ((g4 ^ sw) * 16) + 8 * hh); }
#pragma unroll
          for (int g4 = 0; g4 < 4; ++g4) {
              const float gfv[4] = {bflo(gfw[g4].x), bfhi(gfw[g4].x), bflo(gfw[g4].y), bfhi(gfw[g4].y)}, gbv[4] = {bflo(gbw[g4].x), bfhi(gbw[g4].x), bflo(gbw[g4].y), bfhi(gbw[g4].y)};
              float y[4];
#pragma unroll
              for (int k = 0; k < 4; ++k) { const int i = 4 * g4 + k;
                  const float sf = gfv[k] * __builtin_amdgcn_rcpf(1.0f + __builtin_amdgcn_exp2f(-LOG2E * gfv[k])), sb = gbv[k] * __builtin_amdgcn_rcpf(1.0f + __builtin_amdgcn_exp2f(-LOG2E * gbv[k]));
                  y[k] = ((of[i] - muf) * rf * sf + (ob[i] - mub) * rb * sb) * gnw[e0 + 8 * g4 + k]; }
              u32x2 w; w.x = cvtpk(y[0], y[1]); w.y = cvtpk(y[2], y[3]); *(LAS u32x2*)(gs + r32 * 64 + ((g4 ^ sw) * 16) + 8 * hh) = w; }
          const int tk = lane >> 2, pc = lane & 3; bf16* op = MIX + (size_t)(row0 + 32 * it_ + tk) * DM + M_RET + h * 64 + 32 * et + 8 * pc;
          const v4u o0 = *(const LAS v4u*)(gs + tk * 64 + ((pc ^ ((tk >> 1) & 3)) * 16)), o1 = *(const LAS v4u*)(gs + (tk + 16) * 64 + ((pc ^ (((tk + 16) >> 1) & 3)) * 16));
          *(v4u*)op = o0; *(v4u*)(op + (size_t)16 * DM) = o1; }
    }
#undef RO_LOAD
    __syncthreads();
}
#ifndef FFN_PARTS
#define FFN_PARTS 3
#endif
#ifndef DOWN_WGM
#define DOWN_WGM 8
#endif
#ifndef DOWN_ALIGN
#define DOWN_ALIGN true
#endif
#ifndef DOWN_SP2
#define DOWN_SP2 true
#endif

#ifndef REP_DOWN
#define REP_DOWN 1
#endif
#ifndef REP_NORM
#define REP_NORM 1
#endif
#ifndef REP_UP
#define REP_UP 1
#endif
#ifndef REP_WIN
#define REP_WIN 1
#endif
#ifndef REP_NA
#define REP_NA 1
#endif
#ifndef REP_SG
#define REP_SG 1
#endif
#ifndef REP_KV
#define REP_KV 1
#endif
#ifndef REP_SCAN
#define REP_SCAN 1
#endif
#ifndef REP_RETO
#define REP_RETO 1
#endif
#ifndef REP_PRO
#define REP_PRO 1
#endif

struct Args { In in; float* out; unsigned char* ws; int ph_lo, ph_hi; };
__global__ void __launch_bounds__(NWAVES * 64, 2) hybrid_fwd(Args args) {
    extern __shared__ __attribute__((aligned(16))) unsigned char lds_raw[];
    LAS unsigned char* lds = (LAS unsigned char*)lds_raw;
    volatile LAS unsigned* MISC = (volatile LAS unsigned*)(lds + MISC_OFF);
    const int tid = threadIdx.x, lane = tid & 63, wave = __builtin_amdgcn_readfirstlane(tid >> 6);
    const int G = gridDim.x; const int bx = blockIdx.x; const int vcu = (G % 8 == 0) ? (bx % 8) * (G / 8) + bx / 8 : bx;
    const int NGW = G * NWAVES, nthreads = G * NWAVES * 64;
    unsigned char* ws = args.ws; const In& I = args.in;
    gu32* ctl = (gu32*)(ws + WS_CTL);
    for (int u = tid; u < (LDS_BYTES - LDSCTL_OFF) / 4; u += NWAVES * 64) ((LAS unsigned*)(lds + LDSCTL_OFF))[u] = 0u;
    __syncthreads();
    XcdBarrier bar; bar.bar = (unsigned*)(ctl + CW_BAR); bar.x = 0; bar.st = nullptr;
    if (MK_ONE_LAUNCH) bar = xcd_barrier_post((unsigned*)(ctl + CW_BAR), MISC + 8);
    const int lo = args.ph_lo, hi = args.ph_hi; int ph = 0;
#define PH_ON (ph >= lo && ph < hi)
#define OPQ(x) ({ int _t; asm volatile("v_mbcnt_lo_u32_b32 %0, -1, 0\n\tv_mbcnt_hi_u32_b32 %0, -1, %0" : "=v"(_t)); _t | (wave << 6); })
#define PH_END do { if (MK_ONE_LAUNCH && ph >= lo && ph + 1 < hi) xcd_barrier(bar); ++ph; } while (0)

    float* mod = (float*)(ws + WS_MOD); const float* ropetab = (const float*)(ws + WS_ROPE);
    bf16* W1T = (bf16*)(ws + WS_W1T); bf16* W2T = (bf16*)(ws + WS_W2T); bf16* WINT = (bf16*)(ws + WS_WINT); bf16* WOUTT = (bf16*)(ws + WS_WOUTT);
    float* ctxbuf = (float*)(ws + WS_CTXBUF); bf16* XN = (bf16*)(ws + WS_XN); bf16* PB = (bf16*)(ws + WS_P); bf16* HB = (bf16*)(ws + WS_P);
    float* KV = (float*)(ws + WS_KV); float* PREV = (float*)(ws + WS_PREV);

    if (PH_ON) for (int rep_ = 0; rep_ < REP_PRO; ++rep_) p0_prologue(I, ws, lds, tid, lane, wave, vcu, G);
    PH_END;

    for (int hs = 0; hs < 2 * DEPTH; ++hs) {
        const int L = hs >> 1, half = hs & 1; const bool last = (L == DEPTH - 1), first = (hs == 0);
        const int Mrows = (last && half == 1) ? TL : TT;
        const float* modL = mod + (size_t)L * 9 * 9216;
        const float* xl = first ? I.x : args.out; const float* xc = first ? I.ctx : ctxbuf;
        if (PH_ON) { const int t_ = OPQ(threadIdx.x); norm_phase(xl, xc, Mrows, I.norm_w + (size_t)(L * 3 + (half ? 2 : 0)) * DM, modL, half ? 6 : 0, XN, vcu * NWAVES + (t_ >> 6), NGW, t_ & 63); }
        PH_END;
        for (int part = 0; part < FFN_PARTS; ++part) {
            const int pm0 = part == 2 ? 256 : part * 128, Mp = part == 2 ? TC : TL / 2;
            if (part == 2 && Mrows == TL) break;
            if (PH_ON) for (int rep_ = 0; rep_ < REP_UP; ++rep_) { pg8::Gemm g{XN, W1T + (size_t)(L * 2 + half) * DM * 2 * DFF, Mp, 2 * DFF, DM}; pg8::StaticOrder S; S.init(Mp, 2 * DFF, G, bx, 8, pm0);
                pg8::EpiSwiGLU E{HB, TT};
                pg8::gemm_phase<pg8::EpiSwiGLU, pg8::StaticOrder, true, true>(lds, g, S, E, wave); }
            PH_END;
            if (PH_ON) for (int rep_ = 0; rep_ < REP_DOWN; ++rep_) { pg8::Gemm g{HB, W2T + (size_t)(L * 2 + half) * DFF * DM, Mp, DM, DFF, 64, 64, (size_t)TT * 128, (size_t)DM * 128}; pg8::StaticOrder S; S.init(Mp, DM, G, bx, DOWN_WGM, pm0);
                pg8::EpiResGate E{xl, xc, args.out, ctxbuf, modL + (half ? 8 : 2) * 1024, (rep_ + 1 == REP_DOWN) ? 0.5f : 0.0f};
                pg8::gemm_phase<pg8::EpiResGate, pg8::StaticOrder, DOWN_ALIGN, DOWN_SP2>(lds, g, S, E, wave); }
            PH_END;
        }
        if (half == 0) {
            if (PH_ON) { const int t_ = OPQ(threadIdx.x); norm_phase(args.out, ctxbuf, TT, I.norm_w + (size_t)(L * 3 + 1) * DM, modL, 3, XN, vcu * NWAVES + (t_ >> 6), NGW, t_ & 63); }
            PH_END;
            if (PH_ON) for (int rep_ = 0; rep_ < REP_WIN; ++rep_) { pg8::Gemm g{XN, WINT + (size_t)L * DM * INC, TT, INC, DM}; pg8::StaticOrder S; S.init(TT, INC, G, bx);
                pg8::EpiStoreBf16 E{PB, INC};
                pg8::gemm_phase<pg8::EpiStoreBf16, pg8::StaticOrder, true, true>(lds, g, S, E, wave); }
            PH_END;
            const float* logit = I.ret_logit + L * 12;
            if (PH_ON) {
                for (int rep_ = 0; rep_ < REP_NA; ++rep_) na_mfma(PB, XN, I.na_qn + L * 64, I.na_kn + L * 64, I.na_rpb + (size_t)L * 6 * 15 * 31, !last, lds, OPQ(0), G);
                for (int rep_ = 0; rep_ < REP_SG; ++rep_) sg_mfma(PB, XN, (const bf16*)(ws + WS_WSG) + (size_t)L * 4 * 128 * 128, I.sg_b + L * 4 * 128, I.sg_ln_w + L * 256, I.sg_ln_b + L * 256, lds, OPQ(0), G);
                ret_kv_mfma(PB, KV, logit, ropetab, lds, OPQ(0), G);
            }
            PH_END;
            if (PH_ON) for (int rep_ = 0; rep_ < REP_SCAN; ++rep_) { const int t_ = OPQ(threadIdx.x); ret_scan2(KV, (bf16*)PREV, logit, bx * (NWAVES * 64) + t_, nthreads); }
            PH_END;
            if (PH_ON) { const int t_ = OPQ(threadIdx.x); ret_out_mfma2(PB, (const bf16*)PREV, XN, logit, I.ret_gn_w + L * 384, ropetab, lds, t_, G); }
            PH_END;
            const int Mo = last ? TL : TT;
            if (PH_ON) { pg8::Gemm g{XN, WOUTT + (size_t)L * DM * DM, Mo, DM, DM}; pg8::StaticOrder S; S.init(Mo, DM, G, bx);
                pg8::EpiResGate E{args.out, ctxbuf, args.out, ctxbuf, modL + 5 * 1024, 1.0f};
                pg8::gemm_phase<pg8::EpiResGate, pg8::StaticOrder, true, true>(lds, g, S, E, wave); }
            PH_END;
        }
    }
#undef PH_ON
#undef PH_END
}

extern "C" void kernel_launch(void* const* d_in, const int* in_sizes, int n_in, void* d_out, int out_size, void* d_ws, size_t ws_size, hipStream_t stream) {
    static int grid = 0;
    if (grid == 0) {
        if (n_in != 20 || in_sizes[0] != TL * DM || out_size != TL * DM || ws_size < WS_END) { fprintf(stderr, "kernel_launch: unexpected shapes (n_in %d, in0 %d, out %d, ws %zu); nothing launched\n", n_in, n_in > 0 ? in_sizes[0] : -1, out_size, ws_size); grid = -1; return; }
        int dev = 0, cus = 0, per_cu = 0;
        if (hipGetDevice(&dev) != hipSuccess || hipDeviceGetAttribute(&cus, hipDeviceAttributeMultiprocessorCount, dev) != hipSuccess) { grid = -1; return; }
        if (hipFuncSetAttribute((const void*)hybrid_fwd, hipFuncAttributeMaxDynamicSharedMemorySize, LDS_BYTES) != hipSuccess) { fprintf(stderr, "kernel_launch: hipFuncSetAttribute failed\n"); grid = -1; return; }
        if (hipOccupancyMaxActiveBlocksPerMultiprocessor(&per_cu, (const void*)hybrid_fwd, NWAVES * 64, LDS_BYTES) != hipSuccess || per_cu < 1)
            fprintf(stderr, "kernel_launch: note: occupancy query reports %d workgroups per CU\n", per_cu);
        (void)hipGetLastError();
        grid = cus;
    }
    if (grid < 0) return;
    if (hipMemsetAsync((char*)d_ws + WS_CTL, 0, CTL_ZERO_BYTES, stream) != hipSuccess) return;
    Args a{};
    const float** ip = (const float**)&a.in;
    for (int i = 0; i < 20; ++i) ip[i] = (const float*)d_in[i];
    a.out = (float*)d_out; a.ws = (unsigned char*)d_ws;
#if MK_ONE_LAUNCH
    a.ph_lo = 0; a.ph_hi = NPH;
    hipLaunchKernelGGL(hybrid_fwd, dim3(grid), dim3(NWAVES * 64), LDS_BYTES, stream, a);
#else
    for (int li = 0; li < NPH; ++li) { a.ph_lo = li; a.ph_hi = li + 1; hipLaunchKernelGGL(hybrid_fwd, dim3(grid), dim3(NWAVES * 64), LDS_BYTES, stream, a); }
#endif
}
```

```cpp
#include <hip/hip_runtime.h>
#include <cstdio>
#include <cstdint>
namespace pg8 {
#define PG8_LAS __attribute__((address_space(3)))
typedef unsigned short bf16_t;
typedef short bf16x8 __attribute__((ext_vector_type(8)));
typedef float f32x4 __attribute__((ext_vector_type(4)));
typedef unsigned u32x4 __attribute__((ext_vector_type(4)));
constexpr int BM = 256, BK = 64, HALF = 128, HTB = HALF * BK * 2  , STAGE_BYTES = 8 * HTB, NXCD = 8, WGM = 8;

__host__ __device__ __forceinline__ int lds_byte(int r, int c) { const int st = (r >> 4) * 2 + (c >> 5), rr = r & 15, cc = c & 31, ob = rr * 64 + cc * 2; return st * 1024 + (ob ^ (((ob >> 9) & 1) << 5)); }
__host__ __device__ __forceinline__ void stage_rc(int b, int& R, int& C) { const int st = b / 1024, sb = b % 1024, swz = sb ^ (((sb >> 9) & 1) << 5); R = (st >> 1) * 16 + swz / 64; C = (st & 1) * 32 + (swz % 64) / 2; }
__host__ __device__ __forceinline__ int perm32(int rho) { const int n = rho >> 4, i = rho & 15; return 8 * (i >> 2) + 4 * n + (i & 3); }

struct Unit { int pm, pn; };
struct Gemm { const bf16_t* A; const bf16_t* Bt; int M, N, K; int pa, pb; size_t ksa, ksb; };

struct StaticOrder {
    int nM, nN, nwg, G, c;
    __host__ __device__ void init(int M, int N, int G_, int c_) { nM = M / BM; nN = N / BM; nwg = nM * nN; G = G_; c = c_; }
    __host__ __device__ bool next(int i, Unit& u) const {
        const long L = (long)i * G + c; if (L >= nwg) return false;
        int wgid = (int)L; { const int q = nwg / NXCD, r = nwg % NXCD, xcd = wgid % NXCD, off = wgid / NXCD; wgid = (xcd < r ? xcd * (q + 1) : r * (q + 1) + (xcd - r) * q) + off; }
        const int nig = WGM * nN, gid = wgid / nig, fm = gid * WGM, gsz = (nM - fm) < WGM ? (nM - fm) : WGM;
        u.pm = fm + ((wgid % nig) % gsz); u.pn = (wgid % nig) / gsz; return true;
    }
    __device__ __forceinline__ void a_ready(const Unit&) const {}
    __device__ __forceinline__ void done(const Unit&) const {}
};
__device__ __forceinline__ unsigned cvt_pk_bf16(float lo, float hi) { unsigned r; asm volatile("v_cvt_pk_bf16_f32 %0, %1, %2" : "=v"(r) : "v"(lo), "v"(hi)); return r; }
typedef float f32x2 __attribute__((ext_vector_type(2)));
template <class Epi, class Sched, bool ALIGN_EPI = false, bool SP2 = false>
__device__ __forceinline__ void gemm_phase(PG8_LAS unsigned char* lds, const Gemm g, const Sched& S, const Epi& E, const int wave_s) {
    int tid_o; asm volatile("v_mbcnt_lo_u32_b32 %0, -1, 0\n\tv_mbcnt_hi_u32_b32 %0, -1, %0" : "=v"(tid_o)); tid_o |= wave_s << 6;
    const int tid = tid_o, wid = __builtin_amdgcn_readfirstlane(tid >> 6), lane = tid & 63, wr = wid >> 2, wc = wid & 3, fr = lane & 15, fq = lane >> 4;
    const int K = g.K, nt = K / BK;
    const int pa = g.pa ? g.pa : K, pb = g.pb ? g.pb : K;
    unsigned voffA[2], voffB[2];
#pragma unroll
    for (int i = 0; i < 2; ++i) { int R, C; stage_rc(tid * 16 + i * 8192, R, C); const int Rb = Epi::PERM ? ((R & ~31) + perm32(R & 31)) : R;
        voffA[i] = (unsigned)(R * pa + C) * 2u; voffB[i] = (unsigned)(Rb * pb + C) * 2u; }
    const size_t kstepA = g.ksa ? g.ksa : (size_t)(BK * 2), kstepB = g.ksb ? g.ksb : (size_t)(BK * 2);
    const size_t hstepA = (size_t)HALF * pa * 2, hstepB = (size_t)HALF * pb * 2;
    const size_t tstepA = 2 * hstepA, tstepB = 2 * hstepB;
    const unsigned ldsw = (unsigned)wid * 1024u;
    const int aoff = lds_byte(wr * 64 + fr, fq * 8), boff = lds_byte(wc * 32 + fr, fq * 8);
#define PG8_SA(b, h) (((b) * 2 + (h)) * HTB)
#define PG8_SB(b, h) ((4 + (b) * 2 + (h)) * HTB)
#define PG8_STAGE(bufoff, gbase, voff) do { _Pragma("unroll") for (int _i = 0; _i < 2; ++_i) \
        __builtin_amdgcn_global_load_lds((const unsigned*)((const char*)(gbase) + (voff)[_i]), (PG8_LAS unsigned*)(lds + (bufoff) + ldsw + _i * 8192), 16, 0, 0); } while (0)
#define PG8_LDA(dst, b, h) do { _Pragma("unroll") for (int m = 0; m < 4; ++m) _Pragma("unroll") for (int k = 0; k < 2; ++k) dst[m][k] = *(const PG8_LAS bf16x8*)(lds + PG8_SA(b, h) + aoff + m * 2048 + k * 1024); } while (0)
#define PG8_LDB(dst, b, h) do { _Pragma("unroll") for (int n = 0; n < 2; ++n) _Pragma("unroll") for (int k = 0; k < 2; ++k) dst[n][k] = *(const PG8_LAS bf16x8*)(lds + PG8_SB(b, h) + boff + n * 2048 + k * 1024); } while (0)
#define PG8_MMA(ai, bj, At, Bt) do { __builtin_amdgcn_s_setprio(1); _Pragma("unroll") for (int m = 0; m < 4; ++m) _Pragma("unroll") for (int n = 0; n < 2; ++n) _Pragma("unroll") for (int k = 0; k < 2; ++k) \
        acc[ai][bj][m][n] = __builtin_amdgcn_mfma_f32_16x16x32_bf16(Bt[n][k], At[m][k], acc[ai][bj][m][n], 0, 0, 0); __builtin_amdgcn_s_setprio(0); } while (0)
#define PG8_WAIT_V(n) asm volatile("s_waitcnt vmcnt(" #n ")" ::: "memory")
#define PG8_WAIT_L(n) asm volatile("s_waitcnt lgkmcnt(" #n ")" ::: "memory")
#define PG8_BAR __builtin_amdgcn_s_barrier()
#define PG8_SCHED __builtin_amdgcn_sched_barrier(0)
    Unit cur, nxt; int ui = 0;
    if (!S.next(0, cur)) return;
    f32x4 acc[2][2][4][2];
#pragma unroll
    for (int a = 0; a < 2; ++a)
#pragma unroll
        for (int b = 0; b < 2; ++b)
#pragma unroll
            for (int m = 0; m < 4; ++m)
#pragma unroll
                for (int n = 0; n < 2; ++n) acc[a][b][m][n] = (f32x4){0.f, 0.f, 0.f, 0.f};
    bf16x8 At[4][2], B0[2][2], B1[2][2];
    const char* cA = (const char*)g.A + (size_t)cur.pm * tstepA; const char* cB = (const char*)g.Bt + (size_t)cur.pn * tstepB;
    S.a_ready(cur);
    if constexpr (SP2) {
        PG8_STAGE(PG8_SB(0, 0), cB, voffB); PG8_STAGE(PG8_SB(0, 1), cB + hstepB, voffB); PG8_STAGE(PG8_SA(0, 0), cA, voffA); PG8_STAGE(PG8_SA(0, 1), cA + hstepA, voffA);
        if (wr == 1) PG8_BAR;
        PG8_WAIT_V(2); PG8_BAR;
        PG8_STAGE(PG8_SB(1, 0), cB + kstepB, voffB); PG8_STAGE(PG8_SA(1, 0), cA + kstepA, voffA); PG8_STAGE(PG8_SB(1, 1), cB + hstepB + kstepB, voffB);
        PG8_WAIT_V(6); PG8_BAR;
    } else {
        PG8_STAGE(PG8_SB(0, 0), cB, voffB); PG8_STAGE(PG8_SA(0, 0), cA, voffA); PG8_STAGE(PG8_SB(0, 1), cB + hstepB, voffB); PG8_STAGE(PG8_SA(0, 1), cA + hstepA, voffA);
        if (wr == 1) PG8_BAR;
        PG8_WAIT_V(4); PG8_BAR;
        PG8_STAGE(PG8_SB(1, 0), cB + kstepB, voffB); PG8_STAGE(PG8_SA(1, 0), cA + kstepA, voffA); PG8_STAGE(PG8_SB(1, 1), cB + hstepB + kstepB, voffB);
        PG8_WAIT_V(6); PG8_BAR;
    }
    for (;;) {
        const bool has_next = S.next(ui + 1, nxt);
        const char* nA = has_next ? (const char*)g.A + (size_t)nxt.pm * tstepA : cA; const char* nB = has_next ? (const char*)g.Bt + (size_t)nxt.pn * tstepB : cB;
        for (int t = 0; t < nt; t += 2) {
            const bool last = (t == nt - 2);
            const char* a1 = cA + (size_t)(t + 1) * kstepA;
            const char* a2 = last ? nA : cA + (size_t)(t + 2) * kstepA; const char* b2 = last ? nB : cB + (size_t)(t + 2) * kstepB;
            const char* a3 = a2 + kstepA; const char* b3 = b2 + kstepB;
            if (last && has_next) S.a_ready(nxt);
            if constexpr (SP2) {
            PG8_LDB(B0, 0, 0); PG8_LDB(B1, 0, 1); PG8_SCHED; PG8_LDA(At, 0, 0); PG8_STAGE(PG8_SA(1, 1), a1 + hstepA, voffA);
            PG8_WAIT_V(8); PG8_WAIT_L(0); PG8_BAR; PG8_MMA(0, 0, At, B0); PG8_MMA(0, 1, At, B1); PG8_BAR; PG8_SCHED;
            PG8_LDA(At, 0, 1); PG8_STAGE(PG8_SB(0, 0), b2, voffB); PG8_STAGE(PG8_SB(0, 1), b2 + hstepB, voffB); PG8_STAGE(PG8_SA(0, 0), a2, voffA);
            PG8_WAIT_V(8); PG8_WAIT_L(0); PG8_BAR; PG8_MMA(1, 0, At, B0); PG8_MMA(1, 1, At, B1); PG8_BAR; PG8_SCHED;
            PG8_LDB(B0, 1, 0); PG8_LDB(B1, 1, 1); PG8_SCHED; PG8_LDA(At, 1, 0); PG8_STAGE(PG8_SA(0, 1), a2 + hstepA, voffA);
            PG8_WAIT_V(8); PG8_WAIT_L(0); PG8_BAR; PG8_MMA(0, 0, At, B0); PG8_MMA(0, 1, At, B1); PG8_BAR; PG8_SCHED;
            PG8_LDA(At, 1, 1); PG8_STAGE(PG8_SB(1, 0), b3, voffB); PG8_STAGE(PG8_SB(1, 1), b3 + hstepB, voffB); PG8_STAGE(PG8_SA(1, 0), a3, voffA);
            PG8_WAIT_V(8); PG8_WAIT_L(0); PG8_BAR; PG8_MMA(1, 0, At, B0); PG8_MMA(1, 1, At, B1); PG8_BAR; PG8_SCHED;
            } else {
            PG8_LDB(B0, 0, 0); PG8_SCHED; PG8_LDA(At, 0, 0); PG8_STAGE(PG8_SA(1, 1), a1 + hstepA, voffA);
            PG8_WAIT_L(8); PG8_BAR; PG8_WAIT_L(0); PG8_MMA(0, 0, At, B0); PG8_BAR; PG8_SCHED;
            PG8_LDB(B1, 0, 1); PG8_STAGE(PG8_SB(0, 0), b2, voffB);
            PG8_BAR; PG8_WAIT_L(0); PG8_MMA(0, 1, At, B1); PG8_BAR;
            PG8_LDA(At, 0, 1); PG8_STAGE(PG8_SA(0, 0), a2, voffA);
            PG8_BAR; PG8_WAIT_L(0); PG8_MMA(1, 0, At, B0); PG8_BAR; PG8_SCHED;
            PG8_STAGE(PG8_SB(0, 1), b2 + hstepB, voffB);
            PG8_WAIT_V(6); PG8_BAR; PG8_MMA(1, 1, At, B1); PG8_BAR;
            PG8_LDB(B0, 1, 0); PG8_SCHED; PG8_LDA(At, 1, 0); PG8_STAGE(PG8_SA(0, 1), a2 + hstepA, voffA);
            PG8_WAIT_L(8); PG8_BAR; PG8_WAIT_L(0); PG8_MMA(0, 0, At, B0); PG8_BAR; PG8_SCHED;
            PG8_LDB(B1, 1, 1); PG8_STAGE(PG8_SB(1, 0), b3, voffB);
            PG8_BAR; PG8_WAIT_L(0); PG8_MMA(0, 1, At, B1); PG8_BAR;
            PG8_LDA(At, 1, 1); PG8_STAGE(PG8_SA(1, 0), a3, voffA);
            PG8_BAR; PG8_WAIT_L(0); PG8_MMA(1, 0, At, B0); PG8_BAR; PG8_SCHED;
            PG8_STAGE(PG8_SB(1, 1), b3 + hstepB, voffB);
            PG8_WAIT_V(6); PG8_BAR; PG8_MMA(1, 1, At, B1); PG8_BAR;
            }
        }
        if constexpr (ALIGN_EPI) { if (wr == 0) PG8_BAR; }
        if constexpr (!Epi::AFTER_DRAIN) { E(acc, cur, wr, wc, fr, fq); S.done(cur); }
        if (!has_next) break;
#pragma unroll
        for (int a = 0; a < 2; ++a)
#pragma unroll
            for (int b = 0; b < 2; ++b)
#pragma unroll
                for (int m = 0; m < 4; ++m)
#pragma unroll
                    for (int n = 0; n < 2; ++n) acc[a][b][m][n] = (f32x4){0.f, 0.f, 0.f, 0.f};
        cur = nxt; cA = nA; cB = nB; ++ui;
        if constexpr (ALIGN_EPI) { if (wr == 1) PG8_BAR; }
    }
    PG8_WAIT_V(0);
    if constexpr (!ALIGN_EPI) { if (wr == 0) PG8_BAR; }
    PG8_BAR;
    if constexpr (Epi::AFTER_DRAIN) { E.fused(acc, cur, wr, wc, fr, fq, lds, wid, lane); S.done(cur); }
#undef PG8_SA
#undef PG8_SB
#undef PG8_STAGE
#undef PG8_LDA
#undef PG8_LDB
#undef PG8_MMA
#undef PG8_WAIT_V
#undef PG8_WAIT_L
#undef PG8_BAR
#undef PG8_SCHED
}
}

namespace pg8 {
struct EpiSwiGLU {
    static constexpr bool PERM = true, AFTER_DRAIN = false;
    bf16_t* H; int ldc;
    __device__ __forceinline__ void operator()(const f32x4 (&acc)[2][2][4][2], const Unit& u, int wr, int wc, int fr, int fq) const {
        const int row0 = u.pm * BM + wr * 64 + fr, col0 = u.pn * HALF + wc * 32 + 8 * fq;
#pragma unroll
        for (int ai = 0; ai < 2; ++ai)
#pragma unroll
            for (int m = 0; m < 4; ++m) {
                bf16_t* rowp = H + ((size_t)(col0 >> 6) * ldc   + (row0 + ai * HALF + m * 16)) * 64 + (col0 & 63);
                float h[8];
#pragma unroll
                for (int n = 0; n < 2; ++n)
#pragma unroll
                    for (int i = 0; i < 4; ++i) { const float g = acc[ai][0][m][n][i], uu = acc[ai][1][m][n][i];
                        const float e = __builtin_amdgcn_exp2f(g * -1.4426950408889634f);
                        h[n * 4 + i] = g * uu * __builtin_amdgcn_rcpf(1.0f + e); }
                u32x4 w; w.x = cvt_pk_bf16(h[0], h[1]); w.y = cvt_pk_bf16(h[2], h[3]); w.z = cvt_pk_bf16(h[4], h[5]); w.w = cvt_pk_bf16(h[6], h[7]);
                *(u32x4*)rowp = w;
            }
    }
};
struct EpiResGate {
    static constexpr bool PERM = true, AFTER_DRAIN = false;
    const float* in_lat; const float* in_ctx; bf16_t* xr; float* out32; const float* gate; float f; int mode;
    __device__ __forceinline__ void operator()(const f32x4 (&acc)[2][2][4][2], const Unit& u, int wr, int wc, int fr, int fq) const {
        const bool lat = u.pm < 256; const int mb = lat ? (u.pm >> 5) : 8;
        const int col0 = u.pn * BM + wc * 32 + 8 * fq; const int row0 = u.pm * BM + wr * 64 + fr;
        f32x4 gv[2][2];
#pragma unroll
        for (int bj = 0; bj < 2; ++bj)
#pragma unroll
            for (int n = 0; n < 2; ++n) gv[bj][n] = *(const f32x4*)(gate + (size_t)mb * 9216 + col0 + bj * HALF + n * 4);
        if (mode & 1) {
            const float* base = lat ? in_lat + (size_t)row0 * 1024 : in_ctx + (size_t)(row0 - 65536) * 1024;
#pragma unroll
            for (int ai = 0; ai < 2; ++ai)
#pragma unroll
                for (int m = 0; m < 4; ++m) { const size_t ro = (size_t)(ai * HALF + m * 16) * 1024 + col0;
#pragma unroll
                    for (int bj = 0; bj < 2; ++bj) { const f32x4 b0 = *(const f32x4*)(base + ro + bj * HALF), b1 = *(const f32x4*)(base + ro + bj * HALF + 4);
                        const f32x4 o0 = b0 + gv[bj][0] * (acc[ai][bj][m][0] * f), o1 = b1 + gv[bj][1] * (acc[ai][bj][m][1] * f);
                        u32x4 w; w.x = cvt_pk_bf16(o0[0], o0[1]); w.y = cvt_pk_bf16(o0[2], o0[3]); w.z = cvt_pk_bf16(o1[0], o1[1]); w.w = cvt_pk_bf16(o1[2], o1[3]);
                        *(u32x4*)(xr + (size_t)row0 * 1024 + ro + bj * HALF) = w; }
                    if (m & 1) asm volatile("" ::: "memory"); }
        } else {
            u32x4 bw[2][4][2];
#pragma unroll
            for (int ai = 0; ai < 2; ++ai)
#pragma unroll
                for (int m = 0; m < 4; ++m)
#pragma unroll
                    for (int bj = 0; bj < 2; ++bj) bw[ai][m][bj] = *(const u32x4*)(xr + (size_t)(row0 + ai * HALF + m * 16) * 1024 + col0 + bj * HALF);
#pragma unroll
            for (int ai = 0; ai < 2; ++ai)
#pragma unroll
                for (int m = 0; m < 4; ++m)
#pragma unroll
                    for (int bj = 0; bj < 2; ++bj) { const u32x4 b = bw[ai][m][bj]; const size_t off = (size_t)(row0 + ai * HALF + m * 16) * 1024 + col0 + bj * HALF;
                        const f32x4 b0 = {__uint_as_float(b.x << 16), __uint_as_float(b.x & 0xffff0000u), __uint_as_float(b.y << 16), __uint_as_float(b.y & 0xffff0000u)};
                        const f32x4 b1 = {__uint_as_float(b.z << 16), __uint_as_float(b.z & 0xffff0000u), __uint_as_float(b.w << 16), __uint_as_float(b.w & 0xffff0000u)};
                        const f32x4 o0 = b0 + gv[bj][0] * (acc[ai][bj][m][0] * f), o1 = b1 + gv[bj][1] * (acc[ai][bj][m][1] * f);
                        if (mode & 2) { *(f32x4*)(out32 + off) = o0; *(f32x4*)(out32 + off + 4) = o1; }
                        else { u32x4 w; w.x = cvt_pk_bf16(o0[0], o0[1]); w.y = cvt_pk_bf16(o0[2], o0[3]); w.z = cvt_pk_bf16(o1[0], o1[1]); w.w = cvt_pk_bf16(o1[2], o1[3]); *(u32x4*)(xr + off) = w; } }
        }
    }
};
struct EpiStoreBf16 {
    static constexpr bool PERM = true, AFTER_DRAIN = false;
    bf16_t* O; int ldc;
    __device__ __forceinline__ void operator()(const f32x4 (&acc)[2][2][4][2], const Unit& u, int wr, int wc, int fr, int fq) const {
        const int row0 = u.pm * BM + wr * 64 + fr, col0 = u.pn * BM + wc * 32 + 8 * fq;
#pragma unroll
        for (int ai = 0; ai < 2; ++ai)
#pragma unroll
            for (int m = 0; m < 4; ++m) { bf16_t* rowp = O + (size_t)(row0 + ai * HALF + m * 16) * ldc + col0;
#pragma unroll
                for (int bj = 0; bj < 2; ++bj) { const f32x4 v0 = acc[ai][bj][m][0], v1 = acc[ai][bj][m][1];
                    u32x4 w; w.x = cvt_pk_bf16(v0[0], v0[1]); w.y = cvt_pk_bf16(v0[2], v0[3]); w.z = cvt_pk_bf16(v1[0], v1[1]); w.w = cvt_pk_bf16(v1[2], v1[3]);
                    *(u32x4*)(rowp + bj * HALF) = w; } }
    }
};
}

constexpr int NB = 8, SEQ = 8192, DM = 1024, CTXL = 256, DEPTH = 2, DFF = 2816, NMOD = 9, INC = 3584;
constexpr int TL = NB * SEQ, TC = NB * CTXL, TT = TL + TC;
constexpr int C_NAQ = 0, C_NAK = 384, C_NAV = 768, C_SGU = 1152, C_SGV = 1408, C_RQ = 1664, C_RK = 2048, C_RV = 2432, C_GF = 2816, C_GB = 3200;
constexpr int M_NA = 0, M_SG = 384, M_RET = 640;
constexpr int NCH = TT / 128, NCHL = TL / 128;
constexpr int NWAVES = 8;
#ifndef MK_ONE_LAUNCH
#define MK_ONE_LAUNCH 1
#endif
constexpr int NPH = 1 + DEPTH * 12;

constexpr size_t MiB = 1u << 20;
constexpr size_t WS_CTL = 0, CTL_ZERO_BYTES = 1 * MiB;
constexpr size_t WS_MOD = 1 * MiB;
constexpr size_t WS_ROPE = 2 * MiB;
constexpr size_t WS_WSG = 3 * MiB;
constexpr size_t WS_W1T = 4 * MiB, WS_W2T = 48 * MiB, WS_WINT = 70 * MiB, WS_WOUTT = 84 * MiB;
constexpr size_t WS_CTXBUF = 88 * MiB;
constexpr size_t WS_XN = 96 * MiB;
constexpr size_t WS_P = 228 * MiB;
constexpr size_t WS_KV = 690 * MiB;
constexpr size_t WS_PREV = 789 * MiB;
constexpr size_t WS_XR = 888 * MiB;
constexpr size_t WS_END = 1020 * MiB;
constexpr int CW_BAR = 4096;

constexpr int RING_BYTES = 131072, LDSCTL_OFF = 163840 - 512, MISC_OFF = LDSCTL_OFF + 320, LDS_BYTES = 163840;
#define GAS __attribute__((address_space(1)))
#define LAS __attribute__((address_space(3)))
typedef unsigned short bf16;
typedef unsigned v4u __attribute__((ext_vector_type(4)));
typedef float f32x4 __attribute__((ext_vector_type(4)));
typedef short bf16x8 __attribute__((ext_vector_type(8)));
typedef GAS unsigned gu32;
typedef GAS unsigned long long gu64;
#define RLX_AGENT __ATOMIC_RELAXED, __HIP_MEMORY_SCOPE_AGENT
#define LDS_WAIT() asm volatile("s_waitcnt lgkmcnt(0)" ::: "memory")
#define VM_WAIT() asm volatile("s_waitcnt vmcnt(0)" ::: "memory")
__device__ __forceinline__ unsigned long long rt() { return __builtin_amdgcn_s_memrealtime(); }
__device__ __forceinline__ unsigned f2bf(float f) { unsigned u = __builtin_bit_cast(unsigned, f); return (u + 0x7fffu + ((u >> 16) & 1u)) >> 16; }
__device__ __forceinline__ unsigned pk2(float lo, float hi) { return f2bf(lo) | (f2bf(hi) << 16); }
#define XB_TMO      128
#define XB_XCNT(j)  (256  + 64 * (j))
#define XB_XSUB(j)  (1280 + 64 * (j))
#define XB_XGEN(j)  (2304 + 64 * (j))
#define XB_TOP      3328
#define XB_TOPGEN   3392
#define XCD_BAR_WORDS 3456
#define XB_SPIN_CAP (1u << 18)

__device__ __forceinline__ unsigned xb_ld(unsigned* p)              { return __hip_atomic_load(p, __ATOMIC_RELAXED, __HIP_MEMORY_SCOPE_AGENT); }
__device__ __forceinline__ unsigned xb_add(unsigned* p, unsigned v) { return __hip_atomic_fetch_add(p, v, __ATOMIC_RELAXED, __HIP_MEMORY_SCOPE_AGENT); }
__device__ __forceinline__ unsigned xb_xcc_id() { return (unsigned)__builtin_amdgcn_s_getreg((3 << 11) | 20) & 0xFu; }
#define XB_SPIN(cond, bar) do { unsigned _sp = 0; while (cond) { __builtin_amdgcn_s_sleep(1); \
    if ((++_sp & 255u) == 0u) { if (xb_ld(&(bar)[XB_TMO])) break; if (_sp > XB_SPIN_CAP) { atomicAdd(&(bar)[XB_TMO], 1u); break; } } } } while (0)

struct XcdBarrier {
    unsigned* bar; unsigned x;
    volatile LAS unsigned* st;
};

__device__ __forceinline__ XcdBarrier xcd_barrier_post(unsigned* bar, volatile LAS unsigned* st) {
    XcdBarrier b; b.bar = bar; b.x = xb_xcc_id(); b.st = st;
    if (threadIdx.x == 0) (void)xb_add(&bar[XB_XCNT(b.x)], 1u);
    return b;
}
__device__ __forceinline__ void xcd_barrier_complete(unsigned* bar, unsigned x, unsigned& nloc, unsigned& nx) {
    const unsigned G = gridDim.x * gridDim.y * gridDim.z;
    unsigned sum, cnt, mine, sp = 0u;
    for (;;) {
        sum = 0u; cnt = 0u; mine = 0u;
#pragma unroll
        for (unsigned j = 0; j < 16; ++j) { const unsigned c = xb_ld(&bar[XB_XCNT(j)]); sum += c; cnt += (c > 0u) ? 1u : 0u; mine = (j == x) ? c : mine; }
        if (sum == G) break;
        __builtin_amdgcn_s_sleep(1);
        if ((++sp & 255u) == 0u) { if (xb_ld(&bar[XB_TMO])) break; if (sp > XB_SPIN_CAP) { atomicAdd(&bar[XB_TMO], 1u); break; } }
    }
    nloc = mine > 0u ? mine : 1u; nx = cnt > 0u ? cnt : 1u;
}

__device__ __forceinline__ void xcd_barrier(const XcdBarrier& b) {
    asm volatile("s_waitcnt vmcnt(0)" ::: "memory");
    __syncthreads();
    if (threadIdx.x == 0) {
        unsigned* bar = b.bar;
        __builtin_amdgcn_s_waitcnt(0);
        unsigned nloc = b.st[0], nx = b.st[1];
        if (nloc == 0u) { xcd_barrier_complete(bar, b.x, nloc, nx); b.st[0] = nloc; b.st[1] = nx; }
        const unsigned old = xb_add(&bar[XB_XSUB(b.x)], 1u);
        const unsigned gen = old / nloc;
        if (old + 1u == (gen + 1u) * nloc) {
            __builtin_amdgcn_fence(__ATOMIC_RELEASE, "agent");
            asm volatile("s_waitcnt vmcnt(0)" ::: "memory");
            const unsigned og = xb_add(&bar[XB_TOP], 1u);
            const unsigned tg = og / nx;
            if (og + 1u == (tg + 1u) * nx) xb_add(&bar[XB_TOPGEN], 1u);
            else XB_SPIN(xb_ld(&bar[XB_TOPGEN]) == tg, bar);
            __builtin_amdgcn_fence(__ATOMIC_ACQUIRE, "agent");
            xb_add(&bar[XB_XGEN(b.x)], 1u);
            asm volatile("s_waitcnt vmcnt(0)" ::: "memory");
        } else {
            XB_SPIN(xb_ld(&bar[XB_XGEN(b.x)]) == gen, bar);
            __builtin_amdgcn_fence(__ATOMIC_ACQUIRE, "agent");
            asm volatile("s_waitcnt vmcnt(0)" ::: "memory");
        }
    }
    __syncthreads();
}
#ifndef REP_NORM
#define REP_NORM 1
#endif

typedef unsigned u32x2 __attribute__((ext_vector_type(2)));

#define SHX(v, o) __builtin_bit_cast(float, __builtin_amdgcn_ds_swizzle(__builtin_bit_cast(int, (float)(v)), ((o) << 10) | 0x1f))
__device__ __forceinline__ float xhalf_sum(float v) { auto rr = __builtin_amdgcn_permlane32_swap(__float_as_uint(v), __float_as_uint(v), false, false); return __uint_as_float(rr[0]) + __uint_as_float(rr[1]); }
__device__ __forceinline__ float xhalf_max(float v) { auto rr = __builtin_amdgcn_permlane32_swap(__float_as_uint(v), __float_as_uint(v), false, false); return fmaxf(__uint_as_float(rr[0]), __uint_as_float(rr[1])); }
__device__ __forceinline__ float wave_sum(float v) { v += SHX(v, 1); v += SHX(v, 2); v += SHX(v, 4); v += SHX(v, 8); v += SHX(v, 16); return xhalf_sum(v); }
__device__ __forceinline__ float bflo(unsigned w) { return __uint_as_float(w << 16); }
__device__ __forceinline__ float bfhi(unsigned w) { return __uint_as_float(w & 0xffff0000u); }
__device__ __forceinline__ void load8(const bf16* p, float* o) {
    const v4u w = *(const v4u*)p;
    o[0] = bflo(w.x); o[1] = bfhi(w.x); o[2] = bflo(w.y); o[3] = bfhi(w.y); o[4] = bflo(w.z); o[5] = bfhi(w.z); o[6] = bflo(w.w); o[7] = bfhi(w.w);
}
__device__ __forceinline__ void store8(bf16* p, const float* o) {
    v4u w; w.x = pk2(o[0], o[1]); w.y = pk2(o[2], o[3]); w.z = pk2(o[4], o[5]); w.w = pk2(o[6], o[7]); *(v4u*)p = w;
}
__device__ __forceinline__ float sigmoidf_(float x) { return __builtin_amdgcn_rcpf(1.0f + __builtin_amdgcn_exp2f(-1.4426950408889634f * x)); }
__device__ __forceinline__ float gelu_tanh(float x) { const float y = 0.7978845608028654f * (x + 0.044715f * x * x * x); return x * sigmoidf_(2.0f * y); }
__device__ __forceinline__ float log_sigmoid(float x) { return fminf(x, 0.0f) - log1pf(expf(-fabsf(x))); }

__device__ __forceinline__ void p0_transpose_item(const float* W, int K, int N, bf16* WT, bool swiglu, LAS float* scr, int item, int lane, bool kblocked = false) {
    const int nblk = N / 32, kb = item / nblk, nb = item % nblk, k0 = 64 * kb, n0 = 32 * nb;
    int d0 = n0;
    if (swiglu) { const int hid = n0 < DFF ? n0 : n0 - DFF; d0 = (hid >> 7) * 256 + (n0 < DFF ? 0 : 128) + (hid & 127); }
#pragma unroll 8
    for (int i = 0; i < 32; ++i) { const int kk = 2 * i + (lane >> 5); scr[kk * 33 + (lane & 31)] = W[(size_t)(k0 + kk) * N + n0 + (lane & 31)]; }
    LDS_WAIT(); asm volatile("" ::: "memory");
    const int c = lane & 7;
#pragma unroll
    for (int j = 0; j < 4; ++j) { const int n = (lane >> 3) + 8 * j; const LAS float* s = scr + (8 * c) * 33 + n;
        v4u o; o.x = pk2(s[0 * 33], s[1 * 33]); o.y = pk2(s[2 * 33], s[3 * 33]); o.z = pk2(s[4 * 33], s[5 * 33]); o.w = pk2(s[6 * 33], s[7 * 33]);
        *(GAS v4u*)(WT + (kblocked ? ((size_t)kb * N + d0 + n) * 64 + 8 * c : (size_t)(d0 + n) * K + k0 + 8 * c)) = o; }
    LDS_WAIT(); asm volatile("" ::: "memory");
}
struct In { const float *x, *c, *ctx, *c_ctx, *ada_w, *ada_b, *norm_w, *ffn_w1, *ffn_w2, *w_in, *w_out, *na_qn, *na_kn, *na_rpb, *sg_w, *sg_b, *sg_ln_w, *sg_ln_b, *ret_logit, *ret_gn_w; };

__device__ __forceinline__ void p0_prologue(const In& I, unsigned char* ws, LAS unsigned char* lds, int tid, int lane, int wave, int vcu, int G) {
    LAS float* scr = (LAS float*)(lds + wave * 16384);
    const int gw = vcu * NWAVES + wave, NGW = G * NWAVES;
    constexpr int I_W1 = (DM / 64) * (2 * DFF / 32), I_W2 = (DFF / 64) * (DM / 32), I_WIN = (DM / 64) * (INC / 32), I_WOUT = (DM / 64) * (DM / 32);
    constexpr int PER_L = 2 * I_W1 + 2 * I_W2 + I_WIN + I_WOUT;
    bf16* W1T = (bf16*)(ws + WS_W1T); bf16* W2T = (bf16*)(ws + WS_W2T); bf16* WINT = (bf16*)(ws + WS_WINT); bf16* WOUTT = (bf16*)(ws + WS_WOUTT);
    for (int it = gw; it < DEPTH * PER_L; it += NGW) {
        const int L = it / PER_L; int r = it % PER_L;
        if (r < 2 * I_W1) { const int i = r / I_W1; r %= I_W1; const size_t o = (size_t)(L * 2 + i) * DM * 2 * DFF; p0_transpose_item(I.ffn_w1 + o, DM, 2 * DFF, W1T + o, true, scr, r, lane); continue; } r -= 2 * I_W1;
        if (r < 2 * I_W2) { const int i = r / I_W2; r %= I_W2; const size_t o = (size_t)(L * 2 + i) * DFF * DM; p0_transpose_item(I.ffn_w2 + o, DFF, DM, W2T + o, false, scr, r, lane, true); continue; } r -= 2 * I_W2;
        if (r < I_WIN) { const size_t o = (size_t)L * DM * INC; p0_transpose_item(I.w_in + o, DM, INC, WINT + o, false, scr, r, lane); continue; } r -= I_WIN;
        { const size_t o = (size_t)L * DM * DM; p0_transpose_item(I.w_out + o, DM, DM, WOUTT + o, false, scr, r, lane); }
    }
    __syncthreads();
    LAS float* sc = (LAS float*)lds;
    LAS float* part = (LAS float*)(lds + 36864);
    float* mod = (float*)(ws + WS_MOD);
    for (int cb = blockIdx.x; cb < 256; cb += G) {
        for (int i = tid; i < 9 * 1024; i += 512) { const int mb = i >> 10, k = i & 1023; const float v = mb < 8 ? I.c[mb * 1024 + k] : I.c_ctx[k]; sc[i] = v * sigmoidf_(v); }
        __syncthreads();
        const int cc = tid % 72, kp = tid / 72, colg = cb * 72 + cc, L = colg / 9216, j = colg % 9216;
        if (kp < 7) {
            float acc[9];
#pragma unroll
            for (int mb = 0; mb < 9; ++mb) acc[mb] = 0.f;
            for (int k = kp; k < 1024; k += 7) { const float w = I.ada_w[((size_t)L * 1024 + k) * 9216 + j];
#pragma unroll
                for (int mb = 0; mb < 9; ++mb) acc[mb] += sc[mb * 1024 + k] * w; }
#pragma unroll
            for (int mb = 0; mb < 9; ++mb) part[(kp * 72 + cc) * 9 + mb] = acc[mb];
        }
        __syncthreads();
        for (int o = tid; o < 72 * 9; o += 512) { const int c2 = o / 9, mb = o % 9; const int colg2 = cb * 72 + c2, L2 = colg2 / 9216, j2 = colg2 % 9216;
            float s = I.ada_b[L2 * 9216 + j2];
#pragma unroll
            for (int p = 0; p < 7; ++p) s += part[(p * 72 + c2) * 9 + mb];
            mod[((size_t)L2 * 9 + mb) * 9216 + j2] = s; }
        __syncthreads();
    }
    { bf16* wsg = (bf16*)(ws + WS_WSG); for (int i = blockIdx.x * 512 + tid; i < DEPTH * 4 * 128 * 128 / 8; i += G * 512) { const f32x4 a = ((const f32x4*)I.sg_w)[2 * i], b = ((const f32x4*)I.sg_w)[2 * i + 1];
        v4u o; o.x = pk2(a.x, a.y); o.y = pk2(a.z, a.w); o.z = pk2(b.x, b.y); o.w = pk2(b.z, b.w); ((v4u*)wsg)[i] = o; } }
    if (blockIdx.x == (unsigned)(G - 1)) {
        float* tab = (float*)(ws + WS_ROPE);
        for (int i = tid; i < 128 * 16; i += 512) { const int n = i >> 4, f = i & 15; const float inv = exp2f(-(float)f * (13.287712379549449f / 16.0f)); const float ang = (float)n * inv;
            tab[2 * i] = cosf(ang); tab[2 * i + 1] = sinf(ang); }
    }
}

__device__ __forceinline__ void norm_phase(const float* xl, const float* xc, const bf16* xb, int nrows, const float* nw, const float* modL, int sidx, bf16* XN, int gw, int NGW, int lane) {
    const int rpw = (nrows + NGW - 1) / NGW; const int r0 = gw * rpw; int r1 = r0 + rpw; if (r1 > nrows) r1 = nrows;
    int cur = -1; f32x4 g[4], sh[4];
#pragma unroll
    for (int j = 0; j < 4; ++j) { g[j] = (f32x4){0.f, 0.f, 0.f, 0.f}; sh[j] = g[j]; }
#define NP_SRC(r) ((r) < TL ? xl + (size_t)(r) * DM : xc + (size_t)((r) - TL) * DM)
#define NP_LOAD(dst, r) do { if (xb) { const u32x2* sb_ = (const u32x2*)(xb + (size_t)(r) * DM); _Pragma("unroll") for (int j = 0; j < 4; ++j) { const u32x2 w_ = sb_[lane + 64 * j]; dst[j] = (f32x4){bflo(w_.x), bfhi(w_.x), bflo(w_.y), bfhi(w_.y)}; } } \
        else { const float* s_ = NP_SRC(r); _Pragma("unroll") for (int j = 0; j < 4; ++j) dst[j] = ((const f32x4*)s_)[lane + 64 * j]; } } while (0)
    f32x4 va[4], vb[4], vc[4];
    const int nr = (r1 - r0) * REP_NORM;
    if (nr > 0) NP_LOAD(va, r0);
    if (nr > 1) NP_LOAD(vb, r0 + 1 % (r1 - r0));
    for (int rr_ = 0; rr_ < nr; ++rr_) { const int r = r0 + rr_ % (r1 - r0);
        if (rr_ + 2 < nr) NP_LOAD(vc, r0 + (rr_ + 2) % (r1 - r0));
        const int mb = r < TL ? (r >> 13) : 8;
        if (mb != cur) { cur = mb; const float* sf = modL + (size_t)mb * 9216 + sidx * 1024; const float* sl = sf + 1024;
#pragma unroll
            for (int j = 0; j < 4; ++j) { const f32x4 w = ((const f32x4*)nw)[lane + 64 * j], s1 = ((const f32x4*)sl)[lane + 64 * j]; g[j] = w * (s1 + 1.0f); sh[j] = ((const f32x4*)sf)[lane + 64 * j]; } }
        float s = 0.f;
#pragma unroll
        for (int j = 0; j < 4; ++j) s += (va[j].x * va[j].x + va[j].y * va[j].y) + (va[j].z * va[j].z + va[j].w * va[j].w);
        const float rstd = 1.0f / sqrtf(wave_sum(s) * (1.0f / DM) + 1e-6f);
        unsigned long long* o8 = (unsigned long long*)(XN + (size_t)r * DM) + lane;
#pragma unroll
        for (int j = 0; j < 4; ++j) { const f32x4 y = va[j] * rstd * g[j] + sh[j]; o8[64 * j] = (unsigned long long)pk2(y.x, y.y) | ((unsigned long long)pk2(y.z, y.w) << 32); }
#pragma unroll
        for (int j = 0; j < 4; ++j) { va[j] = vb[j]; vb[j] = vc[j]; }
    }
#undef NP_SRC
#undef NP_LOAD
}

__device__ __forceinline__ void na_naive(const bf16* P, bf16* MIX, const float* wq, const float* wk, const float* rpb, bool with_ctx, int gtid, int nthreads) {
    float mq = 0.f, mk = 0.f, mr = 0.f;
    for (int d = 0; d < 64; ++d) { mq = fmaxf(mq, fabsf(wq[d])); mk = fmaxf(mk, fabsf(wk[d])); }
    for (int i = 0; i < 6 * 15 * 31; ++i) mr = fmaxf(mr, fabsf(rpb[i]));
    const float mbound = 8.0f * mq * mk + mr;
    const int nitems = (TL + (with_ctx ? TC : 0)) * 6;
    for (int item = gtid; item < nitems; item += nthreads) {
        int h, t; bool isctx;
        if (item < TL * 6) { h = item / TL; t = item % TL; isctx = false; } else { const int r = item - TL * 6; h = r / TC; t = TL + r % TC; isctx = true; }
        float q[64], o[64];
        { const bf16* qp = P + (size_t)t * INC + C_NAQ + h * 64; float ss = 0.f;
#pragma unroll
          for (int d8 = 0; d8 < 8; ++d8) { load8(qp + d8 * 8, q + d8 * 8); }
#pragma unroll
          for (int d = 0; d < 64; ++d) ss += q[d] * q[d];
          const float rstd = 1.0f / sqrtf(ss * (1.0f / 64.0f) + 1e-6f);
#pragma unroll
          for (int d = 0; d < 64; ++d) { q[d] = q[d] * rstd * wq[d] * wk[d] * 0.125f; o[d] = 0.f; } }
        float l = 0.f;
        int b, nloc, r = 0, c = 0, rs = 0, cs = 0;
        if (!isctx) { b = t >> 13; const int pos = t & 8191; r = pos >> 6; c = pos & 63; rs = min(max(r - 4, 0), 120); cs = min(max(c - 8, 0), 48); nloc = 128; }
        else { b = (t - TL) >> 8; nloc = 0; }
        for (int kk = 0; kk < nloc + 256; ++kk) {
            int tk; float bias = 0.f;
            if (kk < nloc) { const int i = kk >> 4, j = kk & 15; tk = b * SEQ + (rs + i) * 64 + cs + j; bias = rpb[(h * 15 + (rs + i - r + 7)) * 31 + (cs + j - c + 15)]; }
            else tk = TL + b * CTXL + (kk - nloc);
            const bf16* kp = P + (size_t)tk * INC + C_NAK + h * 64; const bf16* vp = P + (size_t)tk * INC + C_NAV + h * 64;
            float dot = 0.f, ss = 0.f;
#pragma unroll
            for (int d8 = 0; d8 < 8; ++d8) { float k8[8]; load8(kp + d8 * 8, k8);
#pragma unroll
                for (int e = 0; e < 8; ++e) { dot += q[d8 * 8 + e] * k8[e]; ss += k8[e] * k8[e]; } }
            const float s = dot / sqrtf(ss * (1.0f / 64.0f) + 1e-6f) + bias;
            const float p = __expf(s - mbound); l += p;
#pragma unroll
            for (int d8 = 0; d8 < 8; ++d8) { float v8[8]; load8(vp + d8 * 8, v8);
#pragma unroll
                for (int e = 0; e < 8; ++e) o[d8 * 8 + e] += p * v8[e]; }
        }
        const float il = 1.0f / l; bf16* op = MIX + (size_t)t * DM + M_NA + h * 64;
#pragma unroll
        for (int d8 = 0; d8 < 8; ++d8) { float t8[8];
#pragma unroll
            for (int e = 0; e < 8; ++e) t8[e] = o[d8 * 8 + e] * il;
            store8(op + d8 * 8, t8); }
    }
}

__device__ __forceinline__ void sg_naive(const bf16* P, bf16* MIX, const float* sgw, const float* sgb, const float* lnw, const float* lnb, LAS unsigned char* lds, int tid, int G) {
    LAS float* vn = (LAS float*)lds;
    const int tok = tid >> 2, part = tid & 3;
    for (int it = blockIdx.x; it < NCH * 4; it += G) {
        const int ch = it >> 2, g = it & 3, row0 = ch * 128;
        { const bf16* src = P + (size_t)(row0 + tok) * INC + C_SGV + g * 64 + part * 16; float v[16]; load8(src, v); load8(src + 8, v + 8);
          float s = 0.f;
#pragma unroll
          for (int k = 0; k < 16; ++k) { v[k] = gelu_tanh(v[k]); s += v[k]; }
          s += SHX(s, 1); s += SHX(s, 2); const float mu = s * (1.0f / 64.0f); float q = 0.f;
#pragma unroll
          for (int k = 0; k < 16; ++k) { v[k] -= mu; q += v[k] * v[k]; }
          q += SHX(q, 1); q += SHX(q, 2); const float rstd = 1.0f / sqrtf(q * (1.0f / 64.0f) + 1e-5f);
#pragma unroll
          for (int k = 0; k < 16; ++k) { const int cch = g * 64 + part * 16 + k; vn[tok * 64 + part * 16 + k] = v[k] * rstd * lnw[cch] + lnb[cch]; } }
        __syncthreads();
        { float acc[16];
#pragma unroll
          for (int k = 0; k < 16; ++k) acc[k] = 0.f;
          const float* wrow = sgw + ((size_t)g * 128 + tok) * 128;
          for (int q = 0; q < 128; ++q) { const float w = wrow[q];
#pragma unroll
              for (int k = 0; k < 16; ++k) acc[k] += w * vn[q * 64 + part * 16 + k]; }
          const float bias = sgb[g * 128 + tok];
          const bf16* up = P + (size_t)(row0 + tok) * INC + C_SGU + g * 64 + part * 16; float u[16]; load8(up, u); load8(up + 8, u + 8);
#pragma unroll
          for (int k = 0; k < 16; ++k) u[k] = gelu_tanh(u[k]) * (acc[k] + bias);
          bf16* op = MIX + (size_t)(row0 + tok) * DM + M_SG + g * 64 + part * 16; store8(op, u); store8(op + 8, u + 8); }
        __syncthreads();
    }
}

__device__ __forceinline__ void rope_load16(const bf16* P, int row, int colbase, int h, int part, bool latent, const float* ropetab, float* out) {
    const bf16* base = P + (size_t)row * INC + colbase + h * 64;
    float mine[16]; load8(base + part * 16, mine); load8(base + part * 16 + 8, mine + 8);
    if (!latent) {
#pragma unroll
        for (int f = 0; f < 16; ++f) out[f] = mine[f];
        return; }
    float oth[16]; load8(base + (part ^ 1) * 16, oth); load8(base + (part ^ 1) * 16 + 8, oth + 8);
    const int pos = row & (SEQ - 1); const int n = (part < 2) ? (pos >> 6) : (pos & 63);
    const float* tb = ropetab + n * 32;
#pragma unroll
    for (int f = 0; f < 16; ++f) { const float cs = tb[2 * f], sn = tb[2 * f + 1]; out[f] = (part & 1) ? (oth[f] * sn + mine[f] * cs) : (mine[f] * cs - oth[f] * sn); }
}
__device__ __forceinline__ void ret_kv_naive(const bf16* P, float* KV, const float* logit, const float* ropetab, LAS unsigned char* lds, int tid, int G) {
    LAS float* kS = (LAS float*)lds; LAS float* vS = kS + 128 * 64; LAS float* wt = vS + 128 * 64;
    const int tok = tid >> 2, part = tid & 3;
    for (int it = blockIdx.x; it < NCH * 6; it += G) {
        const int ch = it / 6, h = it % 6, row0 = ch * 128; const bool latent = ch < NCHL;
        { float k16[16]; rope_load16(P, row0 + tok, C_RK, h, part, latent, ropetab, k16);
#pragma unroll
          for (int f = 0; f < 16; ++f) kS[tok * 64 + part * 16 + f] = k16[f] * 0.125f;
          const bf16* vp = P + (size_t)(row0 + tok) * INC + C_RV + h * 64 + part * 16; float v16[16]; load8(vp, v16); load8(vp + 8, v16 + 8);
#pragma unroll
          for (int f = 0; f < 16; ++f) vS[tok * 64 + part * 16 + f] = v16[f]; }
        if (tid < 256) { const int dir = tid >> 7, j = tid & 127; const float lg = log_sigmoid(logit[dir * 6 + h]); wt[tid] = expf(lg * (float)(dir == 0 ? 127 - j : j)); }
        __syncthreads();
        { const int d = tid >> 3, e0 = (tid & 7) * 8; float af[8], ab[8];
#pragma unroll
          for (int k = 0; k < 8; ++k) { af[k] = 0.f; ab[k] = 0.f; }
          for (int j = 0; j < 128; ++j) { const float kd = kS[j * 64 + d]; const float a = kd * wt[j], b = kd * wt[128 + j];
#pragma unroll
              for (int k = 0; k < 8; ++k) { const float v = vS[j * 64 + e0 + k]; af[k] += a * v; ab[k] += b * v; } }
          float* of = KV + ((size_t)(ch * 6 + h) * 2 + 0) * 4096 + d * 64 + e0; float* ob = of + 4096;
#pragma unroll
          for (int k = 0; k < 8; ++k) { of[k] = af[k]; ob[k] = ab[k]; } }
        __syncthreads();
    }
}
__device__ __forceinline__ void ret_scan(const float* KV, float* PREV, const float* logit, int gtid, int nthreads) {
    for (int it = gtid; it < NB * 6 * 2 * 4096; it += nthreads) {
        const int idx = it & 4095, dir = (it >> 12) & 1, bh = it >> 13, h = bh % 6, b = bh / 6;
        const float cd = expf(128.0f * log_sigmoid(logit[dir * 6 + h]));
#define KVI(ch) (((size_t)((ch) * 6 + h) * 2 + dir) * 4096 + idx)
        const int c0 = NCHL + 2 * b, c1 = c0 + 1;
        const float k0 = KV[KVI(c0)], k1 = KV[KVI(c1)];
        if (dir == 0) { PREV[KVI(c0)] = 0.f; PREV[KVI(c1)] = k0; float s = cd * k0 + k1;
            for (int n = 0; n < 64; ++n) { const int ch = b * 64 + n; PREV[KVI(ch)] = s; s = cd * s + KV[KVI(ch)]; } }
        else { PREV[KVI(c0)] = k1; PREV[KVI(c1)] = 0.f; float s = k0 + cd * k1;
            for (int n = 63; n >= 0; --n) { const int ch = b * 64 + n; PREV[KVI(ch)] = s; s = cd * s + KV[KVI(ch)]; } }
#undef KVI
    }
}
__device__ __forceinline__ void ret_out_naive(const bf16* P, const float* PREV, bf16* MIX, const float* logit, const float* gnw, const float* ropetab, LAS unsigned char* lds, int tid, int G) {
    LAS bf16* qS = (LAS bf16*)lds; LAS bf16* kS = qS + 128 * 64; LAS bf16* vS = kS + 128 * 64;
    LAS float* S = (LAS float*)(lds + 49152);
    LAS float* dec = (LAS float*)(lds + 49152 + 65536);
    const int tok = tid >> 2, part = tid & 3;
    for (int it = blockIdx.x; it < NCH * 6; it += G) {
        const int ch = it / 6, h = it % 6, row0 = ch * 128; const bool latent = ch < NCHL;
        { float t16[16]; rope_load16(P, row0 + tok, C_RQ, h, part, latent, ropetab, t16);
#pragma unroll
          for (int f = 0; f < 16; ++f) qS[tok * 64 + part * 16 + f] = (bf16)f2bf(t16[f]);
          rope_load16(P, row0 + tok, C_RK, h, part, latent, ropetab, t16);
#pragma unroll
          for (int f = 0; f < 16; ++f) kS[tok * 64 + part * 16 + f] = (bf16)f2bf(t16[f] * 0.125f);
          const bf16* vp = P + (size_t)(row0 + tok) * INC + C_RV + h * 64 + part * 16; const v4u a = *(const v4u*)vp, b = *(const v4u*)(vp + 8);
          *(LAS v4u*)(vS + tok * 64 + part * 16) = a; *(LAS v4u*)(vS + tok * 64 + part * 16 + 8) = b; }
        if (tid < 258) { const int dir = tid / 129, k = tid % 129; dec[tid] = expf(log_sigmoid(logit[dir * 6 + h]) * (float)k); }
        __syncthreads();
        { float q[64];
#pragma unroll
          for (int d = 0; d < 64; ++d) q[d] = __uint_as_float((unsigned)qS[tok * 64 + d] << 16);
          for (int jj = 0; jj < 32; ++jj) { const int j = part + 4 * jj; float dot = 0.f;
#pragma unroll
              for (int d = 0; d < 64; ++d) dot += q[d] * __uint_as_float((unsigned)kS[j * 64 + d] << 16);
              S[tok * 128 + j] = dot; } }
        __syncthreads();
        { const int i = tok, e0 = part * 16; float of[16], ob[16], cf[16], cb[16];
#pragma unroll
          for (int k = 0; k < 16; ++k) { of[k] = 0.f; ob[k] = 0.f; cf[k] = 0.f; cb[k] = 0.f; }
          for (int j = 0; j < 128; ++j) { const float s = S[i * 128 + j]; const float wf = (j <= i) ? s * dec[i - j] : 0.f, wb = (j >= i) ? s * dec[129 + j - i] : 0.f;
#pragma unroll
              for (int k = 0; k < 16; ++k) { const float v = __uint_as_float((unsigned)vS[j * 64 + e0 + k] << 16); of[k] += wf * v; ob[k] += wb * v; } }
          const float* pf = PREV + ((size_t)(ch * 6 + h) * 2) * 4096 + e0; const float* pb = pf + 4096;
          for (int d = 0; d < 64; ++d) { const float qd = __uint_as_float((unsigned)qS[i * 64 + d] << 16);
#pragma unroll
              for (int k = 0; k < 16; ++k) { cf[k] += qd * pf[d * 64 + k]; cb[k] += qd * pb[d * 64 + k]; } }
          const float df = dec[i + 1], db = dec[129 + 128 - i];
          float sf = 0.f, sb = 0.f;
#pragma unroll
          for (int k = 0; k < 16; ++k) { of[k] += df * cf[k]; ob[k] += db * cb[k]; sf += of[k]; sb += ob[k]; }
          sf += SHX(sf, 1); sf += SHX(sf, 2); sb += SHX(sb, 1); sb += SHX(sb, 2);
          const float muf = sf * (1.0f / 64.0f), mub = sb * (1.0f / 64.0f); float qf = 0.f, qb = 0.f;
#pragma unroll
          for (int k = 0; k < 16; ++k) { of[k] -= muf; ob[k] -= mub; qf += of[k] * of[k]; qb += ob[k] * ob[k]; }
          qf += SHX(qf, 1); qf += SHX(qf, 2); qb += SHX(qb, 1); qb += SHX(qb, 2);
          const float rf = 1.0f / sqrtf(qf * (1.0f / 64.0f) + 1e-5f), rb = 1.0f / sqrtf(qb * (1.0f / 64.0f) + 1e-5f);
          const bf16* gp = P + (size_t)(row0 + i) * INC + C_GF + h * 64 + e0; float gf[16], gb[16]; load8(gp, gf); load8(gp + 8, gf + 8); load8(gp + (C_GB - C_GF), gb); load8(gp + (C_GB - C_GF) + 8, gb + 8);
          float y[16];
#pragma unroll
          for (int k = 0; k < 16; ++k) y[k] = (of[k] * rf * (gf[k] * sigmoidf_(gf[k])) + ob[k] * rb * (gb[k] * sigmoidf_(gb[k]))) * gnw[h * 64 + e0 + k];
          bf16* op = MIX + (size_t)(row0 + i) * DM + M_RET + h * 64 + e0; store8(op, y); store8(op + 8, y + 8); }
        __syncthreads();
    }
}
#ifndef REP_KV
#define REP_KV 1
#endif
#ifndef REP_RETO
#define REP_RETO 1
#endif

typedef short s16x4 __attribute__((ext_vector_type(4)));
typedef float f32x16 __attribute__((ext_vector_type(16)));
typedef float f32x2_t __attribute__((ext_vector_type(2)));
typedef __bf16 bf16x2_t __attribute__((ext_vector_type(2)));
#define MFMA32(a, b, c) __builtin_amdgcn_mfma_f32_32x32x16_bf16((a), (b), (c), 0, 0, 0)
#define LOG2E 1.4426950408889634f
#define LDS_BARRIER() do { asm volatile("s_waitcnt lgkmcnt(0)" ::: "memory"); __builtin_amdgcn_s_barrier(); asm volatile("" ::: "memory"); } while (0)
#define OPQV(x) ({ int _t = (x); asm volatile("" : "+v"(_t)); _t; })
#define FRESH_TID(w) ({ int _t; asm volatile("v_mbcnt_lo_u32_b32 %0, -1, 0\n\tv_mbcnt_hi_u32_b32 %0, -1, %0" : "=v"(_t)); _t | ((w) << 6); })
__device__ __forceinline__ unsigned cvtpk(float lo, float hi) { f32x2_t v = {lo, hi}; bf16x2_t b = __builtin_convertvector(v, bf16x2_t); return __builtin_bit_cast(unsigned, b); }
__device__ __forceinline__ int crow0(int reg) { return (reg & 3) + 8 * (reg >> 2); }
__device__ __forceinline__ int swz64(int row) { return (((row >> 1) & 1) << 2) | (((row >> 3) & 1) << 1) | ((row >> 2) & 1); }
__device__ __forceinline__ int off64(int row, int ch) { return 128 * row + 16 * (ch ^ swz64(row)); }
__device__ __forceinline__ bf16x8 rowfrag(LAS unsigned char* img, int row, int ch) { return *(const LAS bf16x8*)(img + off64(row, ch)); }
__device__ __forceinline__ s16x4 tr4(LAS unsigned char* img, int krow, int ct, int lane) {
    const int q = (lane & 15) >> 2, p = lane & 3, blk = (lane >> 4) & 1;
    return __builtin_bit_cast(s16x4, __builtin_amdgcn_ds_read_tr16_b64_v4i16((LAS s16x4*)(img + off64(krow + q, 4 * ct + 2 * blk + (p >> 1)) + 8 * (p & 1))));
}
__device__ __forceinline__ bf16x8 trfrag(LAS unsigned char* img, int krow_lo, int krow_hi, int ct, int lane) {
    const s16x4 lo = tr4(img, krow_lo, ct, lane), hi = tr4(img, krow_hi, ct, lane);
    return (bf16x8){lo[0], lo[1], lo[2], lo[3], hi[0], hi[1], hi[2], hi[3]};
}
__device__ __forceinline__ void st_chunk(LAS unsigned char* img, int row, int ch, const float* v8) {
    v4u w; w.x = cvtpk(v8[0], v8[1]); w.y = cvtpk(v8[2], v8[3]); w.z = cvtpk(v8[4], v8[5]); w.w = cvtpk(v8[6], v8[7]); *(LAS v4u*)(img + off64(row, ch)) = w;
}
#define PACK8(x, s) __builtin_bit_cast(bf16x8, (v4u){cvtpk((x)[8 * (s)], (x)[8 * (s) + 1]), cvtpk((x)[8 * (s) + 2], (x)[8 * (s) + 3]), cvtpk((x)[8 * (s) + 4], (x)[8 * (s) + 5]), cvtpk((x)[8 * (s) + 6], (x)[8 * (s) + 7])})
__device__ __forceinline__ f32x16 zero16() { f32x16 z;
#pragma unroll
    for (int i = 0; i < 16; ++i) z[i] = 0.f;
    return z; }
__device__ __forceinline__ float wave_max(float v) { v = fmaxf(v, SHX(v, 1)); v = fmaxf(v, SHX(v, 2)); v = fmaxf(v, SHX(v, 4)); v = fmaxf(v, SHX(v, 8)); v = fmaxf(v, SHX(v, 16)); return xhalf_max(v); }

__device__ __forceinline__ void na_mfma(const bf16* P, bf16* MIX, const float* wq, const float* wk, const float* rpb, bool with_ctx, LAS unsigned char* lds, int tid_in, int G) {
    const int wave = __builtin_amdgcn_readfirstlane(tid_in >> 6); int tid = tid_in, lane = tid & 63;
    LAS unsigned char* Kimg = lds; LAS unsigned char* Vimg = lds + 16384;
    LAS float* tab = (LAS float*)(lds + 32768) + 64;
    const float mq = wave_max(fabsf(wq[lane])), mk = wave_max(fabsf(wk[lane]));
    const int nunits = NB * 6 * 32 + (with_ctx ? NB * 6 : 0);
    for (int u = blockIdx.x; u < nunits; u += G) {
        tid = FRESH_TID(wave); lane = tid & 63; const int r32 = lane & 31, hh = lane >> 5;
        const int skey = tid >> 3, spart = tid & 7;
        float wk8[8];
#pragma unroll
        for (int j = 0; j < 8; ++j) wk8[j] = wk[8 * spart + j];
        const bool isctx = u >= NB * 6 * 32; int b, h, r0 = 0;
        if (!isctx) { b = u / 192; h = (u >> 5) % 6; r0 = 4 * (u & 31); } else { const int v = u - NB * 6 * 32; b = v / 6; h = v % 6; }
        float mr = 0.f;
        for (int i = lane; i < 465; i += 64) mr = fmaxf(mr, fabsf(rpb[h * 465 + i]));
        mr = wave_max(mr);
        const float mbound = 8.0f * mq * mk + mr, negmb = -mbound * LOG2E;
        if (!isctx) for (int i = tid; i < 465; i += 512) tab[i] = (rpb[h * 465 + i] - mbound) * LOG2E;
        int r = 0, c = 0, tq;
        if (!isctx) { r = r0 + (wave >> 1); c = 32 * (wave & 1) + r32; tq = b * SEQ + r * 64 + c; } else tq = TL + b * CTXL + wave * 32 + r32;
        bf16x8 qf[4];
        { float qv[32]; float ss = 0.f; const bf16* qp = P + (size_t)tq * INC + C_NAQ + h * 64 + 8 * hh;
#pragma unroll
          for (int s = 0; s < 4; ++s) load8(qp + 16 * s, qv + 8 * s);
#pragma unroll
          for (int i = 0; i < 32; ++i) ss += qv[i] * qv[i];
          ss = xhalf_sum(ss);
          const float rstd = (1.0f / sqrtf(ss * (1.0f / 64.0f) + 1e-6f)) * (0.125f * LOG2E);
#pragma unroll
          for (int s = 0; s < 4; ++s) { float t8[8];
#pragma unroll
              for (int j = 0; j < 8; ++j) { const int d = 16 * s + 8 * hh + j; t8[j] = qv[8 * s + j] * rstd * wq[d] * wk[d]; }
              qf[s] = __builtin_bit_cast(bf16x8, (v4u){cvtpk(t8[0], t8[1]), cvtpk(t8[2], t8[3]), cvtpk(t8[4], t8[5]), cvtpk(t8[6], t8[7])}); } }
        const int rs0 = min(max(r0 - 4, 0), 120);
        const int nl = isctx ? 0 : (min(max(r0 + 3 - 4, 0), 120) + 8 - rs0), nchunks = nl + 4;
        const int rs = min(max(r - 4, 0), 120);
#define NA_TOK(ci) ((ci) < nl ? b * SEQ + (rs0 + (ci)) * 64 + skey : TL + b * CTXL + ((ci) - nl) * 64 + skey)
#define NA_STAGE(buf, kw, vw) do { float k8[8]; k8[0] = bflo(kw.x); k8[1] = bfhi(kw.x); k8[2] = bflo(kw.y); k8[3] = bfhi(kw.y); k8[4] = bflo(kw.z); k8[5] = bfhi(kw.z); k8[6] = bflo(kw.w); k8[7] = bfhi(kw.w); \
            float ss_ = 0.f; _Pragma("unroll") for (int j = 0; j < 8; ++j) ss_ += k8[j] * k8[j]; \
            ss_ += SHX(ss_, 1); ss_ += SHX(ss_, 2); ss_ += SHX(ss_, 4); \
            const float rk_ = 1.0f / sqrtf(ss_ * (1.0f / 64.0f) + 1e-6f); \
            _Pragma("unroll") for (int j = 0; j < 8; ++j) k8[j] *= rk_ * wk8[j]; \
            st_chunk(Kimg + (buf) * 8192, skey, spart, k8); *(LAS v4u*)(Vimg + (buf) * 8192 + off64(skey, spart)) = vw; } while (0)
        v4u kw, vw;
        { const bf16* src = P + (size_t)NA_TOK(0) * INC + h * 64 + 8 * spart; kw = *(const v4u*)(src + C_NAK); vw = *(const v4u*)(src + C_NAV); }
        NA_STAGE(0, kw, vw);
        __syncthreads();
        f32x16 o0 = zero16(), o1 = zero16(); float lsum = 0.f;
        for (int ci = 0; ci < nchunks; ++ci) {
            const int buf = ci & 1;
            if (ci + 1 < nchunks) { const bf16* src = P + (size_t)NA_TOK(ci + 1) * INC + h * 64 + 8 * spart; kw = *(const v4u*)(src + C_NAK); vw = *(const v4u*)(src + C_NAV); }
            const bool local = ci < nl; const int kr = rs0 + ci;
            const bool active = local ? (kr >= rs && kr < rs + 8) : true;
            if (active) {
                const int c_o = OPQV(c), cs_o = min(max(c_o - 8, 0), 48);
                const int lane_c = OPQV(lane), r32c = lane_c & 31, hhc = lane_c >> 5;
                LAS unsigned char* Kb = Kimg + buf * 8192; LAS unsigned char* Vb = Vimg + buf * 8192;
#pragma unroll
                for (int kt = 0; kt < 2; ++kt) {
                    f32x16 x;
                    if (local) { const int bidx = (kr - r + 7) * 31 + 32 * kt + 4 * hhc - c_o + 15, t0 = 32 * kt + 4 * hhc - cs_o;
#pragma unroll
                        for (int i = 0; i < 16; ++i) { const float tv = tab[bidx + crow0(i)]; x[i] = ((unsigned)(t0 + crow0(i)) < 16u) ? tv : -INFINITY; } }
                    else {
#pragma unroll
                        for (int i = 0; i < 16; ++i) x[i] = negmb; }
#pragma unroll
                    for (int s = 0; s < 4; ++s) x = MFMA32(rowfrag(Kb, 32 * kt + r32c, 2 * s + hhc), qf[s], x);
#pragma unroll
                    for (int i = 0; i < 16; ++i) { x[i] = __builtin_amdgcn_exp2f(x[i]); lsum += x[i]; }
                    const bf16x8 pa0 = PACK8(x, 0), pa1 = PACK8(x, 1);
                    o0 = MFMA32(trfrag(Vb, 32 * kt + 4 * hhc, 32 * kt + 8 + 4 * hhc, 0, lane_c), pa0, o0);
                    o0 = MFMA32(trfrag(Vb, 32 * kt + 16 + 4 * hhc, 32 * kt + 24 + 4 * hhc, 0, lane_c), pa1, o0);
                    o1 = MFMA32(trfrag(Vb, 32 * kt + 4 * hhc, 32 * kt + 8 + 4 * hhc, 1, lane_c), pa0, o1);
                    o1 = MFMA32(trfrag(Vb, 32 * kt + 16 + 4 * hhc, 32 * kt + 24 + 4 * hhc, 1, lane_c), pa1, o1);
                }
            }
            if (ci + 1 < nchunks) NA_STAGE(buf ^ 1, kw, vw);
            __syncthreads();
        }
#undef NA_TOK
#undef NA_STAGE
        lsum = xhalf_sum(lsum);
        const float il = 1.0f / lsum; bf16* op = MIX + (size_t)tq * DM + M_NA + h * 64 + 4 * hh;
#pragma unroll
        for (int g4 = 0; g4 < 4; ++g4) {
            u32x2 w0; w0.x = cvtpk(o0[4 * g4] * il, o0[4 * g4 + 1] * il); w0.y = cvtpk(o0[4 * g4 + 2] * il, o0[4 * g4 + 3] * il); *(u32x2*)(op + 8 * g4) = w0;
            u32x2 w1; w1.x = cvtpk(o1[4 * g4] * il, o1[4 * g4 + 1] * il); w1.y = cvtpk(o1[4 * g4 + 2] * il, o1[4 * g4 + 3] * il); *(u32x2*)(op + 32 + 8 * g4) = w1; }
    }
}

__device__ __forceinline__ void sg_mfma(const bf16* P, bf16* MIX, const bf16* Wsg, const float* sgb, const float* lnw, const float* lnb, LAS unsigned char* lds, int tid_in, int G) {
    const int wave = __builtin_amdgcn_readfirstlane(tid_in >> 6);
    for (int ch = blockIdx.x; ch < NCH; ch += G) {
        const int tid = FRESH_TID(wave), lane = tid & 63, r32 = lane & 31, hh = lane >> 5, tok = tid >> 2, sg = tid & 3;
        const int row0 = ch * 128;
        { const bf16* src = P + (size_t)(row0 + tok) * INC + C_SGV + sg * 64; float v[64]; float s = 0.f;
#pragma unroll
          for (int k8 = 0; k8 < 8; ++k8) load8(src + 8 * k8, v + 8 * k8);
#pragma unroll
          for (int k = 0; k < 64; ++k) { v[k] = gelu_tanh(v[k]); s += v[k]; }
          const float mu = s * (1.0f / 64.0f); float q = 0.f;
#pragma unroll
          for (int k = 0; k < 64; ++k) { v[k] -= mu; q += v[k] * v[k]; }
          const float rstd = __builtin_amdgcn_rsqf(q * (1.0f / 64.0f) + 1e-5f);
#pragma unroll
          for (int k8 = 0; k8 < 8; ++k8) { float t8[8];
#pragma unroll
              for (int j = 0; j < 8; ++j) { const int cch = sg * 64 + 8 * k8 + j; t8[j] = v[8 * k8 + j] * rstd * lnw[cch] + lnb[cch]; }
              st_chunk(lds + sg * 16384, tok, k8, t8); } }
        __syncthreads();
        { const int g = wave >> 1; LAS unsigned char* img = lds + g * 16384;
#pragma unroll
          for (int pp = 0; pp < 2; ++pp) { const int pt = 2 * (wave & 1) + pp, p = 32 * pt + r32;
            f32x16 a0 = zero16(), a1 = zero16();
            const bf16* wrow = Wsg + ((size_t)g * 128 + p) * 128 + 8 * hh;
#pragma unroll
            for (int ks = 0; ks < 8; ++ks) { const bf16x8 wf = *(const bf16x8*)(wrow + 16 * ks);
                a0 = MFMA32(trfrag(img, 16 * ks + 8 * hh, 16 * ks + 8 * hh + 4, 0, lane), wf, a0);
                a1 = MFMA32(trfrag(img, 16 * ks + 8 * hh, 16 * ks + 8 * hh + 4, 1, lane), wf, a1); }
            const float bias = sgb[g * 128 + p]; const size_t trow = (size_t)(row0 + p);
            const bf16* up = P + trow * INC + C_SGU + g * 64 + 4 * hh; bf16* op = MIX + trow * DM + M_SG + g * 64 + 4 * hh;
#pragma unroll
            for (int g4 = 0; g4 < 4; ++g4) {
                const u32x2 u0 = *(const u32x2*)(up + 8 * g4), u1 = *(const u32x2*)(up + 32 + 8 * g4);
                u32x2 w0, w1;
                w0.x = cvtpk(gelu_tanh(bflo(u0.x)) * (a0[4 * g4] + bias), gelu_tanh(bfhi(u0.x)) * (a0[4 * g4 + 1] + bias)); w0.y = cvtpk(gelu_tanh(bflo(u0.y)) * (a0[4 * g4 + 2] + bias), gelu_tanh(bfhi(u0.y)) * (a0[4 * g4 + 3] + bias));
                w1.x = cvtpk(gelu_tanh(bflo(u1.x)) * (a1[4 * g4] + bias), gelu_tanh(bfhi(u1.x)) * (a1[4 * g4 + 1] + bias)); w1.y = cvtpk(gelu_tanh(bflo(u1.y)) * (a1[4 * g4 + 2] + bias), gelu_tanh(bfhi(u1.y)) * (a1[4 * g4 + 3] + bias));
                *(u32x2*)(op + 8 * g4) = w0; *(u32x2*)(op + 32 + 8 * g4) = w1; asm volatile("" ::: "memory"); } } }
        __syncthreads();
    }
}

__device__ __forceinline__ void ret_kv_mfma(const bf16* P, float* KV, const float* logit, const float* ropetab, LAS unsigned char* lds, int tid_in, int G) {
    const int wave = __builtin_amdgcn_readfirstlane(tid_in >> 6);
    LAS unsigned char* Kf = lds; LAS unsigned char* Kb = lds + 16384; LAS unsigned char* Vi = lds + 32768;
    for (int it_r = blockIdx.x; it_r < NCH * 6 * REP_KV; it_r += G) { const int it = it_r % (NCH * 6);
        const int tid = FRESH_TID(wave), lane = tid & 63, r32 = lane & 31, hh = lane >> 5, tok = tid >> 2, part = tid & 3;
        const int ch = it / 6, h = it % 6, row0 = ch * 128; const bool latent = ch < NCHL;
        { const float lgf = log_sigmoid(logit[h]) * LOG2E, lgb = log_sigmoid(logit[6 + h]) * LOG2E;
          const float wf = __builtin_amdgcn_exp2f(lgf * (float)(127 - tok)) * 0.125f, wb = __builtin_amdgcn_exp2f(lgb * (float)tok) * 0.125f;
          float k16[16], t8[8]; rope_load16(P, row0 + tok, C_RK, h, part, latent, ropetab, k16);
#pragma unroll
          for (int c2 = 0; c2 < 2; ++c2) {
#pragma unroll
              for (int j = 0; j < 8; ++j) t8[j] = k16[8 * c2 + j] * wf;
              st_chunk(Kf, tok, 2 * part + c2, t8);
#pragma unroll
              for (int j = 0; j < 8; ++j) t8[j] = k16[8 * c2 + j] * wb;
              st_chunk(Kb, tok, 2 * part + c2, t8); }
          const bf16* vp = P + (size_t)(row0 + tok) * INC + C_RV + h * 64 + part * 16;
          *(LAS v4u*)(Vi + off64(tok, 2 * part)) = *(const v4u*)vp; *(LAS v4u*)(Vi + off64(tok, 2 * part + 1)) = *(const v4u*)(vp + 8); }
        __syncthreads();
        { const int dir = wave >> 2, et = (wave >> 1) & 1, dt = wave & 1; LAS unsigned char* Kd = dir ? Kb : Kf;
          f32x16 acc = zero16();
#pragma unroll
          for (int ks = 0; ks < 8; ++ks)
              acc = MFMA32(trfrag(Vi, 16 * ks + 8 * hh, 16 * ks + 8 * hh + 4, et, lane), trfrag(Kd, 16 * ks + 8 * hh, 16 * ks + 8 * hh + 4, dt, lane), acc);
          float* o = KV + ((size_t)(ch * 6 + h) * 2 + dir) * 4096 + (size_t)(32 * et + 4 * hh) * 64 + 32 * dt + r32;
#pragma unroll
          for (int i = 0; i < 16; ++i) o[crow0(i) * 64] = acc[i]; }
        __syncthreads();
    }
}
__device__ __forceinline__ void ret_scan2(const float* KV, bf16* PREV, const float* logit, int gtid, int nthreads) {
    for (int it = gtid; it < NB * 6 * 2 * 4096; it += nthreads) {
        const int idx = it & 4095, dir = (it >> 12) & 1, bh = it >> 13, h = bh % 6, b = bh / 6;
        const float cd = expf(128.0f * log_sigmoid(logit[dir * 6 + h]));
#define KVI(ch) (((size_t)((ch) * 6 + h) * 2 + dir) * 4096 + idx)
        const int c0 = NCHL + 2 * b, c1 = c0 + 1;
        const float k0 = KV[KVI(c0)], k1 = KV[KVI(c1)];
        if (dir == 0) { PREV[KVI(c0)] = 0; PREV[KVI(c1)] = (bf16)f2bf(k0); float s = cd * k0 + k1;
            for (int n = 0; n < 64; ++n) { const int ch = b * 64 + n; PREV[KVI(ch)] = (bf16)f2bf(s); s = cd * s + KV[KVI(ch)]; } }
        else { PREV[KVI(c0)] = (bf16)f2bf(k1); PREV[KVI(c1)] = 0; float s = k0 + cd * k1;
            for (int n = 63; n >= 0; --n) { const int ch = b * 64 + n; PREV[KVI(ch)] = (bf16)f2bf(s); s = cd * s + KV[KVI(ch)]; } }
#undef KVI
    }
}
__device__ __forceinline__ void ret_out_mfma(const bf16* P, const bf16* PREV, bf16* MIX, const float* logit, const float* gnw, const float* ropetab, LAS unsigned char* lds, int tid_in, int G) {
    const int wave = __builtin_amdgcn_readfirstlane(tid_in >> 6);
    LAS unsigned char* Qi = lds; LAS unsigned char* Ki = lds + 16384; LAS unsigned char* Vi = lds + 32768;
    LAS float* st = (LAS float*)(lds + 49152);
    const int it_ = wave >> 1, et = wave & 1;
    for (int itm_r = blockIdx.x; itm_r < NCH * 6 * REP_RETO; itm_r += G) { const int itm = itm_r % (NCH * 6);
        const int tid = FRESH_TID(wave), lane = tid & 63, r32 = lane & 31, hh = lane >> 5, tok = tid >> 2, part = tid & 3;
        const int ch = itm / 6, h = itm % 6, row0 = ch * 128; const bool latent = ch < NCHL;
        { float t16[16], t8[8]; rope_load16(P, row0 + tok, C_RQ, h, part, latent, ropetab, t16);
          st_chunk(Qi, tok, 2 * part, t16); st_chunk(Qi, tok, 2 * part + 1, t16 + 8);
          rope_load16(P, row0 + tok, C_RK, h, part, latent, ropetab, t16);
#pragma unroll
          for (int c2 = 0; c2 < 2; ++c2) {
#pragma unroll
              for (int j = 0; j < 8; ++j) t8[j] = t16[8 * c2 + j] * 0.125f;
              st_chunk(Ki, tok, 2 * part + c2, t8); }
          const bf16* vp = P + (size_t)(row0 + tok) * INC + C_RV + h * 64 + part * 16;
          *(LAS v4u*)(Vi + off64(tok, 2 * part)) = *(const v4u*)vp; *(LAS v4u*)(Vi + off64(tok, 2 * part + 1)) = *(const v4u*)(vp + 8); }
        __syncthreads();
        const float lgf = log_sigmoid(logit[h]) * LOG2E, lgb = log_sigmoid(logit[6 + h]) * LOG2E;
        const int il = 32 * it_ + r32;
        bf16x8 qf[4];
#pragma unroll
        for (int s = 0; s < 4; ++s) qf[s] = rowfrag(Qi, il, 2 * s + hh);
        f32x16 of = zero16(), ob = zero16();
#pragma unroll
        for (int jt = 0; jt < 4; ++jt) {
            f32x16 x = zero16();
#pragma unroll
            for (int s = 0; s < 4; ++s) x = MFMA32(rowfrag(Ki, 32 * jt + r32, 2 * s + hh), qf[s], x);
            if (jt <= it_) { f32x16 w;
#pragma unroll
                for (int i = 0; i < 16; ++i) { const int jl = 32 * jt + crow0(i) + 4 * hh; w[i] = (jl <= il) ? x[i] * __builtin_amdgcn_exp2f(lgf * (float)(il - jl)) : 0.f; }
                const bf16x8 p0 = PACK8(w, 0), p1 = PACK8(w, 1);
                of = MFMA32(trfrag(Vi, 32 * jt + 4 * hh, 32 * jt + 8 + 4 * hh, et, lane), p0, of);
                of = MFMA32(trfrag(Vi, 32 * jt + 16 + 4 * hh, 32 * jt + 24 + 4 * hh, et, lane), p1, of); }
            if (jt >= it_) { f32x16 w;
#pragma unroll
                for (int i = 0; i < 16; ++i) { const int jl = 32 * jt + crow0(i) + 4 * hh; w[i] = (jl >= il) ? x[i] * __builtin_amdgcn_exp2f(lgb * (float)(jl - il)) : 0.f; }
                const bf16x8 p0 = PACK8(w, 0), p1 = PACK8(w, 1);
                ob = MFMA32(trfrag(Vi, 32 * jt + 4 * hh, 32 * jt + 8 + 4 * hh, et, lane), p0, ob);
                ob = MFMA32(trfrag(Vi, 32 * jt + 16 + 4 * hh, 32 * jt + 24 + 4 * hh, et, lane), p1, ob); }
        }
        { const bf16* pf = PREV + ((size_t)(ch * 6 + h) * 2) * 4096 + (size_t)(32 * et + r32) * 64 + 8 * hh; const bf16* pb = pf + 4096;
          f32x16 cf = zero16(), cb = zero16();
#pragma unroll
          for (int s = 0; s < 4; ++s) { cf = MFMA32(*(const bf16x8*)(pf + 16 * s), qf[s], cf); cb = MFMA32(*(const bf16x8*)(pb + 16 * s), qf[s], cb); }
          const float df = __builtin_amdgcn_exp2f(lgf * (float)(il + 1)), db = __builtin_amdgcn_exp2f(lgb * (float)(128 - il));
#pragma unroll
          for (int i = 0; i < 16; ++i) { of[i] += df * cf[i]; ob[i] += db * cb[i]; } }
        float s1f = 0.f, s2f = 0.f, s1b = 0.f, s2b = 0.f;
#pragma unroll
        for (int i = 0; i < 16; ++i) { s1f += of[i]; s2f += of[i] * of[i]; s1b += ob[i]; s2b += ob[i] * ob[i]; }
        s1f = xhalf_sum(s1f); s2f = xhalf_sum(s2f); s1b = xhalf_sum(s1b); s2b = xhalf_sum(s2b);
        if (hh == 0) { LAS float* sp = st + (wave * 32 + r32) * 4; sp[0] = s1f; sp[1] = s2f; sp[2] = s1b; sp[3] = s2b; }
        __syncthreads();
        { const LAS float* sp = st + ((wave ^ 1) * 32 + r32) * 4; s1f += sp[0]; s2f += sp[1]; s1b += sp[2]; s2b += sp[3]; }
        const float muf = s1f * (1.0f / 64.0f), mub = s1b * (1.0f / 64.0f);
        const float rf = 1.0f / sqrtf(fmaxf(s2f * (1.0f / 64.0f) - muf * muf, 0.f) + 1e-5f), rb = 1.0f / sqrtf(fmaxf(s2b * (1.0f / 64.0f) - mub * mub, 0.f) + 1e-5f);
        { const size_t trow = (size_t)(row0 + il); const int e0 = h * 64 + 32 * et + 4 * hh;
          const bf16* gp = P + trow * INC + C_GF + e0; bf16* op = MIX + trow * DM + M_RET + e0;
#pragma unroll
          for (int g4 = 0; g4 < 4; ++g4) { const u32x2 gfw = *(const u32x2*)(gp + 8 * g4), gbw = *(const u32x2*)(gp + (C_GB - C_GF) + 8 * g4);
              const float gfv[4] = {bflo(gfw.x), bfhi(gfw.x), bflo(gfw.y), bfhi(gfw.y)}, gbv[4] = {bflo(gbw.x), bfhi(gbw.x), bflo(gbw.y), bfhi(gbw.y)};
              float y[4];
#pragma unroll
              for (int k = 0; k < 4; ++k) { const int i = 4 * g4 + k;
                  y[k] = ((of[i] - muf) * rf * (gfv[k] * sigmoidf_(gfv[k])) + (ob[i] - mub) * rb * (gbv[k] * sigmoidf_(gbv[k]))) * gnw[e0 + 8 * g4 + k]; }
              u32x2 w; w.x = cvtpk(y[0], y[1]); w.y = cvtpk(y[2], y[3]); *(u32x2*)(op + 8 * g4) = w; } }
        __syncthreads();
    }
}

__device__ __forceinline__ void ret_out_mfma2(const bf16* P, const bf16* PREV, bf16* MIX, const float* logit, const float* gnw, const float* ropetab, LAS unsigned char* lds, int tid_in, int G) {
    const int wave = __builtin_amdgcn_readfirstlane(tid_in >> 6);
    const int it_ = wave >> 1, et = wave & 1;
    LAS float* tabL = (LAS float*)(lds + 98304);
    LAS float* stL = (LAS float*)(lds + 98304 + 16384);
    { const int t0 = FRESH_TID(wave); for (int i = t0; i < 1024; i += 512) ((LAS f32x4*)tabL)[i] = ((const f32x4*)ropetab)[i]; }
    __syncthreads();
    v4u rq0, rq1, rk0, rk1, rv0, rv1, rg00, rg01, rg10, rg11;
    LAS unsigned char* gs = lds + 98304 + 16384 + 8192 + wave * 4096;
#define RO_LOAD(uu) do { const int t_ = FRESH_TID(wave); const int ch_ = (uu) / 6, h_ = (uu) % 6, pt_ = t_ & 3; \
        const bf16* b_ = P + (size_t)(ch_ * 128 + (t_ >> 2)) * INC + h_ * 64 + 32 * (pt_ >> 1) + 8 * (pt_ & 1); \
        rq0 = *(const v4u*)(b_ + C_RQ); rq1 = *(const v4u*)(b_ + C_RQ + 16); rk0 = *(const v4u*)(b_ + C_RK); rk1 = *(const v4u*)(b_ + C_RK + 16); rv0 = *(const v4u*)(b_ + C_RV); rv1 = *(const v4u*)(b_ + C_RV + 16); \
        const int l_ = t_ & 63; const bf16* g_ = P + (size_t)(ch_ * 128 + 32 * it_ + (l_ >> 2)) * INC + C_GF + h_ * 64 + 32 * et + 8 * (l_ & 3); \
        rg00 = *(const v4u*)g_; rg01 = *(const v4u*)(g_ + (size_t)16 * INC); rg10 = *(const v4u*)(g_ + (C_GB - C_GF)); rg11 = *(const v4u*)(g_ + (C_GB - C_GF) + (size_t)16 * INC); } while (0)
    int u = blockIdx.x;
    if (u < NCH * 6 * REP_RETO) RO_LOAD(u % (NCH * 6));
    for (int n = 0; u < NCH * 6 * REP_RETO; u += G, ++n) {
        const int itm = u % (NCH * 6);
        const int tid = FRESH_TID(wave), lane = tid & 63, r32 = lane & 31, hh = lane >> 5, tok = tid >> 2, part = tid & 3;
        const int ch = itm / 6, h = itm % 6, row0 = ch * 128; const bool latent = ch < NCHL;
        LAS unsigned char* Qi = lds + (n & 1) * 49152; LAS unsigned char* Ki = Qi + 16384; LAS unsigned char* Vi = Qi + 32768;
        LAS float* st = stL + (n & 1) * 1024;
        { const int c1 = 4 * (part >> 1) + (part & 1), c2 = c1 + 2;
          float q1[8], q2[8], k1[8], k2[8];
          q1[0] = bflo(rq0.x); q1[1] = bfhi(rq0.x); q1[2] = bflo(rq0.y); q1[3] = bfhi(rq0.y); q1[4] = bflo(rq0.z); q1[5] = bfhi(rq0.z); q1[6] = bflo(rq0.w); q1[7] = bfhi(rq0.w);
          q2[0] = bflo(rq1.x); q2[1] = bfhi(rq1.x); q2[2] = bflo(rq1.y); q2[3] = bfhi(rq1.y); q2[4] = bflo(rq1.z); q2[5] = bfhi(rq1.z); q2[6] = bflo(rq1.w); q2[7] = bfhi(rq1.w);
          k1[0] = bflo(rk0.x); k1[1] = bfhi(rk0.x); k1[2] = bflo(rk0.y); k1[3] = bfhi(rk0.y); k1[4] = bflo(rk0.z); k1[5] = bfhi(rk0.z); k1[6] = bflo(rk0.w); k1[7] = bfhi(rk0.w);
          k2[0] = bflo(rk1.x); k2[1] = bfhi(rk1.x); k2[2] = bflo(rk1.y); k2[3] = bfhi(rk1.y); k2[4] = bflo(rk1.z); k2[5] = bfhi(rk1.z); k2[6] = bflo(rk1.w); k2[7] = bfhi(rk1.w);
          if (latent) { const int pos = (row0 + tok) & (SEQ - 1); const int nn = (part >> 1) ? (pos & 63) : (pos >> 6);
              const LAS f32x2_t* tb = (const LAS f32x2_t*)tabL + nn * 16 + 8 * (part & 1);
#pragma unroll
              for (int j = 0; j < 8; ++j) { const f32x2_t cs = tb[j]; const float a = q1[j], b = q2[j], c = k1[j], d = k2[j];
                  q1[j] = a * cs.x - b * cs.y; q2[j] = a * cs.y + b * cs.x; k1[j] = c * cs.x - d * cs.y; k2[j] = c * cs.y + d * cs.x; } }
#pragma unroll
          for (int j = 0; j < 8; ++j) { k1[j] *= 0.125f; k2[j] *= 0.125f; }
          st_chunk(Qi, tok, c1, q1); st_chunk(Qi, tok, c2, q2); st_chunk(Ki, tok, c1, k1); st_chunk(Ki, tok, c2, k2);
          *(LAS v4u*)(Vi + off64(tok, c1)) = rv0; *(LAS v4u*)(Vi + off64(tok, c2)) = rv1; }
        { const int tk = lane >> 2, pc = lane & 3;
          *(LAS v4u*)(gs + tk * 64 + ((pc ^ ((tk >> 1) & 3)) * 16)) = rg00; *(LAS v4u*)(gs + (tk + 16) * 64 + ((pc ^ (((tk + 16) >> 1) & 3)) * 16)) = rg01;
          *(LAS v4u*)(gs + 2048 + tk * 64 + ((pc ^ ((tk >> 1) & 3)) * 16)) = rg10; *(LAS v4u*)(gs + 2048 + (tk + 16) * 64 + ((pc ^ (((tk + 16) >> 1) & 3)) * 16)) = rg11; }
        if (u + G < NCH * 6 * REP_RETO) RO_LOAD((u + G) % (NCH * 6));
        const int il = 32 * it_ + r32;
        const bf16* pf = PREV + ((size_t)(ch * 6 + h) * 2) * 4096 + (size_t)(32 * et + r32) * 64 + 8 * hh;
        bf16x8 pff[4], pfb[4];
#pragma unroll
        for (int s = 0; s < 4; ++s) { pff[s] = *(const bf16x8*)(pf + 16 * s); pfb[s] = *(const bf16x8*)(pf + 4096 + 16 * s); }
        const size_t trow = (size_t)(row0 + il); const int e0 = h * 64 + 32 * et + 4 * hh;
        const float lgf = log_sigmoid(logit[h]) * LOG2E, lgb = log_sigmoid(logit[6 + h]) * LOG2E;
        float af[4], bfv[4], ab[4], bb[4];
#pragma unroll
        for (int k = 0; k < 4; ++k) { af[k] = __builtin_amdgcn_exp2f(-lgf * (float)k); bfv[k] = __builtin_amdgcn_exp2f(-lgf * (float)(8 * k)); ab[k] = __builtin_amdgcn_exp2f(lgb * (float)k); bb[k] = __builtin_amdgcn_exp2f(lgb * (float)(8 * k)); }
        LDS_BARRIER();
        bf16x8 qf[4];
#pragma unroll
        for (int s = 0; s < 4; ++s) qf[s] = rowfrag(Qi, il, 2 * s + hh);
        f32x16 of = zero16(), ob = zero16();
#pragma unroll
        for (int jt = 0; jt < 4; ++jt) {
            f32x16 x = zero16();
#pragma unroll
            for (int s = 0; s < 4; ++s) x = MFMA32(rowfrag(Ki, 32 * jt + r32, 2 * s + hh), qf[s], x);
            if (jt <= it_) { f32x16 w; const float lf = __builtin_amdgcn_exp2f(lgf * (float)(il - 32 * jt - 4 * hh));
#pragma unroll
                for (int g = 0; g < 4; ++g) { const float lg = lf * bfv[g];
#pragma unroll
                    for (int k = 0; k < 4; ++k) { const int i = 4 * g + k; const float v = x[i] * (lg * af[k]); w[i] = (jt < it_ || crow0(i) + 4 * hh <= r32) ? v : 0.f; } }
                const bf16x8 p0 = PACK8(w, 0), p1 = PACK8(w, 1);
                of = MFMA32(trfrag(Vi, 32 * jt + 4 * hh, 32 * jt + 8 + 4 * hh, et, lane), p0, of);
                of = MFMA32(trfrag(Vi, 32 * jt + 16 + 4 * hh, 32 * jt + 24 + 4 * hh, et, lane), p1, of); }
            if (jt >= it_) { f32x16 w; const float lb = __builtin_amdgcn_exp2f(lgb * (float)(32 * jt + 4 * hh - il));
#pragma unroll
                for (int g = 0; g < 4; ++g) { const float lg = lb * bb[g];
#pragma unroll
                    for (int k = 0; k < 4; ++k) { const int i = 4 * g + k; const float v = x[i] * (lg * ab[k]); w[i] = (jt > it_ || crow0(i) + 4 * hh >= r32) ? v : 0.f; } }
                const bf16x8 p0 = PACK8(w, 0), p1 = PACK8(w, 1);
                ob = MFMA32(trfrag(Vi, 32 * jt + 4 * hh, 32 * jt + 8 + 4 * hh, et, lane), p0, ob);
                ob = MFMA32(trfrag(Vi, 32 * jt + 16 + 4 * hh, 32 * jt + 24 + 4 * hh, et, lane), p1, ob); }
        }
        { f32x16 cf = zero16(), cb = zero16();
#pragma unroll
          for (int s = 0; s < 4; ++s) { cf = MFMA32(pff[s], qf[s], cf); cb = MFMA32(pfb[s], qf[s], cb); }
          const float df = __builtin_amdgcn_exp2f(lgf * (float)(il + 1)), db = __builtin_amdgcn_exp2f(lgb * (float)(128 - il));
#pragma unroll
          for (int i = 0; i < 16; ++i) { of[i] += df * cf[i]; ob[i] += db * cb[i]; } }
        float s1f = 0.f, s2f = 0.f, s1b = 0.f, s2b = 0.f;
#pragma unroll
        for (int i = 0; i < 16; ++i) { s1f += of[i]; s2f += of[i] * of[i]; s1b += ob[i]; s2b += ob[i] * ob[i]; }
        s1f = xhalf_sum(s1f); s2f = xhalf_sum(s2f); s1b = xhalf_sum(s1b); s2b = xhalf_sum(s2b);
        if (hh == 0) { LAS float* sp = st + (wave * 32 + r32) * 4; sp[0] = s1f; sp[1] = s2f; sp[2] = s1b; sp[3] = s2b; }
        LDS_BARRIER();
        { const LAS float* sp = st + ((wave ^ 1) * 32 + r32) * 4; s1f += sp[0]; s2f += sp[1]; s1b += sp[2]; s2b += sp[3]; }
        const float muf = s1f * (1.0f / 64.0f), mub = s1b * (1.0f / 64.0f);
        const float rf = __builtin_amdgcn_rsqf(fmaxf(s2f * (1.0f / 64.0f) - muf * muf, 0.f) + 1e-5f), rb = __builtin_amdgcn_rsqf(fmaxf(s2b * (1.0f / 64.0f) - mub * mub, 0.f) + 1e-5f);
        { const int sw = (r32 >> 1) & 3; u32x2 gfw[4], gbw[4];
#pragma unroll
          for (int g4 = 0; g4 < 4; ++g4) { gfw[g4] = *(const LAS u32x2*)(gs + r32 * 64 + ((g4 ^ sw) * 16) + 8 * hh); gbw[g4] = *(const LAS u32x2*)(gs + 2048 + r32 * 64 + ((g4 ^ sw) * 16) + 8 * hh); }
#pragma unroll
          for (int g4 = 0; g4 < 4; ++g4) {
              const float gfv[4] = {bflo(gfw[g4].x), bfhi(gfw[g4].x), bflo(gfw[g4].y), bfhi(gfw[g4].y)}, gbv[4] = {bflo(gbw[g4].x), bfhi(gbw[g4].x), bflo(gbw[g4].y), bfhi(gbw[g4].y)};
              float y[4];
#pragma unroll
              for (int k = 0; k < 4; ++k) { const int i = 4 * g4 + k;
                  const float sf = gfv[k] * __builtin_amdgcn_rcpf(1.0f + __builtin_amdgcn_exp2f(-LOG2E * gfv[k])), sb = gbv[k] * __builtin_amdgcn_rcpf(1.0f + __builtin_amdgcn_exp2f(-LOG2E * gbv[k]));
                  y[k] = ((of[i] - muf) * rf * sf + (ob[i] - mub) * rb * sb) * gnw[e0 + 8 * g4 + k]; }
              u32x2 w; w.x = cvtpk(y[0], y[1]); w.y = cvtpk(y[2], y[3]); *(LAS u32x2*)(gs + r32 * 64 + ((g4 ^ sw) * 16) + 8 * hh) = w; }
          const int tk = lane >> 2, pc = lane & 3; bf16* op = MIX + (size_t)(row0 + 32 * it_ + tk) * DM + M_RET + h * 64 + 32 * et + 8 * pc;
          const v4u o0 = *(const LAS v4u*)(gs + tk * 64 + ((pc ^ ((tk >> 1) & 3)) * 16)), o1 = *(const LAS v4u*)(gs + (tk + 16) * 64 + ((pc ^ (((tk + 16) >> 1) & 3)) * 16));
          *(v4u*)op = o0; *(v4u*)(op + (size_t)16 * DM) = o1; }
    }
#undef RO_LOAD
    __syncthreads();
}

#ifndef REP_DOWN
#define REP_DOWN 1
#endif
#ifndef REP_NORM
#define REP_NORM 1
#endif
#ifndef REP_UP
#define REP_UP 1
#endif
#ifndef REP_WIN
#define REP_WIN 1
#endif
#ifndef REP_NA
#define REP_NA 1
#endif
#ifndef REP_SG
#define REP_SG 1
#endif
#ifndef REP_KV
#define REP_KV 1
#endif
#ifndef REP_SCAN
#define REP_SCAN 1
#endif
#ifndef REP_RETO
#define REP_RETO 1
#endif
#ifndef REP_PRO
#define REP_PRO 1
#endif

struct Args { In in; float* out; unsigned char* ws; int ph_lo, ph_hi; };
__global__ void __launch_bounds__(NWAVES * 64, 2) hybrid_fwd(Args args) {
    extern __shared__ __attribute__((aligned(16))) unsigned char lds_raw[];
    LAS unsigned char* lds = (LAS unsigned char*)lds_raw;
    volatile LAS unsigned* MISC = (volatile LAS unsigned*)(lds + MISC_OFF);
    const int tid = threadIdx.x, lane = tid & 63, wave = __builtin_amdgcn_readfirstlane(tid >> 6);
    const int G = gridDim.x; const int bx = blockIdx.x; const int vcu = (G % 8 == 0) ? (bx % 8) * (G / 8) + bx / 8 : bx;
    const int NGW = G * NWAVES, nthreads = G * NWAVES * 64;
    unsigned char* ws = args.ws; const In& I = args.in;
    gu32* ctl = (gu32*)(ws + WS_CTL);
    for (int u = tid; u < (LDS_BYTES - LDSCTL_OFF) / 4; u += NWAVES * 64) ((LAS unsigned*)(lds + LDSCTL_OFF))[u] = 0u;
    __syncthreads();
    XcdBarrier bar; bar.bar = (unsigned*)(ctl + CW_BAR); bar.x = 0; bar.st = nullptr;
    if (MK_ONE_LAUNCH) bar = xcd_barrier_post((unsigned*)(ctl + CW_BAR), MISC + 8);
    const int lo = args.ph_lo, hi = args.ph_hi; int ph = 0;
#define PH_ON (ph >= lo && ph < hi)
#define OPQ(x) ({ int _t; asm volatile("v_mbcnt_lo_u32_b32 %0, -1, 0\n\tv_mbcnt_hi_u32_b32 %0, -1, %0" : "=v"(_t)); _t | (wave << 6); })
#define PH_END do { if (MK_ONE_LAUNCH && ph >= lo && ph + 1 < hi) xcd_barrier(bar); ++ph; } while (0)

    float* mod = (float*)(ws + WS_MOD); const float* ropetab = (const float*)(ws + WS_ROPE);
    bf16* W1T = (bf16*)(ws + WS_W1T); bf16* W2T = (bf16*)(ws + WS_W2T); bf16* WINT = (bf16*)(ws + WS_WINT); bf16* WOUTT = (bf16*)(ws + WS_WOUTT);
    float* ctxbuf = (float*)(ws + WS_CTXBUF); bf16* XN = (bf16*)(ws + WS_XN); bf16* PB = (bf16*)(ws + WS_P); bf16* HB = (bf16*)(ws + WS_P);
    float* KV = (float*)(ws + WS_KV); float* PREV = (float*)(ws + WS_PREV); bf16* XR = (bf16*)(ws + WS_XR);

    if (PH_ON) for (int rep_ = 0; rep_ < REP_PRO; ++rep_) p0_prologue(I, ws, lds, tid, lane, wave, vcu, G);
    PH_END;

    for (int hs = 0; hs < 2 * DEPTH; ++hs) {
        const int L = hs >> 1, half = hs & 1; const bool last = (L == DEPTH - 1), first = (hs == 0);
        const int Mrows = (last && half == 1) ? TL : TT;
        const float* modL = mod + (size_t)L * 9 * 9216;
        const float* xl = first ? I.x : args.out; const float* xc = first ? I.ctx : ctxbuf;
        if (PH_ON) { const int t_ = OPQ(threadIdx.x); norm_phase(I.x, I.ctx, first ? (const bf16*)nullptr : XR, Mrows, I.norm_w + (size_t)(L * 3 + (half ? 2 : 0)) * DM, modL, half ? 6 : 0, XN, vcu * NWAVES + (t_ >> 6), NGW, t_ & 63); }
        PH_END;
        if (PH_ON) for (int rep_ = 0; rep_ < REP_UP; ++rep_) { pg8::Gemm g{XN, W1T + (size_t)(L * 2 + half) * DM * 2 * DFF, Mrows, 2 * DFF, DM}; pg8::StaticOrder S; S.init(Mrows, 2 * DFF, G, bx);
            pg8::EpiSwiGLU E{HB, TT};
            pg8::gemm_phase<pg8::EpiSwiGLU, pg8::StaticOrder, true, true>(lds, g, S, E, wave); }
        PH_END;
        if (PH_ON) for (int rep_ = 0; rep_ < REP_DOWN; ++rep_) { pg8::Gemm g{HB, W2T + (size_t)(L * 2 + half) * DFF * DM, Mrows, DM, DFF, 64, 64, (size_t)TT * 128, (size_t)DM * 128}; pg8::StaticOrder S; S.init(Mrows, DM, G, bx);
            pg8::EpiResGate E{I.x, I.ctx, XR, args.out, modL + (half ? 8 : 2) * 1024, (rep_ + 1 == REP_DOWN) ? 0.5f : 0.0f, (first ? 1 : 0) | ((last && half == 1 && rep_ + 1 == REP_DOWN) ? 2 : 0)};
            pg8::gemm_phase<pg8::EpiResGate, pg8::StaticOrder, true, true>(lds, g, S, E, wave); }
        PH_END;
        if (half == 0) {
            if (PH_ON) { const int t_ = OPQ(threadIdx.x); norm_phase(I.x, I.ctx, XR, TT, I.norm_w + (size_t)(L * 3 + 1) * DM, modL, 3, XN, vcu * NWAVES + (t_ >> 6), NGW, t_ & 63); }
            PH_END;
            if (PH_ON) for (int rep_ = 0; rep_ < REP_WIN; ++rep_) { pg8::Gemm g{XN, WINT + (size_t)L * DM * INC, TT, INC, DM}; pg8::StaticOrder S; S.init(TT, INC, G, bx);
                pg8::EpiStoreBf16 E{PB, INC};
                pg8::gemm_phase<pg8::EpiStoreBf16, pg8::StaticOrder, true, true>(lds, g, S, E, wave); }
            PH_END;
            const float* logit = I.ret_logit + L * 12;
            if (PH_ON) {
                for (int rep_ = 0; rep_ < REP_NA; ++rep_) na_mfma(PB, XN, I.na_qn + L * 64, I.na_kn + L * 64, I.na_rpb + (size_t)L * 6 * 15 * 31, !last, lds, OPQ(0), G);
                for (int rep_ = 0; rep_ < REP_SG; ++rep_) sg_mfma(PB, XN, (const bf16*)(ws + WS_WSG) + (size_t)L * 4 * 128 * 128, I.sg_b + L * 4 * 128, I.sg_ln_w + L * 256, I.sg_ln_b + L * 256, lds, OPQ(0), G);
                ret_kv_mfma(PB, KV, logit, ropetab, lds, OPQ(0), G);
            }
            PH_END;
            if (PH_ON) for (int rep_ = 0; rep_ < REP_SCAN; ++rep_) { const int t_ = OPQ(threadIdx.x); ret_scan2(KV, (bf16*)PREV, logit, bx * (NWAVES * 64) + t_, nthreads); }
            PH_END;
            if (PH_ON) { const int t_ = OPQ(threadIdx.x); ret_out_mfma2(PB, (const bf16*)PREV, XN, logit, I.ret_gn_w + L * 384, ropetab, lds, t_, G); }
            PH_END;
            const int Mo = last ? TL : TT;
            if (PH_ON) { pg8::Gemm g{XN, WOUTT + (size_t)L * DM * DM, Mo, DM, DM}; pg8::StaticOrder S; S.init(Mo, DM, G, bx);
                pg8::EpiResGate E{I.x, I.ctx, XR, args.out, modL + 5 * 1024, 1.0f, 0};
                pg8::gemm_phase<pg8::EpiResGate, pg8::StaticOrder, true, true>(lds, g, S, E, wave); }
            PH_END;
        }
    }
#undef PH_ON
#undef PH_END
}

extern "C" void kernel_launch(void* const* d_in, const int* in_sizes, int n_in, void* d_out, int out_size, void* d_ws, size_t ws_size, hipStream_t stream) {
    static int grid = 0;
    if (grid == 0) {
        if (n_in != 20 || in_sizes[0] != TL * DM || out_size != TL * DM || ws_size < WS_END) { fprintf(stderr, "kernel_launch: unexpected shapes (n_in %d, in0 %d, out %d, ws %zu); nothing launched\n", n_in, n_in > 0 ? in_sizes[0] : -1, out_size, ws_size); grid = -1; return; }
        int dev = 0, cus = 0, per_cu = 0;
        if (hipGetDevice(&dev) != hipSuccess || hipDeviceGetAttribute(&cus, hipDeviceAttributeMultiprocessorCount, dev) != hipSuccess) { grid = -1; return; }
        if (hipFuncSetAttribute((const void*)hybrid_fwd, hipFuncAttributeMaxDynamicSharedMemorySize, LDS_BYTES) != hipSuccess) { fprintf(stderr, "kernel_launch: hipFuncSetAttribute failed\n"); grid = -1; return; }
        if (hipOccupancyMaxActiveBlocksPerMultiprocessor(&per_cu, (const void*)hybrid_fwd, NWAVES * 64, LDS_BYTES) != hipSuccess || per_cu < 1)
            fprintf(stderr, "kernel_launch: note: occupancy query reports %d workgroups per CU\n", per_cu);
        (void)hipGetLastError();
        grid = cus;
    }
    if (grid < 0) return;
    if (hipMemsetAsync((char*)d_ws + WS_CTL, 0, CTL_ZERO_BYTES, stream) != hipSuccess) return;
    Args a{};
    const float** ip = (const float**)&a.in;
    for (int i = 0; i < 20; ++i) ip[i] = (const float*)d_in[i];
    a.out = (float*)d_out; a.ws = (unsigned char*)d_ws;
#if MK_ONE_LAUNCH
    a.ph_lo = 0; a.ph_hi = NPH;
    hipLaunchKernelGGL(hybrid_fwd, dim3(grid), dim3(NWAVES * 64), LDS_BYTES, stream, a);
#else
    for (int li = 0; li < NPH; ++li) { a.ph_lo = li; a.ph_hi = li + 1; hipLaunchKernelGGL(hybrid_fwd, dim3(grid), dim3(NWAVES * 64), LDS_BYTES, stream, a); }
#endif
}
```

```cpp
#include <hip/hip_runtime.h>
#include <cstdio>
#include <cstdint>
namespace pg8 {
#define PG8_LAS __attribute__((address_space(3)))
typedef unsigned short bf16_t;
typedef short bf16x8 __attribute__((ext_vector_type(8)));
typedef float f32x4 __attribute__((ext_vector_type(4)));
typedef unsigned u32x4 __attribute__((ext_vector_type(4)));
constexpr int BM = 256, BK = 64, HALF = 128, HTB = HALF * BK * 2  , STAGE_BYTES = 8 * HTB, NXCD = 8, WGM = 8;

__host__ __device__ __forceinline__ int lds_byte(int r, int c) { const int st = (r >> 4) * 2 + (c >> 5), rr = r & 15, cc = c & 31, ob = rr * 64 + cc * 2; return st * 1024 + (ob ^ (((ob >> 9) & 1) << 5)); }
__host__ __device__ __forceinline__ void stage_rc(int b, int& R, int& C) { const int st = b / 1024, sb = b % 1024, swz = sb ^ (((sb >> 9) & 1) << 5); R = (st >> 1) * 16 + swz / 64; C = (st & 1) * 32 + (swz % 64) / 2; }
__host__ __device__ __forceinline__ int perm32(int rho) { const int n = rho >> 4, i = rho & 15; return 8 * (i >> 2) + 4 * n + (i & 3); }

struct Unit { int pm, pn; };
struct Gemm { const bf16_t* A; const bf16_t* Bt; int M, N, K; int pa, pb; size_t ksa, ksb; };

struct StaticOrder {
    int nM, nN, nwg, G, c;
    __host__ __device__ void init(int M, int N, int G_, int c_) { nM = M / BM; nN = N / BM; nwg = nM * nN; G = G_; c = c_; }
    __host__ __device__ bool next(int i, Unit& u) const {
        const long L = (long)i * G + c; if (L >= nwg) return false;
        int wgid = (int)L; { const int q = nwg / NXCD, r = nwg % NXCD, xcd = wgid % NXCD, off = wgid / NXCD; wgid = (xcd < r ? xcd * (q + 1) : r * (q + 1) + (xcd - r) * q) + off; }
        const int nig = WGM * nN, gid = wgid / nig, fm = gid * WGM, gsz = (nM - fm) < WGM ? (nM - fm) : WGM;
        u.pm = fm + ((wgid % nig) % gsz); u.pn = (wgid % nig) / gsz; return true;
    }
    __device__ __forceinline__ void a_ready(const Unit&) const {}
    __device__ __forceinline__ void done(const Unit&) const {}
};
__device__ __forceinline__ unsigned cvt_pk_bf16(float lo, float hi) { unsigned r; asm volatile("v_cvt_pk_bf16_f32 %0, %1, %2" : "=v"(r) : "v"(lo), "v"(hi)); return r; }
typedef float f32x2 __attribute__((ext_vector_type(2)));
template <class Epi, class Sched, bool ALIGN_EPI = false, bool SP2 = false>
__device__ __forceinline__ void gemm_phase(PG8_LAS unsigned char* lds, const Gemm g, const Sched& S, const Epi& E, const int wave_s) {
    int tid_o; asm volatile("v_mbcnt_lo_u32_b32 %0, -1, 0\n\tv_mbcnt_hi_u32_b32 %0, -1, %0" : "=v"(tid_o)); tid_o |= wave_s << 6;
    const int tid = tid_o, wid = __builtin_amdgcn_readfirstlane(tid >> 6), lane = tid & 63, wr = wid >> 2, wc = wid & 3, fr = lane & 15, fq = lane >> 4;
    const int K = g.K, nt = K / BK;
    const int pa = g.pa ? g.pa : K, pb = g.pb ? g.pb : K;
    unsigned voffA[2], voffB[2];
#pragma unroll
    for (int i = 0; i < 2; ++i) { int R, C; stage_rc(tid * 16 + i * 8192, R, C); const int Rb = Epi::PERM ? ((R & ~31) + perm32(R & 31)) : R;
        voffA[i] = (unsigned)(R * pa + C) * 2u; voffB[i] = (unsigned)(Rb * pb + C) * 2u; }
    const size_t kstepA = g.ksa ? g.ksa : (size_t)(BK * 2), kstepB = g.ksb ? g.ksb : (size_t)(BK * 2);
    const size_t hstepA = (size_t)HALF * pa * 2, hstepB = (size_t)HALF * pb * 2;
    const size_t tstepA = 2 * hstepA, tstepB = 2 * hstepB;
    const unsigned ldsw = (unsigned)wid * 1024u;
    const int aoff = lds_byte(wr * 64 + fr, fq * 8), boff = lds_byte(wc * 32 + fr, fq * 8);
#define PG8_SA(b, h) (((b) * 2 + (h)) * HTB)
#define PG8_SB(b, h) ((4 + (b) * 2 + (h)) * HTB)
#define PG8_STAGE(bufoff, gbase, voff) do { _Pragma("unroll") for (int _i = 0; _i < 2; ++_i) \
        __builtin_amdgcn_global_load_lds((const unsigned*)((const char*)(gbase) + (voff)[_i]), (PG8_LAS unsigned*)(lds + (bufoff) + ldsw + _i * 8192), 16, 0, 0); } while (0)
#define PG8_LDA(dst, b, h) do { _Pragma("unroll") for (int m = 0; m < 4; ++m) _Pragma("unroll") for (int k = 0; k < 2; ++k) dst[m][k] = *(const PG8_LAS bf16x8*)(lds + PG8_SA(b, h) + aoff + m * 2048 + k * 1024); } while (0)
#define PG8_LDB(dst, b, h) do { _Pragma("unroll") for (int n = 0; n < 2; ++n) _Pragma("unroll") for (int k = 0; k < 2; ++k) dst[n][k] = *(const PG8_LAS bf16x8*)(lds + PG8_SB(b, h) + boff + n * 2048 + k * 1024); } while (0)
#define PG8_MMA(ai, bj, At, Bt) do { __builtin_amdgcn_s_setprio(1); _Pragma("unroll") for (int m = 0; m < 4; ++m) _Pragma("unroll") for (int n = 0; n < 2; ++n) _Pragma("unroll") for (int k = 0; k < 2; ++k) \
        acc[ai][bj][m][n] = __builtin_amdgcn_mfma_f32_16x16x32_bf16(Bt[n][k], At[m][k], acc[ai][bj][m][n], 0, 0, 0); __builtin_amdgcn_s_setprio(0); } while (0)
#define PG8_WAIT_V(n) asm volatile("s_waitcnt vmcnt(" #n ")" ::: "memory")
#define PG8_WAIT_L(n) asm volatile("s_waitcnt lgkmcnt(" #n ")" ::: "memory")
#define PG8_BAR __builtin_amdgcn_s_barrier()
#define PG8_SCHED __builtin_amdgcn_sched_barrier(0)
    Unit cur, nxt; int ui = 0;
    if (!S.next(0, cur)) return;
    f32x4 acc[2][2][4][2];
#pragma unroll
    for (int a = 0; a < 2; ++a)
#pragma unroll
        for (int b = 0; b < 2; ++b)
#pragma unroll
            for (int m = 0; m < 4; ++m)
#pragma unroll
                for (int n = 0; n < 2; ++n) acc[a][b][m][n] = (f32x4){0.f, 0.f, 0.f, 0.f};
    bf16x8 At[4][2], B0[2][2], B1[2][2];
    const char* cA = (const char*)g.A + (size_t)cur.pm * tstepA; const char* cB = (const char*)g.Bt + (size_t)cur.pn * tstepB;
    S.a_ready(cur);
    if constexpr (SP2) {
        PG8_STAGE(PG8_SB(0, 0), cB, voffB); PG8_STAGE(PG8_SB(0, 1), cB + hstepB, voffB); PG8_STAGE(PG8_SA(0, 0), cA, voffA); PG8_STAGE(PG8_SA(0, 1), cA + hstepA, voffA);
        if (wr == 1) PG8_BAR;
        PG8_WAIT_V(2); PG8_BAR;
        PG8_STAGE(PG8_SB(1, 0), cB + kstepB, voffB); PG8_STAGE(PG8_SA(1, 0), cA + kstepA, voffA); PG8_STAGE(PG8_SB(1, 1), cB + hstepB + kstepB, voffB);
        PG8_WAIT_V(6); PG8_BAR;
    } else {
        PG8_STAGE(PG8_SB(0, 0), cB, voffB); PG8_STAGE(PG8_SA(0, 0), cA, voffA); PG8_STAGE(PG8_SB(0, 1), cB + hstepB, voffB); PG8_STAGE(PG8_SA(0, 1), cA + hstepA, voffA);
        if (wr == 1) PG8_BAR;
        PG8_WAIT_V(4); PG8_BAR;
        PG8_STAGE(PG8_SB(1, 0), cB + kstepB, voffB); PG8_STAGE(PG8_SA(1, 0), cA + kstepA, voffA); PG8_STAGE(PG8_SB(1, 1), cB + hstepB + kstepB, voffB);
        PG8_WAIT_V(6); PG8_BAR;
    }
    for (;;) {
        const bool has_next = S.next(ui + 1, nxt);
        const char* nA = has_next ? (const char*)g.A + (size_t)nxt.pm * tstepA : cA; const char* nB = has_next ? (const char*)g.Bt + (size_t)nxt.pn * tstepB : cB;
        for (int t = 0; t < nt; t += 2) {
            const bool last = (t == nt - 2);
            const char* a1 = cA + (size_t)(t + 1) * kstepA;
            const char* a2 = last ? nA : cA + (size_t)(t + 2) * kstepA; const char* b2 = last ? nB : cB + (size_t)(t + 2) * kstepB;
            const char* a3 = a2 + kstepA; const char* b3 = b2 + kstepB;
            if (last && has_next) S.a_ready(nxt);
            if constexpr (SP2) {
            PG8_LDB(B0, 0, 0); PG8_LDB(B1, 0, 1); PG8_SCHED; PG8_LDA(At, 0, 0); PG8_STAGE(PG8_SA(1, 1), a1 + hstepA, voffA);
            PG8_WAIT_V(8); PG8_WAIT_L(0); PG8_BAR; PG8_MMA(0, 0, At, B0); PG8_MMA(0, 1, At, B1); PG8_BAR; PG8_SCHED;
            PG8_LDA(At, 0, 1); PG8_STAGE(PG8_SB(0, 0), b2, voffB); PG8_STAGE(PG8_SB(0, 1), b2 + hstepB, voffB); PG8_STAGE(PG8_SA(0, 0), a2, voffA);
            PG8_WAIT_V(8); PG8_WAIT_L(0); PG8_BAR; PG8_MMA(1, 0, At, B0); PG8_MMA(1, 1, At, B1); PG8_BAR; PG8_SCHED;
            PG8_LDB(B0, 1, 0); PG8_LDB(B1, 1, 1); PG8_SCHED; PG8_LDA(At, 1, 0); PG8_STAGE(PG8_SA(0, 1), a2 + hstepA, voffA);
            PG8_WAIT_V(8); PG8_WAIT_L(0); PG8_BAR; PG8_MMA(0, 0, At, B0); PG8_MMA(0, 1, At, B1); PG8_BAR; PG8_SCHED;
            PG8_LDA(At, 1, 1); PG8_STAGE(PG8_SB(1, 0), b3, voffB); PG8_STAGE(PG8_SB(1, 1), b3 + hstepB, voffB); PG8_STAGE(PG8_SA(1, 0), a3, voffA);
            PG8_WAIT_V(8); PG8_WAIT_L(0); PG8_BAR; PG8_MMA(1, 0, At, B0); PG8_MMA(1, 1, At, B1); PG8_BAR; PG8_SCHED;
            } else {
            PG8_LDB(B0, 0, 0); PG8_SCHED; PG8_LDA(At, 0, 0); PG8_STAGE(PG8_SA(1, 1), a1 + hstepA, voffA);
            PG8_WAIT_L(8); PG8_BAR; PG8_WAIT_L(0); PG8_MMA(0, 0, At, B0); PG8_BAR; PG8_SCHED;
            PG8_LDB(B1, 0, 1); PG8_STAGE(PG8_SB(0, 0), b2, voffB);
            PG8_BAR; PG8_WAIT_L(0); PG8_MMA(0, 1, At, B1); PG8_BAR;
            PG8_LDA(At, 0, 1); PG8_STAGE(PG8_SA(0, 0), a2, voffA);
            PG8_BAR; PG8_WAIT_L(0); PG8_MMA(1, 0, At, B0); PG8_BAR; PG8_SCHED;
            PG8_STAGE(PG8_SB(0, 1), b2 + hstepB, voffB);
            PG8_WAIT_V(6); PG8_BAR; PG8_MMA(1, 1, At, B1); PG8_BAR;
            PG8_LDB(B0, 1, 0); PG8_SCHED; PG8_LDA(At, 1, 0); PG8_STAGE(PG8_SA(0, 1), a2 + hstepA, voffA);
            PG8_WAIT_L(8); PG8_BAR; PG8_WAIT_L(0); PG8_MMA(0, 0, At, B0); PG8_BAR; PG8_SCHED;
            PG8_LDB(B1, 1, 1); PG8_STAGE(PG8_SB(1, 0), b3, voffB);
            PG8_BAR; PG8_WAIT_L(0); PG8_MMA(0, 1, At, B1); PG8_BAR;
            PG8_LDA(At, 1, 1); PG8_STAGE(PG8_SA(1, 0), a3, voffA);
            PG8_BAR; PG8_WAIT_L(0); PG8_MMA(1, 0, At, B0); PG8_BAR; PG8_SCHED;
            PG8_STAGE(PG8_SB(1, 1), b3 + hstepB, voffB);
            PG8_WAIT_V(6); PG8_BAR; PG8_MMA(1, 1, At, B1); PG8_BAR;
            }
        }
        if constexpr (ALIGN_EPI) { if (wr == 0) PG8_BAR; }
        if constexpr (!Epi::AFTER_DRAIN) { E(acc, cur, wr, wc, fr, fq); S.done(cur); }
        if (!has_next) break;
#pragma unroll
        for (int a = 0; a < 2; ++a)
#pragma unroll
            for (int b = 0; b < 2; ++b)
#pragma unroll
                for (int m = 0; m < 4; ++m)
#pragma unroll
                    for (int n = 0; n < 2; ++n) acc[a][b][m][n] = (f32x4){0.f, 0.f, 0.f, 0.f};
        cur = nxt; cA = nA; cB = nB; ++ui;
        if constexpr (ALIGN_EPI) { if (wr == 1) PG8_BAR; }
    }
    PG8_WAIT_V(0);
    if constexpr (!ALIGN_EPI) { if (wr == 0) PG8_BAR; }
    PG8_BAR;
    if constexpr (Epi::AFTER_DRAIN) { E.fused(acc, cur, wr, wc, fr, fq, lds, wid, lane); S.done(cur); }
#undef PG8_SA
#undef PG8_SB
#undef PG8_STAGE
#undef PG8_LDA
#undef PG8_LDB
#undef PG8_MMA
#undef PG8_WAIT_V
#undef PG8_WAIT_L
#undef PG8_BAR
#undef PG8_SCHED
}
}

namespace pg8 {
struct EpiSwiGLU {
    static constexpr bool PERM = true, AFTER_DRAIN = false;
    bf16_t* H; int ldc;
    __device__ __forceinline__ void operator()(const f32x4 (&acc)[2][2][4][2], const Unit& u, int wr, int wc, int fr, int fq) const {
        const int row0 = u.pm * BM + wr * 64 + fr, col0 = u.pn * HALF + wc * 32 + 8 * fq;
#pragma unroll
        for (int ai = 0; ai < 2; ++ai)
#pragma unroll
            for (int m = 0; m < 4; ++m) {
                bf16_t* rowp = H + ((size_t)(col0 >> 6) * ldc   + (row0 + ai * HALF + m * 16)) * 64 + (col0 & 63);
                float h[8];
#pragma unroll
                for (int n = 0; n < 2; ++n)
#pragma unroll
                    for (int i = 0; i < 4; ++i) { const float g = acc[ai][0][m][n][i], uu = acc[ai][1][m][n][i];
                        const float e = __builtin_amdgcn_exp2f(g * -1.4426950408889634f);
                        h[n * 4 + i] = g * uu * __builtin_amdgcn_rcpf(1.0f + e); }
                u32x4 w; w.x = cvt_pk_bf16(h[0], h[1]); w.y = cvt_pk_bf16(h[2], h[3]); w.z = cvt_pk_bf16(h[4], h[5]); w.w = cvt_pk_bf16(h[6], h[7]);
                *(u32x4*)rowp = w;
            }
    }
};
struct EpiResGate {
    static constexpr bool PERM = true, AFTER_DRAIN = false;
    const float* in_lat; const float* in_ctx; bf16_t* xr; float* out32; const float* gate; float f; int mode;
    __device__ __forceinline__ void operator()(const f32x4 (&acc)[2][2][4][2], const Unit& u, int wr, int wc, int fr, int fq) const {
        const bool lat = u.pm < 256; const int mb = lat ? (u.pm >> 5) : 8;
        const int col0 = u.pn * BM + wc * 32 + 8 * fq; const int row0 = u.pm * BM + wr * 64 + fr;
        f32x4 gv[2][2];
#pragma unroll
        for (int bj = 0; bj < 2; ++bj)
#pragma unroll
            for (int n = 0; n < 2; ++n) gv[bj][n] = *(const f32x4*)(gate + (size_t)mb * 9216 + col0 + bj * HALF + n * 4);
        if (mode & 1) {
            const float* base = lat ? in_lat + (size_t)row0 * 1024 : in_ctx + (size_t)(row0 - 65536) * 1024;
#pragma unroll
            for (int ai = 0; ai < 2; ++ai)
#pragma unroll
                for (int m = 0; m < 4; ++m) { const size_t ro = (size_t)(ai * HALF + m * 16) * 1024 + col0;
#pragma unroll
                    for (int bj = 0; bj < 2; ++bj) { const f32x4 b0 = *(const f32x4*)(base + ro + bj * HALF), b1 = *(const f32x4*)(base + ro + bj * HALF + 4);
                        const f32x4 o0 = b0 + gv[bj][0] * (acc[ai][bj][m][0] * f), o1 = b1 + gv[bj][1] * (acc[ai][bj][m][1] * f);
                        u32x4 w; w.x = cvt_pk_bf16(o0[0], o0[1]); w.y = cvt_pk_bf16(o0[2], o0[3]); w.z = cvt_pk_bf16(o1[0], o1[1]); w.w = cvt_pk_bf16(o1[2], o1[3]);
                        *(u32x4*)(xr + (size_t)row0 * 1024 + ro + bj * HALF) = w; }
                    if (m & 1) asm volatile("" ::: "memory"); }
        } else {
            u32x4 bw[2][4][2];
#pragma unroll
            for (int ai = 0; ai < 2; ++ai)
#pragma unroll
                for (int m = 0; m < 4; ++m)
#pragma unroll
                    for (int bj = 0; bj < 2; ++bj) bw[ai][m][bj] = *(const u32x4*)(xr + (size_t)(row0 + ai * HALF + m * 16) * 1024 + col0 + bj * HALF);
#pragma unroll
            for (int ai = 0; ai < 2; ++ai)
#pragma unroll
                for (int m = 0; m < 4; ++m)
#pragma unroll
                    for (int bj = 0; bj < 2; ++bj) { const u32x4 b = bw[ai][m][bj]; const size_t off = (size_t)(row0 + ai * HALF + m * 16) * 1024 + col0 + bj * HALF;
                        const f32x4 b0 = {__uint_as_float(b.x << 16), __uint_as_float(b.x & 0xffff0000u), __uint_as_float(b.y << 16), __uint_as_float(b.y & 0xffff0000u)};
                        const f32x4 b1 = {__uint_as_float(b.z << 16), __uint_as_float(b.z & 0xffff0000u), __uint_as_float(b.w << 16), __uint_as_float(b.w & 0xffff0000u)};
                        const f32x4 o0 = b0 + gv[bj][0] * (acc[ai][bj][m][0] * f), o1 = b1 + gv[bj][1] * (acc[ai][bj][m][1] * f);
                        if (mode & 2) { *(f32x4*)(out32 + off) = o0; *(f32x4*)(out32 + off + 4) = o1; }
                        else { u32x4 w; w.x = cvt_pk_bf16(o0[0], o0[1]); w.y = cvt_pk_bf16(o0[2], o0[3]); w.z = cvt_pk_bf16(o1[0], o1[1]); w.w = cvt_pk_bf16(o1[2], o1[3]); *(u32x4*)(xr + off) = w; } }
        }
    }
};
struct EpiStoreBf16 {
    static constexpr bool PERM = true, AFTER_DRAIN = false;
    bf16_t* O; int ldc;
    __device__ __forceinline__ void operator()(const f32x4 (&acc)[2][2][4][2], const Unit& u, int wr, int wc, int fr, int fq) const {
        const int row0 = u.pm * BM + wr * 64 + fr, col0 = u.pn * BM + wc * 32 + 8 * fq;
#pragma unroll
        for (int ai = 0; ai < 2; ++ai)
#pragma unroll
            for (int m = 0; m < 4; ++m) { bf16_t* rowp = O + (size_t)(row0 + ai * HALF + m * 16) * ldc + col0;
#pragma unroll
                for (int bj = 0; bj < 2; ++bj) { const f32x4 v0 = acc[ai][bj][m][0], v1 = acc[ai][bj][m][1];
                    u32x4 w; w.x = cvt_pk_bf16(v0[0], v0[1]); w.y = cvt_pk_bf16(v0[2], v0[3]); w.z = cvt_pk_bf16(v1[0], v1[1]); w.w = cvt_pk_bf16(v1[2], v1[3]);
                    *(u32x4*)(rowp + bj * HALF) = w; } }
    }
};
}

constexpr int NB = 8, SEQ = 8192, DM = 1024, CTXL = 256, DEPTH = 2, DFF = 2816, NMOD = 9, INC = 3584;
constexpr int TL = NB * SEQ, TC = NB * CTXL, TT = TL + TC;
constexpr int C_NAQ = 0, C_NAK = 384, C_NAV = 768, C_SGU = 1152, C_SGV = 1408, C_RQ = 1664, C_RK = 2048, C_RV = 2432, C_GF = 2816, C_GB = 3200;
constexpr int M_NA = 0, M_SG = 384, M_RET = 640;
constexpr int NCH = TT / 128, NCHL = TL / 128;
constexpr int NWAVES = 8;
#ifndef MK_ONE_LAUNCH
#define MK_ONE_LAUNCH 1
#endif
constexpr int NPH = 1 + DEPTH * 12;

constexpr size_t MiB = 1u << 20;
constexpr size_t WS_CTL = 0, CTL_ZERO_BYTES = 1 * MiB;
constexpr size_t WS_MOD = 1 * MiB;
constexpr size_t WS_ROPE = 2 * MiB;
constexpr size_t WS_WSG = 3 * MiB;
constexpr size_t WS_W1T = 4 * MiB, WS_W2T = 48 * MiB, WS_WINT = 70 * MiB, WS_WOUTT = 84 * MiB;
constexpr size_t WS_CTXBUF = 88 * MiB;
constexpr size_t WS_XN = 96 * MiB;
constexpr size_t WS_P = 228 * MiB;
constexpr size_t WS_KV = 690 * MiB;
constexpr size_t WS_PREV = 789 * MiB;
constexpr size_t WS_XR = 888 * MiB;
constexpr size_t WS_END = 1020 * MiB;
constexpr int CW_BAR = 4096;

constexpr int RING_BYTES = 131072, LDSCTL_OFF = 163840 - 512, MISC_OFF = LDSCTL_OFF + 320, LDS_BYTES = 163840;
#define GAS __attribute__((address_space(1)))
#define LAS __attribute__((address_space(3)))
typedef unsigned short bf16;
typedef unsigned v4u __attribute__((ext_vector_type(4)));
typedef float f32x4 __attribute__((ext_vector_type(4)));
typedef short bf16x8 __attribute__((ext_vector_type(8)));
typedef GAS unsigned gu32;
typedef GAS unsigned long long gu64;
#define RLX_AGENT __ATOMIC_RELAXED, __HIP_MEMORY_SCOPE_AGENT
#define LDS_WAIT() asm volatile("s_waitcnt lgkmcnt(0)" ::: "memory")
#define VM_WAIT() asm volatile("s_waitcnt vmcnt(0)" ::: "memory")
__device__ __forceinline__ unsigned long long rt() { return __builtin_amdgcn_s_memrealtime(); }
__device__ __forceinline__ unsigned f2bf(float f) { unsigned u = __builtin_bit_cast(unsigned, f); return (u + 0x7fffu + ((u >> 16) & 1u)) >> 16; }
__device__ __forceinline__ unsigned pk2(float lo, float hi) { return f2bf(lo) | (f2bf(hi) << 16); }
#define XB_TMO      128
#define XB_XCNT(j)  (256  + 64 * (j))
#define XB_XSUB(j)  (1280 + 64 * (j))
#define XB_XGEN(j)  (2304 + 64 * (j))
#define XB_TOP      3328
#define XB_TOPGEN   3392
#define XCD_BAR_WORDS 3456
#define XB_SPIN_CAP (1u << 18)

__device__ __forceinline__ unsigned xb_ld(unsigned* p)              { return __hip_atomic_load(p, __ATOMIC_RELAXED, __HIP_MEMORY_SCOPE_AGENT); }
__device__ __forceinline__ unsigned xb_add(unsigned* p, unsigned v) { return __hip_atomic_fetch_add(p, v, __ATOMIC_RELAXED, __HIP_MEMORY_SCOPE_AGENT); }
__device__ __forceinline__ unsigned xb_xcc_id() { return (unsigned)__builtin_amdgcn_s_getreg((3 << 11) | 20) & 0xFu; }
#define XB_SPIN(cond, bar) do { unsigned _sp = 0; while (cond) { __builtin_amdgcn_s_sleep(1); \
    if ((++_sp & 255u) == 0u) { if (xb_ld(&(bar)[XB_TMO])) break; if (_sp > XB_SPIN_CAP) { atomicAdd(&(bar)[XB_TMO], 1u); break; } } } } while (0)

struct XcdBarrier {
    unsigned* bar; unsigned x;
    volatile LAS unsigned* st;
};

__device__ __forceinline__ XcdBarrier xcd_barrier_post(unsigned* bar, volatile LAS unsigned* st) {
    XcdBarrier b; b.bar = bar; b.x = xb_xcc_id(); b.st = st;
    if (threadIdx.x == 0) (void)xb_add(&bar[XB_XCNT(b.x)], 1u);
    return b;
}
__device__ __forceinline__ void xcd_barrier_complete(unsigned* bar, unsigned x, unsigned& nloc, unsigned& nx) {
    const unsigned G = gridDim.x * gridDim.y * gridDim.z;
    unsigned sum, cnt, mine, sp = 0u;
    for (;;) {
        sum = 0u; cnt = 0u; mine = 0u;
#pragma unroll
        for (unsigned j = 0; j < 16; ++j) { const unsigned c = xb_ld(&bar[XB_XCNT(j)]); sum += c; cnt += (c > 0u) ? 1u : 0u; mine = (j == x) ? c : mine; }
        if (sum == G) break;
        __builtin_amdgcn_s_sleep(1);
        if ((++sp & 255u) == 0u) { if (xb_ld(&bar[XB_TMO])) break; if (sp > XB_SPIN_CAP) { atomicAdd(&bar[XB_TMO], 1u); break; } }
    }
    nloc = mine > 0u ? mine : 1u; nx = cnt > 0u ? cnt : 1u;
}

__device__ __forceinline__ void xcd_barrier(const XcdBarrier& b) {
    asm volatile("s_waitcnt vmcnt(0)" ::: "memory");
    __syncthreads();
    if (threadIdx.x == 0) {
        unsigned* bar = b.bar;
        __builtin_amdgcn_s_waitcnt(0);
        unsigned nloc = b.st[0], nx = b.st[1];
        if (nloc == 0u) { xcd_barrier_complete(bar, b.x, nloc, nx); b.st[0] = nloc; b.st[1] = nx; }
        const unsigned old = xb_add(&bar[XB_XSUB(b.x)], 1u);
        const unsigned gen = old / nloc;
        if (old + 1u == (gen + 1u) * nloc) {
            __builtin_amdgcn_fence(__ATOMIC_RELEASE, "agent");
            asm volatile("s_waitcnt vmcnt(0)" ::: "memory");
            const unsigned og = xb_add(&bar[XB_TOP], 1u);
            const unsigned tg = og / nx;
            if (og + 1u == (tg + 1u) * nx) xb_add(&bar[XB_TOPGEN], 1u);
            else XB_SPIN(xb_ld(&bar[XB_TOPGEN]) == tg, bar);
            __builtin_amdgcn_fence(__ATOMIC_ACQUIRE, "agent");
            xb_add(&bar[XB_XGEN(b.x)], 1u);
            asm volatile("s_waitcnt vmcnt(0)" ::: "memory");
        } else {
            XB_SPIN(xb_ld(&bar[XB_XGEN(b.x)]) == gen, bar);
            __builtin_amdgcn_fence(__ATOMIC_ACQUIRE, "agent");
            asm volatile("s_waitcnt vmcnt(0)" ::: "memory");
        }
    }
    __syncthreads();
}
#ifndef REP_NORM
#define REP_NORM 1
#endif

typedef unsigned u32x2 __attribute__((ext_vector_type(2)));

#define SHX(v, o) __builtin_bit_cast(float, __builtin_amdgcn_ds_swizzle(__builtin_bit_cast(int, (float)(v)), ((o) << 10) | 0x1f))
__device__ __forceinline__ float xhalf_sum(float v) { auto rr = __builtin_amdgcn_permlane32_swap(__float_as_uint(v), __float_as_uint(v), false, false); return __uint_as_float(rr[0]) + __uint_as_float(rr[1]); }
__device__ __forceinline__ float xhalf_max(float v) { auto rr = __builtin_amdgcn_permlane32_swap(__float_as_uint(v), __float_as_uint(v), false, false); return fmaxf(__uint_as_float(rr[0]), __uint_as_float(rr[1])); }
__device__ __forceinline__ float wave_sum(float v) { v += SHX(v, 1); v += SHX(v, 2); v += SHX(v, 4); v += SHX(v, 8); v += SHX(v, 16); return xhalf_sum(v); }
__device__ __forceinline__ float bflo(unsigned w) { return __uint_as_float(w << 16); }
__device__ __forceinline__ float bfhi(unsigned w) { return __uint_as_float(w & 0xffff0000u); }
__device__ __forceinline__ void load8(const bf16* p, float* o) {
    const v4u w = *(const v4u*)p;
    o[0] = bflo(w.x); o[1] = bfhi(w.x); o[2] = bflo(w.y); o[3] = bfhi(w.y); o[4] = bflo(w.z); o[5] = bfhi(w.z); o[6] = bflo(w.w); o[7] = bfhi(w.w);
}
__device__ __forceinline__ void store8(bf16* p, const float* o) {
    v4u w; w.x = pk2(o[0], o[1]); w.y = pk2(o[2], o[3]); w.z = pk2(o[4], o[5]); w.w = pk2(o[6], o[7]); *(v4u*)p = w;
}
__device__ __forceinline__ float sigmoidf_(float x) { return __builtin_amdgcn_rcpf(1.0f + __builtin_amdgcn_exp2f(-1.4426950408889634f * x)); }
__device__ __forceinline__ float gelu_tanh(float x) { const float y = 0.7978845608028654f * (x + 0.044715f * x * x * x); return x * sigmoidf_(2.0f * y); }
__device__ __forceinline__ float log_sigmoid(float x) { return fminf(x, 0.0f) - log1pf(expf(-fabsf(x))); }

__device__ __forceinline__ void p0_transpose_item(const float* W, int K, int N, bf16* WT, bool swiglu, LAS float* scr, int item, int lane, bool kblocked = false) {
    const int nblk = N / 32, kb = item / nblk, nb = item % nblk, k0 = 64 * kb, n0 = 32 * nb;
    int d0 = n0;
    if (swiglu) { const int hid = n0 < DFF ? n0 : n0 - DFF; d0 = (hid >> 7) * 256 + (n0 < DFF ? 0 : 128) + (hid & 127); }
#pragma unroll 8
    for (int i = 0; i < 32; ++i) { const int kk = 2 * i + (lane >> 5); scr[kk * 33 + (lane & 31)] = W[(size_t)(k0 + kk) * N + n0 + (lane & 31)]; }
    LDS_WAIT(); asm volatile("" ::: "memory");
    const int c = lane & 7;
#pragma unroll
    for (int j = 0; j < 4; ++j) { const int n = (lane >> 3) + 8 * j; const LAS float* s = scr + (8 * c) * 33 + n;
        v4u o; o.x = pk2(s[0 * 33], s[1 * 33]); o.y = pk2(s[2 * 33], s[3 * 33]); o.z = pk2(s[4 * 33], s[5 * 33]); o.w = pk2(s[6 * 33], s[7 * 33]);
        *(GAS v4u*)(WT + (kblocked ? ((size_t)kb * N + d0 + n) * 64 + 8 * c : (size_t)(d0 + n) * K + k0 + 8 * c)) = o; }
    LDS_WAIT(); asm volatile("" ::: "memory");
}
struct In { const float *x, *c, *ctx, *c_ctx, *ada_w, *ada_b, *norm_w, *ffn_w1, *ffn_w2, *w_in, *w_out, *na_qn, *na_kn, *na_rpb, *sg_w, *sg_b, *sg_ln_w, *sg_ln_b, *ret_logit, *ret_gn_w; };

__device__ __forceinline__ void p0_prologue(const In& I, unsigned char* ws, LAS unsigned char* lds, int tid, int lane, int wave, int vcu, int G) {
    LAS float* scr = (LAS float*)(lds + wave * 16384);
    const int gw = vcu * NWAVES + wave, NGW = G * NWAVES;
    constexpr int I_W1 = (DM / 64) * (2 * DFF / 32), I_W2 = (DFF / 64) * (DM / 32), I_WIN = (DM / 64) * (INC / 32), I_WOUT = (DM / 64) * (DM / 32);
    constexpr int PER_L = 2 * I_W1 + 2 * I_W2 + I_WIN + I_WOUT;
    bf16* W1T = (bf16*)(ws + WS_W1T); bf16* W2T = (bf16*)(ws + WS_W2T); bf16* WINT = (bf16*)(ws + WS_WINT); bf16* WOUTT = (bf16*)(ws + WS_WOUTT);
    for (int it = gw; it < DEPTH * PER_L; it += NGW) {
        const int L = it / PER_L; int r = it % PER_L;
        if (r < 2 * I_W1) { const int i = r / I_W1; r %= I_W1; const size_t o = (size_t)(L * 2 + i) * DM * 2 * DFF; p0_transpose_item(I.ffn_w1 + o, DM, 2 * DFF, W1T + o, true, scr, r, lane); continue; } r -= 2 * I_W1;
        if (r < 2 * I_W2) { const int i = r / I_W2; r %= I_W2; const size_t o = (size_t)(L * 2 + i) * DFF * DM; p0_transpose_item(I.ffn_w2 + o, DFF, DM, W2T + o, false, scr, r, lane, true); continue; } r -= 2 * I_W2;
        if (r < I_WIN) { const size_t o = (size_t)L * DM * INC; p0_transpose_item(I.w_in + o, DM, INC, WINT + o, false, scr, r, lane); continue; } r -= I_WIN;
        { const size_t o = (size_t)L * DM * DM; p0_transpose_item(I.w_out + o, DM, DM, WOUTT + o, false, scr, r, lane); }
    }
    __syncthreads();
    LAS float* sc = (LAS float*)lds;
    LAS float* part = (LAS float*)(lds + 36864);
    float* mod = (float*)(ws + WS_MOD);
    for (int cb = blockIdx.x; cb < 256; cb += G) {
        for (int i = tid; i < 9 * 1024; i += 512) { const int mb = i >> 10, k = i & 1023; const float v = mb < 8 ? I.c[mb * 1024 + k] : I.c_ctx[k]; sc[i] = v * sigmoidf_(v); }
        __syncthreads();
        const int cc = tid % 72, kp = tid / 72, colg = cb * 72 + cc, L = colg / 9216, j = colg % 9216;
        if (kp < 7) {
            float acc[9];
#pragma unroll
            for (int mb = 0; mb < 9; ++mb) acc[mb] = 0.f;
            for (int k = kp; k < 1024; k += 7) { const float w = I.ada_w[((size_t)L * 1024 + k) * 9216 + j];
#pragma unroll
                for (int mb = 0; mb < 9; ++mb) acc[mb] += sc[mb * 1024 + k] * w; }
#pragma unroll
            for (int mb = 0; mb < 9; ++mb) part[(kp * 72 + cc) * 9 + mb] = acc[mb];
        }
        __syncthreads();
        for (int o = tid; o < 72 * 9; o += 512) { const int c2 = o / 9, mb = o % 9; const int colg2 = cb * 72 + c2, L2 = colg2 / 9216, j2 = colg2 % 9216;
            float s = I.ada_b[L2 * 9216 + j2];
#pragma unroll
            for (int p = 0; p < 7; ++p) s += part[(p * 72 + c2) * 9 + mb];
            mod[((size_t)L2 * 9 + mb) * 9216 + j2] = s; }
        __syncthreads();
    }
    { bf16* wsg = (bf16*)(ws + WS_WSG); for (int i = blockIdx.x * 512 + tid; i < DEPTH * 4 * 128 * 128 / 8; i += G * 512) { const f32x4 a = ((const f32x4*)I.sg_w)[2 * i], b = ((const f32x4*)I.sg_w)[2 * i + 1];
        v4u o; o.x = pk2(a.x, a.y); o.y = pk2(a.z, a.w); o.z = pk2(b.x, b.y); o.w = pk2(b.z, b.w); ((v4u*)wsg)[i] = o; } }
    if (blockIdx.x == (unsigned)(G - 1)) {
        float* tab = (float*)(ws + WS_ROPE);
        if (tid < DEPTH * 12) ((float*)(ws + WS_ROPE + 32768))[tid] = log_sigmoid(I.ret_logit[tid]) * 1.4426950408889634f;
        for (int i = tid; i < 128 * 16; i += 512) { const int n = i >> 4, f = i & 15; const float inv = exp2f(-(float)f * (13.287712379549449f / 16.0f)); const float ang = (float)n * inv;
            tab[2 * i] = cosf(ang); tab[2 * i + 1] = sinf(ang); }
    }
}

__device__ __forceinline__ void norm_phase(const float* xl, const float* xc, const bf16* xb, int nrows, const float* nw, const float* modL, int sidx, bf16* XN, int gw, int NGW, int lane) {
    const int rpw = (nrows + NGW - 1) / NGW; const int r0 = gw * rpw; int r1 = r0 + rpw; if (r1 > nrows) r1 = nrows;
    int cur = -1; f32x4 g[4], sh[4];
#pragma unroll
    for (int j = 0; j < 4; ++j) { g[j] = (f32x4){0.f, 0.f, 0.f, 0.f}; sh[j] = g[j]; }
#define NP_SRC(r) ((r) < TL ? xl + (size_t)(r) * DM : xc + (size_t)((r) - TL) * DM)
#define NP_LOAD(dst, r) do { if (xb) { const u32x2* sb_ = (const u32x2*)(xb + (size_t)(r) * DM); _Pragma("unroll") for (int j = 0; j < 4; ++j) { const u32x2 w_ = sb_[lane + 64 * j]; dst[j] = (f32x4){bflo(w_.x), bfhi(w_.x), bflo(w_.y), bfhi(w_.y)}; } } \
        else { const float* s_ = NP_SRC(r); _Pragma("unroll") for (int j = 0; j < 4; ++j) dst[j] = ((const f32x4*)s_)[lane + 64 * j]; } } while (0)
    f32x4 va[4], vb[4], vc[4];
    const int nr = (r1 - r0) * REP_NORM;
    if (nr > 0) NP_LOAD(va, r0);
    if (nr > 1) NP_LOAD(vb, r0 + 1 % (r1 - r0));
    for (int rr_ = 0; rr_ < nr; ++rr_) { const int r = r0 + rr_ % (r1 - r0);
        if (rr_ + 2 < nr) NP_LOAD(vc, r0 + (rr_ + 2) % (r1 - r0));
        const int mb = r < TL ? (r >> 13) : 8;
        if (mb != cur) { cur = mb; const float* sf = modL + (size_t)mb * 9216 + sidx * 1024; const float* sl = sf + 1024;
#pragma unroll
            for (int j = 0; j < 4; ++j) { const f32x4 w = ((const f32x4*)nw)[lane + 64 * j], s1 = ((const f32x4*)sl)[lane + 64 * j]; g[j] = w * (s1 + 1.0f); sh[j] = ((const f32x4*)sf)[lane + 64 * j]; } }
        float s = 0.f;
#pragma unroll
        for (int j = 0; j < 4; ++j) s += (va[j].x * va[j].x + va[j].y * va[j].y) + (va[j].z * va[j].z + va[j].w * va[j].w);
        const float rstd = 1.0f / sqrtf(wave_sum(s) * (1.0f / DM) + 1e-6f);
        unsigned long long* o8 = (unsigned long long*)(XN + (size_t)r * DM) + lane;
#pragma unroll
        for (int j = 0; j < 4; ++j) { const f32x4 y = va[j] * rstd * g[j] + sh[j]; o8[64 * j] = (unsigned long long)pk2(y.x, y.y) | ((unsigned long long)pk2(y.z, y.w) << 32); }
#pragma unroll
        for (int j = 0; j < 4; ++j) { va[j] = vb[j]; vb[j] = vc[j]; }
    }
#undef NP_SRC
#undef NP_LOAD
}

__device__ __forceinline__ void na_naive(const bf16* P, bf16* MIX, const float* wq, const float* wk, const float* rpb, bool with_ctx, int gtid, int nthreads) {
    float mq = 0.f, mk = 0.f, mr = 0.f;
    for (int d = 0; d < 64; ++d) { mq = fmaxf(mq, fabsf(wq[d])); mk = fmaxf(mk, fabsf(wk[d])); }
    for (int i = 0; i < 6 * 15 * 31; ++i) mr = fmaxf(mr, fabsf(rpb[i]));
    const float mbound = 8.0f * mq * mk + mr;
    const int nitems = (TL + (with_ctx ? TC : 0)) * 6;
    for (int item = gtid; item < nitems; item += nthreads) {
        int h, t; bool isctx;
        if (item < TL * 6) { h = item / TL; t = item % TL; isctx = false; } else { const int r = item - TL * 6; h = r / TC; t = TL + r % TC; isctx = true; }
        float q[64], o[64];
        { const bf16* qp = P + (size_t)t * INC + C_NAQ + h * 64; float ss = 0.f;
#pragma unroll
          for (int d8 = 0; d8 < 8; ++d8) { load8(qp + d8 * 8, q + d8 * 8); }
#pragma unroll
          for (int d = 0; d < 64; ++d) ss += q[d] * q[d];
          const float rstd = 1.0f / sqrtf(ss * (1.0f / 64.0f) + 1e-6f);
#pragma unroll
          for (int d = 0; d < 64; ++d) { q[d] = q[d] * rstd * wq[d] * wk[d] * 0.125f; o[d] = 0.f; } }
        float l = 0.f;
        int b, nloc, r = 0, c = 0, rs = 0, cs = 0;
        if (!isctx) { b = t >> 13; const int pos = t & 8191; r = pos >> 6; c = pos & 63; rs = min(max(r - 4, 0), 120); cs = min(max(c - 8, 0), 48); nloc = 128; }
        else { b = (t - TL) >> 8; nloc = 0; }
        for (int kk = 0; kk < nloc + 256; ++kk) {
            int tk; float bias = 0.f;
            if (kk < nloc) { const int i = kk >> 4, j = kk & 15; tk = b * SEQ + (rs + i) * 64 + cs + j; bias = rpb[(h * 15 + (rs + i - r + 7)) * 31 + (cs + j - c + 15)]; }
            else tk = TL + b * CTXL + (kk - nloc);
            const bf16* kp = P + (size_t)tk * INC + C_NAK + h * 64; const bf16* vp = P + (size_t)tk * INC + C_NAV + h * 64;
            float dot = 0.f, ss = 0.f;
#pragma unroll
            for (int d8 = 0; d8 < 8; ++d8) { float k8[8]; load8(kp + d8 * 8, k8);
#pragma unroll
                for (int e = 0; e < 8; ++e) { dot += q[d8 * 8 + e] * k8[e]; ss += k8[e] * k8[e]; } }
            const float s = dot / sqrtf(ss * (1.0f / 64.0f) + 1e-6f) + bias;
            const float p = __expf(s - mbound); l += p;
#pragma unroll
            for (int d8 = 0; d8 < 8; ++d8) { float v8[8]; load8(vp + d8 * 8, v8);
#pragma unroll
                for (int e = 0; e < 8; ++e) o[d8 * 8 + e] += p * v8[e]; }
        }
        const float il = 1.0f / l; bf16* op = MIX + (size_t)t * DM + M_NA + h * 64;
#pragma unroll
        for (int d8 = 0; d8 < 8; ++d8) { float t8[8];
#pragma unroll
            for (int e = 0; e < 8; ++e) t8[e] = o[d8 * 8 + e] * il;
            store8(op + d8 * 8, t8); }
    }
}

__device__ __forceinline__ void sg_naive(const bf16* P, bf16* MIX, const float* sgw, const float* sgb, const float* lnw, const float* lnb, LAS unsigned char* lds, int tid, int G) {
    LAS float* vn = (LAS float*)lds;
    const int tok = tid >> 2, part = tid & 3;
    for (int it = blockIdx.x; it < NCH * 4; it += G) {
        const int ch = it >> 2, g = it & 3, row0 = ch * 128;
        { const bf16* src = P + (size_t)(row0 + tok) * INC + C_SGV + g * 64 + part * 16; float v[16]; load8(src, v); load8(src + 8, v + 8);
          float s = 0.f;
#pragma unroll
          for (int k = 0; k < 16; ++k) { v[k] = gelu_tanh(v[k]); s += v[k]; }
          s += SHX(s, 1); s += SHX(s, 2); const float mu = s * (1.0f / 64.0f); float q = 0.f;
#pragma unroll
          for (int k = 0; k < 16; ++k) { v[k] -= mu; q += v[k] * v[k]; }
          q += SHX(q, 1); q += SHX(q, 2); const float rstd = 1.0f / sqrtf(q * (1.0f / 64.0f) + 1e-5f);
#pragma unroll
          for (int k = 0; k < 16; ++k) { const int cch = g * 64 + part * 16 + k; vn[tok * 64 + part * 16 + k] = v[k] * rstd * lnw[cch] + lnb[cch]; } }
        __syncthreads();
        { float acc[16];
#pragma unroll
          for (int k = 0; k < 16; ++k) acc[k] = 0.f;
          const float* wrow = sgw + ((size_t)g * 128 + tok) * 128;
          for (int q = 0; q < 128; ++q) { const float w = wrow[q];
#pragma unroll
              for (int k = 0; k < 16; ++k) acc[k] += w * vn[q * 64 + part * 16 + k]; }
          const float bias = sgb[g * 128 + tok];
          const bf16* up = P + (size_t)(row0 + tok) * INC + C_SGU + g * 64 + part * 16; float u[16]; load8(up, u); load8(up + 8, u + 8);
#pragma unroll
          for (int k = 0; k < 16; ++k) u[k] = gelu_tanh(u[k]) * (acc[k] + bias);
          bf16* op = MIX + (size_t)(row0 + tok) * DM + M_SG + g * 64 + part * 16; store8(op, u); store8(op + 8, u + 8); }
        __syncthreads();
    }
}

__device__ __forceinline__ void rope_load16(const bf16* P, int row, int colbase, int h, int part, bool latent, const float* ropetab, float* out) {
    const bf16* base = P + (size_t)row * INC + colbase + h * 64;
    float mine[16]; load8(base + part * 16, mine); load8(base + part * 16 + 8, mine + 8);
    if (!latent) {
#pragma unroll
        for (int f = 0; f < 16; ++f) out[f] = mine[f];
        return; }
    float oth[16]; load8(base + (part ^ 1) * 16, oth); load8(base + (part ^ 1) * 16 + 8, oth + 8);
    const int pos = row & (SEQ - 1); const int n = (part < 2) ? (pos >> 6) : (pos & 63);
    const float* tb = ropetab + n * 32;
#pragma unroll
    for (int f = 0; f < 16; ++f) { const float cs = tb[2 * f], sn = tb[2 * f + 1]; out[f] = (part & 1) ? (oth[f] * sn + mine[f] * cs) : (mine[f] * cs - oth[f] * sn); }
}
__device__ __forceinline__ void ret_kv_naive(const bf16* P, float* KV, const float* logit, const float* ropetab, LAS unsigned char* lds, int tid, int G) {
    LAS float* kS = (LAS float*)lds; LAS float* vS = kS + 128 * 64; LAS float* wt = vS + 128 * 64;
    const int tok = tid >> 2, part = tid & 3;
    for (int it = blockIdx.x; it < NCH * 6; it += G) {
        const int ch = it / 6, h = it % 6, row0 = ch * 128; const bool latent = ch < NCHL;
        { float k16[16]; rope_load16(P, row0 + tok, C_RK, h, part, latent, ropetab, k16);
#pragma unroll
          for (int f = 0; f < 16; ++f) kS[tok * 64 + part * 16 + f] = k16[f] * 0.125f;
          const bf16* vp = P + (size_t)(row0 + tok) * INC + C_RV + h * 64 + part * 16; float v16[16]; load8(vp, v16); load8(vp + 8, v16 + 8);
#pragma unroll
          for (int f = 0; f < 16; ++f) vS[tok * 64 + part * 16 + f] = v16[f]; }
        if (tid < 256) { const int dir = tid >> 7, j = tid & 127; const float lg = log_sigmoid(logit[dir * 6 + h]); wt[tid] = expf(lg * (float)(dir == 0 ? 127 - j : j)); }
        __syncthreads();
        { const int d = tid >> 3, e0 = (tid & 7) * 8; float af[8], ab[8];
#pragma unroll
          for (int k = 0; k < 8; ++k) { af[k] = 0.f; ab[k] = 0.f; }
          for (int j = 0; j < 128; ++j) { const float kd = kS[j * 64 + d]; const float a = kd * wt[j], b = kd * wt[128 + j];
#pragma unroll
              for (int k = 0; k < 8; ++k) { const float v = vS[j * 64 + e0 + k]; af[k] += a * v; ab[k] += b * v; } }
          float* of = KV + ((size_t)(ch * 6 + h) * 2 + 0) * 4096 + d * 64 + e0; float* ob = of + 4096;
#pragma unroll
          for (int k = 0; k < 8; ++k) { of[k] = af[k]; ob[k] = ab[k]; } }
        __syncthreads();
    }
}
__device__ __forceinline__ void ret_scan(const float* KV, float* PREV, const float* logit, int gtid, int nthreads) {
    for (int it = gtid; it < NB * 6 * 2 * 4096; it += nthreads) {
        const int idx = it & 4095, dir = (it >> 12) & 1, bh = it >> 13, h = bh % 6, b = bh / 6;
        const float cd = expf(128.0f * log_sigmoid(logit[dir * 6 + h]));
#define KVI(ch) (((size_t)((ch) * 6 + h) * 2 + dir) * 4096 + idx)
        const int c0 = NCHL + 2 * b, c1 = c0 + 1;
        const float k0 = KV[KVI(c0)], k1 = KV[KVI(c1)];
        if (dir == 0) { PREV[KVI(c0)] = 0.f; PREV[KVI(c1)] = k0; float s = cd * k0 + k1;
            for (int n = 0; n < 64; ++n) { const int ch = b * 64 + n; PREV[KVI(ch)] = s; s = cd * s + KV[KVI(ch)]; } }
        else { PREV[KVI(c0)] = k1; PREV[KVI(c1)] = 0.f; float s = k0 + cd * k1;
            for (int n = 63; n >= 0; --n) { const int ch = b * 64 + n; PREV[KVI(ch)] = s; s = cd * s + KV[KVI(ch)]; } }
#undef KVI
    }
}
__device__ __forceinline__ void ret_out_naive(const bf16* P, const float* PREV, bf16* MIX, const float* logit, const float* gnw, const float* ropetab, LAS unsigned char* lds, int tid, int G) {
    LAS bf16* qS = (LAS bf16*)lds; LAS bf16* kS = qS + 128 * 64; LAS bf16* vS = kS + 128 * 64;
    LAS float* S = (LAS float*)(lds + 49152);
    LAS float* dec = (LAS float*)(lds + 49152 + 65536);
    const int tok = tid >> 2, part = tid & 3;
    for (int it = blockIdx.x; it < NCH * 6; it += G) {
        const int ch = it / 6, h = it % 6, row0 = ch * 128; const bool latent = ch < NCHL;
        { float t16[16]; rope_load16(P, row0 + tok, C_RQ, h, part, latent, ropetab, t16);
#pragma unroll
          for (int f = 0; f < 16; ++f) qS[tok * 64 + part * 16 + f] = (bf16)f2bf(t16[f]);
          rope_load16(P, row0 + tok, C_RK, h, part, latent, ropetab, t16);
#pragma unroll
          for (int f = 0; f < 16; ++f) kS[tok * 64 + part * 16 + f] = (bf16)f2bf(t16[f] * 0.125f);
          const bf16* vp = P + (size_t)(row0 + tok) * INC + C_RV + h * 64 + part * 16; const v4u a = *(const v4u*)vp, b = *(const v4u*)(vp + 8);
          *(LAS v4u*)(vS + tok * 64 + part * 16) = a; *(LAS v4u*)(vS + tok * 64 + part * 16 + 8) = b; }
        if (tid < 258) { const int dir = tid / 129, k = tid % 129; dec[tid] = expf(log_sigmoid(logit[dir * 6 + h]) * (float)k); }
        __syncthreads();
        { float q[64];
#pragma unroll
          for (int d = 0; d < 64; ++d) q[d] = __uint_as_float((unsigned)qS[tok * 64 + d] << 16);
          for (int jj = 0; jj < 32; ++jj) { const int j = part + 4 * jj; float dot = 0.f;
#pragma unroll
              for (int d = 0; d < 64; ++d) dot += q[d] * __uint_as_float((unsigned)kS[j * 64 + d] << 16);
              S[tok * 128 + j] = dot; } }
        __syncthreads();
        { const int i = tok, e0 = part * 16; float of[16], ob[16], cf[16], cb[16];
#pragma unroll
          for (int k = 0; k < 16; ++k) { of[k] = 0.f; ob[k] = 0.f; cf[k] = 0.f; cb[k] = 0.f; }
          for (int j = 0; j < 128; ++j) { const float s = S[i * 128 + j]; const float wf = (j <= i) ? s * dec[i - j] : 0.f, wb = (j >= i) ? s * dec[129 + j - i] : 0.f;
#pragma unroll
              for (int k = 0; k < 16; ++k) { const float v = __uint_as_float((unsigned)vS[j * 64 + e0 + k] << 16); of[k] += wf * v; ob[k] += wb * v; } }
          const float* pf = PREV + ((size_t)(ch * 6 + h) * 2) * 4096 + e0; const float* pb = pf + 4096;
          for (int d = 0; d < 64; ++d) { const float qd = __uint_as_float((unsigned)qS[i * 64 + d] << 16);
#pragma unroll
              for (int k = 0; k < 16; ++k) { cf[k] += qd * pf[d * 64 + k]; cb[k] += qd * pb[d * 64 + k]; } }
          const float df = dec[i + 1], db = dec[129 + 128 - i];
          float sf = 0.f, sb = 0.f;
#pragma unroll
          for (int k = 0; k < 16; ++k) { of[k] += df * cf[k]; ob[k] += db * cb[k]; sf += of[k]; sb += ob[k]; }
          sf += SHX(sf, 1); sf += SHX(sf, 2); sb += SHX(sb, 1); sb += SHX(sb, 2);
          const float muf = sf * (1.0f / 64.0f), mub = sb * (1.0f / 64.0f); float qf = 0.f, qb = 0.f;
#pragma unroll
          for (int k = 0; k < 16; ++k) { of[k] -= muf; ob[k] -= mub; qf += of[k] * of[k]; qb += ob[k] * ob[k]; }
          qf += SHX(qf, 1); qf += SHX(qf, 2); qb += SHX(qb, 1); qb += SHX(qb, 2);
          const float rf = 1.0f / sqrtf(qf * (1.0f / 64.0f) + 1e-5f), rb = 1.0f / sqrtf(qb * (1.0f / 64.0f) + 1e-5f);
          const bf16* gp = P + (size_t)(row0 + i) * INC + C_GF + h * 64 + e0; float gf[16], gb[16]; load8(gp, gf); load8(gp + 8, gf + 8); load8(gp + (C_GB - C_GF), gb); load8(gp + (C_GB - C_GF) + 8, gb + 8);
          float y[16];
#pragma unroll
          for (int k = 0; k < 16; ++k) y[k] = (of[k] * rf * (gf[k] * sigmoidf_(gf[k])) + ob[k] * rb * (gb[k] * sigmoidf_(gb[k]))) * gnw[h * 64 + e0 + k];
          bf16* op = MIX + (size_t)(row0 + i) * DM + M_RET + h * 64 + e0; store8(op, y); store8(op + 8, y + 8); }
        __syncthreads();
    }
}
#ifndef REP_NA
#define REP_NA 1
#endif
#ifndef REP_SG
#define REP_SG 1
#endif
#ifndef REP_KV
#define REP_KV 1
#endif
#ifndef REP_RETO
#define REP_RETO 1
#endif

typedef short s16x4 __attribute__((ext_vector_type(4)));
typedef float f32x16 __attribute__((ext_vector_type(16)));
typedef float f32x2_t __attribute__((ext_vector_type(2)));
typedef __bf16 bf16x2_t __attribute__((ext_vector_type(2)));
#define MFMA32(a, b, c) __builtin_amdgcn_mfma_f32_32x32x16_bf16((a), (b), (c), 0, 0, 0)
#define LOG2E 1.4426950408889634f
#define LDS_BARRIER() do { asm volatile("s_waitcnt lgkmcnt(0)" ::: "memory"); __builtin_amdgcn_s_barrier(); asm volatile("" ::: "memory"); } while (0)
#define OPQV(x) ({ int _t = (x); asm volatile("" : "+v"(_t)); _t; })
#define FRESH_TID(w) ({ int _t; asm volatile("v_mbcnt_lo_u32_b32 %0, -1, 0\n\tv_mbcnt_hi_u32_b32 %0, -1, %0" : "=v"(_t)); _t | ((w) << 6); })
__device__ __forceinline__ unsigned cvtpk(float lo, float hi) { f32x2_t v = {lo, hi}; bf16x2_t b = __builtin_convertvector(v, bf16x2_t); return __builtin_bit_cast(unsigned, b); }
__device__ __forceinline__ int crow0(int reg) { return (reg & 3) + 8 * (reg >> 2); }
__device__ __forceinline__ int swz64(int row) { return (((row >> 1) & 1) << 2) | (((row >> 3) & 1) << 1) | ((row >> 2) & 1); }
__device__ __forceinline__ int off64(int row, int ch) { return 128 * row + 16 * (ch ^ swz64(row)); }
__device__ __forceinline__ bf16x8 rowfrag(LAS unsigned char* img, int row, int ch) { return *(const LAS bf16x8*)(img + off64(row, ch)); }
__device__ __forceinline__ s16x4 tr4(LAS unsigned char* img, int krow, int ct, int lane) {
    const int q = (lane & 15) >> 2, p = lane & 3, blk = (lane >> 4) & 1;
    return __builtin_bit_cast(s16x4, __builtin_amdgcn_ds_read_tr16_b64_v4i16((LAS s16x4*)(img + off64(krow + q, 4 * ct + 2 * blk + (p >> 1)) + 8 * (p & 1))));
}
__device__ __forceinline__ bf16x8 trfrag(LAS unsigned char* img, int krow_lo, int krow_hi, int ct, int lane) {
    const s16x4 lo = tr4(img, krow_lo, ct, lane), hi = tr4(img, krow_hi, ct, lane);
    return (bf16x8){lo[0], lo[1], lo[2], lo[3], hi[0], hi[1], hi[2], hi[3]};
}
__device__ __forceinline__ void st_chunk(LAS unsigned char* img, int row, int ch, const float* v8) {
    v4u w; w.x = cvtpk(v8[0], v8[1]); w.y = cvtpk(v8[2], v8[3]); w.z = cvtpk(v8[4], v8[5]); w.w = cvtpk(v8[6], v8[7]); *(LAS v4u*)(img + off64(row, ch)) = w;
}
#define PACK8(x, s) __builtin_bit_cast(bf16x8, (v4u){cvtpk((x)[8 * (s)], (x)[8 * (s) + 1]), cvtpk((x)[8 * (s) + 2], (x)[8 * (s) + 3]), cvtpk((x)[8 * (s) + 4], (x)[8 * (s) + 5]), cvtpk((x)[8 * (s) + 6], (x)[8 * (s) + 7])})
__device__ __forceinline__ f32x16 zero16() { f32x16 z;
#pragma unroll
    for (int i = 0; i < 16; ++i) z[i] = 0.f;
    return z; }
__device__ __forceinline__ float wave_max(float v) { v = fmaxf(v, SHX(v, 1)); v = fmaxf(v, SHX(v, 2)); v = fmaxf(v, SHX(v, 4)); v = fmaxf(v, SHX(v, 8)); v = fmaxf(v, SHX(v, 16)); return xhalf_max(v); }

__device__ __forceinline__ void na_mfma(const bf16* P, bf16* MIX, const float* wq, const float* wk, const float* rpb, bool with_ctx, LAS unsigned char* lds, int tid_in, int G) {
    const int wave = __builtin_amdgcn_readfirstlane(tid_in >> 6); int tid = tid_in, lane = tid & 63;
    LAS unsigned char* Kimg = lds; LAS unsigned char* Vimg = lds + 16384;
    LAS float* tab = (LAS float*)(lds + 32768) + 64;
    const float mq = wave_max(fabsf(wq[lane])), mk = wave_max(fabsf(wk[lane]));
    const int nunits = NB * 6 * 32 + (with_ctx ? NB * 6 : 0);
    for (int u_r = blockIdx.x; u_r < nunits * REP_NA; u_r += G) { const int u = u_r % nunits;
        tid = FRESH_TID(wave); lane = tid & 63; const int r32 = lane & 31, hh = lane >> 5;
        const int skey = tid >> 3, spart = tid & 7;
        float wk8[8];
#pragma unroll
        for (int j = 0; j < 8; ++j) wk8[j] = wk[8 * spart + j];
        const bool isctx = u >= NB * 6 * 32; int b, h, r0 = 0;
        if (!isctx) { b = u / 192; h = (u >> 5) % 6; r0 = 4 * (u & 31); } else { const int v = u - NB * 6 * 32; b = v / 6; h = v % 6; }
        float mr = 0.f;
        for (int i = lane; i < 465; i += 64) mr = fmaxf(mr, fabsf(rpb[h * 465 + i]));
        mr = wave_max(mr);
        const float mbound = 8.0f * mq * mk + mr, negmb = -mbound * LOG2E;
        if (!isctx) for (int i = tid; i < 465; i += 512) tab[i] = (rpb[h * 465 + i] - mbound) * LOG2E;
        int r = 0, c = 0, tq;
        if (!isctx) { r = r0 + (wave >> 1); c = 32 * (wave & 1) + r32; tq = b * SEQ + r * 64 + c; } else tq = TL + b * CTXL + wave * 32 + r32;
        bf16x8 qf[4];
        { float qv[32]; float ss = 0.f; const bf16* qp = P + (size_t)tq * INC + C_NAQ + h * 64 + 8 * hh;
#pragma unroll
          for (int s = 0; s < 4; ++s) load8(qp + 16 * s, qv + 8 * s);
#pragma unroll
          for (int i = 0; i < 32; ++i) ss += qv[i] * qv[i];
          ss = xhalf_sum(ss);
          const float rstd = (1.0f / sqrtf(ss * (1.0f / 64.0f) + 1e-6f)) * (0.125f * LOG2E);
#pragma unroll
          for (int s = 0; s < 4; ++s) { float t8[8];
#pragma unroll
              for (int j = 0; j < 8; ++j) { const int d = 16 * s + 8 * hh + j; t8[j] = qv[8 * s + j] * rstd * wq[d] * wk[d]; }
              qf[s] = __builtin_bit_cast(bf16x8, (v4u){cvtpk(t8[0], t8[1]), cvtpk(t8[2], t8[3]), cvtpk(t8[4], t8[5]), cvtpk(t8[6], t8[7])}); } }
        const int rs0 = min(max(r0 - 4, 0), 120);
        const int nl = isctx ? 0 : (min(max(r0 + 3 - 4, 0), 120) + 8 - rs0), nchunks = nl + 4;
        const int rs = min(max(r - 4, 0), 120);
#define NA_TOK(ci) ((ci) < nl ? b * SEQ + (rs0 + (ci)) * 64 + skey : TL + b * CTXL + ((ci) - nl) * 64 + skey)
#define NA_STAGE(buf, kw, vw) do { float k8[8]; k8[0] = bflo(kw.x); k8[1] = bfhi(kw.x); k8[2] = bflo(kw.y); k8[3] = bfhi(kw.y); k8[4] = bflo(kw.z); k8[5] = bfhi(kw.z); k8[6] = bflo(kw.w); k8[7] = bfhi(kw.w); \
            float ss_ = 0.f; _Pragma("unroll") for (int j = 0; j < 8; ++j) ss_ += k8[j] * k8[j]; \
            ss_ += SHX(ss_, 1); ss_ += SHX(ss_, 2); ss_ += SHX(ss_, 4); \
            const float rk_ = 1.0f / sqrtf(ss_ * (1.0f / 64.0f) + 1e-6f); \
            _Pragma("unroll") for (int j = 0; j < 8; ++j) k8[j] *= rk_ * wk8[j]; \
            st_chunk(Kimg + (buf) * 8192, skey, spart, k8); *(LAS v4u*)(Vimg + (buf) * 8192 + off64(skey, spart)) = vw; } while (0)
        v4u kw, vw, kw2, vw2;
        { const bf16* src = P + (size_t)NA_TOK(0) * INC + h * 64 + 8 * spart; kw = *(const v4u*)(src + C_NAK); vw = *(const v4u*)(src + C_NAV); }
        { const bf16* src = P + (size_t)NA_TOK(1) * INC + h * 64 + 8 * spart; kw2 = *(const v4u*)(src + C_NAK); vw2 = *(const v4u*)(src + C_NAV); }
        NA_STAGE(0, kw, vw);
        kw = kw2; vw = vw2;
        __syncthreads();
        f32x16 o0 = zero16(), o1 = zero16(); float lsum = 0.f;
        for (int ci = 0; ci < nchunks; ++ci) {
            const int buf = ci & 1;
            if (ci + 2 < nchunks) { const bf16* src = P + (size_t)NA_TOK(ci + 2) * INC + h * 64 + 8 * spart; kw2 = *(const v4u*)(src + C_NAK); vw2 = *(const v4u*)(src + C_NAV); }
            const bool local = ci < nl; const int kr = rs0 + ci;
            const bool active = local ? (kr >= rs && kr < rs + 8) : true;
            if (active) {
                const int c_o = OPQV(c), cs_o = min(max(c_o - 8, 0), 48);
                const int lane_c = OPQV(lane), r32c = lane_c & 31, hhc = lane_c >> 5;
                LAS unsigned char* Kb = Kimg + buf * 8192; LAS unsigned char* Vb = Vimg + buf * 8192;
#define NA_FULL(KT, LOCAL) do { f32x16 x; \
                    if (LOCAL) { const int bidx = (kr - r + 7) * 31 + 32 * (KT) + 4 * hhc - c_o + 15, t0 = 32 * (KT) + 4 * hhc - cs_o; \
                        _Pragma("unroll") for (int i = 0; i < 16; ++i) { const float tv = tab[bidx + crow0(i)]; x[i] = ((unsigned)(t0 + crow0(i)) < 16u) ? tv : -INFINITY; } } \
                    else { _Pragma("unroll") for (int i = 0; i < 16; ++i) x[i] = negmb; } \
                    _Pragma("unroll") for (int s = 0; s < 4; ++s) x = MFMA32(rowfrag(Kb, 32 * (KT) + r32c, 2 * s + hhc), qf[s], x); \
                    _Pragma("unroll") for (int i = 0; i < 16; ++i) { x[i] = __builtin_amdgcn_exp2f(x[i]); lsum += x[i]; } \
                    const bf16x8 pa0 = PACK8(x, 0), pa1 = PACK8(x, 1); \
                    o0 = MFMA32(trfrag(Vb, 32 * (KT) + 4 * hhc, 32 * (KT) + 8 + 4 * hhc, 0, lane_c), pa0, o0); \
                    o0 = MFMA32(trfrag(Vb, 32 * (KT) + 16 + 4 * hhc, 32 * (KT) + 24 + 4 * hhc, 0, lane_c), pa1, o0); \
                    o1 = MFMA32(trfrag(Vb, 32 * (KT) + 4 * hhc, 32 * (KT) + 8 + 4 * hhc, 1, lane_c), pa0, o1); \
                    o1 = MFMA32(trfrag(Vb, 32 * (KT) + 16 + 4 * hhc, 32 * (KT) + 24 + 4 * hhc, 1, lane_c), pa1, o1); } while (0)
#define NA_MINOR(KT, I0, S2, PAV) do { f32x16 x = zero16(); \
                    const int bidx = (kr - r + 7) * 31 + 32 * (KT) + 4 * hhc - c_o + 15, t0 = 32 * (KT) + 4 * hhc - cs_o; \
                    x[I0] = ((unsigned)(t0 + crow0(I0)) < 16u) ? tab[bidx + crow0(I0)] : -INFINITY; x[I0 + 1] = ((unsigned)(t0 + crow0(I0 + 1)) < 16u) ? tab[bidx + crow0(I0 + 1)] : -INFINITY; \
                    x[I0 + 2] = ((unsigned)(t0 + crow0(I0 + 2)) < 16u) ? tab[bidx + crow0(I0 + 2)] : -INFINITY; x[I0 + 3] = ((unsigned)(t0 + crow0(I0 + 3)) < 16u) ? tab[bidx + crow0(I0 + 3)] : -INFINITY; \
                    _Pragma("unroll") for (int s = 0; s < 4; ++s) x = MFMA32(rowfrag(Kb, 32 * (KT) + r32c, 2 * s + hhc), qf[s], x); \
                    const float pA = __builtin_amdgcn_exp2f(x[I0]), pB = __builtin_amdgcn_exp2f(x[I0 + 1]), pC = __builtin_amdgcn_exp2f(x[I0 + 2]), pD = __builtin_amdgcn_exp2f(x[I0 + 3]); \
                    lsum += (pA + pB) + (pC + pD); const unsigned w01 = cvtpk(pA, pB), w23 = cvtpk(pC, pD); \
                    const bf16x8 pa = __builtin_bit_cast(bf16x8, PAV); \
                    o0 = MFMA32(trfrag(Vb, 32 * (KT) + 16 * (S2) + 4 * hhc, 32 * (KT) + 16 * (S2) + 8 + 4 * hhc, 0, lane_c), pa, o0); \
                    o1 = MFMA32(trfrag(Vb, 32 * (KT) + 16 * (S2) + 4 * hhc, 32 * (KT) + 16 * (S2) + 8 + 4 * hhc, 1, lane_c), pa, o1); } while (0)
                if (!local) { NA_FULL(0, false); NA_FULL(1, false); }
                else if ((wave & 1) == 0) { NA_FULL(0, true); NA_MINOR(1, 0, 0, ((v4u){w01, w23, 0u, 0u})); }
                else { NA_FULL(1, true); NA_MINOR(0, 12, 1, ((v4u){0u, 0u, w01, w23})); }
#undef NA_FULL
#undef NA_MINOR
            }
            if (ci + 1 < nchunks) NA_STAGE(buf ^ 1, kw, vw);
            kw = kw2; vw = vw2;
            LDS_BARRIER();
        }
#undef NA_TOK
#undef NA_STAGE
        lsum = xhalf_sum(lsum);
        const float il = 1.0f / lsum; bf16* op = MIX + (size_t)tq * DM + M_NA + h * 64 + 4 * hh;
#pragma unroll
        for (int g4 = 0; g4 < 4; ++g4) {
            u32x2 w0; w0.x = cvtpk(o0[4 * g4] * il, o0[4 * g4 + 1] * il); w0.y = cvtpk(o0[4 * g4 + 2] * il, o0[4 * g4 + 3] * il); *(u32x2*)(op + 8 * g4) = w0;
            u32x2 w1; w1.x = cvtpk(o1[4 * g4] * il, o1[4 * g4 + 1] * il); w1.y = cvtpk(o1[4 * g4 + 2] * il, o1[4 * g4 + 3] * il); *(u32x2*)(op + 32 + 8 * g4) = w1; }
    }
}

__device__ __forceinline__ void sg_mfma(const bf16* P, bf16* MIX, const bf16* Wsg, const float* sgb, const float* lnw, const float* lnb, LAS unsigned char* lds, int tid_in, int G) {
    const int wave = __builtin_amdgcn_readfirstlane(tid_in >> 6);
    for (int ch = blockIdx.x; ch < NCH; ch += G) {
        const int tid = FRESH_TID(wave), lane = tid & 63, r32 = lane & 31, hh = lane >> 5, tok = tid >> 2, sg = tid & 3;
        const int row0 = ch * 128;
        { const bf16* src = P + (size_t)(row0 + tok) * INC + C_SGV + sg * 64; float v[64]; float s = 0.f;
#pragma unroll
          for (int k8 = 0; k8 < 8; ++k8) load8(src + 8 * k8, v + 8 * k8);
#pragma unroll
          for (int k = 0; k < 64; ++k) { v[k] = gelu_tanh(v[k]); s += v[k]; }
          const float mu = s * (1.0f / 64.0f); float q = 0.f;
#pragma unroll
          for (int k = 0; k < 64; ++k) { v[k] -= mu; q += v[k] * v[k]; }
          const float rstd = __builtin_amdgcn_rsqf(q * (1.0f / 64.0f) + 1e-5f);
#pragma unroll
          for (int k8 = 0; k8 < 8; ++k8) { float t8[8];
#pragma unroll
              for (int j = 0; j < 8; ++j) { const int cch = sg * 64 + 8 * k8 + j; t8[j] = v[8 * k8 + j] * rstd * lnw[cch] + lnb[cch]; }
              st_chunk(lds + sg * 16384, tok, k8, t8); } }
        __syncthreads();
        { const int g = wave >> 1; LAS unsigned char* img = lds + g * 16384;
#pragma unroll
          for (int pp = 0; pp < 2; ++pp) { const int pt = 2 * (wave & 1) + pp, p = 32 * pt + r32;
            f32x16 a0 = zero16(), a1 = zero16();
            const bf16* wrow = Wsg + ((size_t)g * 128 + p) * 128 + 8 * hh;
#pragma unroll
            for (int ks = 0; ks < 8; ++ks) { const bf16x8 wf = *(const bf16x8*)(wrow + 16 * ks);
                a0 = MFMA32(trfrag(img, 16 * ks + 8 * hh, 16 * ks + 8 * hh + 4, 0, lane), wf, a0);
                a1 = MFMA32(trfrag(img, 16 * ks + 8 * hh, 16 * ks + 8 * hh + 4, 1, lane), wf, a1); }
            const float bias = sgb[g * 128 + p]; const size_t trow = (size_t)(row0 + p);
            const bf16* up = P + trow * INC + C_SGU + g * 64 + 4 * hh; bf16* op = MIX + trow * DM + M_SG + g * 64 + 4 * hh;
#pragma unroll
            for (int g4 = 0; g4 < 4; ++g4) {
                const u32x2 u0 = *(const u32x2*)(up + 8 * g4), u1 = *(const u32x2*)(up + 32 + 8 * g4);
                u32x2 w0, w1;
                w0.x = cvtpk(gelu_tanh(bflo(u0.x)) * (a0[4 * g4] + bias), gelu_tanh(bfhi(u0.x)) * (a0[4 * g4 + 1] + bias)); w0.y = cvtpk(gelu_tanh(bflo(u0.y)) * (a0[4 * g4 + 2] + bias), gelu_tanh(bfhi(u0.y)) * (a0[4 * g4 + 3] + bias));
                w1.x = cvtpk(gelu_tanh(bflo(u1.x)) * (a1[4 * g4] + bias), gelu_tanh(bfhi(u1.x)) * (a1[4 * g4 + 1] + bias)); w1.y = cvtpk(gelu_tanh(bflo(u1.y)) * (a1[4 * g4 + 2] + bias), gelu_tanh(bfhi(u1.y)) * (a1[4 * g4 + 3] + bias));
                *(u32x2*)(op + 8 * g4) = w0; *(u32x2*)(op + 32 + 8 * g4) = w1; asm volatile("" ::: "memory"); } } }
        __syncthreads();
    }
}

__device__ __forceinline__ void ret_kv_mfma(const bf16* P, float* KV, const float* logit, const float* ropetab, LAS unsigned char* lds, int tid_in, int G) {
    const int wave = __builtin_amdgcn_readfirstlane(tid_in >> 6);
    LAS unsigned char* Kf = lds; LAS unsigned char* Kb = lds + 16384; LAS unsigned char* Vi = lds + 32768;
    for (int it_r = blockIdx.x; it_r < NCH * 6 * REP_KV; it_r += G) { const int it = it_r % (NCH * 6);
        const int tid = FRESH_TID(wave), lane = tid & 63, r32 = lane & 31, hh = lane >> 5, tok = tid >> 2, part = tid & 3;
        const int ch = it / 6, h = it % 6, row0 = ch * 128; const bool latent = ch < NCHL;
        { const float lgf = log_sigmoid(logit[h]) * LOG2E, lgb = log_sigmoid(logit[6 + h]) * LOG2E;
          const float wf = __builtin_amdgcn_exp2f(lgf * (float)(127 - tok)) * 0.125f, wb = __builtin_amdgcn_exp2f(lgb * (float)tok) * 0.125f;
          float k16[16], t8[8]; rope_load16(P, row0 + tok, C_RK, h, part, latent, ropetab, k16);
#pragma unroll
          for (int c2 = 0; c2 < 2; ++c2) {
#pragma unroll
              for (int j = 0; j < 8; ++j) t8[j] = k16[8 * c2 + j] * wf;
              st_chunk(Kf, tok, 2 * part + c2, t8);
#pragma unroll
              for (int j = 0; j < 8; ++j) t8[j] = k16[8 * c2 + j] * wb;
              st_chunk(Kb, tok, 2 * part + c2, t8); }
          const bf16* vp = P + (size_t)(row0 + tok) * INC + C_RV + h * 64 + part * 16;
          *(LAS v4u*)(Vi + off64(tok, 2 * part)) = *(const v4u*)vp; *(LAS v4u*)(Vi + off64(tok, 2 * part + 1)) = *(const v4u*)(vp + 8); }
        __syncthreads();
        { const int dir = wave >> 2, et = (wave >> 1) & 1, dt = wave & 1; LAS unsigned char* Kd = dir ? Kb : Kf;
          f32x16 acc = zero16();
#pragma unroll
          for (int ks = 0; ks < 8; ++ks)
              acc = MFMA32(trfrag(Vi, 16 * ks + 8 * hh, 16 * ks + 8 * hh + 4, et, lane), trfrag(Kd, 16 * ks + 8 * hh, 16 * ks + 8 * hh + 4, dt, lane), acc);
          float* o = KV + ((size_t)(ch * 6 + h) * 2 + dir) * 4096 + (size_t)(32 * et + 4 * hh) * 64 + 32 * dt + r32;
#pragma unroll
          for (int i = 0; i < 16; ++i) o[crow0(i) * 64] = acc[i]; }
        __syncthreads();
    }
}
__device__ __forceinline__ void ret_scan2(const float* KV, bf16* PREV, const float* logit, int gtid, int nthreads) {
    for (int it = gtid; it < NB * 6 * 2 * 4096; it += nthreads) {
        const int idx = it & 4095, dir = (it >> 12) & 1, bh = it >> 13, h = bh % 6, b = bh / 6;
        const float cd = __builtin_amdgcn_exp2f(128.0f * logit[dir * 6 + h]);
#define KVI(ch) (((size_t)((ch) * 6 + h) * 2 + dir) * 4096 + idx)
        const int c0 = NCHL + 2 * b, c1 = c0 + 1;
        const float k0 = KV[KVI(c0)], k1 = KV[KVI(c1)];
        if (dir == 0) { PREV[KVI(c0)] = 0; PREV[KVI(c1)] = (bf16)f2bf(k0); float s = cd * k0 + k1;
            for (int n = 0; n < 64; ++n) { const int ch = b * 64 + n; PREV[KVI(ch)] = (bf16)f2bf(s); s = cd * s + KV[KVI(ch)]; } }
        else { PREV[KVI(c0)] = (bf16)f2bf(k1); PREV[KVI(c1)] = 0; float s = k0 + cd * k1;
            for (int n = 63; n >= 0; --n) { const int ch = b * 64 + n; PREV[KVI(ch)] = (bf16)f2bf(s); s = cd * s + KV[KVI(ch)]; } }
#undef KVI
    }
}
__device__ __forceinline__ void ret_out_mfma(const bf16* P, const bf16* PREV, bf16* MIX, const float* logit, const float* gnw, const float* ropetab, LAS unsigned char* lds, int tid_in, int G) {
    const int wave = __builtin_amdgcn_readfirstlane(tid_in >> 6);
    LAS unsigned char* Qi = lds; LAS unsigned char* Ki = lds + 16384; LAS unsigned char* Vi = lds + 32768;
    LAS float* st = (LAS float*)(lds + 49152);
    const int it_ = wave >> 1, et = wave & 1;
    for (int itm_r = blockIdx.x; itm_r < NCH * 6 * REP_RETO; itm_r += G) { const int itm = itm_r % (NCH * 6);
        const int tid = FRESH_TID(wave), lane = tid & 63, r32 = lane & 31, hh = lane >> 5, tok = tid >> 2, part = tid & 3;
        const int ch = itm / 6, h = itm % 6, row0 = ch * 128; const bool latent = ch < NCHL;
        { float t16[16], t8[8]; rope_load16(P, row0 + tok, C_RQ, h, part, latent, ropetab, t16);
          st_chunk(Qi, tok, 2 * part, t16); st_chunk(Qi, tok, 2 * part + 1, t16 + 8);
          rope_load16(P, row0 + tok, C_RK, h, part, latent, ropetab, t16);
#pragma unroll
          for (int c2 = 0; c2 < 2; ++c2) {
#pragma unroll
              for (int j = 0; j < 8; ++j) t8[j] = t16[8 * c2 + j] * 0.125f;
              st_chunk(Ki, tok, 2 * part + c2, t8); }
          const bf16* vp = P + (size_t)(row0 + tok) * INC + C_RV + h * 64 + part * 16;
          *(LAS v4u*)(Vi + off64(tok, 2 * part)) = *(const v4u*)vp; *(LAS v4u*)(Vi + off64(tok, 2 * part + 1)) = *(const v4u*)(vp + 8); }
        __syncthreads();
        const float lgf = log_sigmoid(logit[h]) * LOG2E, lgb = log_sigmoid(logit[6 + h]) * LOG2E;
        const int il = 32 * it_ + r32;
        bf16x8 qf[4];
#pragma unroll
        for (int s = 0; s < 4; ++s) qf[s] = rowfrag(Qi, il, 2 * s + hh);
        f32x16 of = zero16(), ob = zero16();
#pragma unroll
        for (int jt = 0; jt < 4; ++jt) {
            f32x16 x = zero16();
#pragma unroll
            for (int s = 0; s < 4; ++s) x = MFMA32(rowfrag(Ki, 32 * jt + r32, 2 * s + hh), qf[s], x);
            if (jt <= it_) { f32x16 w;
#pragma unroll
                for (int i = 0; i < 16; ++i) { const int jl = 32 * jt + crow0(i) + 4 * hh; w[i] = (jl <= il) ? x[i] * __builtin_amdgcn_exp2f(lgf * (float)(il - jl)) : 0.f; }
                const bf16x8 p0 = PACK8(w, 0), p1 = PACK8(w, 1);
                of = MFMA32(trfrag(Vi, 32 * jt + 4 * hh, 32 * jt + 8 + 4 * hh, et, lane), p0, of);
                of = MFMA32(trfrag(Vi, 32 * jt + 16 + 4 * hh, 32 * jt + 24 + 4 * hh, et, lane), p1, of); }
            if (jt >= it_) { f32x16 w;
#pragma unroll
                for (int i = 0; i < 16; ++i) { const int jl = 32 * jt + crow0(i) + 4 * hh; w[i] = (jl >= il) ? x[i] * __builtin_amdgcn_exp2f(lgb * (float)(jl - il)) : 0.f; }
                const bf16x8 p0 = PACK8(w, 0), p1 = PACK8(w, 1);
                ob = MFMA32(trfrag(Vi, 32 * jt + 4 * hh, 32 * jt + 8 + 4 * hh, et, lane), p0, ob);
                ob = MFMA32(trfrag(Vi, 32 * jt + 16 + 4 * hh, 32 * jt + 24 + 4 * hh, et, lane), p1, ob); }
        }
        { const bf16* pf = PREV + ((size_t)(ch * 6 + h) * 2) * 4096 + (size_t)(32 * et + r32) * 64 + 8 * hh; const bf16* pb = pf + 4096;
          f32x16 cf = zero16(), cb = zero16();
#pragma unroll
          for (int s = 0; s < 4; ++s) { cf = MFMA32(*(const bf16x8*)(pf + 16 * s), qf[s], cf); cb = MFMA32(*(const bf16x8*)(pb + 16 * s), qf[s], cb); }
          const float df = __builtin_amdgcn_exp2f(lgf * (float)(il + 1)), db = __builtin_amdgcn_exp2f(lgb * (float)(128 - il));
#pragma unroll
          for (int i = 0; i < 16; ++i) { of[i] += df * cf[i]; ob[i] += db * cb[i]; } }
        float s1f = 0.f, s2f = 0.f, s1b = 0.f, s2b = 0.f;
#pragma unroll
        for (int i = 0; i < 16; ++i) { s1f += of[i]; s2f += of[i] * of[i]; s1b += ob[i]; s2b += ob[i] * ob[i]; }
        s1f = xhalf_sum(s1f); s2f = xhalf_sum(s2f); s1b = xhalf_sum(s1b); s2b = xhalf_sum(s2b);
        if (hh == 0) { LAS float* sp = st + (wave * 32 + r32) * 4; sp[0] = s1f; sp[1] = s2f; sp[2] = s1b; sp[3] = s2b; }
        __syncthreads();
        { const LAS float* sp = st + ((wave ^ 1) * 32 + r32) * 4; s1f += sp[0]; s2f += sp[1]; s1b += sp[2]; s2b += sp[3]; }
        const float muf = s1f * (1.0f / 64.0f), mub = s1b * (1.0f / 64.0f);
        const float rf = 1.0f / sqrtf(fmaxf(s2f * (1.0f / 64.0f) - muf * muf, 0.f) + 1e-5f), rb = 1.0f / sqrtf(fmaxf(s2b * (1.0f / 64.0f) - mub * mub, 0.f) + 1e-5f);
        { const size_t trow = (size_t)(row0 + il); const int e0 = h * 64 + 32 * et + 4 * hh;
          const bf16* gp = P + trow * INC + C_GF + e0; bf16* op = MIX + trow * DM + M_RET + e0;
#pragma unroll
          for (int g4 = 0; g4 < 4; ++g4) { const u32x2 gfw = *(const u32x2*)(gp + 8 * g4), gbw = *(const u32x2*)(gp + (C_GB - C_GF) + 8 * g4);
              const float gfv[4] = {bflo(gfw.x), bfhi(gfw.x), bflo(gfw.y), bfhi(gfw.y)}, gbv[4] = {bflo(gbw.x), bfhi(gbw.x), bflo(gbw.y), bfhi(gbw.y)};
              float y[4];
#pragma unroll
              for (int k = 0; k < 4; ++k) { const int i = 4 * g4 + k;
                  y[k] = ((of[i] - muf) * rf * (gfv[k] * sigmoidf_(gfv[k])) + (ob[i] - mub) * rb * (gbv[k] * sigmoidf_(gbv[k]))) * gnw[e0 + 8 * g4 + k]; }
              u32x2 w; w.x = cvtpk(y[0], y[1]); w.y = cvtpk(y[2], y[3]); *(u32x2*)(op + 8 * g4) = w; } }
        __syncthreads();
    }
}

__device__ __forceinline__ void ret_out_mfma2(const bf16* P, const bf16* PREV, bf16* MIX, const float* logit, const float* gnw, const float* ropetab, LAS unsigned char* lds, int tid_in, int G) {
    const int wave = __builtin_amdgcn_readfirstlane(tid_in >> 6);
    const int it_ = wave >> 1, et = wave & 1;
    LAS float* tabL = (LAS float*)(lds + 98304);
    LAS float* stL = (LAS float*)(lds + 98304 + 16384);
    { const int t0 = FRESH_TID(wave); for (int i = t0; i < 1024; i += 512) ((LAS f32x4*)tabL)[i] = ((const f32x4*)ropetab)[i]; }
    __syncthreads();
    v4u rq0, rq1, rk0, rk1, rv0, rv1, rg00, rg01, rg10, rg11;
    LAS unsigned char* gs = lds + 98304 + 16384 + 8192 + wave * 4096;
#define RO_LOAD(uu) do { const int t_ = FRESH_TID(wave); const int ch_ = (uu) / 6, h_ = (uu) % 6, pt_ = t_ & 3; \
        const bf16* b_ = P + (size_t)(ch_ * 128 + (t_ >> 2)) * INC + h_ * 64 + 32 * (pt_ >> 1) + 8 * (pt_ & 1); \
        rq0 = *(const v4u*)(b_ + C_RQ); rq1 = *(const v4u*)(b_ + C_RQ + 16); rk0 = *(const v4u*)(b_ + C_RK); rk1 = *(const v4u*)(b_ + C_RK + 16); rv0 = *(const v4u*)(b_ + C_RV); rv1 = *(const v4u*)(b_ + C_RV + 16); \
        const int l_ = t_ & 63; const bf16* g_ = P + (size_t)(ch_ * 128 + 32 * it_ + (l_ >> 2)) * INC + C_GF + h_ * 64 + 32 * et + 8 * (l_ & 3); \
        rg00 = *(const v4u*)g_; rg01 = *(const v4u*)(g_ + (size_t)16 * INC); rg10 = *(const v4u*)(g_ + (C_GB - C_GF)); rg11 = *(const v4u*)(g_ + (C_GB - C_GF) + (size_t)16 * INC); } while (0)
    int u = blockIdx.x;
    if (u < NCH * 6 * REP_RETO) RO_LOAD(u % (NCH * 6));
    for (int n = 0; u < NCH * 6 * REP_RETO; u += G, ++n) {
        const int itm = u % (NCH * 6);
        const int tid = FRESH_TID(wave), lane = tid & 63, r32 = lane & 31, hh = lane >> 5, tok = tid >> 2, part = tid & 3;
        const int ch = itm / 6, h = itm % 6, row0 = ch * 128; const bool latent = ch < NCHL;
        LAS unsigned char* Qi = lds + (n & 1) * 49152; LAS unsigned char* Ki = Qi + 16384; LAS unsigned char* Vi = Qi + 32768;
        LAS float* st = stL + (n & 1) * 1024;
        { const int c1 = 4 * (part >> 1) + (part & 1), c2 = c1 + 2;
          float q1[8], q2[8], k1[8], k2[8];
          q1[0] = bflo(rq0.x); q1[1] = bfhi(rq0.x); q1[2] = bflo(rq0.y); q1[3] = bfhi(rq0.y); q1[4] = bflo(rq0.z); q1[5] = bfhi(rq0.z); q1[6] = bflo(rq0.w); q1[7] = bfhi(rq0.w);
          q2[0] = bflo(rq1.x); q2[1] = bfhi(rq1.x); q2[2] = bflo(rq1.y); q2[3] = bfhi(rq1.y); q2[4] = bflo(rq1.z); q2[5] = bfhi(rq1.z); q2[6] = bflo(rq1.w); q2[7] = bfhi(rq1.w);
          k1[0] = bflo(rk0.x); k1[1] = bfhi(rk0.x); k1[2] = bflo(rk0.y); k1[3] = bfhi(rk0.y); k1[4] = bflo(rk0.z); k1[5] = bfhi(rk0.z); k1[6] = bflo(rk0.w); k1[7] = bfhi(rk0.w);
          k2[0] = bflo(rk1.x); k2[1] = bfhi(rk1.x); k2[2] = bflo(rk1.y); k2[3] = bfhi(rk1.y); k2[4] = bflo(rk1.z); k2[5] = bfhi(rk1.z); k2[6] = bflo(rk1.w); k2[7] = bfhi(rk1.w);
          if (latent) { const int pos = (row0 + tok) & (SEQ - 1); const int nn = (part >> 1) ? (pos & 63) : (pos >> 6);
              const LAS f32x2_t* tb = (const LAS f32x2_t*)tabL + nn * 16 + 8 * (part & 1);
#pragma unroll
              for (int j = 0; j < 8; ++j) { const f32x2_t cs = tb[j]; const float a = q1[j], b = q2[j], c = k1[j], d = k2[j];
                  q1[j] = a * cs.x - b * cs.y; q2[j] = a * cs.y + b * cs.x; k1[j] = c * cs.x - d * cs.y; k2[j] = c * cs.y + d * cs.x; } }
#pragma unroll
          for (int j = 0; j < 8; ++j) { k1[j] *= 0.125f; k2[j] *= 0.125f; }
          st_chunk(Qi, tok, c1, q1); st_chunk(Qi, tok, c2, q2); st_chunk(Ki, tok, c1, k1); st_chunk(Ki, tok, c2, k2);
          *(LAS v4u*)(Vi + off64(tok, c1)) = rv0; *(LAS v4u*)(Vi + off64(tok, c2)) = rv1; }
        { const int tk = lane >> 2, pc = lane & 3;
          *(LAS v4u*)(gs + tk * 64 + ((pc ^ ((tk >> 1) & 3)) * 16)) = rg00; *(LAS v4u*)(gs + (tk + 16) * 64 + ((pc ^ (((tk + 16) >> 1) & 3)) * 16)) = rg01;
          *(LAS v4u*)(gs + 2048 + tk * 64 + ((pc ^ ((tk >> 1) & 3)) * 16)) = rg10; *(LAS v4u*)(gs + 2048 + (tk + 16) * 64 + ((pc ^ (((tk + 16) >> 1) & 3)) * 16)) = rg11; }
        if (u + G < NCH * 6 * REP_RETO) RO_LOAD((u + G) % (NCH * 6));
        const int il = 32 * it_ + r32;
        const bf16* pf = PREV + ((size_t)(ch * 6 + h) * 2) * 4096 + (size_t)(32 * et + r32) * 64 + 8 * hh;
        bf16x8 pff[4], pfb[4];
#pragma unroll
        for (int s = 0; s < 4; ++s) { pff[s] = *(const bf16x8*)(pf + 16 * s); pfb[s] = *(const bf16x8*)(pf + 4096 + 16 * s); }
        const size_t trow = (size_t)(row0 + il); const int e0 = h * 64 + 32 * et + 4 * hh;
        const float lgf = logit[h], lgb = logit[6 + h];
        float af[4], bfv[4], ab[4], bb[4];
#pragma unroll
        for (int k = 0; k < 4; ++k) { af[k] = __builtin_amdgcn_exp2f(-lgf * (float)k); bfv[k] = __builtin_amdgcn_exp2f(-lgf * (float)(8 * k)); ab[k] = __builtin_amdgcn_exp2f(lgb * (float)k); bb[k] = __builtin_amdgcn_exp2f(lgb * (float)(8 * k)); }
        LDS_BARRIER();
        bf16x8 qf[4];
#pragma unroll
        for (int s = 0; s < 4; ++s) qf[s] = rowfrag(Qi, il, 2 * s + hh);
        f32x16 of = zero16(), ob = zero16();
#pragma unroll
        for (int jt = 0; jt < 4; ++jt) {
            f32x16 x = zero16();
#pragma unroll
            for (int s = 0; s < 4; ++s) x = MFMA32(rowfrag(Ki, 32 * jt + r32, 2 * s + hh), qf[s], x);
            if (jt <= it_) { f32x16 w; const float lf = __builtin_amdgcn_exp2f(lgf * (float)(il - 32 * jt - 4 * hh));
#pragma unroll
                for (int g = 0; g < 4; ++g) { const float lg = lf * bfv[g];
#pragma unroll
                    for (int k = 0; k < 4; ++k) { const int i = 4 * g + k; const float v = x[i] * (lg * af[k]); w[i] = (jt < it_ || crow0(i) + 4 * hh <= r32) ? v : 0.f; } }
                const bf16x8 p0 = PACK8(w, 0), p1 = PACK8(w, 1);
                of = MFMA32(trfrag(Vi, 32 * jt + 4 * hh, 32 * jt + 8 + 4 * hh, et, lane), p0, of);
                of = MFMA32(trfrag(Vi, 32 * jt + 16 + 4 * hh, 32 * jt + 24 + 4 * hh, et, lane), p1, of); }
            if (jt >= it_) { f32x16 w; const float lb = __builtin_amdgcn_exp2f(lgb * (float)(32 * jt + 4 * hh - il));
#pragma unroll
                for (int g = 0; g < 4; ++g) { const float lg = lb * bb[g];
#pragma unroll
                    for (int k = 0; k < 4; ++k) { const int i = 4 * g + k; const float v = x[i] * (lg * ab[k]); w[i] = (jt > it_ || crow0(i) + 4 * hh >= r32) ? v : 0.f; } }
                const bf16x8 p0 = PACK8(w, 0), p1 = PACK8(w, 1);
                ob = MFMA32(trfrag(Vi, 32 * jt + 4 * hh, 32 * jt + 8 + 4 * hh, et, lane), p0, ob);
                ob = MFMA32(trfrag(Vi, 32 * jt + 16 + 4 * hh, 32 * jt + 24 + 4 * hh, et, lane), p1, ob); }
        }
        { f32x16 cf = zero16(), cb = zero16();
#pragma unroll
          for (int s = 0; s < 4; ++s) { cf = MFMA32(pff[s], qf[s], cf); cb = MFMA32(pfb[s], qf[s], cb); }
          const float df = __builtin_amdgcn_exp2f(lgf * (float)(il + 1)), db = __builtin_amdgcn_exp2f(lgb * (float)(128 - il));
#pragma unroll
          for (int i = 0; i < 16; ++i) { of[i] += df * cf[i]; ob[i] += db * cb[i]; } }
        float s1f = 0.f, s2f = 0.f, s1b = 0.f, s2b = 0.f;
#pragma unroll
        for (int i = 0; i < 16; ++i) { s1f += of[i]; s2f += of[i] * of[i]; s1b += ob[i]; s2b += ob[i] * ob[i]; }
        s1f = xhalf_sum(s1f); s2f = xhalf_sum(s2f); s1b = xhalf_sum(s1b); s2b = xhalf_sum(s2b);
        if (hh == 0) { LAS float* sp = st + (wave * 32 + r32) * 4; sp[0] = s1f; sp[1] = s2f; sp[2] = s1b; sp[3] = s2b; }
        LDS_BARRIER();
        { const LAS float* sp = st + ((wave ^ 1) * 32 + r32) * 4; s1f += sp[0]; s2f += sp[1]; s1b += sp[2]; s2b += sp[3]; }
        const float muf = s1f * (1.0f / 64.0f), mub = s1b * (1.0f / 64.0f);
        const float rf = __builtin_amdgcn_rsqf(fmaxf(s2f * (1.0f / 64.0f) - muf * muf, 0.f) + 1e-5f), rb = __builtin_amdgcn_rsqf(fmaxf(s2b * (1.0f / 64.0f) - mub * mub, 0.f) + 1e-5f);
        { const int sw = (r32 >> 1) & 3; u32x2 gfw[4], gbw[4];
#pragma unroll
          for (int g4 = 0; g4 < 4; ++g4) { gfw[g4] = *(const LAS u32x2*)(gs + r32 * 64 + ((g4 ^ sw) * 16) + 8 * hh); gbw[g4] = *(const LAS u32x2*)(gs + 2048 + r32 * 64 + ((g4 ^ sw) * 16) + 8 * hh); }
#pragma unroll
          for (int g4 = 0; g4 < 4; ++g4) {
              const float gfv[4] = {bflo(gfw[g4].x), bfhi(gfw[g4].x), bflo(gfw[g4].y), bfhi(gfw[g4].y)}, gbv[4] = {bflo(gbw[g4].x), bfhi(gbw[g4].x), bflo(gbw[g4].y), bfhi(gbw[g4].y)};
              float y[4];
#pragma unroll
              for (int k = 0; k < 4; ++k) { const int i = 4 * g4 + k;
                  const float sf = gfv[k] * __builtin_amdgcn_rcpf(1.0f + __builtin_amdgcn_exp2f(-LOG2E * gfv[k])), sb = gbv[k] * __builtin_amdgcn_rcpf(1.0f + __builtin_amdgcn_exp2f(-LOG2E * gbv[k]));
                  y[k] = ((of[i] - muf) * rf * sf + (ob[i] - mub) * rb * sb) * gnw[e0 + 8 * g4 + k]; }
              u32x2 w; w.x = cvtpk(y[0], y[1]); w.y = cvtpk(y[2], y[3]); *(LAS u32x2*)(gs + r32 * 64 + ((g4 ^ sw) * 16) + 8 * hh) = w; }
          const int tk = lane >> 2, pc = lane & 3; bf16* op = MIX + (size_t)(row0 + 32 * it_ + tk) * DM + M_RET + h * 64 + 32 * et + 8 * pc;
          const v4u o0 = *(const LAS v4u*)(gs + tk * 64 + ((pc ^ ((tk >> 1) & 3)) * 16)), o1 = *(const LAS v4u*)(gs + (tk + 16) * 64 + ((pc ^ (((tk + 16) >> 1) & 3)) * 16));
          *(v4u*)op = o0; *(v4u*)(op + (size_t)16 * DM) = o1; }
    }
#undef RO_LOAD
    __syncthreads();
}


__device__ __forceinline__ void sg_mfma2(const bf16* P, bf16* MIX, const bf16* Wsg, const float* sgb, const float* lnw, const float* lnb, LAS unsigned char* lds, const int wave, int G) {
    const int pt = wave >> 1, ct = wave & 1;
    v4u rv0, rv1; u32x2 ru[4], uc[4];
#define SG_LOAD(uu) do { const int t_ = FRESH_TID(wave); const int ch_ = (uu) >> 2, g_ = (uu) & 3, l_ = t_ & 63; \
        const bf16* v_ = P + (size_t)(ch_ * 128 + (t_ >> 2)) * INC + C_SGV + g_ * 64 + 16 * (t_ & 3); rv0 = *(const v4u*)v_; rv1 = *(const v4u*)(v_ + 8); \
        const bf16* u_ = P + (size_t)(ch_ * 128 + 32 * pt + (l_ & 31)) * INC + C_SGU + g_ * 64 + 32 * ct + 4 * (l_ >> 5); \
        _Pragma("unroll") for (int g4 = 0; g4 < 4; ++g4) ru[g4] = *(const u32x2*)(u_ + 8 * g4); } while (0)
    int u = blockIdx.x;
    if (u < NCH * 4 * REP_SG) SG_LOAD(u % (NCH * 4));
    for (int n = 0; u < NCH * 4 * REP_SG; u += G, ++n) {
        const int itm = u % (NCH * 4); const int ch = itm >> 2, g = itm & 3, row0 = ch * 128;
        const int tid = FRESH_TID(wave), lane = tid & 63, r32 = lane & 31, hh = lane >> 5, tok = tid >> 2, part = tid & 3;
        LAS unsigned char* img = lds + (n & 1) * 16384;
        { float v[16]; float s = 0.f;
          v[0] = bflo(rv0.x); v[1] = bfhi(rv0.x); v[2] = bflo(rv0.y); v[3] = bfhi(rv0.y); v[4] = bflo(rv0.z); v[5] = bfhi(rv0.z); v[6] = bflo(rv0.w); v[7] = bfhi(rv0.w);
          v[8] = bflo(rv1.x); v[9] = bfhi(rv1.x); v[10] = bflo(rv1.y); v[11] = bfhi(rv1.y); v[12] = bflo(rv1.z); v[13] = bfhi(rv1.z); v[14] = bflo(rv1.w); v[15] = bfhi(rv1.w);
#pragma unroll
          for (int k = 0; k < 16; ++k) { v[k] = gelu_tanh(v[k]); s += v[k]; }
          s += SHX(s, 1); s += SHX(s, 2); const float mu = s * (1.0f / 64.0f); float q = 0.f;
#pragma unroll
          for (int k = 0; k < 16; ++k) { v[k] -= mu; q += v[k] * v[k]; }
          q += SHX(q, 1); q += SHX(q, 2); const float rstd = __builtin_amdgcn_rsqf(q * (1.0f / 64.0f) + 1e-5f);
#pragma unroll
          for (int k = 0; k < 16; ++k) { const int cch = g * 64 + part * 16 + k; v[k] = v[k] * rstd * lnw[cch] + lnb[cch]; }
          st_chunk(img, tok, 2 * part, v); st_chunk(img, tok, 2 * part + 1, v + 8); }
#pragma unroll
        for (int g4 = 0; g4 < 4; ++g4) uc[g4] = ru[g4];
        if (u + G < NCH * 4 * REP_SG) SG_LOAD((u + G) % (NCH * 4));
        LDS_BARRIER();
        { const int p = 32 * pt + r32; f32x16 a = zero16();
          const bf16* wrow = Wsg + ((size_t)g * 128 + p) * 128 + 8 * hh;
#pragma unroll
          for (int ks = 0; ks < 8; ++ks) a = MFMA32(trfrag(img, 16 * ks + 8 * hh, 16 * ks + 8 * hh + 4, ct, lane), *(const bf16x8*)(wrow + 16 * ks), a);
          const float bias = sgb[g * 128 + p];
          bf16* op = MIX + (size_t)(row0 + p) * DM + M_SG + g * 64 + 32 * ct + 4 * hh;
#pragma unroll
          for (int g4 = 0; g4 < 4; ++g4) { u32x2 w0;
              w0.x = cvtpk(gelu_tanh(bflo(uc[g4].x)) * (a[4 * g4] + bias), gelu_tanh(bfhi(uc[g4].x)) * (a[4 * g4 + 1] + bias)); w0.y = cvtpk(gelu_tanh(bflo(uc[g4].y)) * (a[4 * g4 + 2] + bias), gelu_tanh(bfhi(uc[g4].y)) * (a[4 * g4 + 3] + bias));
              *(u32x2*)(op + 8 * g4) = w0; } }
    }
#undef SG_LOAD
    __syncthreads();
}

__device__ __forceinline__ void ret_kv_mfma2(const bf16* P, float* KV, const float* logit, const float* ropetab, LAS unsigned char* lds, const int wave, int G) {
    LAS float* tabL = (LAS float*)(lds + 98304);
    LAS float* lgL = (LAS float*)(lds + 98304 + 16384);
    { const int t0 = FRESH_TID(wave); for (int i = t0; i < 1024; i += 512) ((LAS f32x4*)tabL)[i] = ((const f32x4*)ropetab)[i];
      if (t0 < 12) lgL[t0] = logit[t0]; }
    __syncthreads();
    const int dir = wave >> 2, et = (wave >> 1) & 1, dt = wave & 1;
    v4u rk0, rk1, rv0, rv1;
#define KV_LOAD(uu) do { const int t_ = FRESH_TID(wave); const int ch_ = (uu) / 6, h_ = (uu) % 6, pt_ = t_ & 3; \
        const bf16* b_ = P + (size_t)(ch_ * 128 + (t_ >> 2)) * INC + h_ * 64 + 32 * (pt_ >> 1) + 8 * (pt_ & 1); \
        rk0 = *(const v4u*)(b_ + C_RK); rk1 = *(const v4u*)(b_ + C_RK + 16); rv0 = *(const v4u*)(b_ + C_RV); rv1 = *(const v4u*)(b_ + C_RV + 16); } while (0)
    int u = blockIdx.x;
    if (u < NCH * 6 * REP_KV) KV_LOAD(u % (NCH * 6));
    for (int n = 0; u < NCH * 6 * REP_KV; u += G, ++n) {
        const int it = u % (NCH * 6);
        const int tid = FRESH_TID(wave), lane = tid & 63, r32 = lane & 31, hh = lane >> 5, tok = tid >> 2, part = tid & 3;
        const int ch = it / 6, h = it % 6, row0 = ch * 128; const bool latent = ch < NCHL;
        LAS unsigned char* Kf = lds + (n & 1) * 49152; LAS unsigned char* Kb = Kf + 16384; LAS unsigned char* Vi = Kf + 32768;
        { const int c1 = 4 * (part >> 1) + (part & 1), c2 = c1 + 2;
          float k1[8], k2[8], t8[8];
          k1[0] = bflo(rk0.x); k1[1] = bfhi(rk0.x); k1[2] = bflo(rk0.y); k1[3] = bfhi(rk0.y); k1[4] = bflo(rk0.z); k1[5] = bfhi(rk0.z); k1[6] = bflo(rk0.w); k1[7] = bfhi(rk0.w);
          k2[0] = bflo(rk1.x); k2[1] = bfhi(rk1.x); k2[2] = bflo(rk1.y); k2[3] = bfhi(rk1.y); k2[4] = bflo(rk1.z); k2[5] = bfhi(rk1.z); k2[6] = bflo(rk1.w); k2[7] = bfhi(rk1.w);
          if (latent) { const int pos = (row0 + tok) & (SEQ - 1); const int nn = (part >> 1) ? (pos & 63) : (pos >> 6);
              const LAS f32x2_t* tb = (const LAS f32x2_t*)tabL + nn * 16 + 8 * (part & 1);
#pragma unroll
              for (int j = 0; j < 8; ++j) { const f32x2_t cs = tb[j]; const float c = k1[j], d = k2[j]; k1[j] = c * cs.x - d * cs.y; k2[j] = c * cs.y + d * cs.x; } }
          const float wf = __builtin_amdgcn_exp2f(lgL[h] * (float)(127 - tok)) * 0.125f, wb = __builtin_amdgcn_exp2f(lgL[6 + h] * (float)tok) * 0.125f;
#pragma unroll
          for (int j = 0; j < 8; ++j) t8[j] = k1[j] * wf;
          st_chunk(Kf, tok, c1, t8);
#pragma unroll
          for (int j = 0; j < 8; ++j) t8[j] = k2[j] * wf;
          st_chunk(Kf, tok, c2, t8);
#pragma unroll
          for (int j = 0; j < 8; ++j) t8[j] = k1[j] * wb;
          st_chunk(Kb, tok, c1, t8);
#pragma unroll
          for (int j = 0; j < 8; ++j) t8[j] = k2[j] * wb;
          st_chunk(Kb, tok, c2, t8);
          *(LAS v4u*)(Vi + off64(tok, c1)) = rv0; *(LAS v4u*)(Vi + off64(tok, c2)) = rv1; }
        if (u + G < NCH * 6 * REP_KV) KV_LOAD((u + G) % (NCH * 6));
        LDS_BARRIER();
        { LAS unsigned char* Kd = dir ? Kb : Kf;
          f32x16 acc = zero16();
#pragma unroll
          for (int ks = 0; ks < 8; ++ks)
              acc = MFMA32(trfrag(Vi, 16 * ks + 8 * hh, 16 * ks + 8 * hh + 4, et, lane), trfrag(Kd, 16 * ks + 8 * hh, 16 * ks + 8 * hh + 4, dt, lane), acc);
          float* o = KV + ((size_t)(ch * 6 + h) * 2 + dir) * 4096 + (size_t)(32 * et + 4 * hh) * 64 + 32 * dt + r32;
#pragma unroll
          for (int i = 0; i < 16; ++i) o[crow0(i) * 64] = acc[i]; }
    }
#undef KV_LOAD
    __syncthreads();
}
#ifndef REP_DOWN
#define REP_DOWN 1
#endif
#ifndef REP_NORM
#define REP_NORM 1
#endif
#ifndef REP_UP
#define REP_UP 1
#endif
#ifndef REP_WIN
#define REP_WIN 1
#endif
#ifndef REP_NA
#define REP_NA 1
#endif
#ifndef REP_SG
#define REP_SG 1
#endif
#ifndef REP_KV
#define REP_KV 1
#endif
#ifndef REP_SCAN
#define REP_SCAN 1
#endif
#ifndef REP_RETO
#define REP_RETO 1
#endif
#ifndef REP_PRO
#define REP_PRO 1
#endif

struct Args { In in; float* out; unsigned char* ws; int ph_lo, ph_hi; };
__global__ void __launch_bounds__(NWAVES * 64, 2) hybrid_fwd(Args args) {
    extern __shared__ __attribute__((aligned(16))) unsigned char lds_raw[];
    LAS unsigned char* lds = (LAS unsigned char*)lds_raw;
    volatile LAS unsigned* MISC = (volatile LAS unsigned*)(lds + MISC_OFF);
    const int tid = threadIdx.x, lane = tid & 63, wave = __builtin_amdgcn_readfirstlane(tid >> 6);
    const int G = gridDim.x; const int bx = blockIdx.x; const int vcu = (G % 8 == 0) ? (bx % 8) * (G / 8) + bx / 8 : bx;
    const int NGW = G * NWAVES, nthreads = G * NWAVES * 64;
    unsigned char* ws = args.ws; const In& I = args.in;
    gu32* ctl = (gu32*)(ws + WS_CTL);
    for (int u = tid; u < (LDS_BYTES - LDSCTL_OFF) / 4; u += NWAVES * 64) ((LAS unsigned*)(lds + LDSCTL_OFF))[u] = 0u;
    __syncthreads();
    XcdBarrier bar; bar.bar = (unsigned*)(ctl + CW_BAR); bar.x = 0; bar.st = nullptr;
    if (MK_ONE_LAUNCH) bar = xcd_barrier_post((unsigned*)(ctl + CW_BAR), MISC + 8);
    const int lo = args.ph_lo, hi = args.ph_hi; int ph = 0;
#define PH_ON (ph >= lo && ph < hi)
#define OPQ(x) ({ int _t; asm volatile("v_mbcnt_lo_u32_b32 %0, -1, 0\n\tv_mbcnt_hi_u32_b32 %0, -1, %0" : "=v"(_t)); _t | (wave << 6); })
#define PH_END do { if (MK_ONE_LAUNCH && ph >= lo && ph + 1 < hi) xcd_barrier(bar); ++ph; } while (0)

    float* mod = (float*)(ws + WS_MOD); const float* ropetab = (const float*)(ws + WS_ROPE);
    bf16* W1T = (bf16*)(ws + WS_W1T); bf16* W2T = (bf16*)(ws + WS_W2T); bf16* WINT = (bf16*)(ws + WS_WINT); bf16* WOUTT = (bf16*)(ws + WS_WOUTT);
    float* ctxbuf = (float*)(ws + WS_CTXBUF); bf16* XN = (bf16*)(ws + WS_XN); bf16* PB = (bf16*)(ws + WS_P); bf16* HB = (bf16*)(ws + WS_P);
    float* KV = (float*)(ws + WS_KV); float* PREV = (float*)(ws + WS_PREV); bf16* XR = (bf16*)(ws + WS_XR);

    if (PH_ON) for (int rep_ = 0; rep_ < REP_PRO; ++rep_) p0_prologue(I, ws, lds, tid, lane, wave, vcu, G);
    PH_END;

    for (int hs = 0; hs < 2 * DEPTH; ++hs) {
        const int L = hs >> 1, half = hs & 1; const bool last = (L == DEPTH - 1), first = (hs == 0);
        const int Mrows = (last && half == 1) ? TL : TT;
        const float* modL = mod + (size_t)L * 9 * 9216;
        const float* xl = first ? I.x : args.out; const float* xc = first ? I.ctx : ctxbuf;
        if (PH_ON) { const int t_ = OPQ(threadIdx.x); norm_phase(I.x, I.ctx, first ? (const bf16*)nullptr : XR, Mrows, I.norm_w + (size_t)(L * 3 + (half ? 2 : 0)) * DM, modL, half ? 6 : 0, XN, vcu * NWAVES + (t_ >> 6), NGW, t_ & 63); }
        PH_END;
        if (PH_ON) for (int rep_ = 0; rep_ < REP_UP; ++rep_) { pg8::Gemm g{XN, W1T + (size_t)(L * 2 + half) * DM * 2 * DFF, Mrows, 2 * DFF, DM}; pg8::StaticOrder S; S.init(Mrows, 2 * DFF, G, bx);
            pg8::EpiSwiGLU E{HB, TT};
            pg8::gemm_phase<pg8::EpiSwiGLU, pg8::StaticOrder, true, true>(lds, g, S, E, wave); }
        PH_END;
        if (PH_ON) for (int rep_ = 0; rep_ < REP_DOWN; ++rep_) { pg8::Gemm g{HB, W2T + (size_t)(L * 2 + half) * DFF * DM, Mrows, DM, DFF, 64, 64, (size_t)TT * 128, (size_t)DM * 128}; pg8::StaticOrder S; S.init(Mrows, DM, G, bx);
            pg8::EpiResGate E{I.x, I.ctx, XR, args.out, modL + (half ? 8 : 2) * 1024, (rep_ + 1 == REP_DOWN) ? 0.5f : 0.0f, (first ? 1 : 0) | ((last && half == 1 && rep_ + 1 == REP_DOWN) ? 2 : 0)};
            pg8::gemm_phase<pg8::EpiResGate, pg8::StaticOrder, true, true>(lds, g, S, E, wave); }
        PH_END;
        if (half == 0) {
            if (PH_ON) { const int t_ = OPQ(threadIdx.x); norm_phase(I.x, I.ctx, XR, TT, I.norm_w + (size_t)(L * 3 + 1) * DM, modL, 3, XN, vcu * NWAVES + (t_ >> 6), NGW, t_ & 63); }
            PH_END;
            if (PH_ON) for (int rep_ = 0; rep_ < REP_WIN; ++rep_) { pg8::Gemm g{XN, WINT + (size_t)L * DM * INC, TT, INC, DM}; pg8::StaticOrder S; S.init(TT, INC, G, bx);
                pg8::EpiStoreBf16 E{PB, INC};
                pg8::gemm_phase<pg8::EpiStoreBf16, pg8::StaticOrder, true, true>(lds, g, S, E, wave); }
            PH_END;
            const float* logit = (const float*)(ws + WS_ROPE + 32768) + L * 12;
            if (PH_ON) {
                na_mfma(PB, XN, I.na_qn + L * 64, I.na_kn + L * 64, I.na_rpb + (size_t)L * 6 * 15 * 31, !last, lds, OPQ(0), G);
                sg_mfma2(PB, XN, (const bf16*)(ws + WS_WSG) + (size_t)L * 4 * 128 * 128, I.sg_b + L * 4 * 128, I.sg_ln_w + L * 256, I.sg_ln_b + L * 256, lds, wave, G);
                ret_kv_mfma2(PB, KV, logit, ropetab, lds, wave, G);
            }
            PH_END;
            if (PH_ON) for (int rep_ = 0; rep_ < REP_SCAN; ++rep_) { const int t_ = OPQ(threadIdx.x); ret_scan2(KV, (bf16*)PREV, logit, bx * (NWAVES * 64) + t_, nthreads); }
            PH_END;
            if (PH_ON) { const int t_ = OPQ(threadIdx.x); ret_out_mfma2(PB, (const bf16*)PREV, XN, logit, I.ret_gn_w + L * 384, ropetab, lds, t_, G); }
            PH_END;
            const int Mo = last ? TL : TT;
            if (PH_ON) { pg8::Gemm g{XN, WOUTT + (size_t)L * DM * DM, Mo, DM, DM}; pg8::StaticOrder S; S.init(Mo, DM, G, bx);
                pg8::EpiResGate E{I.x, I.ctx, XR, args.out, modL + 5 * 1024, 1.0f, 0};
                pg8::gemm_phase<pg8::EpiResGate, pg8::StaticOrder, true, true>(lds, g, S, E, wave); }
            PH_END;
        }
    }
#undef PH_ON
#undef PH_END
}

extern "C" void kernel_launch(void* const* d_in, const int* in_sizes, int n_in, void* d_out, int out_size, void* d_ws, size_t ws_size, hipStream_t stream) {
    static int grid = 0;
    if (grid == 0) {
        if (n_in != 20 || in_sizes[0] != TL * DM || out_size != TL * DM || ws_size < WS_END) { fprintf(stderr, "kernel_launch: unexpected shapes (n_in %d, in0 %d, out %d, ws %zu); nothing launched\n", n_in, n_in > 0 ? in_sizes[0] : -1, out_size, ws_size); grid = -1; return; }
        int dev = 0, cus = 0, per_cu = 0;
        if (hipGetDevice(&dev) != hipSuccess || hipDeviceGetAttribute(&cus, hipDeviceAttributeMultiprocessorCount, dev) != hipSuccess) { grid = -1; return; }
        if (hipFuncSetAttribute((const void*)hybrid_fwd, hipFuncAttributeMaxDynamicSharedMemorySize, LDS_BYTES) != hipSuccess) { fprintf(stderr, "kernel_launch: hipFuncSetAttribute failed\n"); grid = -1; return; }
        if (hipOccupancyMaxActiveBlocksPerMultiprocessor(&per_cu, (const void*)hybrid_fwd, NWAVES * 64, LDS_BYTES) != hipSuccess || per_cu < 1)
            fprintf(stderr, "kernel_launch: note: occupancy query reports %d workgroups per CU\n", per_cu);
        (void)hipGetLastError();
        grid = cus;
    }
    if (grid < 0) return;
    if (hipMemsetAsync((char*)d_ws + WS_CTL, 0, CTL_ZERO_BYTES, stream) != hipSuccess) return;
    Args a{};
    const float** ip = (const float**)&a.in;
    for (int i = 0; i < 20; ++i) ip[i] = (const float*)d_in[i];
    a.out = (float*)d_out; a.ws = (unsigned char*)d_ws;
#if MK_ONE_LAUNCH
    a.ph_lo = 0; a.ph_hi = NPH;
    hipLaunchKernelGGL(hybrid_fwd, dim3(grid), dim3(NWAVES * 64), LDS_BYTES, stream, a);
#else
    for (int li = 0; li < NPH; ++li) { a.ph_lo = li; a.ph_hi = li + 1; hipLaunchKernelGGL(hybrid_fwd, dim3(grid), dim3(NWAVES * 64), LDS_BYTES, stream, a); }
#endif
}
```
